# Optimizing an MI355X kernel written in HIP

```python
import jax, jax.numpy as jnp
from jax import lax
import numpy as np

D_MODEL = 1024
BATCH = 32
SEQ = 2048
DEPTH = 1

CHUNK = 64
EPS = 1e-6

GLA_HEADS = 4
GLA_KEY = D_MODEL // 2
GLA_VAL = D_MODEL
GLA_DK = GLA_KEY // GLA_HEADS
GLA_DV = GLA_VAL // GLA_HEADS
GLA_RANK = 16
GLA_GATE_NORM = 16.0

SSD_INNER = 2 * D_MODEL
SSD_HEADDIM = 64
SSD_HEADS = SSD_INNER // SSD_HEADDIM
SSD_STATE = 128
SSD_GROUPS = 8
SSD_HPG = SSD_HEADS // SSD_GROUPS
SSD_CONV = 4
SSD_CONV_DIM = SSD_INNER + 2 * SSD_GROUPS * SSD_STATE

D_FF = 2816

N_BRANCH = 2
IN_SPLITS = (GLA_KEY, GLA_KEY, GLA_VAL, GLA_VAL, GLA_RANK,
             SSD_INNER, SSD_CONV_DIM, SSD_HEADS, N_BRANCH * D_MODEL)
IN_DIM = sum(IN_SPLITS)

kernel_name = "chunk_causal_gla_ssd_macaron_hybrid"


def rmsnorm(x, w):
    xf = x.astype(jnp.float32)
    y = xf * lax.rsqrt(jnp.mean(xf * xf, axis=-1, keepdims=True) + EPS)
    return (y * w.astype(jnp.float32)).astype(x.dtype)


def swiglu(h, w_gate, w_up, w_down):
    return (jax.nn.silu(h @ w_gate) * (h @ w_up)) @ w_down


def to_scan(t):
    return jnp.swapaxes(t, 0, 1)


def causal_dwconv(x, w, b):
    seq = x.shape[1]
    xp = jnp.pad(x, ((0, 0), (SSD_CONV - 1, 0), (0, 0)))
    y = xp[:, 0:seq] * w[0]
    for i in range(1, SSD_CONV):
        y = y + xp[:, i:i + seq] * w[i]
    return y + b


def gla_mixer(q, k, v, g, f_low, w_f_up, b_f, norm_w, w_o):
    bsz, seq, _ = q.shape
    nc = seq // CHUNK
    log_a = jax.nn.log_sigmoid((f_low @ w_f_up + b_f).astype(jnp.float32)) / GLA_GATE_NORM
    log_a = log_a.reshape(bsz, nc, CHUNK, GLA_HEADS, GLA_DK)
    cum = jnp.cumsum(log_a, axis=2)
    end = cum[:, :, -1]
    qh = (q * GLA_DK ** -0.5).reshape(bsz, nc, CHUNK, GLA_HEADS, GLA_DK)
    k_dec = k.reshape(bsz, nc, CHUNK, GLA_HEADS, GLA_DK) * jnp.exp(end[:, :, None] - cum).astype(k.dtype)
    vh = v.reshape(bsz, nc, CHUNK, GLA_HEADS, GLA_DV)
    decay = jnp.exp(end)

    def step(state, inp):
        qc, kc, vc, dc = inp
        state = state * dc[..., None]
        inter = jnp.einsum('bihd,bhde->bihe', qc, state)
        scores = jnp.einsum('bihd,bjhd->bhij', qc, kc)
        intra = jnp.einsum('bhij,bjhe->bihe', scores, vc)
        state = (state + jnp.einsum('bjhd,bjhe->bhde', kc, vc)).astype(jnp.float32)
        return state, inter + intra

    s0 = jnp.zeros((bsz, GLA_HEADS, GLA_DK, GLA_DV), jnp.float32)
    _, o = lax.scan(step, s0, (to_scan(qh), to_scan(k_dec), to_scan(vh), to_scan(decay)))
    o = jnp.swapaxes(o, 0, 1).reshape(bsz, seq, GLA_HEADS, GLA_DV)
    o = rmsnorm(o, norm_w) * jax.nn.silu(g.reshape(bsz, seq, GLA_HEADS, GLA_DV).astype(jnp.float32))
    return o.reshape(bsz, seq, GLA_VAL).astype(q.dtype) @ w_o


def ssd_mixer(z, xbc, dt_raw, conv_w, conv_b, dt_bias, a_log, d_skip, norm_w, w_o):
    bsz, seq, _ = z.shape
    nc = seq // CHUNK
    xbc = jax.nn.silu(causal_dwconv(xbc, conv_w, conv_b))
    xs, bm, cm = jnp.split(xbc, [SSD_INNER, SSD_INNER + SSD_GROUPS * SSD_STATE], axis=-1)
    dt = jax.nn.softplus(dt_raw.astype(jnp.float32) + dt_bias.astype(jnp.float32))
    da = dt * (-jnp.exp(a_log.astype(jnp.float32)))
    cum = jnp.cumsum(da.reshape(bsz, nc, CHUNK, SSD_HEADS), axis=2)
    end = cum[:, :, -1]
    wgt = (jnp.exp(end[:, :, None] - cum) * dt.reshape(bsz, nc, CHUNK, SSD_HEADS))
    wgt = wgt.reshape(bsz, nc, CHUNK, SSD_GROUPS, SSD_HPG)
    decay = jnp.exp(end).reshape(bsz, nc, SSD_GROUPS, SSD_HPG)
    xh = xs.reshape(bsz, nc, CHUNK, SSD_GROUPS, SSD_HPG, SSD_HEADDIM)
    bh = bm.reshape(bsz, nc, CHUNK, SSD_GROUPS, SSD_STATE)
    ch = cm.reshape(bsz, nc, CHUNK, SSD_GROUPS, SSD_STATE)

    def step(h, inp):
        xc, bc, cc, wc, dc = inp
        h = h * dc[..., None, None]
        y_inter = jnp.einsum('bign,bgrpn->bigrp', cc, h)
        cb = jnp.einsum('bign,bjgn->bgij', cc, bc)
        y_intra = jnp.einsum('bgij,bjgr,bjgrp->bigrp', cb, wc, xc)
        h = (h + jnp.einsum('bjgr,bjgrp,bjgn->bgrpn', wc, xc, bc)).astype(jnp.float32)
        return h, y_inter + y_intra

    h0 = jnp.zeros((bsz, SSD_GROUPS, SSD_HPG, SSD_HEADDIM, SSD_STATE), jnp.float32)
    _, y = lax.scan(step, h0, (to_scan(xh), to_scan(bh), to_scan(ch), to_scan(wgt), to_scan(decay)))
    y = jnp.swapaxes(y, 0, 1).reshape(bsz, seq, SSD_GROUPS, SSD_HPG, SSD_HEADDIM)
    y = y + d_skip.reshape(SSD_GROUPS, SSD_HPG, 1) * xs.reshape(bsz, seq, SSD_GROUPS, SSD_HPG, SSD_HEADDIM)
    y = y.reshape(bsz, seq, SSD_INNER) * jax.nn.silu(z.astype(jnp.float32))
    y = rmsnorm(y.reshape(bsz, seq, SSD_GROUPS, SSD_INNER // SSD_GROUPS),
                norm_w.reshape(SSD_GROUPS, SSD_INNER // SSD_GROUPS))
    return y.reshape(bsz, seq, SSD_INNER).astype(z.dtype) @ w_o


def setup_inputs(seed: int = 0) -> dict:
    key = jax.random.key(seed)
    ks = jax.random.split(key, 24)
    f32 = jnp.float32

    def nrm(k, shape, scale):
        return jax.random.normal(k, shape, f32) * scale

    def gain(k, shape):
        return 1.0 + 0.02 * jax.random.normal(k, shape, f32)

    L = DEPTH
    u = jax.random.uniform(ks[13], (L, SSD_HEADS), f32)
    dt0 = jnp.exp(u * (np.log(0.1) - np.log(0.001)) + np.log(0.001)).astype(f32)
    dt_bias = dt0 + jnp.log(-jnp.expm1(-dt0))
    return {
        "x": jax.random.normal(ks[0], (BATCH, SEQ, D_MODEL), f32),
        "ffn1_norm": gain(ks[1], (L, D_MODEL)),
        "ffn1_w_gate": nrm(ks[2], (L, D_MODEL, D_FF), D_MODEL ** -0.5),
        "ffn1_w_up": nrm(ks[3], (L, D_MODEL, D_FF), D_MODEL ** -0.5),
        "ffn1_w_down": nrm(ks[4], (L, D_FF, D_MODEL), D_FF ** -0.5),
        "mix_norm": gain(ks[5], (L, D_MODEL)),
        "w_in": nrm(ks[6], (L, D_MODEL, IN_DIM), D_MODEL ** -0.5),
        "gla_w_f_up": nrm(ks[7], (L, GLA_RANK, GLA_KEY), GLA_RANK ** -0.5),
        "gla_b_f": nrm(ks[8], (L, GLA_KEY), 0.02),
        "gla_norm": gain(ks[9], (L, GLA_DV)),
        "gla_w_o": nrm(ks[10], (L, GLA_VAL, D_MODEL), GLA_VAL ** -0.5),
        "ssd_conv_w": nrm(ks[11], (L, SSD_CONV, SSD_CONV_DIM), SSD_CONV ** -0.5),
        "ssd_conv_b": nrm(ks[12], (L, SSD_CONV_DIM), 0.01),
        "ssd_dt_bias": dt_bias,
        "ssd_a_log": jnp.log(jax.random.uniform(ks[14], (L, SSD_HEADS), f32, 1.0, 16.0)),
        "ssd_d": gain(ks[15], (L, SSD_HEADS)),
        "ssd_norm": gain(ks[16], (L, SSD_INNER)),
        "ssd_w_o": nrm(ks[17], (L, SSD_INNER, D_MODEL), SSD_INNER ** -0.5),
        "w_out": nrm(ks[18], (L, D_MODEL, D_MODEL), D_MODEL ** -0.5),
        "ffn2_norm": gain(ks[19], (L, D_MODEL)),
        "ffn2_w_gate": nrm(ks[20], (L, D_MODEL, D_FF), D_MODEL ** -0.5),
        "ffn2_w_up": nrm(ks[21], (L, D_MODEL, D_FF), D_MODEL ** -0.5),
        "ffn2_w_down": nrm(ks[22], (L, D_FF, D_MODEL), D_FF ** -0.5),
        "final_norm": gain(ks[23], (D_MODEL,)),
    }


def reference(x, ffn1_norm, ffn1_w_gate, ffn1_w_up, ffn1_w_down, mix_norm, w_in,
              gla_w_f_up, gla_b_f, gla_norm, gla_w_o, ssd_conv_w, ssd_conv_b,
              ssd_dt_bias, ssd_a_log, ssd_d, ssd_norm, ssd_w_o, w_out,
              ffn2_norm, ffn2_w_gate, ffn2_w_up, ffn2_w_down, final_norm):
    bsz, seq, _ = x.shape
    split_idx = list(np.cumsum(IN_SPLITS)[:-1])
    for l in range(DEPTH):
        h = rmsnorm(x, ffn1_norm[l])
        x = x + 0.5 * swiglu(h, ffn1_w_gate[l], ffn1_w_up[l], ffn1_w_down[l])

        h = rmsnorm(x, mix_norm[l])
        proj = h @ w_in[l]
        gq, gk, gv, gg, gf, sz, sxbc, sdt, gates = jnp.split(proj, split_idx, axis=-1)
        u_a = gla_mixer(gq, gk, gv, gg, gf, gla_w_f_up[l], gla_b_f[l], gla_norm[l], gla_w_o[l])
        u_b = ssd_mixer(sz, sxbc, sdt, ssd_conv_w[l], ssd_conv_b[l], ssd_dt_bias[l],
                        ssd_a_log[l], ssd_d[l], ssd_norm[l], ssd_w_o[l])
        gts = jax.nn.sigmoid(gates.astype(jnp.float32)).reshape(bsz, seq, N_BRANCH, D_MODEL)
        merged = gts[:, :, 0] * u_a + gts[:, :, 1] * u_b
        x = x + merged.astype(x.dtype) @ w_out[l]

        h = rmsnorm(x, ffn2_norm[l])
        x = x + 0.5 * swiglu(h, ffn2_w_gate[l], ffn2_w_up[l], ffn2_w_down[l])
    return rmsnorm(x, final_norm)
```

```cpp
#include <hip/hip_runtime.h>
#include <hip/hip_cooperative_groups.h>
#include <cstdio>
#include <cstdint>
namespace cg = cooperative_groups;

#define LAS __attribute__((address_space(3)))
typedef unsigned short bf16_t;
typedef short bf16x8 __attribute__((ext_vector_type(8)));
typedef short s16x4 __attribute__((ext_vector_type(4)));
typedef float f32x4 __attribute__((ext_vector_type(4)));
typedef float f32x16 __attribute__((ext_vector_type(16)));
typedef unsigned u32x4 __attribute__((ext_vector_type(4)));
typedef unsigned u32x2 __attribute__((ext_vector_type(2)));

constexpr int D = 1024, BATCH = 32, SEQ = 2048, MTOK = BATCH * SEQ;
constexpr int NCH = SEQ / 64;
constexpr int DFF = 2816, NGU = 2 * DFF;
constexpr int IN_DIM = 11312, NIN = 45 * 256;
constexpr int HB = 16, MH = HB * SEQ;
constexpr float EPS = 1e-6f;

constexpr size_t MiB = 1u << 20;
constexpr size_t WS_SSQ = 0;
constexpr size_t WS_WGU1 = 1 * MiB, WS_WD1 = 12 * MiB, WS_WIN = 18 * MiB, WS_WGO = 41 * MiB, WS_WSO = 43 * MiB, WS_WOUT = 47 * MiB, WS_WGU2 = 49 * MiB, WS_WD2 = 60 * MiB;
constexpr size_t WS_DEC = 66 * MiB, WS_DECS = 67 * MiB, WS_WG = 68 * MiB, WS_HALO = 72 * MiB, WS_SM = 84 * MiB;
constexpr size_t WS_XB = 96 * MiB;
constexpr size_t WS_BIG = 224 * MiB;
constexpr size_t T_Q = 0, T_K = 32 * MiB, T_V = 64 * MiB, T_SG = 128 * MiB, T_SZ = 192 * MiB, T_XBC = 320 * MiB, T_GT = 576 * MiB, T_END = 704 * MiB;
constexpr size_t T_T1 = T_Q, T_MRG = T_SG;
constexpr size_t WS_NEED = WS_BIG + T_END;

constexpr int LDS_BYTES = 131072;

__device__ __forceinline__ unsigned cvt_pk_bf16(float lo, float hi) { unsigned r; asm volatile("v_cvt_pk_bf16_f32 %0, %1, %2" : "=v"(r) : "v"(lo), "v"(hi)); return r; }
__device__ __forceinline__ float bf_lo(unsigned u) { return __uint_as_float(u << 16); }
__device__ __forceinline__ float bf_hi(unsigned u) { return __uint_as_float(u & 0xffff0000u); }
__device__ __forceinline__ float fast_rcp(float x) { return __builtin_amdgcn_rcpf(x); }
__device__ __forceinline__ float sigmoidf_(float x) { return fast_rcp(1.f + __expf(-x)); }
__device__ __forceinline__ float siluf_(float x) { return x * sigmoidf_(x); }
__device__ __forceinline__ float softplusf_(float x) { return fmaxf(x, 0.f) + __logf(1.f + __expf(-fabsf(x))); }
__device__ __forceinline__ float wave_sum(float v) {
#pragma unroll
    for (int o = 1; o < 64; o <<= 1) v += __shfl_xor(v, o);
    return v;
}

namespace pg8 {
constexpr int BM = 256, BK = 64, HALF = 128, HTB = HALF * BK * 2, STAGE_BYTES = 8 * HTB, NXCD = 8, WGM = 8;
__host__ __device__ __forceinline__ int lds_byte(int r, int c) { const int st = (r >> 4) * 2 + (c >> 5), rr = r & 15, cc = c & 31, ob = rr * 64 + cc * 2; return st * 1024 + (ob ^ (((ob >> 9) & 1) << 5)); }
__host__ __device__ __forceinline__ void stage_rc(int b, int& R, int& C) { const int st = b / 1024, sb = b % 1024, swz = sb ^ (((sb >> 9) & 1) << 5); R = (st >> 1) * 16 + swz / 64; C = (st & 1) * 32 + (swz % 64) / 2; }
__host__ __device__ __forceinline__ int perm32(int rho) { const int n = rho >> 4, i = rho & 15; return 8 * (i >> 2) + 4 * n + (i & 3); }

struct Unit { int pm, pn; };
struct Gemm { const bf16_t* A; const bf16_t* Bt; int M, N, K, lda, ldb; };

struct StaticOrder {
    int nM, nN, nwg, G, c;
    __device__ void init(int M, int N, int G_, int c_) { nM = M / BM; nN = N / BM; nwg = nM * nN; G = G_; c = c_; }
    __device__ bool next(int i, Unit& u) const {
        const long L = (long)i * G + c; if (L >= nwg) return false;
        int wgid = (int)L; { const int q = nwg / NXCD, r = nwg % NXCD, xcd = wgid % NXCD, off = wgid / NXCD; wgid = (xcd < r ? xcd * (q + 1) : r * (q + 1) + (xcd - r) * q) + off; }
        const int nig = WGM * nN, gid = wgid / nig, fm = gid * WGM, gsz = (nM - fm) < WGM ? (nM - fm) : WGM;
        u.pm = fm + ((wgid % nig) % gsz); u.pn = (wgid % nig) / gsz; return true;
    }
};

template <class Epi>
__device__ __forceinline__ void gemm_phase(LAS unsigned char* lds, const Gemm g, const StaticOrder& S, const Epi& E) {
    int tid = threadIdx.x; asm volatile("" : "+v"(tid));
    const int wid = __builtin_amdgcn_readfirstlane(tid >> 6), lane = tid & 63, wr = wid >> 2, wc = wid & 3, fr = lane & 15, fq = lane >> 4;
    const int K = g.K, nt = K / BK;
    unsigned voffA[2], voffB[2];
#pragma unroll
    for (int i = 0; i < 2; ++i) { int R, C; stage_rc(tid * 16 + i * 8192, R, C); const int Rb = (R & ~31) + perm32(R & 31);
        voffA[i] = (unsigned)(R * g.lda + C) * 2u; voffB[i] = (unsigned)(Rb * g.ldb + C) * 2u; }
    const size_t kstep = (size_t)(BK * 2);
    const size_t hstA = (size_t)HALF * g.lda * 2, hstB = (size_t)HALF * g.ldb * 2;
    const size_t tstA = 2 * hstA, tstB = 2 * hstB;
    const unsigned ldsw = (unsigned)wid * 1024u;
    const int aoff = lds_byte(wr * 64 + fr, fq * 8), boff = lds_byte(wc * 32 + fr, fq * 8);
#define PG8_SA(b, h) (((b) * 2 + (h)) * HTB)
#define PG8_SB(b, h) ((4 + (b) * 2 + (h)) * HTB)
#define PG8_STAGE(bufoff, gbase, voff) do { _Pragma("unroll") for (int _i = 0; _i < 2; ++_i) \
        __builtin_amdgcn_global_load_lds((const unsigned*)((const char*)(gbase) + (voff)[_i]), (LAS unsigned*)(lds + (bufoff) + ldsw + _i * 8192), 16, 0, 0); } while (0)
#define PG8_LDA(dst, b, h) do { _Pragma("unroll") for (int m = 0; m < 4; ++m) _Pragma("unroll") for (int k = 0; k < 2; ++k) dst[m][k] = *(const LAS bf16x8*)(lds + PG8_SA(b, h) + aoff + m * 2048 + k * 1024); } while (0)
#define PG8_LDB(dst, b, h) do { _Pragma("unroll") for (int n = 0; n < 2; ++n) _Pragma("unroll") for (int k = 0; k < 2; ++k) dst[n][k] = *(const LAS bf16x8*)(lds + PG8_SB(b, h) + boff + n * 2048 + k * 1024); } while (0)
#define PG8_MMA(ai, bj, At, Bt) do { __builtin_amdgcn_s_setprio(1); _Pragma("unroll") for (int m = 0; m < 4; ++m) _Pragma("unroll") for (int n = 0; n < 2; ++n) _Pragma("unroll") for (int k = 0; k < 2; ++k) \
        acc[ai][bj][m][n] = __builtin_amdgcn_mfma_f32_16x16x32_bf16(Bt[n][k], At[m][k], acc[ai][bj][m][n], 0, 0, 0); __builtin_amdgcn_s_setprio(0); } while (0)
#define PG8_WAIT_V(n) asm volatile("s_waitcnt vmcnt(" #n ")" ::: "memory")
#define PG8_WAIT_L(n) asm volatile("s_waitcnt lgkmcnt(" #n ")" ::: "memory")
#define PG8_BAR __builtin_amdgcn_s_barrier()
#define PG8_SCHED __builtin_amdgcn_sched_barrier(0)
    Unit cur, nxt; int ui = 0;
    if (!S.next(0, cur)) return;
    f32x4 acc[2][2][4][2];
#pragma unroll
    for (int a = 0; a < 2; ++a)
#pragma unroll
        for (int b = 0; b < 2; ++b)
#pragma unroll
            for (int m = 0; m < 4; ++m)
#pragma unroll
                for (int n = 0; n < 2; ++n) acc[a][b][m][n] = (f32x4){0.f, 0.f, 0.f, 0.f};
    bf16x8 At[4][2], B0[2][2], B1[2][2];
    const char* cA = (const char*)g.A + (size_t)cur.pm * tstA; const char* cB = (const char*)g.Bt + (size_t)cur.pn * tstB;
    PG8_STAGE(PG8_SB(0, 0), cB, voffB); PG8_STAGE(PG8_SA(0, 0), cA, voffA); PG8_STAGE(PG8_SB(0, 1), cB + hstB, voffB); PG8_STAGE(PG8_SA(0, 1), cA + hstA, voffA);
    if (wr == 1) PG8_BAR;
    PG8_WAIT_V(4); PG8_BAR;
    PG8_STAGE(PG8_SB(1, 0), cB + kstep, voffB); PG8_STAGE(PG8_SA(1, 0), cA + kstep, voffA); PG8_STAGE(PG8_SB(1, 1), cB + hstB + kstep, voffB);
    PG8_WAIT_V(6); PG8_BAR;
    for (;;) {
        const bool has_next = S.next(ui + 1, nxt);
        const char* nA = has_next ? (const char*)g.A + (size_t)nxt.pm * tstA : cA; const char* nB = has_next ? (const char*)g.Bt + (size_t)nxt.pn * tstB : cB;
        for (int t = 0; t < nt; t += 2) {
            const bool last = (t == nt - 2);
            const char* a1 = cA + (size_t)(t + 1) * kstep;
            const char* a2 = last ? nA : cA + (size_t)(t + 2) * kstep; const char* b2 = last ? nB : cB + (size_t)(t + 2) * kstep;
            const char* a3 = a2 + kstep; const char* b3 = b2 + kstep;
            PG8_LDB(B0, 0, 0); PG8_SCHED; PG8_LDA(At, 0, 0); PG8_STAGE(PG8_SA(1, 1), a1 + hstA, voffA);
            PG8_WAIT_L(8); PG8_BAR; PG8_WAIT_L(0); PG8_MMA(0, 0, At, B0); PG8_BAR; PG8_SCHED;
            PG8_LDB(B1, 0, 1); PG8_STAGE(PG8_SB(0, 0), b2, voffB);
            PG8_BAR; PG8_WAIT_L(0); PG8_MMA(0, 1, At, B1); PG8_BAR;
            PG8_LDA(At, 0, 1); PG8_STAGE(PG8_SA(0, 0), a2, voffA);
            PG8_BAR; PG8_WAIT_L(0); PG8_MMA(1, 0, At, B0); PG8_BAR; PG8_SCHED;
            PG8_STAGE(PG8_SB(0, 1), b2 + hstB, voffB);
            PG8_WAIT_V(6); PG8_BAR; PG8_MMA(1, 1, At, B1); PG8_BAR;
            PG8_LDB(B0, 1, 0); PG8_SCHED; PG8_LDA(At, 1, 0); PG8_STAGE(PG8_SA(0, 1), a2 + hstA, voffA);
            PG8_WAIT_L(8); PG8_BAR; PG8_WAIT_L(0); PG8_MMA(0, 0, At, B0); PG8_BAR; PG8_SCHED;
            PG8_LDB(B1, 1, 1); PG8_STAGE(PG8_SB(1, 0), b3, voffB);
            PG8_BAR; PG8_WAIT_L(0); PG8_MMA(0, 1, At, B1); PG8_BAR;
            PG8_LDA(At, 1, 1); PG8_STAGE(PG8_SA(1, 0), a3, voffA);
            PG8_BAR; PG8_WAIT_L(0); PG8_MMA(1, 0, At, B0); PG8_BAR; PG8_SCHED;
            PG8_STAGE(PG8_SB(1, 1), b3 + hstB, voffB);
            PG8_WAIT_V(6); PG8_BAR; PG8_MMA(1, 1, At, B1); PG8_BAR;
        }
        E(acc, cur, wr, wc, fr, fq);
        if (!has_next) break;
#pragma unroll
        for (int a = 0; a < 2; ++a)
#pragma unroll
            for (int b = 0; b < 2; ++b)
#pragma unroll
                for (int m = 0; m < 4; ++m)
#pragma unroll
                    for (int n = 0; n < 2; ++n) acc[a][b][m][n] = (f32x4){0.f, 0.f, 0.f, 0.f};
        cur = nxt; cA = nA; cB = nB; ++ui;
    }
    PG8_WAIT_V(0);
    if (wr == 0) PG8_BAR;
    PG8_BAR;
#undef PG8_SA
#undef PG8_SB
#undef PG8_STAGE
#undef PG8_LDA
#undef PG8_LDB
#undef PG8_MMA
#undef PG8_WAIT_V
#undef PG8_WAIT_L
#undef PG8_BAR
#undef PG8_SCHED
}
}

typedef f32x4 AccT[2][2][4][2];

struct EpiGU {
    const float* ssq; bf16_t* O;
    __device__ __forceinline__ void operator()(const AccT& acc, const pg8::Unit& u, int wr, int wc, int fr, int fq) const {
        const int row0 = u.pm * 256 + wr * 64 + fr, col0 = u.pn * 128 + wc * 32 + 8 * fq;
#pragma unroll
        for (int ai = 0; ai < 2; ++ai)
#pragma unroll
            for (int m = 0; m < 4; ++m) {
                const int row = row0 + ai * 128 + m * 16;
                const float rstd = rsqrtf(ssq[row] * (1.f / D) + EPS);
                float v[8];
#pragma unroll
                for (int n = 0; n < 2; ++n)
#pragma unroll
                    for (int j = 0; j < 4; ++j) { const float gg = acc[ai][0][m][n][j] * rstd, uu = acc[ai][1][m][n][j] * rstd; v[4 * n + j] = siluf_(gg) * uu; }
                u32x4 w; w.x = cvt_pk_bf16(v[0], v[1]); w.y = cvt_pk_bf16(v[2], v[3]); w.z = cvt_pk_bf16(v[4], v[5]); w.w = cvt_pk_bf16(v[6], v[7]);
                *(u32x4*)(O + (size_t)row * DFF + col0) = w;
            }
    }
};
struct EpiRes {
    const float* xin; float* xout; bf16_t* xb; float* ssq; float alpha;
    __device__ __forceinline__ void operator()(const AccT& acc, const pg8::Unit& u, int wr, int wc, int fr, int fq) const {
        const int row0 = u.pm * 256 + wr * 64 + fr, col0 = u.pn * 256 + wc * 32 + 8 * fq;
#pragma unroll
        for (int ai = 0; ai < 2; ++ai)
#pragma unroll
            for (int m = 0; m < 4; ++m) {
                const int row = row0 + ai * 128 + m * 16;
                float s = 0.f;
#pragma unroll
                for (int bj = 0; bj < 2; ++bj) {
                    const size_t o = (size_t)row * D + col0 + bj * 128;
                    const f32x4 x0 = *(const f32x4*)(xin + o), x1 = *(const f32x4*)(xin + o + 4);
                    f32x4 y0 = x0 + acc[ai][bj][m][0] * alpha, y1 = x1 + acc[ai][bj][m][1] * alpha;
                    *(f32x4*)(xout + o) = y0; *(f32x4*)(xout + o + 4) = y1;
                    s += y0.x * y0.x + y0.y * y0.y + y0.z * y0.z + y0.w * y0.w + y1.x * y1.x + y1.y * y1.y + y1.z * y1.z + y1.w * y1.w;
                    if (xb) { u32x4 w; w.x = cvt_pk_bf16(y0.x, y0.y); w.y = cvt_pk_bf16(y0.z, y0.w); w.z = cvt_pk_bf16(y1.x, y1.y); w.w = cvt_pk_bf16(y1.z, y1.w); *(u32x4*)(xb + o) = w; }
                }
                s += __shfl_xor(s, 16); s += __shfl_xor(s, 32);
                if (fq == 0) atomicAdd(ssq + row, s);
            }
    }
};
struct EpiIn {
    const float* ssq; unsigned char* T; bf16_t* halo; float* sm;
    __device__ __forceinline__ void operator()(const AccT& acc, const pg8::Unit& u, int wr, int wc, int fr, int fq) const {
        const int pn = u.pn;
        const int row0 = u.pm * 256 + wr * 64 + fr;
        int act = 0, ld, ct; bf16_t* base;
        if (pn < 2) { base = (bf16_t*)(T + T_Q); ld = 512; ct = pn; }
        else if (pn < 4) { base = (bf16_t*)(T + T_K); ld = 512; ct = pn - 2; }
        else if (pn < 8) { base = (bf16_t*)(T + T_V); ld = 1024; ct = pn - 4; }
        else if (pn < 12) { base = (bf16_t*)(T + T_SG); ld = 1024; ct = pn - 8; act = 1; }
        else if (pn < 20) { base = (bf16_t*)(T + T_SZ); ld = 2048; ct = pn - 12; act = 1; }
        else if (pn < 36) { base = (bf16_t*)(T + T_XBC); ld = 4096; ct = pn - 20; act = 3; }
        else if (pn < 44) { base = (bf16_t*)(T + T_GT); ld = 2048; ct = pn - 36; act = 2; }
        else { base = nullptr; ld = 0; ct = 0; act = 4; }
        if (act == 4) {
            if (wc < 2) {
#pragma unroll
                for (int ai = 0; ai < 2; ++ai)
#pragma unroll
                    for (int m = 0; m < 4; ++m) {
                        const int row = row0 + ai * 128 + m * 16;
                        const float rstd = rsqrtf(ssq[row] * (1.f / D) + EPS);
                        float* p = sm + (size_t)row * 64 + wc * 32 + 8 * fq;
                        *(f32x4*)p = acc[ai][0][m][0] * rstd; *(f32x4*)(p + 4) = acc[ai][0][m][1] * rstd;
                    }
            }
            return;
        }
        const int col0 = ct * 256 + wc * 32 + 8 * fq;
#pragma unroll
        for (int ai = 0; ai < 2; ++ai)
#pragma unroll
            for (int m = 0; m < 4; ++m) {
                const int row = row0 + ai * 128 + m * 16;
                const float rstd = rsqrtf(ssq[row] * (1.f / D) + EPS);
#pragma unroll
                for (int bj = 0; bj < 2; ++bj) {
                    float v[8];
#pragma unroll
                    for (int n = 0; n < 2; ++n)
#pragma unroll
                        for (int j = 0; j < 4; ++j) { float x = acc[ai][bj][m][n][j] * rstd; if (act == 1) x = siluf_(x); else if (act == 2) x = sigmoidf_(x); v[4 * n + j] = x; }
                    u32x4 w; w.x = cvt_pk_bf16(v[0], v[1]); w.y = cvt_pk_bf16(v[2], v[3]); w.z = cvt_pk_bf16(v[4], v[5]); w.w = cvt_pk_bf16(v[6], v[7]);
                    *(u32x4*)(base + (size_t)row * ld + col0 + bj * 128) = w;
                    if (act == 3 && (row & 63) >= 61) *(u32x4*)(halo + ((size_t)(row >> 6) * 3 + ((row & 63) - 61)) * 4096 + col0 + bj * 128) = w;
                }
            }
    }
};
struct EpiGate {
    const bf16_t* gt; const bf16_t* t1; bf16_t* out; int mode;
    __device__ __forceinline__ void operator()(const AccT& acc, const pg8::Unit& u, int wr, int wc, int fr, int fq) const {
        const int row0 = u.pm * 256 + wr * 64 + fr, col0 = u.pn * 256 + wc * 32 + 8 * fq;
#pragma unroll
        for (int ai = 0; ai < 2; ++ai)
#pragma unroll
            for (int m = 0; m < 4; ++m) {
                const int row = row0 + ai * 128 + m * 16;
#pragma unroll
                for (int bj = 0; bj < 2; ++bj) {
                    const int col = col0 + bj * 128;
                    const u32x4 gq = *(const u32x4*)(gt + (size_t)row * 2048 + mode * 1024 + col);
                    float v[8];
                    v[0] = acc[ai][bj][m][0].x * bf_lo(gq.x); v[1] = acc[ai][bj][m][0].y * bf_hi(gq.x); v[2] = acc[ai][bj][m][0].z * bf_lo(gq.y); v[3] = acc[ai][bj][m][0].w * bf_hi(gq.y);
                    v[4] = acc[ai][bj][m][1].x * bf_lo(gq.z); v[5] = acc[ai][bj][m][1].y * bf_hi(gq.z); v[6] = acc[ai][bj][m][1].z * bf_lo(gq.w); v[7] = acc[ai][bj][m][1].w * bf_hi(gq.w);
                    if (mode) { const u32x4 tq = *(const u32x4*)(t1 + (size_t)row * D + col);
                        v[0] += bf_lo(tq.x); v[1] += bf_hi(tq.x); v[2] += bf_lo(tq.y); v[3] += bf_hi(tq.y); v[4] += bf_lo(tq.z); v[5] += bf_hi(tq.z); v[6] += bf_lo(tq.w); v[7] += bf_hi(tq.w); }
                    u32x4 w; w.x = cvt_pk_bf16(v[0], v[1]); w.y = cvt_pk_bf16(v[2], v[3]); w.z = cvt_pk_bf16(v[4], v[5]); w.w = cvt_pk_bf16(v[6], v[7]);
                    *(u32x4*)(out + (size_t)row * D + col) = w;
                }
            }
    }
};

__device__ __forceinline__ void tr_item(const float* srcp, int ld, const float* sk, float mul, int k0, int K, bf16_t* dst, int n0, LAS float* scr, int lane) {
#pragma unroll 8
    for (int i = 0; i < 32; ++i) { const int kk = 2 * i + (lane >> 5);
        float v = 0.f; if (srcp) v = srcp[(size_t)(k0 + kk) * ld] * (sk ? sk[k0 + kk] : 1.f) * mul;
        scr[kk * 33 + (lane & 31)] = v; }
    asm volatile("s_waitcnt lgkmcnt(0)" ::: "memory");
    const int c = lane & 7;
#pragma unroll
    for (int j = 0; j < 4; ++j) { const int n = (lane >> 3) + 8 * j; const LAS float* s = scr + (8 * c) * 33 + n;
        u32x4 o; o.x = cvt_pk_bf16(s[0 * 33], s[1 * 33]); o.y = cvt_pk_bf16(s[2 * 33], s[3 * 33]); o.z = cvt_pk_bf16(s[4 * 33], s[5 * 33]); o.w = cvt_pk_bf16(s[6 * 33], s[7 * 33]);
        *(u32x4*)(dst + (size_t)(n0 + n) * K + k0 + 8 * c) = o; }
    asm volatile("s_waitcnt lgkmcnt(0)" ::: "memory");
}
__device__ __forceinline__ int win_src_col(int nd) {
    if (nd < 3072) return nd;
    if (nd < 5120) return 3088 + (nd - 3072);
    if (nd < 9216) return 5136 + (nd - 5120);
    if (nd < 11264) return 9264 + (nd - 9216);
    if (nd < 11280) return 3072 + (nd - 11264);
    if (nd < 11312) return 9232 + (nd - 11280);
    return -1;
}

struct Params {
    const float* in[24];
    float* out;
    unsigned char* ws;
};

typedef __attribute__((address_space(4))) const Params* KP;
__device__ __forceinline__ Params load_params(KP p) { Params r;
#pragma unroll
    for (int i = 0; i < 24; ++i) r.in[i] = p->in[i];
    r.out = p->out; r.ws = p->ws; return r; }
__device__ __forceinline__ int tid_fresh() { int t = threadIdx.x; asm volatile("" : "+v"(t)); return t; }
__device__ __forceinline__ void p0_prologue(KP Pp, LAS unsigned char* lds, int G) {
    const Params P = load_params(Pp);
    const int tid = tid_fresh(), lane = tid & 63, wave = tid >> 6;
    LAS float* scr = (LAS float*)(lds + wave * 16384);
    const int gw = blockIdx.x * 8 + wave, NGW = G * 8;
    unsigned char* ws = P.ws;
    constexpr int I_GU = (D / 64) * (NGU / 32), I_DN = (DFF / 64) * (D / 32), I_IN = (D / 64) * (NIN / 32), I_GO = (D / 64) * (D / 32), I_SO = (2048 / 64) * (D / 32);
    constexpr int NITEMS = 2 * I_GU + 2 * I_DN + I_IN + 2 * I_GO + I_SO;
    for (int it = gw; it < NITEMS; it += NGW) {
        int r = it; const int j = lane & 31;
        if (r < 2 * I_GU) { const int l2 = r >= I_GU; r -= l2 * I_GU; const int nb = r % (NGU / 32), kb = r / (NGU / 32); const int nd = nb * 32 + j, tile = nd >> 8, w = nd & 255;
            const float* Wg = P.in[l2 ? 20 : 2]; const float* Wu = P.in[l2 ? 21 : 3];
            const float* sp = (w < 128 ? Wg : Wu) + 128 * tile + (w & 127);
            tr_item(sp, DFF, P.in[l2 ? 19 : 1], 1.f, kb * 64, D, (bf16_t*)(ws + (l2 ? WS_WGU2 : WS_WGU1)), nb * 32, scr, lane); continue; }
        r -= 2 * I_GU;
        if (r < 2 * I_DN) { const int l2 = r >= I_DN; r -= l2 * I_DN; const int nb = r % (D / 32), kb = r / (D / 32);
            tr_item(P.in[l2 ? 22 : 4] + nb * 32 + j, D, nullptr, 1.f, kb * 64, DFF, (bf16_t*)(ws + (l2 ? WS_WD2 : WS_WD1)), nb * 32, scr, lane); continue; }
        r -= 2 * I_DN;
        if (r < I_IN) { const int nb = r % (NIN / 32), kb = r / (NIN / 32); const int nd = nb * 32 + j, sc = win_src_col(nd);
            tr_item(sc >= 0 ? P.in[6] + sc : nullptr, IN_DIM, P.in[5], nd < 512 ? 0.08838834764831845f : 1.f, kb * 64, D, (bf16_t*)(ws + WS_WIN), nb * 32, scr, lane); continue; }
        r -= I_IN;
        if (r < 2 * I_GO) { const int l2 = r >= I_GO; r -= l2 * I_GO; const int nb = r % (D / 32), kb = r / (D / 32);
            tr_item(P.in[l2 ? 18 : 10] + nb * 32 + j, D, nullptr, 1.f, kb * 64, D, (bf16_t*)(ws + (l2 ? WS_WOUT : WS_WGO)), nb * 32, scr, lane); continue; }
        r -= 2 * I_GO;
        { const int nb = r % (D / 32), kb = r / (D / 32);
            tr_item(P.in[17] + nb * 32 + j, D, nullptr, 1.f, kb * 64, 2048, (bf16_t*)(ws + WS_WSO), nb * 32, scr, lane); }
    }
    const float* x = P.in[0]; bf16_t* xb = (bf16_t*)(ws + WS_XB); float* ssq = (float*)(ws + WS_SSQ);
    for (int m = gw; m < MTOK; m += NGW) {
        const f32x4* xr = (const f32x4*)(x + (size_t)m * D) + lane;
        unsigned long long* o8 = (unsigned long long*)(xb + (size_t)m * D) + lane;
        float s = 0.f;
#pragma unroll
        for (int jj = 0; jj < 4; ++jj) { const f32x4 v = xr[64 * jj]; s += v.x * v.x + v.y * v.y + v.z * v.z + v.w * v.w;
            o8[64 * jj] = (unsigned long long)cvt_pk_bf16(v.x, v.y) | ((unsigned long long)cvt_pk_bf16(v.z, v.w) << 32); }
        s = wave_sum(s);
        if (lane == 0) { ssq[m] = s; ssq[MTOK + m] = 0.f; ssq[2 * MTOK + m] = 0.f; ssq[3 * MTOK + m] = 0.f; }
    }
}

__device__ __forceinline__ void p4_prep(KP Pp, int G) {
    const Params P = load_params(Pp);
    const int tid = tid_fresh();
    unsigned char* ws = P.ws; unsigned char* T = ws + WS_BIG;
    const float* sm = (const float*)(ws + WS_SM);
    for (int it = blockIdx.x; it < HB * NCH; it += G) {
        const int row0 = it * 64;
        {
            const int hc = tid;
            const float* wf = P.in[7]; float w[16];
#pragma unroll
            for (int j = 0; j < 16; ++j) w[j] = wf[j * 512 + hc];
            const float bfv = P.in[8][hc];
            float cum = 0.f;
            for (int t = 0; t < 64; ++t) { const float* f = sm + (size_t)(row0 + t) * 64; float z = bfv;
#pragma unroll
                for (int j = 0; j < 16; ++j) z += f[j] * w[j];
                cum += (fminf(z, 0.f) - __logf(1.f + __expf(-fabsf(z)))) * (1.f / 16.f); }
            const float end = cum; cum = 0.f;
            bf16_t* kp = (bf16_t*)(T + T_K) + (size_t)row0 * 512 + hc;
            for (int t = 0; t < 64; ++t) { const float* f = sm + (size_t)(row0 + t) * 64; float z = bfv;
#pragma unroll
                for (int j = 0; j < 16; ++j) z += f[j] * w[j];
                cum += (fminf(z, 0.f) - __logf(1.f + __expf(-fabsf(z)))) * (1.f / 16.f);
                const float kv = __uint_as_float((unsigned)kp[(size_t)t * 512] << 16) * __expf(end - cum);
                kp[(size_t)t * 512] = (bf16_t)(cvt_pk_bf16(kv, 0.f) & 0xffffu); }
            ((float*)(ws + WS_DEC))[(size_t)it * 512 + hc] = __expf(end);
        }
        if (tid < 32) {
            const float bias = P.in[13][tid], A = -__expf(P.in[14][tid]);
            float cum = 0.f;
            for (int t = 0; t < 64; ++t) cum += softplusf_(sm[(size_t)(row0 + t) * 64 + 16 + tid] + bias) * A;
            const float end = cum; cum = 0.f;
            float* wg = (float*)(ws + WS_WG);
            for (int t = 0; t < 64; ++t) { const float dt = softplusf_(sm[(size_t)(row0 + t) * 64 + 16 + tid] + bias); cum += dt * A; wg[(size_t)(row0 + t) * 32 + tid] = __expf(end - cum) * dt; }
            ((float*)(ws + WS_DECS))[it * 32 + tid] = __expf(end);
        }
    }
    const int co = tid & 63, rg = tid >> 6;
    for (int it = blockIdx.x; it < HB * NCH * 8; it += G) {
        const int ci = it >> 3, cb = it & 7, col = cb * 512 + co * 8, row0 = ci * 64 + rg * 8;
        bf16_t* xp = (bf16_t*)(T + T_XBC) + (size_t)row0 * 4096 + col;
        u32x4 raw[11];
#pragma unroll
        for (int i = 0; i < 8; ++i) raw[3 + i] = *(const u32x4*)(xp + (size_t)i * 4096);
        if (rg > 0) {
#pragma unroll
            for (int i = 0; i < 3; ++i) raw[i] = *(const u32x4*)(xp - (size_t)(3 - i) * 4096);
        } else if ((ci & (NCH - 1)) != 0) {
            const bf16_t* hp = (const bf16_t*)(ws + WS_HALO) + (size_t)(ci - 1) * 3 * 4096 + col;
#pragma unroll
            for (int i = 0; i < 3; ++i) raw[i] = *(const u32x4*)(hp + (size_t)i * 4096);
        } else {
#pragma unroll
            for (int i = 0; i < 3; ++i) raw[i] = (u32x4){0u, 0u, 0u, 0u};
        }
        float cw[4][8], cbv[8];
#pragma unroll
        for (int k = 0; k < 4; ++k) { const f32x4 a = *(const f32x4*)(P.in[11] + k * 4096 + col), b = *(const f32x4*)(P.in[11] + k * 4096 + col + 4);
            cw[k][0] = a.x; cw[k][1] = a.y; cw[k][2] = a.z; cw[k][3] = a.w; cw[k][4] = b.x; cw[k][5] = b.y; cw[k][6] = b.z; cw[k][7] = b.w; }
        { const f32x4 a = *(const f32x4*)(P.in[12] + col), b = *(const f32x4*)(P.in[12] + col + 4);
            cbv[0] = a.x; cbv[1] = a.y; cbv[2] = a.z; cbv[3] = a.w; cbv[4] = b.x; cbv[5] = b.y; cbv[6] = b.z; cbv[7] = b.w; }
        asm volatile("s_waitcnt vmcnt(0)" ::: "memory");
        __syncthreads();
#pragma unroll
        for (int i = 0; i < 8; ++i) {
            float v[8];
#pragma unroll
            for (int e = 0; e < 8; ++e) v[e] = cbv[e];
#pragma unroll
            for (int k = 0; k < 4; ++k) { const u32x4 q = raw[i + k];
                v[0] += cw[k][0] * bf_lo(q.x); v[1] += cw[k][1] * bf_hi(q.x); v[2] += cw[k][2] * bf_lo(q.y); v[3] += cw[k][3] * bf_hi(q.y);
                v[4] += cw[k][4] * bf_lo(q.z); v[5] += cw[k][5] * bf_hi(q.z); v[6] += cw[k][6] * bf_lo(q.w); v[7] += cw[k][7] * bf_hi(q.w); }
#pragma unroll
            for (int e = 0; e < 8; ++e) v[e] = siluf_(v[e]);
            u32x4 w; w.x = cvt_pk_bf16(v[0], v[1]); w.y = cvt_pk_bf16(v[2], v[3]); w.z = cvt_pk_bf16(v[4], v[5]); w.w = cvt_pk_bf16(v[6], v[7]);
            *(u32x4*)(xp + (size_t)i * 4096) = w;
        }
        __syncthreads();
    }
}

struct MixArgs {
    const bf16_t* ak; int ld_ak;
    const bf16_t* qq; int ld_q;
    const bf16_t* bv; int ld_bv;
    const bf16_t* gt; int ld_g;
    bf16_t* out; int ld_o;
    const float* dec;
    const float* wg;
    const float* nw;
    const float* dsk;
};
constexpr int RSA = 320, RSB = 576, RSQ = 264;
constexpr int OFF_AK = 0, OFF_BV = 64 * RSA, OFF_QQ = OFF_BV + 64 * RSB, OFF_WGT = OFF_QQ + 64 * RSQ, OFF_DEC = OFF_WGT + 1024, OFF_RED = OFF_DEC + 512, OFF_NW = OFF_RED + 2048;
static_assert(OFF_NW + 1024 <= LDS_BYTES, "mixer LDS");

template <bool SSD>
__device__ __forceinline__ void mixer_item(LAS unsigned char* lds, const MixArgs& a) {
    const int tid = tid_fresh(), lane = tid & 63, w = __builtin_amdgcn_readfirstlane(tid >> 6);
    const int r = lane & 31, h = lane >> 5, gg = lane >> 4, q = (lane & 15) >> 2, p = lane & 3;
    const int arow0 = tid >> 4, apc = tid & 15;
    const int brow0 = tid >> 5, bpc = tid & 31;
    u32x4 stA[2], stQ[2], stB[4], stW, stD;
    stW = (u32x4){0u, 0u, 0u, 0u}; stD = stW;
#define MIX_LOAD(c) do { const size_t _r0 = (size_t)(c) * 64; \
        _Pragma("unroll") for (int i = 0; i < 2; ++i) { stA[i] = *(const u32x4*)(a.ak + (_r0 + arow0 + 32 * i) * a.ld_ak + apc * 8); stQ[i] = *(const u32x4*)(a.qq + (_r0 + arow0 + 32 * i) * a.ld_q + apc * 8); } \
        _Pragma("unroll") for (int i = 0; i < 4; ++i) stB[i] = *(const u32x4*)(a.bv + (_r0 + brow0 + 16 * i) * a.ld_bv + bpc * 8); \
        if (SSD) { if (tid < 64) stW = *(const u32x4*)(a.wg + (_r0 + tid) * 32); } \
        else { if (tid < 32) stD = *(const u32x4*)(a.dec + (size_t)(c) * 512 + tid * 4); } } while (0)
#define MIX_STORE() do { \
        _Pragma("unroll") for (int i = 0; i < 2; ++i) { *(LAS u32x4*)(lds + OFF_AK + (arow0 + 32 * i) * RSA + apc * 16) = stA[i]; \
            *(LAS u32x2*)(lds + OFF_QQ + (arow0 + 32 * i) * RSQ + apc * 16) = (u32x2){stQ[i].x, stQ[i].y}; *(LAS u32x2*)(lds + OFF_QQ + (arow0 + 32 * i) * RSQ + apc * 16 + 8) = (u32x2){stQ[i].z, stQ[i].w}; } \
        _Pragma("unroll") for (int i = 0; i < 4; ++i) *(LAS u32x4*)(lds + OFF_BV + (brow0 + 16 * i) * RSB + bpc * 16) = stB[i]; \
        if (SSD) { if (tid < 64) *(LAS u32x4*)(lds + OFF_WGT + tid * 16) = stW; } \
        else { if (tid < 32) *(LAS u32x4*)(lds + OFF_DEC + tid * 16) = stD; } } while (0)

    if (tid < 256) *(LAS float*)(lds + OFF_NW + tid * 4) = a.nw[tid];
    MIX_LOAD(0);
    MIX_STORE();
    __syncthreads();

    f32x16 S[4];
#pragma unroll
    for (int i = 0; i < 4; ++i)
#pragma unroll
        for (int e = 0; e < 16; ++e) S[i][e] = 0.f;

    const int trA = OFF_AK + (8 * h + q) * RSA + (16 * (gg & 1) + 4 * p) * 2;
    const int trB = OFF_BV + (8 * h + q) * RSB + (32 * w + 16 * (gg & 1) + 4 * p) * 2;
    const int qB = OFF_QQ + r * RSQ + 8 * h;
    const float dsk = SSD ? a.dsk[w >> 1] : 0.f;

    for (int c = 0; c < NCH; ++c) {
        if (c + 1 < NCH) MIX_LOAD(c + 1);
        u32x2 gv[2][4];
#pragma unroll
        for (int j2 = 0; j2 < 2; ++j2)
#pragma unroll
            for (int g = 0; g < 4; ++g) gv[j2][g] = *(const u32x2*)(a.gt + ((size_t)c * 64 + 32 * j2 + r) * a.ld_g + 32 * w + 8 * g + 4 * h);
        if (SSD) {
            const float dc = a.dec[(size_t)c * 32 + (w >> 1)];
#pragma unroll
            for (int i = 0; i < 4; ++i)
#pragma unroll
                for (int e = 0; e < 16; ++e) S[i][e] *= dc;
        } else {
#pragma unroll
            for (int i = 0; i < 4; ++i)
#pragma unroll
                for (int g = 0; g < 4; ++g) { const f32x4 d4 = *(const LAS f32x4*)(lds + OFF_DEC + (32 * i + 8 * g + 4 * h) * 4);
                    S[i][4 * g + 0] *= d4.x; S[i][4 * g + 1] *= d4.y; S[i][4 * g + 2] *= d4.z; S[i][4 * g + 3] *= d4.w; }
        }
#pragma unroll
        for (int s = 0; s < 4; ++s) {
            const s16x4 b0 = __builtin_bit_cast(s16x4, __builtin_amdgcn_ds_read_tr16_b64_v4i16((LAS s16x4*)(lds + trB + (16 * s) * RSB)));
            const s16x4 b1 = __builtin_bit_cast(s16x4, __builtin_amdgcn_ds_read_tr16_b64_v4i16((LAS s16x4*)(lds + trB + (16 * s + 4) * RSB)));
            bf16x8 bfr = __builtin_shufflevector(b0, b1, 0, 1, 2, 3, 4, 5, 6, 7);
            if (SSD) {
                u32x4 bu = __builtin_bit_cast(u32x4, bfr);
                float wt[8];
#pragma unroll
                for (int j = 0; j < 8; ++j) wt[j] = *(const LAS float*)(lds + OFF_WGT + (16 * s + 8 * h + j) * 16 + (w >> 1) * 4);
                bu.x = cvt_pk_bf16(bf_lo(bu.x) * wt[0], bf_hi(bu.x) * wt[1]); bu.y = cvt_pk_bf16(bf_lo(bu.y) * wt[2], bf_hi(bu.y) * wt[3]);
                bu.z = cvt_pk_bf16(bf_lo(bu.z) * wt[4], bf_hi(bu.z) * wt[5]); bu.w = cvt_pk_bf16(bf_lo(bu.w) * wt[6], bf_hi(bu.w) * wt[7]);
                bfr = __builtin_bit_cast(bf16x8, bu);
            }
#pragma unroll
            for (int i = 0; i < 4; ++i) {
                const s16x4 a0 = __builtin_bit_cast(s16x4, __builtin_amdgcn_ds_read_tr16_b64_v4i16((LAS s16x4*)(lds + trA + (16 * s) * RSA + 64 * i)));
                const s16x4 a1 = __builtin_bit_cast(s16x4, __builtin_amdgcn_ds_read_tr16_b64_v4i16((LAS s16x4*)(lds + trA + (16 * s + 4) * RSA + 64 * i)));
                const bf16x8 afr = __builtin_shufflevector(a0, a1, 0, 1, 2, 3, 4, 5, 6, 7);
                S[i] = __builtin_amdgcn_mfma_f32_32x32x16_bf16(afr, bfr, S[i], 0, 0, 0);
            }
        }
        f32x16 OT[2];
#pragma unroll
        for (int j2 = 0; j2 < 2; ++j2)
#pragma unroll
            for (int e = 0; e < 16; ++e) OT[j2][e] = 0.f;
#pragma unroll
        for (int sp = 0; sp < 8; ++sp) {
            const int i = sp >> 1, o8 = 8 * (sp & 1);
            u32x4 pk;
            pk.x = cvt_pk_bf16(S[i][o8 + 0], S[i][o8 + 1]); pk.y = cvt_pk_bf16(S[i][o8 + 2], S[i][o8 + 3]);
            pk.z = cvt_pk_bf16(S[i][o8 + 4], S[i][o8 + 5]); pk.w = cvt_pk_bf16(S[i][o8 + 6], S[i][o8 + 7]);
            const bf16x8 sfr = __builtin_bit_cast(bf16x8, pk);
#pragma unroll
            for (int j2 = 0; j2 < 2; ++j2) {
                const u32x2 q0 = *(const LAS u32x2*)(lds + qB + 32 * j2 * RSQ + (16 * sp) * 2);
                const u32x2 q1 = *(const LAS u32x2*)(lds + qB + 32 * j2 * RSQ + (16 * sp + 8) * 2);
                const bf16x8 qfr = __builtin_bit_cast(bf16x8, (u32x4){q0.x, q0.y, q1.x, q1.y});
                OT[j2] = __builtin_amdgcn_mfma_f32_32x32x16_bf16(sfr, qfr, OT[j2], 0, 0, 0);
            }
        }
        float part[2] = {0.f, 0.f};
#pragma unroll
        for (int j2 = 0; j2 < 2; ++j2)
#pragma unroll
            for (int g = 0; g < 4; ++g) {
                if (SSD) {
                    const u32x2 xs = *(const LAS u32x2*)(lds + OFF_BV + (32 * j2 + r) * RSB + (32 * w + 8 * g + 4 * h) * 2);
                    OT[j2][4 * g + 0] = (OT[j2][4 * g + 0] + dsk * bf_lo(xs.x)) * bf_lo(gv[j2][g].x);
                    OT[j2][4 * g + 1] = (OT[j2][4 * g + 1] + dsk * bf_hi(xs.x)) * bf_hi(gv[j2][g].x);
                    OT[j2][4 * g + 2] = (OT[j2][4 * g + 2] + dsk * bf_lo(xs.y)) * bf_lo(gv[j2][g].y);
                    OT[j2][4 * g + 3] = (OT[j2][4 * g + 3] + dsk * bf_hi(xs.y)) * bf_hi(gv[j2][g].y);
                }
#pragma unroll
                for (int k = 0; k < 4; ++k) part[j2] += OT[j2][4 * g + k] * OT[j2][4 * g + k];
            }
        part[0] += __shfl_xor(part[0], 32); part[1] += __shfl_xor(part[1], 32);
        if (h == 0) { *(LAS float*)(lds + OFF_RED + (w * 64 + r) * 4) = part[0]; *(LAS float*)(lds + OFF_RED + (w * 64 + 32 + r) * 4) = part[1]; }
        __syncthreads();
#pragma unroll
        for (int j2 = 0; j2 < 2; ++j2) {
            float tot = 0.f;
#pragma unroll
            for (int ww = 0; ww < 8; ++ww) tot += *(const LAS float*)(lds + OFF_RED + (ww * 64 + 32 * j2 + r) * 4);
            const float rstd = rsqrtf(tot * (1.f / 256.f) + EPS);
#pragma unroll
            for (int g = 0; g < 4; ++g) {
                const f32x4 n4 = *(const LAS f32x4*)(lds + OFF_NW + (32 * w + 8 * g + 4 * h) * 4);
                float v0 = OT[j2][4 * g + 0] * rstd * n4.x, v1 = OT[j2][4 * g + 1] * rstd * n4.y, v2 = OT[j2][4 * g + 2] * rstd * n4.z, v3 = OT[j2][4 * g + 3] * rstd * n4.w;
                if (!SSD) { v0 *= bf_lo(gv[j2][g].x); v1 *= bf_hi(gv[j2][g].x); v2 *= bf_lo(gv[j2][g].y); v3 *= bf_hi(gv[j2][g].y); }
                *(u32x2*)(a.out + ((size_t)c * 64 + 32 * j2 + r) * a.ld_o + 32 * w + 8 * g + 4 * h) = (u32x2){cvt_pk_bf16(v0, v1), cvt_pk_bf16(v2, v3)};
            }
        }
        __syncthreads();
        if (c + 1 < NCH) MIX_STORE();
        __syncthreads();
    }
#undef MIX_LOAD
#undef MIX_STORE
}

__device__ __forceinline__ void p5_mixer(KP Pp, LAS unsigned char* lds, int G) {
    const Params P = load_params(Pp);
    unsigned char* ws = P.ws; unsigned char* T = ws + WS_BIG;
    for (int it = blockIdx.x; it < HB * 12; it += G) {
        const int b = it / 12, k = it % 12;
        const size_t row0 = (size_t)b * SEQ;
        MixArgs a;
        if (k < 4) {
            const int hd = k;
            a.ak = (const bf16_t*)(T + T_K) + row0 * 512 + hd * 128; a.ld_ak = 512;
            a.qq = (const bf16_t*)(T + T_Q) + row0 * 512 + hd * 128; a.ld_q = 512;
            a.bv = (const bf16_t*)(T + T_V) + row0 * 1024 + hd * 256; a.ld_bv = 1024;
            a.gt = (const bf16_t*)(T + T_SG) + row0 * 1024 + hd * 256; a.ld_g = 1024;
            a.out = (bf16_t*)(T + T_V) + row0 * 1024 + hd * 256; a.ld_o = 1024;
            a.dec = (const float*)(ws + WS_DEC) + (size_t)b * NCH * 512 + hd * 128;
            a.wg = nullptr; a.nw = P.in[9]; a.dsk = nullptr;
            mixer_item<false>(lds, a);
        } else {
            const int g = k - 4;
            const bf16_t* X = (const bf16_t*)(T + T_XBC) + row0 * 4096;
            a.ak = X + 2048 + g * 128; a.ld_ak = 4096;
            a.qq = X + 3072 + g * 128; a.ld_q = 4096;
            a.bv = X + g * 256; a.ld_bv = 4096;
            a.gt = (const bf16_t*)(T + T_SZ) + row0 * 2048 + g * 256; a.ld_g = 2048;
            a.out = (bf16_t*)(T + T_XBC) + row0 * 4096 + g * 256; a.ld_o = 4096;
            a.dec = (const float*)(ws + WS_DECS) + (size_t)b * NCH * 32 + g * 4;
            a.wg = (const float*)(ws + WS_WG) + row0 * 32 + g * 4;
            a.nw = P.in[16] + g * 256; a.dsk = P.in[15] + g * 4;
            mixer_item<true>(lds, a);
        }
        __syncthreads();
    }
}

__device__ __forceinline__ KP get_params() {
    KP p = (KP)__builtin_amdgcn_kernarg_segment_ptr(); asm volatile("" : "+s"(p)); return p;
}
__global__ void __launch_bounds__(512, 2) fwd_megakernel(Params Parg) {
    extern __shared__ __attribute__((aligned(16))) unsigned char lds_raw[];
    LAS unsigned char* lds = (LAS unsigned char*)lds_raw;
    cg::grid_group grid = cg::this_grid();
    const int G = gridDim.x;
    pg8::StaticOrder S;

    p0_prologue(get_params(), lds, G);
    grid.sync();
    { KP P = get_params(); unsigned char* ws = P->ws;
      pg8::Gemm g{(const bf16_t*)(ws + WS_XB), (const bf16_t*)(ws + WS_WGU1), MTOK, NGU, D, D, D}; S.init(MTOK, NGU, G, blockIdx.x);
      EpiGU E{(const float*)(ws + WS_SSQ), (bf16_t*)(ws + WS_BIG)}; pg8::gemm_phase(lds, g, S, E); }
    grid.sync();
    { KP P = get_params(); unsigned char* ws = P->ws;
      pg8::Gemm g{(const bf16_t*)(ws + WS_BIG), (const bf16_t*)(ws + WS_WD1), MTOK, D, DFF, DFF, DFF}; S.init(MTOK, D, G, blockIdx.x);
      EpiRes E{P->in[0], P->out, (bf16_t*)(ws + WS_XB), (float*)(ws + WS_SSQ) + MTOK, 0.5f}; pg8::gemm_phase(lds, g, S, E); }
    grid.sync();
    for (int hf = 0; hf < 2; ++hf) {
        const size_t r0 = (size_t)hf * MH;
        { KP P = get_params(); unsigned char* ws = P->ws;
          pg8::Gemm g{(const bf16_t*)(ws + WS_XB) + r0 * D, (const bf16_t*)(ws + WS_WIN), MH, NIN, D, D, D}; S.init(MH, NIN, G, blockIdx.x);
          EpiIn E{(const float*)(ws + WS_SSQ) + MTOK + r0, ws + WS_BIG, (bf16_t*)(ws + WS_HALO), (float*)(ws + WS_SM)}; pg8::gemm_phase(lds, g, S, E); }
        grid.sync();
        p4_prep(get_params(), G);
        grid.sync();
        p5_mixer(get_params(), lds, G);
        grid.sync();
        { KP P = get_params(); unsigned char* ws = P->ws; unsigned char* T = ws + WS_BIG;
          pg8::Gemm g{(const bf16_t*)(T + T_V), (const bf16_t*)(ws + WS_WGO), MH, D, D, D, D}; S.init(MH, D, G, blockIdx.x);
          EpiGate E{(const bf16_t*)(T + T_GT), nullptr, (bf16_t*)(T + T_T1), 0}; pg8::gemm_phase(lds, g, S, E); }
        { KP P = get_params(); unsigned char* ws = P->ws; unsigned char* T = ws + WS_BIG;
          pg8::Gemm g{(const bf16_t*)(T + T_XBC), (const bf16_t*)(ws + WS_WSO), MH, D, 2048, 4096, 2048}; S.init(MH, D, G, blockIdx.x);
          EpiGate E{(const bf16_t*)(T + T_GT), (const bf16_t*)(T + T_T1), (bf16_t*)(T + T_MRG), 1}; pg8::gemm_phase(lds, g, S, E); }
        grid.sync();
        { KP P = get_params(); unsigned char* ws = P->ws;
          pg8::Gemm g{(const bf16_t*)(ws + WS_BIG + T_MRG), (const bf16_t*)(ws + WS_WOUT), MH, D, D, D, D}; S.init(MH, D, G, blockIdx.x);
          EpiRes E{P->out + r0 * D, P->out + r0 * D, (bf16_t*)(ws + WS_XB) + r0 * D, (float*)(ws + WS_SSQ) + 2 * MTOK + r0, 1.0f}; pg8::gemm_phase(lds, g, S, E); }
        grid.sync();
    }
    { KP P = get_params(); unsigned char* ws = P->ws;
      pg8::Gemm g{(const bf16_t*)(ws + WS_XB), (const bf16_t*)(ws + WS_WGU2), MTOK, NGU, D, D, D}; S.init(MTOK, NGU, G, blockIdx.x);
      EpiGU E{(const float*)(ws + WS_SSQ) + 2 * MTOK, (bf16_t*)(ws + WS_BIG)}; pg8::gemm_phase(lds, g, S, E); }
    grid.sync();
    { KP P = get_params(); unsigned char* ws = P->ws;
      pg8::Gemm g{(const bf16_t*)(ws + WS_BIG), (const bf16_t*)(ws + WS_WD2), MTOK, D, DFF, DFF, DFF}; S.init(MTOK, D, G, blockIdx.x);
      EpiRes E{P->out, P->out, nullptr, (float*)(ws + WS_SSQ) + 3 * MTOK, 0.5f}; pg8::gemm_phase(lds, g, S, E); }
    grid.sync();
    {
        KP P = get_params(); const float* ssq = (const float*)(P->ws + WS_SSQ) + 3 * MTOK;
        const int tid = tid_fresh(), lane = tid & 63, gw = blockIdx.x * 8 + (tid >> 6), NGW = G * 8;
        const float* fw = P->in[23]; float* outp = P->out;
        for (int m = gw; m < MTOK; m += NGW) {
            const float rstd = rsqrtf(ssq[m] * (1.f / D) + EPS);
            f32x4* xr = (f32x4*)(outp + (size_t)m * D) + lane;
#pragma unroll
            for (int jj = 0; jj < 4; ++jj) { const f32x4 wv = ((const f32x4*)fw)[lane + 64 * jj]; f32x4 v = xr[64 * jj]; v = v * rstd; v.x *= wv.x; v.y *= wv.y; v.z *= wv.z; v.w *= wv.w; xr[64 * jj] = v; }
        }
    }
}

extern "C" void kernel_launch(void* const* d_in, const int* in_sizes, int n_in, void* d_out, int out_size, void* d_ws, size_t ws_size, hipStream_t stream) {
    static int grid = 0;
    if (grid == 0) {
        if (n_in != 24 || ws_size < WS_NEED) { fprintf(stderr, "kernel_launch: unexpected n_in %d or ws_size %zu (need %zu)\n", n_in, ws_size, (size_t)WS_NEED); grid = -1; return; }
        int dev = 0, cus = 0, per_cu = 0;
        hipGetDevice(&dev);
        hipDeviceGetAttribute(&cus, hipDeviceAttributeMultiprocessorCount, dev);
        hipFuncSetAttribute((const void*)fwd_megakernel, hipFuncAttributeMaxDynamicSharedMemorySize, LDS_BYTES);
        hipOccupancyMaxActiveBlocksPerMultiprocessor(&per_cu, (const void*)fwd_megakernel, 512, LDS_BYTES);
        if (per_cu < 1) { fprintf(stderr, "kernel_launch: occupancy query gave %d\n", per_cu); per_cu = 1; }
        grid = cus * per_cu;
        (void)hipGetLastError();
    }
    if (grid < 0) return;
    Params p{};
    for (int i = 0; i < 24; ++i) p.in[i] = (const float*)d_in[i];
    p.out = (float*)d_out; p.ws = (unsigned char*)d_ws;
    void* args[] = {&p};
    hipError_t e = hipLaunchCooperativeKernel((const void*)fwd_megakernel, dim3(grid), dim3(512), args, LDS_BYTES, stream);
    if (e != hipSuccess) fprintf(stderr, "cooperative launch failed: %s (grid %d)\n", hipGetErrorString(e), grid);
}
```

```cpp
#include <hip/hip_runtime.h>
#include <hip/hip_cooperative_groups.h>
#include <cstdio>
#include <cstdint>
namespace cg = cooperative_groups;

#define LAS __attribute__((address_space(3)))
typedef unsigned short bf16_t;
typedef short bf16x8 __attribute__((ext_vector_type(8)));
typedef short s16x4 __attribute__((ext_vector_type(4)));
typedef float f32x4 __attribute__((ext_vector_type(4)));
typedef float f32x16 __attribute__((ext_vector_type(16)));
typedef unsigned u32x4 __attribute__((ext_vector_type(4)));
typedef unsigned u32x2 __attribute__((ext_vector_type(2)));

constexpr int D = 1024, BATCH = 32, SEQ = 2048, MTOK = BATCH * SEQ;
constexpr int NCH = SEQ / 64;
constexpr int DFF = 2816, NGU = 2 * DFF;
constexpr int IN_DIM = 11312, NIN = 45 * 256;
constexpr int HB = 16, MH = HB * SEQ;
constexpr float EPS = 1e-6f;

constexpr size_t MiB = 1u << 20;
constexpr size_t WS_SSQ = 0;
constexpr size_t WS_WGU1 = 1 * MiB, WS_WD1 = 12 * MiB, WS_WIN = 18 * MiB, WS_WGO = 41 * MiB, WS_WSO = 43 * MiB, WS_WOUT = 47 * MiB, WS_WGU2 = 49 * MiB, WS_WD2 = 60 * MiB;
constexpr size_t WS_DEC = 66 * MiB, WS_DECS = 67 * MiB, WS_WG = 68 * MiB, WS_HALO = 72 * MiB, WS_SM = 84 * MiB;
constexpr size_t WS_XB = 96 * MiB;
constexpr size_t WS_BIG = 224 * MiB;
constexpr size_t T_Q = 0, T_K = 32 * MiB, T_V = 64 * MiB, T_SG = 128 * MiB, T_SZ = 192 * MiB, T_XBC = 320 * MiB, T_GT = 576 * MiB, T_END = 704 * MiB;
constexpr size_t T_T1 = T_Q, T_MRG = T_SG;
constexpr size_t WS_NEED = WS_BIG + T_END;

constexpr int LDS_BYTES = 131072;

__device__ __forceinline__ unsigned cvt_pk_bf16(float lo, float hi) { unsigned r; asm volatile("v_cvt_pk_bf16_f32 %0, %1, %2" : "=v"(r) : "v"(lo), "v"(hi)); return r; }
__device__ __forceinline__ float bf_lo(unsigned u) { return __uint_as_float(u << 16); }
__device__ __forceinline__ float bf_hi(unsigned u) { return __uint_as_float(u & 0xffff0000u); }
__device__ __forceinline__ float fast_rcp(float x) { return __builtin_amdgcn_rcpf(x); }
__device__ __forceinline__ float sigmoidf_(float x) { return fast_rcp(1.f + __expf(-x)); }
__device__ __forceinline__ float siluf_(float x) { return x * sigmoidf_(x); }
__device__ __forceinline__ float softplusf_(float x) { return fmaxf(x, 0.f) + __logf(1.f + __expf(-fabsf(x))); }
__device__ __forceinline__ float wave_sum(float v) {
#pragma unroll
    for (int o = 1; o < 64; o <<= 1) v += __shfl_xor(v, o);
    return v;
}

namespace pg8 {
constexpr int BM = 256, BK = 64, HALF = 128, HTB = HALF * BK * 2, STAGE_BYTES = 8 * HTB, NXCD = 8, WGM = 8;
__host__ __device__ __forceinline__ int lds_byte(int r, int c) { const int st = (r >> 4) * 2 + (c >> 5), rr = r & 15, cc = c & 31, ob = rr * 64 + cc * 2; return st * 1024 + (ob ^ (((ob >> 9) & 1) << 5)); }
__host__ __device__ __forceinline__ void stage_rc(int b, int& R, int& C) { const int st = b / 1024, sb = b % 1024, swz = sb ^ (((sb >> 9) & 1) << 5); R = (st >> 1) * 16 + swz / 64; C = (st & 1) * 32 + (swz % 64) / 2; }
__host__ __device__ __forceinline__ int perm32(int rho) { const int n = rho >> 4, i = rho & 15; return 8 * (i >> 2) + 4 * n + (i & 3); }

struct Unit { int pm, pn; };
struct Gemm { const bf16_t* A; const bf16_t* Bt; int M, N, K, lda, ldb; };

struct StaticOrder {
    int nM, nN, nwg, G, c;
    __device__ void init(int M, int N, int G_, int c_) { nM = M / BM; nN = N / BM; nwg = nM * nN; G = G_; c = c_; }
    __device__ bool next(int i, Unit& u) const {
        const long L = (long)i * G + c; if (L >= nwg) return false;
        int wgid = (int)L; { const int q = nwg / NXCD, r = nwg % NXCD, xcd = wgid % NXCD, off = wgid / NXCD; wgid = (xcd < r ? xcd * (q + 1) : r * (q + 1) + (xcd - r) * q) + off; }
        const int nig = WGM * nN, gid = wgid / nig, fm = gid * WGM, gsz = (nM - fm) < WGM ? (nM - fm) : WGM;
        u.pm = fm + ((wgid % nig) % gsz); u.pn = (wgid % nig) / gsz; return true;
    }
};

template <class Epi>
__device__ __forceinline__ void gemm_phase(LAS unsigned char* lds, const Gemm g, const StaticOrder& S, const Epi& E) {
    int tid = threadIdx.x; asm volatile("" : "+v"(tid));
    const int wid = __builtin_amdgcn_readfirstlane(tid >> 6), lane = tid & 63, wr = wid >> 2, wc = wid & 3, fr = lane & 15, fq = lane >> 4;
    const int K = g.K, nt = K / BK;
    unsigned voffA[2], voffB[2];
#pragma unroll
    for (int i = 0; i < 2; ++i) { int R, C; stage_rc(tid * 16 + i * 8192, R, C); const int Rb = (R & ~31) + perm32(R & 31);
        voffA[i] = (unsigned)(R * g.lda + C) * 2u; voffB[i] = (unsigned)(Rb * g.ldb + C) * 2u; }
    const size_t kstep = (size_t)(BK * 2);
    const size_t hstA = (size_t)HALF * g.lda * 2, hstB = (size_t)HALF * g.ldb * 2;
    const size_t tstA = 2 * hstA, tstB = 2 * hstB;
    const unsigned ldsw = (unsigned)wid * 1024u;
    const int aoff = lds_byte(wr * 64 + fr, fq * 8), boff = lds_byte(wc * 32 + fr, fq * 8);
#define PG8_SA(b, h) (((b) * 2 + (h)) * HTB)
#define PG8_SB(b, h) ((4 + (b) * 2 + (h)) * HTB)
#define PG8_STAGE(bufoff, gbase, voff) do { _Pragma("unroll") for (int _i = 0; _i < 2; ++_i) \
        __builtin_amdgcn_global_load_lds((const unsigned*)((const char*)(gbase) + (voff)[_i]), (LAS unsigned*)(lds + (bufoff) + ldsw + _i * 8192), 16, 0, 0); } while (0)
#define PG8_LDA(dst, b, h) do { _Pragma("unroll") for (int m = 0; m < 4; ++m) _Pragma("unroll") for (int k = 0; k < 2; ++k) dst[m][k] = *(const LAS bf16x8*)(lds + PG8_SA(b, h) + aoff + m * 2048 + k * 1024); } while (0)
#define PG8_LDB(dst, b, h) do { _Pragma("unroll") for (int n = 0; n < 2; ++n) _Pragma("unroll") for (int k = 0; k < 2; ++k) dst[n][k] = *(const LAS bf16x8*)(lds + PG8_SB(b, h) + boff + n * 2048 + k * 1024); } while (0)
#define PG8_MMA(ai, bj, At, Bt) do { __builtin_amdgcn_s_setprio(1); _Pragma("unroll") for (int m = 0; m < 4; ++m) _Pragma("unroll") for (int n = 0; n < 2; ++n) _Pragma("unroll") for (int k = 0; k < 2; ++k) \
        acc[ai][bj][m][n] = __builtin_amdgcn_mfma_f32_16x16x32_bf16(Bt[n][k], At[m][k], acc[ai][bj][m][n], 0, 0, 0); __builtin_amdgcn_s_setprio(0); } while (0)
#define PG8_WAIT_V(n) asm volatile("s_waitcnt vmcnt(" #n ")" ::: "memory")
#define PG8_WAIT_L(n) asm volatile("s_waitcnt lgkmcnt(" #n ")" ::: "memory")
#define PG8_BAR __builtin_amdgcn_s_barrier()
#define PG8_SCHED __builtin_amdgcn_sched_barrier(0)
    Unit cur, nxt; int ui = 0;
    if (!S.next(0, cur)) return;
    f32x4 acc[2][2][4][2];
#pragma unroll
    for (int a = 0; a < 2; ++a)
#pragma unroll
        for (int b = 0; b < 2; ++b)
#pragma unroll
            for (int m = 0; m < 4; ++m)
#pragma unroll
                for (int n = 0; n < 2; ++n) acc[a][b][m][n] = (f32x4){0.f, 0.f, 0.f, 0.f};
    bf16x8 At[4][2], B0[2][2], B1[2][2];
    const char* cA = (const char*)g.A + (size_t)cur.pm * tstA; const char* cB = (const char*)g.Bt + (size_t)cur.pn * tstB;
    PG8_STAGE(PG8_SB(0, 0), cB, voffB); PG8_STAGE(PG8_SA(0, 0), cA, voffA); PG8_STAGE(PG8_SB(0, 1), cB + hstB, voffB); PG8_STAGE(PG8_SA(0, 1), cA + hstA, voffA);
    if (wr == 1) PG8_BAR;
    PG8_WAIT_V(4); PG8_BAR;
    PG8_STAGE(PG8_SB(1, 0), cB + kstep, voffB); PG8_STAGE(PG8_SA(1, 0), cA + kstep, voffA); PG8_STAGE(PG8_SB(1, 1), cB + hstB + kstep, voffB);
    PG8_WAIT_V(6); PG8_BAR;
    for (;;) {
        const bool has_next = S.next(ui + 1, nxt);
        const char* nA = has_next ? (const char*)g.A + (size_t)nxt.pm * tstA : cA; const char* nB = has_next ? (const char*)g.Bt + (size_t)nxt.pn * tstB : cB;
        for (int t = 0; t < nt; t += 2) {
            const bool last = (t == nt - 2);
            const char* a1 = cA + (size_t)(t + 1) * kstep;
            const char* a2 = last ? nA : cA + (size_t)(t + 2) * kstep; const char* b2 = last ? nB : cB + (size_t)(t + 2) * kstep;
            const char* a3 = a2 + kstep; const char* b3 = b2 + kstep;
            PG8_LDB(B0, 0, 0); PG8_SCHED; PG8_LDA(At, 0, 0); PG8_STAGE(PG8_SA(1, 1), a1 + hstA, voffA);
            PG8_WAIT_L(8); PG8_BAR; PG8_WAIT_L(0); PG8_MMA(0, 0, At, B0); PG8_BAR; PG8_SCHED;
            PG8_LDB(B1, 0, 1); PG8_STAGE(PG8_SB(0, 0), b2, voffB);
            PG8_BAR; PG8_WAIT_L(0); PG8_MMA(0, 1, At, B1); PG8_BAR;
            PG8_LDA(At, 0, 1); PG8_STAGE(PG8_SA(0, 0), a2, voffA);
            PG8_BAR; PG8_WAIT_L(0); PG8_MMA(1, 0, At, B0); PG8_BAR; PG8_SCHED;
            PG8_STAGE(PG8_SB(0, 1), b2 + hstB, voffB);
            PG8_WAIT_V(6); PG8_BAR; PG8_MMA(1, 1, At, B1); PG8_BAR;
            PG8_LDB(B0, 1, 0); PG8_SCHED; PG8_LDA(At, 1, 0); PG8_STAGE(PG8_SA(0, 1), a2 + hstA, voffA);
            PG8_WAIT_L(8); PG8_BAR; PG8_WAIT_L(0); PG8_MMA(0, 0, At, B0); PG8_BAR; PG8_SCHED;
            PG8_LDB(B1, 1, 1); PG8_STAGE(PG8_SB(1, 0), b3, voffB);
            PG8_BAR; PG8_WAIT_L(0); PG8_MMA(0, 1, At, B1); PG8_BAR;
            PG8_LDA(At, 1, 1); PG8_STAGE(PG8_SA(1, 0), a3, voffA);
            PG8_BAR; PG8_WAIT_L(0); PG8_MMA(1, 0, At, B0); PG8_BAR; PG8_SCHED;
            PG8_STAGE(PG8_SB(1, 1), b3 + hstB, voffB);
            PG8_WAIT_V(6); PG8_BAR; PG8_MMA(1, 1, At, B1); PG8_BAR;
        }
        E(acc, cur, wr, wc, fr, fq);
        if (!has_next) break;
#pragma unroll
        for (int a = 0; a < 2; ++a)
#pragma unroll
            for (int b = 0; b < 2; ++b)
#pragma unroll
                for (int m = 0; m < 4; ++m)
#pragma unroll
                    for (int n = 0; n < 2; ++n) acc[a][b][m][n] = (f32x4){0.f, 0.f, 0.f, 0.f};
        cur = nxt; cA = nA; cB = nB; ++ui;
    }
    PG8_WAIT_V(0);
    if (wr == 0) PG8_BAR;
    PG8_BAR;
#undef PG8_SA
#undef PG8_SB
#undef PG8_STAGE
#undef PG8_LDA
#undef PG8_LDB
#undef PG8_MMA
#undef PG8_WAIT_V
#undef PG8_WAIT_L
#undef PG8_BAR
#undef PG8_SCHED
}
}

typedef f32x4 AccT[2][2][4][2];

struct EpiGU {
    const float* ssq; bf16_t* O;
    __device__ __forceinline__ void operator()(const AccT& acc, const pg8::Unit& u, int wr, int wc, int fr, int fq) const {
        const int row0 = u.pm * 256 + wr * 64 + fr, col0 = u.pn * 128 + wc * 32 + 8 * fq;
#pragma unroll
        for (int ai = 0; ai < 2; ++ai)
#pragma unroll
            for (int m = 0; m < 4; ++m) {
                const int row = row0 + ai * 128 + m * 16;
                const float rstd = rsqrtf(ssq[row] * (1.f / D) + EPS);
                float v[8];
#pragma unroll
                for (int n = 0; n < 2; ++n)
#pragma unroll
                    for (int j = 0; j < 4; ++j) { const float gg = acc[ai][0][m][n][j] * rstd, uu = acc[ai][1][m][n][j] * rstd; v[4 * n + j] = siluf_(gg) * uu; }
                u32x4 w; w.x = cvt_pk_bf16(v[0], v[1]); w.y = cvt_pk_bf16(v[2], v[3]); w.z = cvt_pk_bf16(v[4], v[5]); w.w = cvt_pk_bf16(v[6], v[7]);
                *(u32x4*)(O + (size_t)row * DFF + col0) = w;
            }
    }
};
struct EpiRes {
    const float* xin; float* xout; bf16_t* xb; float* ssq; float alpha;
    __device__ __forceinline__ void operator()(const AccT& acc, const pg8::Unit& u, int wr, int wc, int fr, int fq) const {
        const int row0 = u.pm * 256 + wr * 64 + fr, col0 = u.pn * 256 + wc * 32 + 8 * fq;
#pragma unroll
        for (int ai = 0; ai < 2; ++ai)
#pragma unroll
            for (int m = 0; m < 4; ++m) {
                const int row = row0 + ai * 128 + m * 16;
                float s = 0.f;
#pragma unroll
                for (int bj = 0; bj < 2; ++bj) {
                    const size_t o = (size_t)row * D + col0 + bj * 128;
                    const f32x4 x0 = *(const f32x4*)(xin + o), x1 = *(const f32x4*)(xin + o + 4);
                    f32x4 y0 = x0 + acc[ai][bj][m][0] * alpha, y1 = x1 + acc[ai][bj][m][1] * alpha;
                    *(f32x4*)(xout + o) = y0; *(f32x4*)(xout + o + 4) = y1;
                    s += y0.x * y0.x + y0.y * y0.y + y0.z * y0.z + y0.w * y0.w + y1.x * y1.x + y1.y * y1.y + y1.z * y1.z + y1.w * y1.w;
                    if (xb) { u32x4 w; w.x = cvt_pk_bf16(y0.x, y0.y); w.y = cvt_pk_bf16(y0.z, y0.w); w.z = cvt_pk_bf16(y1.x, y1.y); w.w = cvt_pk_bf16(y1.z, y1.w); *(u32x4*)(xb + o) = w; }
                }
                s += __shfl_xor(s, 16); s += __shfl_xor(s, 32);
                if (fq == 0) atomicAdd(ssq + row, s);
            }
    }
};
struct EpiIn {
    const float* ssq; unsigned char* T; bf16_t* halo; float* sm;
    __device__ __forceinline__ void operator()(const AccT& acc, const pg8::Unit& u, int wr, int wc, int fr, int fq) const {
        const int pn = u.pn;
        const int row0 = u.pm * 256 + wr * 64 + fr;
        int act = 0, ld, ct; bf16_t* base;
        if (pn < 2) { base = (bf16_t*)(T + T_Q); ld = 512; ct = pn; }
        else if (pn < 4) { base = (bf16_t*)(T + T_K); ld = 512; ct = pn - 2; }
        else if (pn < 8) { base = (bf16_t*)(T + T_V); ld = 1024; ct = pn - 4; }
        else if (pn < 12) { base = (bf16_t*)(T + T_SG); ld = 1024; ct = pn - 8; act = 1; }
        else if (pn < 20) { base = (bf16_t*)(T + T_SZ); ld = 2048; ct = pn - 12; act = 1; }
        else if (pn < 36) { base = (bf16_t*)(T + T_XBC); ld = 4096; ct = pn - 20; act = 3; }
        else if (pn < 44) { base = (bf16_t*)(T + T_GT); ld = 2048; ct = pn - 36; act = 2; }
        else { base = nullptr; ld = 0; ct = 0; act = 4; }
        if (act == 4) {
            if (wc < 2) {
#pragma unroll
                for (int ai = 0; ai < 2; ++ai)
#pragma unroll
                    for (int m = 0; m < 4; ++m) {
                        const int row = row0 + ai * 128 + m * 16;
                        const float rstd = rsqrtf(ssq[row] * (1.f / D) + EPS);
                        float* p = sm + (size_t)row * 64 + wc * 32 + 8 * fq;
                        *(f32x4*)p = acc[ai][0][m][0] * rstd; *(f32x4*)(p + 4) = acc[ai][0][m][1] * rstd;
                    }
            }
            return;
        }
        const int col0 = ct * 256 + wc * 32 + 8 * fq;
#pragma unroll
        for (int ai = 0; ai < 2; ++ai)
#pragma unroll
            for (int m = 0; m < 4; ++m) {
                const int row = row0 + ai * 128 + m * 16;
                const float rstd = rsqrtf(ssq[row] * (1.f / D) + EPS);
#pragma unroll
                for (int bj = 0; bj < 2; ++bj) {
                    float v[8];
#pragma unroll
                    for (int n = 0; n < 2; ++n)
#pragma unroll
                        for (int j = 0; j < 4; ++j) { float x = acc[ai][bj][m][n][j] * rstd; if (act == 1) x = siluf_(x); else if (act == 2) x = sigmoidf_(x); v[4 * n + j] = x; }
                    u32x4 w; w.x = cvt_pk_bf16(v[0], v[1]); w.y = cvt_pk_bf16(v[2], v[3]); w.z = cvt_pk_bf16(v[4], v[5]); w.w = cvt_pk_bf16(v[6], v[7]);
                    *(u32x4*)(base + (size_t)row * ld + col0 + bj * 128) = w;
                    if (act == 3 && (row & 63) >= 61) *(u32x4*)(halo + ((size_t)(row >> 6) * 3 + ((row & 63) - 61)) * 4096 + col0 + bj * 128) = w;
                }
            }
    }
};
struct EpiGate {
    const bf16_t* gt; const bf16_t* t1; bf16_t* out; int mode;
    __device__ __forceinline__ void operator()(const AccT& acc, const pg8::Unit& u, int wr, int wc, int fr, int fq) const {
        const int row0 = u.pm * 256 + wr * 64 + fr, col0 = u.pn * 256 + wc * 32 + 8 * fq;
#pragma unroll
        for (int ai = 0; ai < 2; ++ai)
#pragma unroll
            for (int m = 0; m < 4; ++m) {
                const int row = row0 + ai * 128 + m * 16;
#pragma unroll
                for (int bj = 0; bj < 2; ++bj) {
                    const int col = col0 + bj * 128;
                    const u32x4 gq = *(const u32x4*)(gt + (size_t)row * 2048 + mode * 1024 + col);
                    float v[8];
                    v[0] = acc[ai][bj][m][0].x * bf_lo(gq.x); v[1] = acc[ai][bj][m][0].y * bf_hi(gq.x); v[2] = acc[ai][bj][m][0].z * bf_lo(gq.y); v[3] = acc[ai][bj][m][0].w * bf_hi(gq.y);
                    v[4] = acc[ai][bj][m][1].x * bf_lo(gq.z); v[5] = acc[ai][bj][m][1].y * bf_hi(gq.z); v[6] = acc[ai][bj][m][1].z * bf_lo(gq.w); v[7] = acc[ai][bj][m][1].w * bf_hi(gq.w);
                    if (mode) { const u32x4 tq = *(const u32x4*)(t1 + (size_t)row * D + col);
                        v[0] += bf_lo(tq.x); v[1] += bf_hi(tq.x); v[2] += bf_lo(tq.y); v[3] += bf_hi(tq.y); v[4] += bf_lo(tq.z); v[5] += bf_hi(tq.z); v[6] += bf_lo(tq.w); v[7] += bf_hi(tq.w); }
                    u32x4 w; w.x = cvt_pk_bf16(v[0], v[1]); w.y = cvt_pk_bf16(v[2], v[3]); w.z = cvt_pk_bf16(v[4], v[5]); w.w = cvt_pk_bf16(v[6], v[7]);
                    *(u32x4*)(out + (size_t)row * D + col) = w;
                }
            }
    }
};

__device__ __forceinline__ void tr_item(const float* srcp, int ld, const float* sk, float mul, int k0, int K, bf16_t* dst, int n0, LAS float* scr, int lane) {
#pragma unroll 8
    for (int i = 0; i < 32; ++i) { const int kk = 2 * i + (lane >> 5);
        float v = 0.f; if (srcp) v = srcp[(size_t)(k0 + kk) * ld] * (sk ? sk[k0 + kk] : 1.f) * mul;
        scr[kk * 33 + (lane & 31)] = v; }
    asm volatile("s_waitcnt lgkmcnt(0)" ::: "memory");
    const int c = lane & 7;
#pragma unroll
    for (int j = 0; j < 4; ++j) { const int n = (lane >> 3) + 8 * j; const LAS float* s = scr + (8 * c) * 33 + n;
        u32x4 o; o.x = cvt_pk_bf16(s[0 * 33], s[1 * 33]); o.y = cvt_pk_bf16(s[2 * 33], s[3 * 33]); o.z = cvt_pk_bf16(s[4 * 33], s[5 * 33]); o.w = cvt_pk_bf16(s[6 * 33], s[7 * 33]);
        *(u32x4*)(dst + (size_t)(n0 + n) * K + k0 + 8 * c) = o; }
    asm volatile("s_waitcnt lgkmcnt(0)" ::: "memory");
}
__device__ __forceinline__ int win_src_col(int nd) {
    if (nd < 3072) return nd;
    if (nd < 5120) return 3088 + (nd - 3072);
    if (nd < 9216) return 5136 + (nd - 5120);
    if (nd < 11264) return 9264 + (nd - 9216);
    if (nd < 11280) return 3072 + (nd - 11264);
    if (nd < 11312) return 9232 + (nd - 11280);
    return -1;
}

struct Params {
    const float* in[24];
    float* out;
    unsigned char* ws;
};

typedef __attribute__((address_space(4))) const Params* KP;
__device__ __forceinline__ Params load_params(KP p) { Params r;
#pragma unroll
    for (int i = 0; i < 24; ++i) r.in[i] = p->in[i];
    r.out = p->out; r.ws = p->ws; return r; }
__device__ __forceinline__ int tid_fresh() { int t = threadIdx.x; asm volatile("" : "+v"(t)); return t; }
__device__ __forceinline__ void p0_prologue(KP Pp, LAS unsigned char* lds, int G) {
    const Params P = load_params(Pp);
    const int tid = tid_fresh(), lane = tid & 63, wave = tid >> 6;
    LAS float* scr = (LAS float*)(lds + wave * 16384);
    const int gw = blockIdx.x * 8 + wave, NGW = G * 8;
    unsigned char* ws = P.ws;
    constexpr int I_GU = (D / 64) * (NGU / 32), I_DN = (DFF / 64) * (D / 32), I_IN = (D / 64) * (NIN / 32), I_GO = (D / 64) * (D / 32), I_SO = (2048 / 64) * (D / 32);
    constexpr int NITEMS = 2 * I_GU + 2 * I_DN + I_IN + 2 * I_GO + I_SO;
    for (int it = gw; it < NITEMS; it += NGW) {
        int r = it; const int j = lane & 31;
        if (r < 2 * I_GU) { const int l2 = r >= I_GU; r -= l2 * I_GU; const int nb = r % (NGU / 32), kb = r / (NGU / 32); const int nd = nb * 32 + j, tile = nd >> 8, w = nd & 255;
            const float* Wg = P.in[l2 ? 20 : 2]; const float* Wu = P.in[l2 ? 21 : 3];
            const float* sp = (w < 128 ? Wg : Wu) + 128 * tile + (w & 127);
            tr_item(sp, DFF, P.in[l2 ? 19 : 1], 1.f, kb * 64, D, (bf16_t*)(ws + (l2 ? WS_WGU2 : WS_WGU1)), nb * 32, scr, lane); continue; }
        r -= 2 * I_GU;
        if (r < 2 * I_DN) { const int l2 = r >= I_DN; r -= l2 * I_DN; const int nb = r % (D / 32), kb = r / (D / 32);
            tr_item(P.in[l2 ? 22 : 4] + nb * 32 + j, D, nullptr, 1.f, kb * 64, DFF, (bf16_t*)(ws + (l2 ? WS_WD2 : WS_WD1)), nb * 32, scr, lane); continue; }
        r -= 2 * I_DN;
        if (r < I_IN) { const int nb = r % (NIN / 32), kb = r / (NIN / 32); const int nd = nb * 32 + j, sc = win_src_col(nd);
            tr_item(sc >= 0 ? P.in[6] + sc : nullptr, IN_DIM, P.in[5], nd < 512 ? 0.08838834764831845f : 1.f, kb * 64, D, (bf16_t*)(ws + WS_WIN), nb * 32, scr, lane); continue; }
        r -= I_IN;
        if (r < 2 * I_GO) { const int l2 = r >= I_GO; r -= l2 * I_GO; const int nb = r % (D / 32), kb = r / (D / 32);
            tr_item(P.in[l2 ? 18 : 10] + nb * 32 + j, D, nullptr, 1.f, kb * 64, D, (bf16_t*)(ws + (l2 ? WS_WOUT : WS_WGO)), nb * 32, scr, lane); continue; }
        r -= 2 * I_GO;
        { const int nb = r % (D / 32), kb = r / (D / 32);
            tr_item(P.in[17] + nb * 32 + j, D, nullptr, 1.f, kb * 64, 2048, (bf16_t*)(ws + WS_WSO), nb * 32, scr, lane); }
    }
    const float* x = P.in[0]; bf16_t* xb = (bf16_t*)(ws + WS_XB); float* ssq = (float*)(ws + WS_SSQ);
    for (int m = gw; m < MTOK; m += NGW) {
        const f32x4* xr = (const f32x4*)(x + (size_t)m * D) + lane;
        unsigned long long* o8 = (unsigned long long*)(xb + (size_t)m * D) + lane;
        float s = 0.f;
#pragma unroll
        for (int jj = 0; jj < 4; ++jj) { const f32x4 v = xr[64 * jj]; s += v.x * v.x + v.y * v.y + v.z * v.z + v.w * v.w;
            o8[64 * jj] = (unsigned long long)cvt_pk_bf16(v.x, v.y) | ((unsigned long long)cvt_pk_bf16(v.z, v.w) << 32); }
        s = wave_sum(s);
        if (lane == 0) { ssq[m] = s; ssq[MTOK + m] = 0.f; ssq[2 * MTOK + m] = 0.f; ssq[3 * MTOK + m] = 0.f; }
    }
}

__device__ __forceinline__ void p4_prep(KP Pp, LAS unsigned char* lds, int G) {
    const Params P = load_params(Pp);
    const int tid = tid_fresh();
    unsigned char* ws = P.ws; unsigned char* T = ws + WS_BIG;
    const float* sm = (const float*)(ws + WS_SM);
    for (int it = blockIdx.x; it < HB * NCH; it += G) {
        const int row0 = it * 64;
#pragma unroll
        for (int i = 0; i < 2; ++i) { const int idx = tid + 512 * i; *(LAS f32x4*)(lds + idx * 16) = *(const f32x4*)(sm + (size_t)row0 * 64 + idx * 4); }
        __syncthreads();
        {
            const int hc = tid;
            const float* wf = P.in[7]; float w[16];
#pragma unroll
            for (int j = 0; j < 16; ++j) w[j] = wf[j * 512 + hc];
            const float bfv = P.in[8][hc];
            float cum = 0.f;
#pragma unroll 4
            for (int t = 0; t < 64; ++t) { float z = bfv;
#pragma unroll
                for (int j4 = 0; j4 < 4; ++j4) { const f32x4 f = *(const LAS f32x4*)(lds + t * 256 + j4 * 16); z += f.x * w[4 * j4] + f.y * w[4 * j4 + 1] + f.z * w[4 * j4 + 2] + f.w * w[4 * j4 + 3]; }
                cum += (fminf(z, 0.f) - __logf(1.f + __expf(-fabsf(z)))) * (1.f / 16.f); }
            const float end = cum; cum = 0.f;
            bf16_t* kp = (bf16_t*)(T + T_K) + (size_t)row0 * 512 + hc;
            for (int tb = 0; tb < 4; ++tb) {
                bf16_t kk[16];
#pragma unroll
                for (int u = 0; u < 16; ++u) kk[u] = kp[(size_t)(tb * 16 + u) * 512];
#pragma unroll
                for (int u = 0; u < 16; ++u) { const int t = tb * 16 + u; float z = bfv;
#pragma unroll
                    for (int j4 = 0; j4 < 4; ++j4) { const f32x4 f = *(const LAS f32x4*)(lds + t * 256 + j4 * 16); z += f.x * w[4 * j4] + f.y * w[4 * j4 + 1] + f.z * w[4 * j4 + 2] + f.w * w[4 * j4 + 3]; }
                    cum += (fminf(z, 0.f) - __logf(1.f + __expf(-fabsf(z)))) * (1.f / 16.f);
                    const float kv = __uint_as_float((unsigned)kk[u] << 16) * __expf(end - cum);
                    kp[(size_t)t * 512] = (bf16_t)(cvt_pk_bf16(kv, 0.f) & 0xffffu); }
            }
            ((float*)(ws + WS_DEC))[(size_t)it * 512 + hc] = __expf(end);
        }
        if (tid < 32) {
            const float bias = P.in[13][tid], A = -__expf(P.in[14][tid]);
            float cum = 0.f;
#pragma unroll 4
            for (int t = 0; t < 64; ++t) cum += softplusf_(*(const LAS float*)(lds + t * 256 + (16 + tid) * 4) + bias) * A;
            const float end = cum; cum = 0.f;
            float* wg = (float*)(ws + WS_WG);
#pragma unroll 4
            for (int t = 0; t < 64; ++t) { const float dt = softplusf_(*(const LAS float*)(lds + t * 256 + (16 + tid) * 4) + bias); cum += dt * A; wg[(size_t)(row0 + t) * 32 + tid] = __expf(end - cum) * dt; }
            ((float*)(ws + WS_DECS))[it * 32 + tid] = __expf(end);
        }
        __syncthreads();
    }
    const int co = tid & 63, rg = tid >> 6;
    for (int it = blockIdx.x; it < HB * NCH * 8; it += G) {
        const int ci = it >> 3, cb = it & 7, col = cb * 512 + co * 8, row0 = ci * 64 + rg * 8;
        bf16_t* xp = (bf16_t*)(T + T_XBC) + (size_t)row0 * 4096 + col;
        u32x4 raw[11];
#pragma unroll
        for (int i = 0; i < 8; ++i) raw[3 + i] = *(const u32x4*)(xp + (size_t)i * 4096);
        if (rg > 0) {
#pragma unroll
            for (int i = 0; i < 3; ++i) raw[i] = *(const u32x4*)(xp - (size_t)(3 - i) * 4096);
        } else if ((ci & (NCH - 1)) != 0) {
            const bf16_t* hp = (const bf16_t*)(ws + WS_HALO) + (size_t)(ci - 1) * 3 * 4096 + col;
#pragma unroll
            for (int i = 0; i < 3; ++i) raw[i] = *(const u32x4*)(hp + (size_t)i * 4096);
        } else {
#pragma unroll
            for (int i = 0; i < 3; ++i) raw[i] = (u32x4){0u, 0u, 0u, 0u};
        }
        float cw[4][8], cbv[8];
#pragma unroll
        for (int k = 0; k < 4; ++k) { const f32x4 a = *(const f32x4*)(P.in[11] + k * 4096 + col), b = *(const f32x4*)(P.in[11] + k * 4096 + col + 4);
            cw[k][0] = a.x; cw[k][1] = a.y; cw[k][2] = a.z; cw[k][3] = a.w; cw[k][4] = b.x; cw[k][5] = b.y; cw[k][6] = b.z; cw[k][7] = b.w; }
        { const f32x4 a = *(const f32x4*)(P.in[12] + col), b = *(const f32x4*)(P.in[12] + col + 4);
            cbv[0] = a.x; cbv[1] = a.y; cbv[2] = a.z; cbv[3] = a.w; cbv[4] = b.x; cbv[5] = b.y; cbv[6] = b.z; cbv[7] = b.w; }
        asm volatile("s_waitcnt vmcnt(0)" ::: "memory");
        __syncthreads();
#pragma unroll
        for (int i = 0; i < 8; ++i) {
            float v[8];
#pragma unroll
            for (int e = 0; e < 8; ++e) v[e] = cbv[e];
#pragma unroll
            for (int k = 0; k < 4; ++k) { const u32x4 q = raw[i + k];
                v[0] += cw[k][0] * bf_lo(q.x); v[1] += cw[k][1] * bf_hi(q.x); v[2] += cw[k][2] * bf_lo(q.y); v[3] += cw[k][3] * bf_hi(q.y);
                v[4] += cw[k][4] * bf_lo(q.z); v[5] += cw[k][5] * bf_hi(q.z); v[6] += cw[k][6] * bf_lo(q.w); v[7] += cw[k][7] * bf_hi(q.w); }
#pragma unroll
            for (int e = 0; e < 8; ++e) v[e] = siluf_(v[e]);
            u32x4 w; w.x = cvt_pk_bf16(v[0], v[1]); w.y = cvt_pk_bf16(v[2], v[3]); w.z = cvt_pk_bf16(v[4], v[5]); w.w = cvt_pk_bf16(v[6], v[7]);
            *(u32x4*)(xp + (size_t)i * 4096) = w;
        }
        __syncthreads();
    }
}

struct MixArgs {
    const bf16_t* ak; int ld_ak;
    const bf16_t* qq; int ld_q;
    const bf16_t* bv; int ld_bv;
    const bf16_t* gt; int ld_g;
    bf16_t* out; int ld_o;
    const float* dec;
    const float* wg;
    const float* nw;
    const float* dsk;
};
constexpr int RSA = 320, RSB = 576, RSQ = 264;
constexpr int OFF_AK = 0, OFF_BV = 64 * RSA, OFF_QQ = OFF_BV + 64 * RSB, OFF_WGT = OFF_QQ + 64 * RSQ, OFF_DEC = OFF_WGT + 1024, OFF_RED = OFF_DEC + 512, OFF_NW = OFF_RED + 2048;
static_assert(OFF_NW + 1024 <= LDS_BYTES, "mixer LDS");

#define LBAR() do { asm volatile("s_waitcnt lgkmcnt(0)" ::: "memory"); __builtin_amdgcn_s_barrier(); asm volatile("" ::: "memory"); } while (0)
template <bool SSD>
__device__ __forceinline__ void mixer_item(LAS unsigned char* lds, const MixArgs& a) {
    const int tid = tid_fresh(), lane = tid & 63, w = __builtin_amdgcn_readfirstlane(tid >> 6);
    const int r = lane & 31, h = lane >> 5, gg = lane >> 4, q = (lane & 15) >> 2, p = lane & 3;
    const int arow0 = tid >> 4, apc = tid & 15;
    const int brow0 = tid >> 5, bpc = tid & 31;
    u32x4 stA[2], stQ[2], stB[4], stW, stD;
    stW = (u32x4){0u, 0u, 0u, 0u}; stD = stW;
#define MIX_LOAD(c) do { const size_t _r0 = (size_t)(c) * 64; \
        _Pragma("unroll") for (int i = 0; i < 2; ++i) { stA[i] = *(const u32x4*)(a.ak + (_r0 + arow0 + 32 * i) * a.ld_ak + apc * 8); stQ[i] = *(const u32x4*)(a.qq + (_r0 + arow0 + 32 * i) * a.ld_q + apc * 8); } \
        _Pragma("unroll") for (int i = 0; i < 4; ++i) stB[i] = *(const u32x4*)(a.bv + (_r0 + brow0 + 16 * i) * a.ld_bv + bpc * 8); \
        if (SSD) { if (tid < 64) stW = *(const u32x4*)(a.wg + (_r0 + tid) * 32); } \
        else { if (tid < 32) stD = *(const u32x4*)(a.dec + (size_t)(c) * 512 + tid * 4); } } while (0)
#define MIX_STORE() do { \
        _Pragma("unroll") for (int i = 0; i < 2; ++i) { *(LAS u32x4*)(lds + OFF_AK + (arow0 + 32 * i) * RSA + apc * 16) = stA[i]; \
            *(LAS u32x2*)(lds + OFF_QQ + (arow0 + 32 * i) * RSQ + apc * 16) = (u32x2){stQ[i].x, stQ[i].y}; *(LAS u32x2*)(lds + OFF_QQ + (arow0 + 32 * i) * RSQ + apc * 16 + 8) = (u32x2){stQ[i].z, stQ[i].w}; } \
        _Pragma("unroll") for (int i = 0; i < 4; ++i) *(LAS u32x4*)(lds + OFF_BV + (brow0 + 16 * i) * RSB + bpc * 16) = stB[i]; \
        if (SSD) { if (tid < 64) *(LAS u32x4*)(lds + OFF_WGT + tid * 16) = stW; } \
        else { if (tid < 32) *(LAS u32x4*)(lds + OFF_DEC + tid * 16) = stD; } } while (0)

    if (tid < 256) *(LAS float*)(lds + OFF_NW + tid * 4) = a.nw[tid];
    MIX_LOAD(0);
    MIX_STORE();
    __syncthreads();

    f32x16 S[4];
#pragma unroll
    for (int i = 0; i < 4; ++i)
#pragma unroll
        for (int e = 0; e < 16; ++e) S[i][e] = 0.f;

    const int trA = OFF_AK + (8 * h + q) * RSA + (16 * (gg & 1) + 4 * p) * 2;
    const int trB = OFF_BV + (8 * h + q) * RSB + (32 * w + 16 * (gg & 1) + 4 * p) * 2;
    const int qB = OFF_QQ + r * RSQ + 8 * h;
    const float dsk = SSD ? a.dsk[w >> 1] : 0.f;

    for (int c = 0; c < NCH; ++c) {
        if (c + 1 < NCH) MIX_LOAD(c + 1);
        u32x2 gv[2][4];
#pragma unroll
        for (int j2 = 0; j2 < 2; ++j2)
#pragma unroll
            for (int g = 0; g < 4; ++g) gv[j2][g] = *(const u32x2*)(a.gt + ((size_t)c * 64 + 32 * j2 + r) * a.ld_g + 32 * w + 8 * g + 4 * h);
        if (SSD) {
            const float dc = a.dec[(size_t)c * 32 + (w >> 1)];
#pragma unroll
            for (int i = 0; i < 4; ++i)
#pragma unroll
                for (int e = 0; e < 16; ++e) S[i][e] *= dc;
        } else {
#pragma unroll
            for (int i = 0; i < 4; ++i)
#pragma unroll
                for (int g = 0; g < 4; ++g) { const f32x4 d4 = *(const LAS f32x4*)(lds + OFF_DEC + (32 * i + 8 * g + 4 * h) * 4);
                    S[i][4 * g + 0] *= d4.x; S[i][4 * g + 1] *= d4.y; S[i][4 * g + 2] *= d4.z; S[i][4 * g + 3] *= d4.w; }
        }
#pragma unroll
        for (int s = 0; s < 4; ++s) {
            const s16x4 b0 = __builtin_bit_cast(s16x4, __builtin_amdgcn_ds_read_tr16_b64_v4i16((LAS s16x4*)(lds + trB + (16 * s) * RSB)));
            const s16x4 b1 = __builtin_bit_cast(s16x4, __builtin_amdgcn_ds_read_tr16_b64_v4i16((LAS s16x4*)(lds + trB + (16 * s + 4) * RSB)));
            bf16x8 bfr = __builtin_shufflevector(b0, b1, 0, 1, 2, 3, 4, 5, 6, 7);
            if (SSD) {
                u32x4 bu = __builtin_bit_cast(u32x4, bfr);
                float wt[8];
#pragma unroll
                for (int j = 0; j < 8; ++j) wt[j] = *(const LAS float*)(lds + OFF_WGT + (16 * s + 8 * h + j) * 16 + (w >> 1) * 4);
                bu.x = cvt_pk_bf16(bf_lo(bu.x) * wt[0], bf_hi(bu.x) * wt[1]); bu.y = cvt_pk_bf16(bf_lo(bu.y) * wt[2], bf_hi(bu.y) * wt[3]);
                bu.z = cvt_pk_bf16(bf_lo(bu.z) * wt[4], bf_hi(bu.z) * wt[5]); bu.w = cvt_pk_bf16(bf_lo(bu.w) * wt[6], bf_hi(bu.w) * wt[7]);
                bfr = __builtin_bit_cast(bf16x8, bu);
            }
#pragma unroll
            for (int i = 0; i < 4; ++i) {
                const s16x4 a0 = __builtin_bit_cast(s16x4, __builtin_amdgcn_ds_read_tr16_b64_v4i16((LAS s16x4*)(lds + trA + (16 * s) * RSA + 64 * i)));
                const s16x4 a1 = __builtin_bit_cast(s16x4, __builtin_amdgcn_ds_read_tr16_b64_v4i16((LAS s16x4*)(lds + trA + (16 * s + 4) * RSA + 64 * i)));
                const bf16x8 afr = __builtin_shufflevector(a0, a1, 0, 1, 2, 3, 4, 5, 6, 7);
                S[i] = __builtin_amdgcn_mfma_f32_32x32x16_bf16(afr, bfr, S[i], 0, 0, 0);
            }
        }
        f32x16 OT[2];
#pragma unroll
        for (int j2 = 0; j2 < 2; ++j2)
#pragma unroll
            for (int e = 0; e < 16; ++e) OT[j2][e] = 0.f;
#pragma unroll
        for (int sp = 0; sp < 8; ++sp) {
            const int i = sp >> 1, o8 = 8 * (sp & 1);
            u32x4 pk;
            pk.x = cvt_pk_bf16(S[i][o8 + 0], S[i][o8 + 1]); pk.y = cvt_pk_bf16(S[i][o8 + 2], S[i][o8 + 3]);
            pk.z = cvt_pk_bf16(S[i][o8 + 4], S[i][o8 + 5]); pk.w = cvt_pk_bf16(S[i][o8 + 6], S[i][o8 + 7]);
            const bf16x8 sfr = __builtin_bit_cast(bf16x8, pk);
#pragma unroll
            for (int j2 = 0; j2 < 2; ++j2) {
                const u32x2 q0 = *(const LAS u32x2*)(lds + qB + 32 * j2 * RSQ + (16 * sp) * 2);
                const u32x2 q1 = *(const LAS u32x2*)(lds + qB + 32 * j2 * RSQ + (16 * sp + 8) * 2);
                const bf16x8 qfr = __builtin_bit_cast(bf16x8, (u32x4){q0.x, q0.y, q1.x, q1.y});
                OT[j2] = __builtin_amdgcn_mfma_f32_32x32x16_bf16(sfr, qfr, OT[j2], 0, 0, 0);
            }
        }
        float part[2] = {0.f, 0.f};
#pragma unroll
        for (int j2 = 0; j2 < 2; ++j2)
#pragma unroll
            for (int g = 0; g < 4; ++g) {
                if (SSD) {
                    const u32x2 xs = *(const LAS u32x2*)(lds + OFF_BV + (32 * j2 + r) * RSB + (32 * w + 8 * g + 4 * h) * 2);
                    OT[j2][4 * g + 0] = (OT[j2][4 * g + 0] + dsk * bf_lo(xs.x)) * bf_lo(gv[j2][g].x);
                    OT[j2][4 * g + 1] = (OT[j2][4 * g + 1] + dsk * bf_hi(xs.x)) * bf_hi(gv[j2][g].x);
                    OT[j2][4 * g + 2] = (OT[j2][4 * g + 2] + dsk * bf_lo(xs.y)) * bf_lo(gv[j2][g].y);
                    OT[j2][4 * g + 3] = (OT[j2][4 * g + 3] + dsk * bf_hi(xs.y)) * bf_hi(gv[j2][g].y);
                }
#pragma unroll
                for (int k = 0; k < 4; ++k) part[j2] += OT[j2][4 * g + k] * OT[j2][4 * g + k];
            }
        part[0] += __shfl_xor(part[0], 32); part[1] += __shfl_xor(part[1], 32);
        if (h == 0) { *(LAS float*)(lds + OFF_RED + (w * 64 + r) * 4) = part[0]; *(LAS float*)(lds + OFF_RED + (w * 64 + 32 + r) * 4) = part[1]; }
        LBAR();
#pragma unroll
        for (int j2 = 0; j2 < 2; ++j2) {
            float tot = 0.f;
#pragma unroll
            for (int ww = 0; ww < 8; ++ww) tot += *(const LAS float*)(lds + OFF_RED + (ww * 64 + 32 * j2 + r) * 4);
            const float rstd = rsqrtf(tot * (1.f / 256.f) + EPS);
#pragma unroll
            for (int g = 0; g < 4; ++g) {
                const f32x4 n4 = *(const LAS f32x4*)(lds + OFF_NW + (32 * w + 8 * g + 4 * h) * 4);
                float v0 = OT[j2][4 * g + 0] * rstd * n4.x, v1 = OT[j2][4 * g + 1] * rstd * n4.y, v2 = OT[j2][4 * g + 2] * rstd * n4.z, v3 = OT[j2][4 * g + 3] * rstd * n4.w;
                if (!SSD) { v0 *= bf_lo(gv[j2][g].x); v1 *= bf_hi(gv[j2][g].x); v2 *= bf_lo(gv[j2][g].y); v3 *= bf_hi(gv[j2][g].y); }
                *(u32x2*)(a.out + ((size_t)c * 64 + 32 * j2 + r) * a.ld_o + 32 * w + 8 * g + 4 * h) = (u32x2){cvt_pk_bf16(v0, v1), cvt_pk_bf16(v2, v3)};
            }
        }
        LBAR();
        if (c + 1 < NCH) MIX_STORE();
        LBAR();
    }
#undef MIX_LOAD
#undef MIX_STORE
}

__device__ __forceinline__ void p5_mixer(KP Pp, LAS unsigned char* lds, int G) {
    const Params P = load_params(Pp);
    unsigned char* ws = P.ws; unsigned char* T = ws + WS_BIG;
    for (int it = blockIdx.x; it < HB * 12; it += G) {
        const int b = it / 12, k = it % 12;
        const size_t row0 = (size_t)b * SEQ;
        MixArgs a;
        if (k < 4) {
            const int hd = k;
            a.ak = (const bf16_t*)(T + T_K) + row0 * 512 + hd * 128; a.ld_ak = 512;
            a.qq = (const bf16_t*)(T + T_Q) + row0 * 512 + hd * 128; a.ld_q = 512;
            a.bv = (const bf16_t*)(T + T_V) + row0 * 1024 + hd * 256; a.ld_bv = 1024;
            a.gt = (const bf16_t*)(T + T_SG) + row0 * 1024 + hd * 256; a.ld_g = 1024;
            a.out = (bf16_t*)(T + T_V) + row0 * 1024 + hd * 256; a.ld_o = 1024;
            a.dec = (const float*)(ws + WS_DEC) + (size_t)b * NCH * 512 + hd * 128;
            a.wg = nullptr; a.nw = P.in[9]; a.dsk = nullptr;
            mixer_item<false>(lds, a);
        } else {
            const int g = k - 4;
            const bf16_t* X = (const bf16_t*)(T + T_XBC) + row0 * 4096;
            a.ak = X + 2048 + g * 128; a.ld_ak = 4096;
            a.qq = X + 3072 + g * 128; a.ld_q = 4096;
            a.bv = X + g * 256; a.ld_bv = 4096;
            a.gt = (const bf16_t*)(T + T_SZ) + row0 * 2048 + g * 256; a.ld_g = 2048;
            a.out = (bf16_t*)(T + T_XBC) + row0 * 4096 + g * 256; a.ld_o = 4096;
            a.dec = (const float*)(ws + WS_DECS) + (size_t)b * NCH * 32 + g * 4;
            a.wg = (const float*)(ws + WS_WG) + row0 * 32 + g * 4;
            a.nw = P.in[16] + g * 256; a.dsk = P.in[15] + g * 4;
            mixer_item<true>(lds, a);
        }
        __syncthreads();
    }
}

__device__ __forceinline__ KP get_params() {
    KP p = (KP)__builtin_amdgcn_kernarg_segment_ptr(); asm volatile("" : "+s"(p)); return p;
}
#define PROBE_MASK 0x0
#define PROBE_DSYNC 0
#if PROBE_MASK
#define PH_BEGIN(i) const unsigned long long _t##i = __builtin_amdgcn_s_memrealtime();
#define PH_END(i) if ((PROBE_MASK >> (i)) & 1) probe_acc += __builtin_amdgcn_s_memrealtime() - _t##i;
#else
#define PH_BEGIN(i)
#define PH_END(i)
#endif
#if PROBE_DSYNC
#define GSYNC() do { grid.sync(); grid.sync(); } while (0)
#else
#define GSYNC() grid.sync()
#endif
__global__ void __launch_bounds__(512, 2) fwd_megakernel(Params Parg) {
    extern __shared__ __attribute__((aligned(16))) unsigned char lds_raw[];
    LAS unsigned char* lds = (LAS unsigned char*)lds_raw;
    cg::grid_group grid = cg::this_grid();
    const int G = gridDim.x;
    pg8::StaticOrder S;
#if PROBE_MASK
    unsigned long long probe_acc = 0;
#endif

    { PH_BEGIN(0) p0_prologue(get_params(), lds, G);
    GSYNC(); PH_END(0) }
    { PH_BEGIN(1) { KP P = get_params(); unsigned char* ws = P->ws;
      pg8::Gemm g{(const bf16_t*)(ws + WS_XB), (const bf16_t*)(ws + WS_WGU1), MTOK, NGU, D, D, D}; S.init(MTOK, NGU, G, blockIdx.x);
      EpiGU E{(const float*)(ws + WS_SSQ), (bf16_t*)(ws + WS_BIG)}; pg8::gemm_phase(lds, g, S, E); }
    GSYNC(); PH_END(1) }
    { PH_BEGIN(2) { KP P = get_params(); unsigned char* ws = P->ws;
      pg8::Gemm g{(const bf16_t*)(ws + WS_BIG), (const bf16_t*)(ws + WS_WD1), MTOK, D, DFF, DFF, DFF}; S.init(MTOK, D, G, blockIdx.x);
      EpiRes E{P->in[0], P->out, (bf16_t*)(ws + WS_XB), (float*)(ws + WS_SSQ) + MTOK, 0.5f}; pg8::gemm_phase(lds, g, S, E); }
    GSYNC(); PH_END(2) }
    for (int hf = 0; hf < 2; ++hf) {
        const size_t r0 = (size_t)hf * MH;
        { PH_BEGIN(3) { KP P = get_params(); unsigned char* ws = P->ws;
          pg8::Gemm g{(const bf16_t*)(ws + WS_XB) + r0 * D, (const bf16_t*)(ws + WS_WIN), MH, NIN, D, D, D}; S.init(MH, NIN, G, blockIdx.x);
          EpiIn E{(const float*)(ws + WS_SSQ) + MTOK + r0, ws + WS_BIG, (bf16_t*)(ws + WS_HALO), (float*)(ws + WS_SM)}; pg8::gemm_phase(lds, g, S, E); }
        GSYNC(); PH_END(3) }
        { PH_BEGIN(4) p4_prep(get_params(), lds, G);
        GSYNC(); PH_END(4) }
        { PH_BEGIN(5) p5_mixer(get_params(), lds, G);
        GSYNC(); PH_END(5) }
        { PH_BEGIN(6) { KP P = get_params(); unsigned char* ws = P->ws; unsigned char* T = ws + WS_BIG;
          pg8::Gemm g{(const bf16_t*)(T + T_V), (const bf16_t*)(ws + WS_WGO), MH, D, D, D, D}; S.init(MH, D, G, blockIdx.x);
          EpiGate E{(const bf16_t*)(T + T_GT), nullptr, (bf16_t*)(T + T_T1), 0}; pg8::gemm_phase(lds, g, S, E); }
        { KP P = get_params(); unsigned char* ws = P->ws; unsigned char* T = ws + WS_BIG;
          pg8::Gemm g{(const bf16_t*)(T + T_XBC), (const bf16_t*)(ws + WS_WSO), MH, D, 2048, 4096, 2048}; S.init(MH, D, G, blockIdx.x);
          EpiGate E{(const bf16_t*)(T + T_GT), (const bf16_t*)(T + T_T1), (bf16_t*)(T + T_MRG), 1}; pg8::gemm_phase(lds, g, S, E); }
        GSYNC(); PH_END(6) }
        { PH_BEGIN(7) { KP P = get_params(); unsigned char* ws = P->ws;
          pg8::Gemm g{(const bf16_t*)(ws + WS_BIG + T_MRG), (const bf16_t*)(ws + WS_WOUT), MH, D, D, D, D}; S.init(MH, D, G, blockIdx.x);
          EpiRes E{P->out + r0 * D, P->out + r0 * D, (bf16_t*)(ws + WS_XB) + r0 * D, (float*)(ws + WS_SSQ) + 2 * MTOK + r0, 1.0f}; pg8::gemm_phase(lds, g, S, E); }
        GSYNC(); PH_END(7) }
    }
    { PH_BEGIN(8) { KP P = get_params(); unsigned char* ws = P->ws;
      pg8::Gemm g{(const bf16_t*)(ws + WS_XB), (const bf16_t*)(ws + WS_WGU2), MTOK, NGU, D, D, D}; S.init(MTOK, NGU, G, blockIdx.x);
      EpiGU E{(const float*)(ws + WS_SSQ) + 2 * MTOK, (bf16_t*)(ws + WS_BIG)}; pg8::gemm_phase(lds, g, S, E); }
    GSYNC(); PH_END(8) }
    { PH_BEGIN(9) { KP P = get_params(); unsigned char* ws = P->ws;
      pg8::Gemm g{(const bf16_t*)(ws + WS_BIG), (const bf16_t*)(ws + WS_WD2), MTOK, D, DFF, DFF, DFF}; S.init(MTOK, D, G, blockIdx.x);
      EpiRes E{P->out, P->out, nullptr, (float*)(ws + WS_SSQ) + 3 * MTOK, 0.5f}; pg8::gemm_phase(lds, g, S, E); }
    GSYNC(); PH_END(9) }
    { PH_BEGIN(10)
    {
        KP P = get_params(); const float* ssq = (const float*)(P->ws + WS_SSQ) + 3 * MTOK;
        const int tid = tid_fresh(), lane = tid & 63, gw = blockIdx.x * 8 + (tid >> 6), NGW = G * 8;
        const float* fw = P->in[23]; float* outp = P->out;
        for (int m = gw; m < MTOK; m += NGW) {
            const float rstd = rsqrtf(ssq[m] * (1.f / D) + EPS);
            f32x4* xr = (f32x4*)(outp + (size_t)m * D) + lane;
#pragma unroll
            for (int jj = 0; jj < 4; ++jj) { const f32x4 wv = ((const f32x4*)fw)[lane + 64 * jj]; f32x4 v = xr[64 * jj]; v = v * rstd; v.x *= wv.x; v.y *= wv.y; v.z *= wv.z; v.w *= wv.w; xr[64 * jj] = v; }
        }
    }
    PH_END(10) }
#if PROBE_MASK
    if (blockIdx.x == 0) {
        const unsigned long long t0 = __builtin_amdgcn_s_memrealtime();
        while (__builtin_amdgcn_s_memrealtime() - t0 < probe_acc) __builtin_amdgcn_s_sleep(8);
    }
#endif
}

extern "C" void kernel_launch(void* const* d_in, const int* in_sizes, int n_in, void* d_out, int out_size, void* d_ws, size_t ws_size, hipStream_t stream) {
    static int grid = 0;
    if (grid == 0) {
        if (n_in != 24 || ws_size < WS_NEED) { fprintf(stderr, "kernel_launch: unexpected n_in %d or ws_size %zu (need %zu)\n", n_in, ws_size, (size_t)WS_NEED); grid = -1; return; }
        int dev = 0, cus = 0, per_cu = 0;
        hipGetDevice(&dev);
        hipDeviceGetAttribute(&cus, hipDeviceAttributeMultiprocessorCount, dev);
        hipFuncSetAttribute((const void*)fwd_megakernel, hipFuncAttributeMaxDynamicSharedMemorySize, LDS_BYTES);
        hipOccupancyMaxActiveBlocksPerMultiprocessor(&per_cu, (const void*)fwd_megakernel, 512, LDS_BYTES);
        if (per_cu < 1) { fprintf(stderr, "kernel_launch: occupancy query gave %d\n", per_cu); per_cu = 1; }
        grid = cus * per_cu;
        (void)hipGetLastError();
    }
    if (grid < 0) return;
    Params p{};
    for (int i = 0; i < 24; ++i) p.in[i] = (const float*)d_in[i];
    p.out = (float*)d_out; p.ws = (unsigned char*)d_ws;
    void* args[] = {&p};
    hipError_t e = hipLaunchCooperativeKernel((const void*)fwd_megakernel, dim3(grid), dim3(512), args, LDS_BYTES, stream);
    if (e != hipSuccess) fprintf(stderr, "cooperative launch failed: %s (grid %d)\n", hipGetErrorString(e), grid);
}
```

```cpp
#include <hip/hip_runtime.h>
#include <hip/hip_cooperative_groups.h>
#include <cstdio>
#include <cstdint>
namespace cg = cooperative_groups;

#define LAS __attribute__((address_space(3)))
typedef unsigned short bf16_t;
typedef short bf16x8 __attribute__((ext_vector_type(8)));
typedef short s16x4 __attribute__((ext_vector_type(4)));
typedef float f32x4 __attribute__((ext_vector_type(4)));
typedef float f32x16 __attribute__((ext_vector_type(16)));
typedef unsigned u32x4 __attribute__((ext_vector_type(4)));
typedef unsigned u32x2 __attribute__((ext_vector_type(2)));

constexpr int D = 1024, BATCH = 32, SEQ = 2048, MTOK = BATCH * SEQ;
constexpr int NCH = SEQ / 64;
constexpr int DFF = 2816, NGU = 2 * DFF;
constexpr int IN_DIM = 11312, NIN = 45 * 256;
constexpr int HB = 16, MH = HB * SEQ;
constexpr float EPS = 1e-6f;

constexpr size_t MiB = 1u << 20;
constexpr size_t WS_SSQ = 0;
constexpr size_t WS_WGU1 = 1 * MiB, WS_WD1 = 12 * MiB, WS_WIN = 18 * MiB, WS_WGO = 41 * MiB, WS_WSO = 43 * MiB, WS_WOUT = 47 * MiB, WS_WGU2 = 49 * MiB, WS_WD2 = 60 * MiB;
constexpr size_t WS_DEC = 66 * MiB, WS_DECS = 67 * MiB, WS_WG = 68 * MiB, WS_HALO = 72 * MiB, WS_SM = 84 * MiB;
constexpr size_t WS_BAR = 92 * MiB;
constexpr size_t WS_XB = 96 * MiB;
constexpr size_t WS_BIG = 224 * MiB;
constexpr size_t T_Q = 0, T_K = 32 * MiB, T_V = 64 * MiB, T_SG = 128 * MiB, T_SZ = 192 * MiB, T_XBC = 320 * MiB, T_GT = 576 * MiB, T_END = 704 * MiB;
constexpr size_t T_T1 = T_Q, T_MRG = T_SG;
constexpr size_t WS_NEED = WS_BIG + T_END;

constexpr int LDS_MAIN = 131072, LDS_BYTES = LDS_MAIN + 64;

__device__ __forceinline__ unsigned cvt_pk_bf16(float lo, float hi) { unsigned r; asm volatile("v_cvt_pk_bf16_f32 %0, %1, %2" : "=v"(r) : "v"(lo), "v"(hi)); return r; }
__device__ __forceinline__ float bf_lo(unsigned u) { return __uint_as_float(u << 16); }
__device__ __forceinline__ float bf_hi(unsigned u) { return __uint_as_float(u & 0xffff0000u); }
__device__ __forceinline__ float fast_rcp(float x) { return __builtin_amdgcn_rcpf(x); }
__device__ __forceinline__ float sigmoidf_(float x) { return fast_rcp(1.f + __expf(-x)); }
__device__ __forceinline__ float siluf_(float x) { return x * sigmoidf_(x); }
__device__ __forceinline__ float softplusf_(float x) { return fmaxf(x, 0.f) + __logf(1.f + __expf(-fabsf(x))); }
__device__ __forceinline__ float wave_sum(float v) {
#pragma unroll
    for (int o = 1; o < 64; o <<= 1) v += __shfl_xor(v, o);
    return v;
}

namespace pg8 {
constexpr int BM = 256, BK = 64, HALF = 128, HTB = HALF * BK * 2, STAGE_BYTES = 8 * HTB, NXCD = 8, WGM = 8;
__host__ __device__ __forceinline__ int lds_byte(int r, int c) { const int st = (r >> 4) * 2 + (c >> 5), rr = r & 15, cc = c & 31, ob = rr * 64 + cc * 2; return st * 1024 + (ob ^ (((ob >> 9) & 1) << 5)); }
__host__ __device__ __forceinline__ void stage_rc(int b, int& R, int& C) { const int st = b / 1024, sb = b % 1024, swz = sb ^ (((sb >> 9) & 1) << 5); R = (st >> 1) * 16 + swz / 64; C = (st & 1) * 32 + (swz % 64) / 2; }
__host__ __device__ __forceinline__ int perm32(int rho) { const int n = rho >> 4, i = rho & 15; return 8 * (i >> 2) + 4 * n + (i & 3); }

struct Unit { int pm, pn; };
struct Gemm { const bf16_t* A; const bf16_t* Bt; int M, N, K, lda, ldb; };

struct StaticOrder {
    int nM, nN, nwg, G, c;
    __device__ void init(int M, int N, int G_, int c_) { nM = M / BM; nN = N / BM; nwg = nM * nN; G = G_; c = c_; }
    __device__ bool next(int i, Unit& u) const {
        const long L = (long)i * G + c; if (L >= nwg) return false;
        int wgid = (int)L; { const int q = nwg / NXCD, r = nwg % NXCD, xcd = wgid % NXCD, off = wgid / NXCD; wgid = (xcd < r ? xcd * (q + 1) : r * (q + 1) + (xcd - r) * q) + off; }
        const int nig = WGM * nN, gid = wgid / nig, fm = gid * WGM, gsz = (nM - fm) < WGM ? (nM - fm) : WGM;
        u.pm = fm + ((wgid % nig) % gsz); u.pn = (wgid % nig) / gsz; return true;
    }
};

template <class Epi>
__device__ __forceinline__ void gemm_phase(LAS unsigned char* lds, const Gemm g, const StaticOrder& S, const Epi& E) {
    int tid = threadIdx.x; asm volatile("" : "+v"(tid));
    const int wid = __builtin_amdgcn_readfirstlane(tid >> 6), lane = tid & 63, wr = wid >> 2, wc = wid & 3, fr = lane & 15, fq = lane >> 4;
    const int K = g.K, nt = K / BK;
    unsigned voffA[2], voffB[2];
#pragma unroll
    for (int i = 0; i < 2; ++i) { int R, C; stage_rc(tid * 16 + i * 8192, R, C); const int Rb = (R & ~31) + perm32(R & 31);
        voffA[i] = (unsigned)(R * g.lda + C) * 2u; voffB[i] = (unsigned)(Rb * g.ldb + C) * 2u; }
    const size_t kstep = (size_t)(BK * 2);
    const size_t hstA = (size_t)HALF * g.lda * 2, hstB = (size_t)HALF * g.ldb * 2;
    const size_t tstA = 2 * hstA, tstB = 2 * hstB;
    const unsigned ldsw = (unsigned)wid * 1024u;
    const int aoff = lds_byte(wr * 64 + fr, fq * 8), boff = lds_byte(wc * 32 + fr, fq * 8);
#define PG8_SA(b, h) (((b) * 2 + (h)) * HTB)
#define PG8_SB(b, h) ((4 + (b) * 2 + (h)) * HTB)
#define PG8_STAGE(bufoff, gbase, voff) do { _Pragma("unroll") for (int _i = 0; _i < 2; ++_i) \
        __builtin_amdgcn_global_load_lds((const unsigned*)((const char*)(gbase) + (voff)[_i]), (LAS unsigned*)(lds + (bufoff) + ldsw + _i * 8192), 16, 0, 0); } while (0)
#define PG8_LDA(dst, b, h) do { _Pragma("unroll") for (int m = 0; m < 4; ++m) _Pragma("unroll") for (int k = 0; k < 2; ++k) dst[m][k] = *(const LAS bf16x8*)(lds + PG8_SA(b, h) + aoff + m * 2048 + k * 1024); } while (0)
#define PG8_LDB(dst, b, h) do { _Pragma("unroll") for (int n = 0; n < 2; ++n) _Pragma("unroll") for (int k = 0; k < 2; ++k) dst[n][k] = *(const LAS bf16x8*)(lds + PG8_SB(b, h) + boff + n * 2048 + k * 1024); } while (0)
#define PG8_MMA(ai, bj, At, Bt) do { __builtin_amdgcn_s_setprio(1); _Pragma("unroll") for (int m = 0; m < 4; ++m) _Pragma("unroll") for (int n = 0; n < 2; ++n) _Pragma("unroll") for (int k = 0; k < 2; ++k) \
        acc[ai][bj][m][n] = __builtin_amdgcn_mfma_f32_16x16x32_bf16(Bt[n][k], At[m][k], acc[ai][bj][m][n], 0, 0, 0); __builtin_amdgcn_s_setprio(0); } while (0)
#define PG8_WAIT_V(n) asm volatile("s_waitcnt vmcnt(" #n ")" ::: "memory")
#define PG8_WAIT_L(n) asm volatile("s_waitcnt lgkmcnt(" #n ")" ::: "memory")
#define PG8_BAR __builtin_amdgcn_s_barrier()
#define PG8_SCHED __builtin_amdgcn_sched_barrier(0)
    Unit cur, nxt; int ui = 0;
    if (!S.next(0, cur)) return;
    f32x4 acc[2][2][4][2];
#pragma unroll
    for (int a = 0; a < 2; ++a)
#pragma unroll
        for (int b = 0; b < 2; ++b)
#pragma unroll
            for (int m = 0; m < 4; ++m)
#pragma unroll
                for (int n = 0; n < 2; ++n) acc[a][b][m][n] = (f32x4){0.f, 0.f, 0.f, 0.f};
    bf16x8 At[4][2], B0[2][2], B1[2][2];
    const char* cA = (const char*)g.A + (size_t)cur.pm * tstA; const char* cB = (const char*)g.Bt + (size_t)cur.pn * tstB;
    PG8_STAGE(PG8_SB(0, 0), cB, voffB); PG8_STAGE(PG8_SA(0, 0), cA, voffA); PG8_STAGE(PG8_SB(0, 1), cB + hstB, voffB); PG8_STAGE(PG8_SA(0, 1), cA + hstA, voffA);
    if (wr == 1) PG8_BAR;
    PG8_WAIT_V(4); PG8_BAR;
    PG8_STAGE(PG8_SB(1, 0), cB + kstep, voffB); PG8_STAGE(PG8_SA(1, 0), cA + kstep, voffA); PG8_STAGE(PG8_SB(1, 1), cB + hstB + kstep, voffB);
    PG8_WAIT_V(6); PG8_BAR;
    for (;;) {
        const bool has_next = S.next(ui + 1, nxt);
        const char* nA = has_next ? (const char*)g.A + (size_t)nxt.pm * tstA : cA; const char* nB = has_next ? (const char*)g.Bt + (size_t)nxt.pn * tstB : cB;
        for (int t = 0; t < nt; t += 2) {
            const bool last = (t == nt - 2);
            const char* a1 = cA + (size_t)(t + 1) * kstep;
            const char* a2 = last ? nA : cA + (size_t)(t + 2) * kstep; const char* b2 = last ? nB : cB + (size_t)(t + 2) * kstep;
            const char* a3 = a2 + kstep; const char* b3 = b2 + kstep;
            PG8_LDB(B0, 0, 0); PG8_SCHED; PG8_LDA(At, 0, 0); PG8_STAGE(PG8_SA(1, 1), a1 + hstA, voffA);
            PG8_WAIT_L(8); PG8_BAR; PG8_WAIT_L(0); PG8_MMA(0, 0, At, B0); PG8_BAR; PG8_SCHED;
            PG8_LDB(B1, 0, 1); PG8_STAGE(PG8_SB(0, 0), b2, voffB);
            PG8_BAR; PG8_WAIT_L(0); PG8_MMA(0, 1, At, B1); PG8_BAR;
            PG8_LDA(At, 0, 1); PG8_STAGE(PG8_SA(0, 0), a2, voffA);
            PG8_BAR; PG8_WAIT_L(0); PG8_MMA(1, 0, At, B0); PG8_BAR; PG8_SCHED;
            PG8_STAGE(PG8_SB(0, 1), b2 + hstB, voffB);
            PG8_WAIT_V(6); PG8_BAR; PG8_MMA(1, 1, At, B1); PG8_BAR;
            PG8_LDB(B0, 1, 0); PG8_SCHED; PG8_LDA(At, 1, 0); PG8_STAGE(PG8_SA(0, 1), a2 + hstA, voffA);
            PG8_WAIT_L(8); PG8_BAR; PG8_WAIT_L(0); PG8_MMA(0, 0, At, B0); PG8_BAR; PG8_SCHED;
            PG8_LDB(B1, 1, 1); PG8_STAGE(PG8_SB(1, 0), b3, voffB);
            PG8_BAR; PG8_WAIT_L(0); PG8_MMA(0, 1, At, B1); PG8_BAR;
            PG8_LDA(At, 1, 1); PG8_STAGE(PG8_SA(1, 0), a3, voffA);
            PG8_BAR; PG8_WAIT_L(0); PG8_MMA(1, 0, At, B0); PG8_BAR; PG8_SCHED;
            PG8_STAGE(PG8_SB(1, 1), b3 + hstB, voffB);
            PG8_WAIT_V(6); PG8_BAR; PG8_MMA(1, 1, At, B1); PG8_BAR;
        }
        E(acc, cur, wr, wc, fr, fq);
        if (!has_next) break;
#pragma unroll
        for (int a = 0; a < 2; ++a)
#pragma unroll
            for (int b = 0; b < 2; ++b)
#pragma unroll
                for (int m = 0; m < 4; ++m)
#pragma unroll
                    for (int n = 0; n < 2; ++n) acc[a][b][m][n] = (f32x4){0.f, 0.f, 0.f, 0.f};
        cur = nxt; cA = nA; cB = nB; ++ui;
    }
    PG8_WAIT_V(0);
    if (wr == 0) PG8_BAR;
    PG8_BAR;
#undef PG8_SA
#undef PG8_SB
#undef PG8_STAGE
#undef PG8_LDA
#undef PG8_LDB
#undef PG8_MMA
#undef PG8_WAIT_V
#undef PG8_WAIT_L
#undef PG8_BAR
#undef PG8_SCHED
}
}

typedef f32x4 AccT[2][2][4][2];

struct EpiGU {
    const float* ssq; bf16_t* O;
    __device__ __forceinline__ void operator()(const AccT& acc, const pg8::Unit& u, int wr, int wc, int fr, int fq) const {
        const int row0 = u.pm * 256 + wr * 64 + fr, col0 = u.pn * 128 + wc * 32 + 8 * fq;
#pragma unroll
        for (int ai = 0; ai < 2; ++ai)
#pragma unroll
            for (int m = 0; m < 4; ++m) {
                const int row = row0 + ai * 128 + m * 16;
                const float rstd = rsqrtf(ssq[row] * (1.f / D) + EPS);
                float v[8];
#pragma unroll
                for (int n = 0; n < 2; ++n)
#pragma unroll
                    for (int j = 0; j < 4; ++j) { const float gg = acc[ai][0][m][n][j] * rstd, uu = acc[ai][1][m][n][j] * rstd; v[4 * n + j] = siluf_(gg) * uu; }
                u32x4 w; w.x = cvt_pk_bf16(v[0], v[1]); w.y = cvt_pk_bf16(v[2], v[3]); w.z = cvt_pk_bf16(v[4], v[5]); w.w = cvt_pk_bf16(v[6], v[7]);
                *(u32x4*)(O + (size_t)row * DFF + col0) = w;
            }
    }
};
struct EpiRes {
    const float* xin; float* xout; bf16_t* xb; float* ssq; float alpha;
    __device__ __forceinline__ void operator()(const AccT& acc, const pg8::Unit& u, int wr, int wc, int fr, int fq) const {
        const int row0 = u.pm * 256 + wr * 64 + fr, col0 = u.pn * 256 + wc * 32 + 8 * fq;
#pragma unroll
        for (int ai = 0; ai < 2; ++ai)
#pragma unroll
            for (int m = 0; m < 4; ++m) {
                const int row = row0 + ai * 128 + m * 16;
                float s = 0.f;
#pragma unroll
                for (int bj = 0; bj < 2; ++bj) {
                    const size_t o = (size_t)row * D + col0 + bj * 128;
                    const f32x4 x0 = *(const f32x4*)(xin + o), x1 = *(const f32x4*)(xin + o + 4);
                    f32x4 y0 = x0 + acc[ai][bj][m][0] * alpha, y1 = x1 + acc[ai][bj][m][1] * alpha;
                    *(f32x4*)(xout + o) = y0; *(f32x4*)(xout + o + 4) = y1;
                    s += y0.x * y0.x + y0.y * y0.y + y0.z * y0.z + y0.w * y0.w + y1.x * y1.x + y1.y * y1.y + y1.z * y1.z + y1.w * y1.w;
                    if (xb) { u32x4 w; w.x = cvt_pk_bf16(y0.x, y0.y); w.y = cvt_pk_bf16(y0.z, y0.w); w.z = cvt_pk_bf16(y1.x, y1.y); w.w = cvt_pk_bf16(y1.z, y1.w); *(u32x4*)(xb + o) = w; }
                }
                s += __shfl_xor(s, 16); s += __shfl_xor(s, 32);
                if (fq == 0) atomicAdd(ssq + row, s);
            }
    }
};
struct EpiIn {
    const float* ssq; unsigned char* T; bf16_t* halo; float* sm;
    __device__ __forceinline__ void operator()(const AccT& acc, const pg8::Unit& u, int wr, int wc, int fr, int fq) const {
        const int pn = u.pn;
        const int row0 = u.pm * 256 + wr * 64 + fr;
        int act = 0, ld, ct; bf16_t* base;
        if (pn < 2) { base = (bf16_t*)(T + T_Q); ld = 512; ct = pn; }
        else if (pn < 4) { base = (bf16_t*)(T + T_K); ld = 512; ct = pn - 2; }
        else if (pn < 8) { base = (bf16_t*)(T + T_V); ld = 1024; ct = pn - 4; }
        else if (pn < 12) { base = (bf16_t*)(T + T_SG); ld = 1024; ct = pn - 8; act = 1; }
        else if (pn < 20) { base = (bf16_t*)(T + T_SZ); ld = 2048; ct = pn - 12; act = 1; }
        else if (pn < 36) { base = (bf16_t*)(T + T_XBC); ld = 4096; ct = pn - 20; act = 3; }
        else if (pn < 44) { base = (bf16_t*)(T + T_GT); ld = 2048; ct = pn - 36; act = 2; }
        else { base = nullptr; ld = 0; ct = 0; act = 4; }
        if (act == 4) {
            if (wc < 2) {
#pragma unroll
                for (int ai = 0; ai < 2; ++ai)
#pragma unroll
                    for (int m = 0; m < 4; ++m) {
                        const int row = row0 + ai * 128 + m * 16;
                        const float rstd = rsqrtf(ssq[row] * (1.f / D) + EPS);
                        float* p = sm + (size_t)row * 64 + wc * 32 + 8 * fq;
                        *(f32x4*)p = acc[ai][0][m][0] * rstd; *(f32x4*)(p + 4) = acc[ai][0][m][1] * rstd;
                    }
            }
            return;
        }
        const int col0 = ct * 256 + wc * 32 + 8 * fq;
#pragma unroll
        for (int ai = 0; ai < 2; ++ai)
#pragma unroll
            for (int m = 0; m < 4; ++m) {
                const int row = row0 + ai * 128 + m * 16;
                const float rstd = rsqrtf(ssq[row] * (1.f / D) + EPS);
#pragma unroll
                for (int bj = 0; bj < 2; ++bj) {
                    float v[8];
#pragma unroll
                    for (int n = 0; n < 2; ++n)
#pragma unroll
                        for (int j = 0; j < 4; ++j) { float x = acc[ai][bj][m][n][j] * rstd; if (act == 1) x = siluf_(x); else if (act == 2) x = sigmoidf_(x); v[4 * n + j] = x; }
                    u32x4 w; w.x = cvt_pk_bf16(v[0], v[1]); w.y = cvt_pk_bf16(v[2], v[3]); w.z = cvt_pk_bf16(v[4], v[5]); w.w = cvt_pk_bf16(v[6], v[7]);
                    *(u32x4*)(base + (size_t)row * ld + col0 + bj * 128) = w;
                    if (act == 3 && (row & 63) >= 61) *(u32x4*)(halo + ((size_t)(row >> 6) * 3 + ((row & 63) - 61)) * 4096 + col0 + bj * 128) = w;
                }
            }
    }
};
struct EpiGate {
    const bf16_t* gt; const bf16_t* t1; bf16_t* out; int mode;
    __device__ __forceinline__ void operator()(const AccT& acc, const pg8::Unit& u, int wr, int wc, int fr, int fq) const {
        const int row0 = u.pm * 256 + wr * 64 + fr, col0 = u.pn * 256 + wc * 32 + 8 * fq;
#pragma unroll
        for (int ai = 0; ai < 2; ++ai)
#pragma unroll
            for (int m = 0; m < 4; ++m) {
                const int row = row0 + ai * 128 + m * 16;
#pragma unroll
                for (int bj = 0; bj < 2; ++bj) {
                    const int col = col0 + bj * 128;
                    const u32x4 gq = *(const u32x4*)(gt + (size_t)row * 2048 + mode * 1024 + col);
                    float v[8];
                    v[0] = acc[ai][bj][m][0].x * bf_lo(gq.x); v[1] = acc[ai][bj][m][0].y * bf_hi(gq.x); v[2] = acc[ai][bj][m][0].z * bf_lo(gq.y); v[3] = acc[ai][bj][m][0].w * bf_hi(gq.y);
                    v[4] = acc[ai][bj][m][1].x * bf_lo(gq.z); v[5] = acc[ai][bj][m][1].y * bf_hi(gq.z); v[6] = acc[ai][bj][m][1].z * bf_lo(gq.w); v[7] = acc[ai][bj][m][1].w * bf_hi(gq.w);
                    if (mode) { const u32x4 tq = *(const u32x4*)(t1 + (size_t)row * D + col);
                        v[0] += bf_lo(tq.x); v[1] += bf_hi(tq.x); v[2] += bf_lo(tq.y); v[3] += bf_hi(tq.y); v[4] += bf_lo(tq.z); v[5] += bf_hi(tq.z); v[6] += bf_lo(tq.w); v[7] += bf_hi(tq.w); }
                    u32x4 w; w.x = cvt_pk_bf16(v[0], v[1]); w.y = cvt_pk_bf16(v[2], v[3]); w.z = cvt_pk_bf16(v[4], v[5]); w.w = cvt_pk_bf16(v[6], v[7]);
                    *(u32x4*)(out + (size_t)row * D + col) = w;
                }
            }
    }
};

__device__ __forceinline__ void tr_item(const float* srcp, int ld, const float* sk, float mul, int k0, int K, bf16_t* dst, int n0, LAS float* scr, int lane) {
#pragma unroll 8
    for (int i = 0; i < 32; ++i) { const int kk = 2 * i + (lane >> 5);
        float v = 0.f; if (srcp) v = srcp[(size_t)(k0 + kk) * ld] * (sk ? sk[k0 + kk] : 1.f) * mul;
        scr[kk * 33 + (lane & 31)] = v; }
    asm volatile("s_waitcnt lgkmcnt(0)" ::: "memory");
    const int c = lane & 7;
#pragma unroll
    for (int j = 0; j < 4; ++j) { const int n = (lane >> 3) + 8 * j; const LAS float* s = scr + (8 * c) * 33 + n;
        u32x4 o; o.x = cvt_pk_bf16(s[0 * 33], s[1 * 33]); o.y = cvt_pk_bf16(s[2 * 33], s[3 * 33]); o.z = cvt_pk_bf16(s[4 * 33], s[5 * 33]); o.w = cvt_pk_bf16(s[6 * 33], s[7 * 33]);
        *(u32x4*)(dst + (size_t)(n0 + n) * K + k0 + 8 * c) = o; }
    asm volatile("s_waitcnt lgkmcnt(0)" ::: "memory");
}
__device__ __forceinline__ int win_src_col(int nd) {
    if (nd < 3072) return nd;
    if (nd < 5120) return 3088 + (nd - 3072);
    if (nd < 9216) return 5136 + (nd - 5120);
    if (nd < 11264) return 9264 + (nd - 9216);
    if (nd < 11280) return 3072 + (nd - 11264);
    if (nd < 11312) return 9232 + (nd - 11280);
    return -1;
}

struct Params {
    const float* in[24];
    float* out;
    unsigned char* ws;
};

typedef __attribute__((address_space(4))) const Params* KP;
__device__ __forceinline__ Params load_params(KP p) { Params r;
#pragma unroll
    for (int i = 0; i < 24; ++i) r.in[i] = p->in[i];
    r.out = p->out; r.ws = p->ws; return r; }
__device__ __forceinline__ int tid_fresh() { int t = threadIdx.x; asm volatile("" : "+v"(t)); return t; }
__device__ __forceinline__ void p0_prologue(KP Pp, LAS unsigned char* lds, int G) {
    const Params P = load_params(Pp);
    const int tid = tid_fresh(), lane = tid & 63, wave = tid >> 6;
    LAS float* scr = (LAS float*)(lds + wave * 16384);
    const int gw = blockIdx.x * 8 + wave, NGW = G * 8;
    unsigned char* ws = P.ws;
    constexpr int I_GU = (D / 64) * (NGU / 32), I_DN = (DFF / 64) * (D / 32), I_IN = (D / 64) * (NIN / 32), I_GO = (D / 64) * (D / 32), I_SO = (2048 / 64) * (D / 32);
    constexpr int NITEMS = 2 * I_GU + 2 * I_DN + I_IN + 2 * I_GO + I_SO;
    for (int it = gw; it < NITEMS; it += NGW) {
        int r = it; const int j = lane & 31;
        if (r < 2 * I_GU) { const int l2 = r >= I_GU; r -= l2 * I_GU; const int nb = r % (NGU / 32), kb = r / (NGU / 32); const int nd = nb * 32 + j, tile = nd >> 8, w = nd & 255;
            const float* Wg = P.in[l2 ? 20 : 2]; const float* Wu = P.in[l2 ? 21 : 3];
            const float* sp = (w < 128 ? Wg : Wu) + 128 * tile + (w & 127);
            tr_item(sp, DFF, P.in[l2 ? 19 : 1], 1.f, kb * 64, D, (bf16_t*)(ws + (l2 ? WS_WGU2 : WS_WGU1)), nb * 32, scr, lane); continue; }
        r -= 2 * I_GU;
        if (r < 2 * I_DN) { const int l2 = r >= I_DN; r -= l2 * I_DN; const int nb = r % (D / 32), kb = r / (D / 32);
            tr_item(P.in[l2 ? 22 : 4] + nb * 32 + j, D, nullptr, 1.f, kb * 64, DFF, (bf16_t*)(ws + (l2 ? WS_WD2 : WS_WD1)), nb * 32, scr, lane); continue; }
        r -= 2 * I_DN;
        if (r < I_IN) { const int nb = r % (NIN / 32), kb = r / (NIN / 32); const int nd = nb * 32 + j, sc = win_src_col(nd);
            tr_item(sc >= 0 ? P.in[6] + sc : nullptr, IN_DIM, P.in[5], nd < 512 ? 0.08838834764831845f : 1.f, kb * 64, D, (bf16_t*)(ws + WS_WIN), nb * 32, scr, lane); continue; }
        r -= I_IN;
        if (r < 2 * I_GO) { const int l2 = r >= I_GO; r -= l2 * I_GO; const int nb = r % (D / 32), kb = r / (D / 32);
            tr_item(P.in[l2 ? 18 : 10] + nb * 32 + j, D, nullptr, 1.f, kb * 64, D, (bf16_t*)(ws + (l2 ? WS_WOUT : WS_WGO)), nb * 32, scr, lane); continue; }
        r -= 2 * I_GO;
        { const int nb = r % (D / 32), kb = r / (D / 32);
            tr_item(P.in[17] + nb * 32 + j, D, nullptr, 1.f, kb * 64, 2048, (bf16_t*)(ws + WS_WSO), nb * 32, scr, lane); }
    }
    const float* x = P.in[0]; bf16_t* xb = (bf16_t*)(ws + WS_XB); float* ssq = (float*)(ws + WS_SSQ);
    for (int m = gw; m < MTOK; m += NGW) {
        const f32x4* xr = (const f32x4*)(x + (size_t)m * D) + lane;
        unsigned long long* o8 = (unsigned long long*)(xb + (size_t)m * D) + lane;
        float s = 0.f;
#pragma unroll
        for (int jj = 0; jj < 4; ++jj) { const f32x4 v = xr[64 * jj]; s += v.x * v.x + v.y * v.y + v.z * v.z + v.w * v.w;
            o8[64 * jj] = (unsigned long long)cvt_pk_bf16(v.x, v.y) | ((unsigned long long)cvt_pk_bf16(v.z, v.w) << 32); }
        s = wave_sum(s);
        if (lane == 0) { ssq[m] = s; ssq[MTOK + m] = 0.f; ssq[2 * MTOK + m] = 0.f; ssq[3 * MTOK + m] = 0.f; }
    }
}

__device__ __forceinline__ void p4_prep(KP Pp, LAS unsigned char* lds, int G) {
    const Params P = load_params(Pp);
    const int tid = tid_fresh();
    unsigned char* ws = P.ws; unsigned char* T = ws + WS_BIG;
    const float* sm = (const float*)(ws + WS_SM);
    for (int it = blockIdx.x; it < HB * NCH; it += G) {
        const int row0 = it * 64;
#pragma unroll
        for (int i = 0; i < 2; ++i) { const int idx = tid + 512 * i; *(LAS f32x4*)(lds + idx * 16) = *(const f32x4*)(sm + (size_t)row0 * 64 + idx * 4); }
        __syncthreads();
        {
            const int hc = tid;
            const float* wf = P.in[7]; float w[16];
#pragma unroll
            for (int j = 0; j < 16; ++j) w[j] = wf[j * 512 + hc];
            const float bfv = P.in[8][hc];
            float cum = 0.f;
#pragma unroll 4
            for (int t = 0; t < 64; ++t) { float z = bfv;
#pragma unroll
                for (int j4 = 0; j4 < 4; ++j4) { const f32x4 f = *(const LAS f32x4*)(lds + t * 256 + j4 * 16); z += f.x * w[4 * j4] + f.y * w[4 * j4 + 1] + f.z * w[4 * j4 + 2] + f.w * w[4 * j4 + 3]; }
                cum += (fminf(z, 0.f) - __logf(1.f + __expf(-fabsf(z)))) * (1.f / 16.f); }
            const float end = cum; cum = 0.f;
            bf16_t* kp = (bf16_t*)(T + T_K) + (size_t)row0 * 512 + hc;
            for (int tb = 0; tb < 4; ++tb) {
                bf16_t kk[16];
#pragma unroll
                for (int u = 0; u < 16; ++u) kk[u] = kp[(size_t)(tb * 16 + u) * 512];
#pragma unroll
                for (int u = 0; u < 16; ++u) { const int t = tb * 16 + u; float z = bfv;
#pragma unroll
                    for (int j4 = 0; j4 < 4; ++j4) { const f32x4 f = *(const LAS f32x4*)(lds + t * 256 + j4 * 16); z += f.x * w[4 * j4] + f.y * w[4 * j4 + 1] + f.z * w[4 * j4 + 2] + f.w * w[4 * j4 + 3]; }
                    cum += (fminf(z, 0.f) - __logf(1.f + __expf(-fabsf(z)))) * (1.f / 16.f);
                    const float kv = __uint_as_float((unsigned)kk[u] << 16) * __expf(end - cum);
                    kp[(size_t)t * 512] = (bf16_t)(cvt_pk_bf16(kv, 0.f) & 0xffffu); }
            }
            ((float*)(ws + WS_DEC))[(size_t)it * 512 + hc] = __expf(end);
        }
        if (tid < 32) {
            const float bias = P.in[13][tid], A = -__expf(P.in[14][tid]);
            float cum = 0.f;
#pragma unroll 4
            for (int t = 0; t < 64; ++t) cum += softplusf_(*(const LAS float*)(lds + t * 256 + (16 + tid) * 4) + bias) * A;
            const float end = cum; cum = 0.f;
            float* wg = (float*)(ws + WS_WG);
#pragma unroll 4
            for (int t = 0; t < 64; ++t) { const float dt = softplusf_(*(const LAS float*)(lds + t * 256 + (16 + tid) * 4) + bias); cum += dt * A; wg[(size_t)(row0 + t) * 32 + tid] = __expf(end - cum) * dt; }
            ((float*)(ws + WS_DECS))[it * 32 + tid] = __expf(end);
        }
        __syncthreads();
    }
    const int co = tid & 63, rg = tid >> 6;
    u32x4 raw[11];
#define CONV_LOAD(itx) do { const int _ci = (itx) >> 3, _col = ((itx) & 7) * 512 + co * 8; \
        const bf16_t* _xp = (const bf16_t*)(T + T_XBC) + (size_t)(_ci * 64 + rg * 8) * 4096 + _col; \
        _Pragma("unroll") for (int i = 0; i < 8; ++i) raw[3 + i] = *(const u32x4*)(_xp + (size_t)i * 4096); \
        if (rg > 0) { _Pragma("unroll") for (int i = 0; i < 3; ++i) raw[i] = *(const u32x4*)(_xp - (size_t)(3 - i) * 4096); } \
        else if ((_ci & (NCH - 1)) != 0) { const bf16_t* _hp = (const bf16_t*)(ws + WS_HALO) + (size_t)(_ci - 1) * 3 * 4096 + _col; \
            _Pragma("unroll") for (int i = 0; i < 3; ++i) raw[i] = *(const u32x4*)(_hp + (size_t)i * 4096); } \
        else { _Pragma("unroll") for (int i = 0; i < 3; ++i) raw[i] = (u32x4){0u, 0u, 0u, 0u}; } } while (0)
    if ((int)blockIdx.x < HB * NCH * 8) CONV_LOAD((int)blockIdx.x);
    for (int it = blockIdx.x; it < HB * NCH * 8; it += G) {
        const int ci = it >> 3, cb = it & 7, col = cb * 512 + co * 8, row0 = ci * 64 + rg * 8;
        bf16_t* xp = (bf16_t*)(T + T_XBC) + (size_t)row0 * 4096 + col;
        float cw[4][8], cbv[8];
#pragma unroll
        for (int k = 0; k < 4; ++k) { const f32x4 a = *(const f32x4*)(P.in[11] + k * 4096 + col), b = *(const f32x4*)(P.in[11] + k * 4096 + col + 4);
            cw[k][0] = a.x; cw[k][1] = a.y; cw[k][2] = a.z; cw[k][3] = a.w; cw[k][4] = b.x; cw[k][5] = b.y; cw[k][6] = b.z; cw[k][7] = b.w; }
        { const f32x4 a = *(const f32x4*)(P.in[12] + col), b = *(const f32x4*)(P.in[12] + col + 4);
            cbv[0] = a.x; cbv[1] = a.y; cbv[2] = a.z; cbv[3] = a.w; cbv[4] = b.x; cbv[5] = b.y; cbv[6] = b.z; cbv[7] = b.w; }
        asm volatile("s_waitcnt vmcnt(0)" ::: "memory");
        __syncthreads();
        u32x4 outv[8];
#pragma unroll
        for (int i = 0; i < 8; ++i) {
            float v[8];
#pragma unroll
            for (int e = 0; e < 8; ++e) v[e] = cbv[e];
#pragma unroll
            for (int k = 0; k < 4; ++k) { const u32x4 q = raw[i + k];
                v[0] += cw[k][0] * bf_lo(q.x); v[1] += cw[k][1] * bf_hi(q.x); v[2] += cw[k][2] * bf_lo(q.y); v[3] += cw[k][3] * bf_hi(q.y);
                v[4] += cw[k][4] * bf_lo(q.z); v[5] += cw[k][5] * bf_hi(q.z); v[6] += cw[k][6] * bf_lo(q.w); v[7] += cw[k][7] * bf_hi(q.w); }
#pragma unroll
            for (int e = 0; e < 8; ++e) v[e] = siluf_(v[e]);
            outv[i].x = cvt_pk_bf16(v[0], v[1]); outv[i].y = cvt_pk_bf16(v[2], v[3]); outv[i].z = cvt_pk_bf16(v[4], v[5]); outv[i].w = cvt_pk_bf16(v[6], v[7]);
        }
        if (it + G < HB * NCH * 8) CONV_LOAD(it + G);
#pragma unroll
        for (int i = 0; i < 8; ++i) *(u32x4*)(xp + (size_t)i * 4096) = outv[i];
    }
#undef CONV_LOAD
}

struct MixArgs {
    const bf16_t* ak; int ld_ak;
    const bf16_t* qq; int ld_q;
    const bf16_t* bv; int ld_bv;
    const bf16_t* gt; int ld_g;
    bf16_t* out; int ld_o;
    const float* dec;
    const float* wg;
    const float* nw;
    const float* dsk;
};
constexpr int RSA = 320, RSB = 576, RSQ = 264;
constexpr int OFF_AK = 0, OFF_BV = 64 * RSA, OFF_QQ = OFF_BV + 64 * RSB, OFF_WGT = OFF_QQ + 64 * RSQ, OFF_DEC = OFF_WGT + 1024, OFF_RED = OFF_DEC + 512, OFF_NW = OFF_RED + 2048;
static_assert(OFF_NW + 1024 <= LDS_BYTES, "mixer LDS");

#define LBAR() do { asm volatile("s_waitcnt lgkmcnt(0)" ::: "memory"); __builtin_amdgcn_s_barrier(); asm volatile("" ::: "memory"); } while (0)
template <bool SSD>
__device__ __forceinline__ void mixer_item(LAS unsigned char* lds, const MixArgs& a) {
    const int tid = tid_fresh(), lane = tid & 63, w = __builtin_amdgcn_readfirstlane(tid >> 6);
    const int r = lane & 31, h = lane >> 5, gg = lane >> 4, q = (lane & 15) >> 2, p = lane & 3;
    const int arow0 = tid >> 4, apc = tid & 15;
    const int brow0 = tid >> 5, bpc = tid & 31;
    u32x4 stA[2], stQ[2], stB[4], stW, stD;
    stW = (u32x4){0u, 0u, 0u, 0u}; stD = stW;
#define MIX_LOAD(c) do { const size_t _r0 = (size_t)(c) * 64; \
        _Pragma("unroll") for (int i = 0; i < 2; ++i) { stA[i] = *(const u32x4*)(a.ak + (_r0 + arow0 + 32 * i) * a.ld_ak + apc * 8); stQ[i] = *(const u32x4*)(a.qq + (_r0 + arow0 + 32 * i) * a.ld_q + apc * 8); } \
        _Pragma("unroll") for (int i = 0; i < 4; ++i) stB[i] = *(const u32x4*)(a.bv + (_r0 + brow0 + 16 * i) * a.ld_bv + bpc * 8); \
        if (SSD) { if (tid < 64) stW = *(const u32x4*)(a.wg + (_r0 + tid) * 32); } \
        else { if (tid < 32) stD = *(const u32x4*)(a.dec + (size_t)(c) * 512 + tid * 4); } } while (0)
#define MIX_STORE() do { \
        _Pragma("unroll") for (int i = 0; i < 2; ++i) { *(LAS u32x4*)(lds + OFF_AK + (arow0 + 32 * i) * RSA + apc * 16) = stA[i]; \
            *(LAS u32x2*)(lds + OFF_QQ + (arow0 + 32 * i) * RSQ + apc * 16) = (u32x2){stQ[i].x, stQ[i].y}; *(LAS u32x2*)(lds + OFF_QQ + (arow0 + 32 * i) * RSQ + apc * 16 + 8) = (u32x2){stQ[i].z, stQ[i].w}; } \
        _Pragma("unroll") for (int i = 0; i < 4; ++i) *(LAS u32x4*)(lds + OFF_BV + (brow0 + 16 * i) * RSB + bpc * 16) = stB[i]; \
        if (SSD) { if (tid < 64) *(LAS u32x4*)(lds + OFF_WGT + tid * 16) = stW; } \
        else { if (tid < 32) *(LAS u32x4*)(lds + OFF_DEC + tid * 16) = stD; } } while (0)

    if (tid < 256) *(LAS float*)(lds + OFF_NW + tid * 4) = a.nw[tid];
    MIX_LOAD(0);
    MIX_STORE();
    __syncthreads();

    f32x16 S[4];
#pragma unroll
    for (int i = 0; i < 4; ++i)
#pragma unroll
        for (int e = 0; e < 16; ++e) S[i][e] = 0.f;

    const int trA = OFF_AK + (8 * h + q) * RSA + (16 * (gg & 1) + 4 * p) * 2;
    const int trB = OFF_BV + (8 * h + q) * RSB + (32 * w + 16 * (gg & 1) + 4 * p) * 2;
    const int qB = OFF_QQ + r * RSQ + 8 * h;
    const float dsk = SSD ? a.dsk[w >> 1] : 0.f;

    for (int c = 0; c < NCH; ++c) {
        if (c + 1 < NCH) MIX_LOAD(c + 1);
        u32x2 gv[2][4];
#pragma unroll
        for (int j2 = 0; j2 < 2; ++j2)
#pragma unroll
            for (int g = 0; g < 4; ++g) gv[j2][g] = *(const u32x2*)(a.gt + ((size_t)c * 64 + 32 * j2 + r) * a.ld_g + 32 * w + 8 * g + 4 * h);
        if (SSD) {
            const float dc = a.dec[(size_t)c * 32 + (w >> 1)];
#pragma unroll
            for (int i = 0; i < 4; ++i)
#pragma unroll
                for (int e = 0; e < 16; ++e) S[i][e] *= dc;
        } else {
#pragma unroll
            for (int i = 0; i < 4; ++i)
#pragma unroll
                for (int g = 0; g < 4; ++g) { const f32x4 d4 = *(const LAS f32x4*)(lds + OFF_DEC + (32 * i + 8 * g + 4 * h) * 4);
                    S[i][4 * g + 0] *= d4.x; S[i][4 * g + 1] *= d4.y; S[i][4 * g + 2] *= d4.z; S[i][4 * g + 3] *= d4.w; }
        }
#pragma unroll
        for (int s = 0; s < 4; ++s) {
            const s16x4 b0 = __builtin_bit_cast(s16x4, __builtin_amdgcn_ds_read_tr16_b64_v4i16((LAS s16x4*)(lds + trB + (16 * s) * RSB)));
            const s16x4 b1 = __builtin_bit_cast(s16x4, __builtin_amdgcn_ds_read_tr16_b64_v4i16((LAS s16x4*)(lds + trB + (16 * s + 4) * RSB)));
            bf16x8 bfr = __builtin_shufflevector(b0, b1, 0, 1, 2, 3, 4, 5, 6, 7);
            if (SSD) {
                u32x4 bu = __builtin_bit_cast(u32x4, bfr);
                float wt[8];
#pragma unroll
                for (int j = 0; j < 8; ++j) wt[j] = *(const LAS float*)(lds + OFF_WGT + (16 * s + 8 * h + j) * 16 + (w >> 1) * 4);
                bu.x = cvt_pk_bf16(bf_lo(bu.x) * wt[0], bf_hi(bu.x) * wt[1]); bu.y = cvt_pk_bf16(bf_lo(bu.y) * wt[2], bf_hi(bu.y) * wt[3]);
                bu.z = cvt_pk_bf16(bf_lo(bu.z) * wt[4], bf_hi(bu.z) * wt[5]); bu.w = cvt_pk_bf16(bf_lo(bu.w) * wt[6], bf_hi(bu.w) * wt[7]);
                bfr = __builtin_bit_cast(bf16x8, bu);
            }
#pragma unroll
            for (int i = 0; i < 4; ++i) {
                const s16x4 a0 = __builtin_bit_cast(s16x4, __builtin_amdgcn_ds_read_tr16_b64_v4i16((LAS s16x4*)(lds + trA + (16 * s) * RSA + 64 * i)));
                const s16x4 a1 = __builtin_bit_cast(s16x4, __builtin_amdgcn_ds_read_tr16_b64_v4i16((LAS s16x4*)(lds + trA + (16 * s + 4) * RSA + 64 * i)));
                const bf16x8 afr = __builtin_shufflevector(a0, a1, 0, 1, 2, 3, 4, 5, 6, 7);
                S[i] = __builtin_amdgcn_mfma_f32_32x32x16_bf16(afr, bfr, S[i], 0, 0, 0);
            }
        }
        f32x16 OT[2];
#pragma unroll
        for (int j2 = 0; j2 < 2; ++j2)
#pragma unroll
            for (int e = 0; e < 16; ++e) OT[j2][e] = 0.f;
#pragma unroll
        for (int sp = 0; sp < 8; ++sp) {
            const int i = sp >> 1, o8 = 8 * (sp & 1);
            u32x4 pk;
            pk.x = cvt_pk_bf16(S[i][o8 + 0], S[i][o8 + 1]); pk.y = cvt_pk_bf16(S[i][o8 + 2], S[i][o8 + 3]);
            pk.z = cvt_pk_bf16(S[i][o8 + 4], S[i][o8 + 5]); pk.w = cvt_pk_bf16(S[i][o8 + 6], S[i][o8 + 7]);
            const bf16x8 sfr = __builtin_bit_cast(bf16x8, pk);
#pragma unroll
            for (int j2 = 0; j2 < 2; ++j2) {
                const u32x2 q0 = *(const LAS u32x2*)(lds + qB + 32 * j2 * RSQ + (16 * sp) * 2);
                const u32x2 q1 = *(const LAS u32x2*)(lds + qB + 32 * j2 * RSQ + (16 * sp + 8) * 2);
                const bf16x8 qfr = __builtin_bit_cast(bf16x8, (u32x4){q0.x, q0.y, q1.x, q1.y});
                OT[j2] = __builtin_amdgcn_mfma_f32_32x32x16_bf16(sfr, qfr, OT[j2], 0, 0, 0);
            }
        }
        float part[2] = {0.f, 0.f};
#pragma unroll
        for (int j2 = 0; j2 < 2; ++j2)
#pragma unroll
            for (int g = 0; g < 4; ++g) {
                if (SSD) {
                    const u32x2 xs = *(const LAS u32x2*)(lds + OFF_BV + (32 * j2 + r) * RSB + (32 * w + 8 * g + 4 * h) * 2);
                    OT[j2][4 * g + 0] = (OT[j2][4 * g + 0] + dsk * bf_lo(xs.x)) * bf_lo(gv[j2][g].x);
                    OT[j2][4 * g + 1] = (OT[j2][4 * g + 1] + dsk * bf_hi(xs.x)) * bf_hi(gv[j2][g].x);
                    OT[j2][4 * g + 2] = (OT[j2][4 * g + 2] + dsk * bf_lo(xs.y)) * bf_lo(gv[j2][g].y);
                    OT[j2][4 * g + 3] = (OT[j2][4 * g + 3] + dsk * bf_hi(xs.y)) * bf_hi(gv[j2][g].y);
                }
#pragma unroll
                for (int k = 0; k < 4; ++k) part[j2] += OT[j2][4 * g + k] * OT[j2][4 * g + k];
            }
        part[0] += __shfl_xor(part[0], 32); part[1] += __shfl_xor(part[1], 32);
        if (h == 0) { *(LAS float*)(lds + OFF_RED + (w * 64 + r) * 4) = part[0]; *(LAS float*)(lds + OFF_RED + (w * 64 + 32 + r) * 4) = part[1]; }
        LBAR();
#pragma unroll
        for (int j2 = 0; j2 < 2; ++j2) {
            float tot = 0.f;
#pragma unroll
            for (int ww = 0; ww < 8; ++ww) tot += *(const LAS float*)(lds + OFF_RED + (ww * 64 + 32 * j2 + r) * 4);
            const float rstd = rsqrtf(tot * (1.f / 256.f) + EPS);
#pragma unroll
            for (int g = 0; g < 4; ++g) {
                const f32x4 n4 = *(const LAS f32x4*)(lds + OFF_NW + (32 * w + 8 * g + 4 * h) * 4);
                float v0 = OT[j2][4 * g + 0] * rstd * n4.x, v1 = OT[j2][4 * g + 1] * rstd * n4.y, v2 = OT[j2][4 * g + 2] * rstd * n4.z, v3 = OT[j2][4 * g + 3] * rstd * n4.w;
                if (!SSD) { v0 *= bf_lo(gv[j2][g].x); v1 *= bf_hi(gv[j2][g].x); v2 *= bf_lo(gv[j2][g].y); v3 *= bf_hi(gv[j2][g].y); }
                *(u32x2*)(a.out + ((size_t)c * 64 + 32 * j2 + r) * a.ld_o + 32 * w + 8 * g + 4 * h) = (u32x2){cvt_pk_bf16(v0, v1), cvt_pk_bf16(v2, v3)};
            }
        }
        LBAR();
        if (c + 1 < NCH) MIX_STORE();
        LBAR();
    }
#undef MIX_LOAD
#undef MIX_STORE
}

__device__ __forceinline__ void p5_mixer(KP Pp, LAS unsigned char* lds, int G) {
    const Params P = load_params(Pp);
    unsigned char* ws = P.ws; unsigned char* T = ws + WS_BIG;
    for (int it = blockIdx.x; it < HB * 12; it += G) {
        const int b = it / 12, k = it % 12;
        const size_t row0 = (size_t)b * SEQ;
        MixArgs a;
        if (k < 4) {
            const int hd = k;
            a.ak = (const bf16_t*)(T + T_K) + row0 * 512 + hd * 128; a.ld_ak = 512;
            a.qq = (const bf16_t*)(T + T_Q) + row0 * 512 + hd * 128; a.ld_q = 512;
            a.bv = (const bf16_t*)(T + T_V) + row0 * 1024 + hd * 256; a.ld_bv = 1024;
            a.gt = (const bf16_t*)(T + T_SG) + row0 * 1024 + hd * 256; a.ld_g = 1024;
            a.out = (bf16_t*)(T + T_V) + row0 * 1024 + hd * 256; a.ld_o = 1024;
            a.dec = (const float*)(ws + WS_DEC) + (size_t)b * NCH * 512 + hd * 128;
            a.wg = nullptr; a.nw = P.in[9]; a.dsk = nullptr;
            mixer_item<false>(lds, a);
        } else {
            const int g = k - 4;
            const bf16_t* X = (const bf16_t*)(T + T_XBC) + row0 * 4096;
            a.ak = X + 2048 + g * 128; a.ld_ak = 4096;
            a.qq = X + 3072 + g * 128; a.ld_q = 4096;
            a.bv = X + g * 256; a.ld_bv = 4096;
            a.gt = (const bf16_t*)(T + T_SZ) + row0 * 2048 + g * 256; a.ld_g = 2048;
            a.out = (bf16_t*)(T + T_XBC) + row0 * 4096 + g * 256; a.ld_o = 4096;
            a.dec = (const float*)(ws + WS_DECS) + (size_t)b * NCH * 32 + g * 4;
            a.wg = (const float*)(ws + WS_WG) + row0 * 32 + g * 4;
            a.nw = P.in[16] + g * 256; a.dsk = P.in[15] + g * 4;
            mixer_item<true>(lds, a);
        }
        __syncthreads();
    }
}

__device__ __forceinline__ KP get_params() {
    KP p = (KP)__builtin_amdgcn_kernarg_segment_ptr(); asm volatile("" : "+s"(p)); return p;
}

#define XB_TMO      128
#define XB_XCNT(j)  (256  + 64 * (j))
#define XB_XSUB(j)  (1280 + 64 * (j))
#define XB_XGEN(j)  (2304 + 64 * (j))
#define XB_TOP      3328
#define XB_TOPGEN   3392
#define XCD_BAR_WORDS 3456
#define XB_SPIN_CAP (1u << 18)
__device__ __forceinline__ unsigned xb_ld(unsigned* p)              { return __hip_atomic_load(p, __ATOMIC_RELAXED, __HIP_MEMORY_SCOPE_AGENT); }
__device__ __forceinline__ unsigned xb_add(unsigned* p, unsigned v) { return __hip_atomic_fetch_add(p, v, __ATOMIC_RELAXED, __HIP_MEMORY_SCOPE_AGENT); }
__device__ __forceinline__ unsigned xb_xcc_id() { return (unsigned)__builtin_amdgcn_s_getreg((3 << 11) | 20) & 0xFu; }
#define XB_SPIN(cond, bar) do { unsigned _sp = 0; while (cond) { __builtin_amdgcn_s_sleep(1); \
    if ((++_sp & 255u) == 0u) { if (xb_ld(&(bar)[XB_TMO])) break; if (_sp > XB_SPIN_CAP) { atomicAdd(&(bar)[XB_TMO], 1u); break; } } } } while (0)
struct XcdBarrier { unsigned* bar; unsigned x; volatile LAS unsigned* st; };
__device__ __forceinline__ XcdBarrier xcd_barrier_post(unsigned* bar, volatile LAS unsigned* st) {
    XcdBarrier b; b.bar = bar; b.x = xb_xcc_id(); b.st = st;
    if (threadIdx.x == 0) (void)xb_add(&bar[XB_XCNT(b.x)], 1u);
    return b;
}
__device__ __forceinline__ void xcd_barrier_complete(unsigned* bar, unsigned x, unsigned& nloc, unsigned& nx) {
    const unsigned G = gridDim.x * gridDim.y * gridDim.z;
    unsigned sum, cnt, mine, sp = 0u;
    for (;;) {
        sum = 0u; cnt = 0u; mine = 0u;
#pragma unroll
        for (unsigned j = 0; j < 16; ++j) { const unsigned c = xb_ld(&bar[XB_XCNT(j)]); sum += c; cnt += (c > 0u) ? 1u : 0u; mine = (j == x) ? c : mine; }
        if (sum == G) break;
        __builtin_amdgcn_s_sleep(1);
        if ((++sp & 255u) == 0u) { if (xb_ld(&bar[XB_TMO])) break; if (sp > XB_SPIN_CAP) { atomicAdd(&bar[XB_TMO], 1u); break; } }
    }
    nloc = mine > 0u ? mine : 1u; nx = cnt > 0u ? cnt : 1u;
}
__device__ __forceinline__ void xcd_barrier(const XcdBarrier& b) {
    asm volatile("s_waitcnt vmcnt(0)" ::: "memory");
    __syncthreads();
    if (threadIdx.x == 0) {
        unsigned* bar = b.bar;
        __builtin_amdgcn_s_waitcnt(0);
        unsigned nloc = b.st[0], nx = b.st[1];
        if (nloc == 0u) { xcd_barrier_complete(bar, b.x, nloc, nx); b.st[0] = nloc; b.st[1] = nx; }
        const unsigned old = xb_add(&bar[XB_XSUB(b.x)], 1u);
        const unsigned gen = old / nloc;
        if (old + 1u == (gen + 1u) * nloc) {
            __builtin_amdgcn_fence(__ATOMIC_RELEASE, "agent");
            asm volatile("s_waitcnt vmcnt(0)" ::: "memory");
            const unsigned og = xb_add(&bar[XB_TOP], 1u);
            const unsigned tg = og / nx;
            if (og + 1u == (tg + 1u) * nx) xb_add(&bar[XB_TOPGEN], 1u);
            else XB_SPIN(xb_ld(&bar[XB_TOPGEN]) == tg, bar);
            __builtin_amdgcn_fence(__ATOMIC_ACQUIRE, "agent");
            xb_add(&bar[XB_XGEN(b.x)], 1u);
            asm volatile("s_waitcnt vmcnt(0)" ::: "memory");
        } else {
            XB_SPIN(xb_ld(&bar[XB_XGEN(b.x)]) == gen, bar);
            __builtin_amdgcn_fence(__ATOMIC_ACQUIRE, "agent");
            asm volatile("s_waitcnt vmcnt(0)" ::: "memory");
        }
    }
    __syncthreads();
}

#define PROBE_MASK 0x0
#define PROBE_DSYNC 0
#if PROBE_MASK
#define PH_BEGIN(i) const unsigned long long _t##i = __builtin_amdgcn_s_memrealtime();
#define PH_END(i) if ((PROBE_MASK >> (i)) & 1) probe_acc += __builtin_amdgcn_s_memrealtime() - _t##i;
#else
#define PH_BEGIN(i)
#define PH_END(i)
#endif
#if PROBE_DSYNC
#define GSYNC() do { xcd_barrier(xbar); xcd_barrier(xbar); } while (0)
#else
#define GSYNC() xcd_barrier(xbar)
#endif
__global__ void __launch_bounds__(512, 2) fwd_megakernel(Params Parg) {
    extern __shared__ __attribute__((aligned(16))) unsigned char lds_raw[];
    LAS unsigned char* lds = (LAS unsigned char*)lds_raw;
    cg::grid_group grid = cg::this_grid();
    const int G = gridDim.x;
    pg8::StaticOrder S;
#if PROBE_MASK
    unsigned long long probe_acc = 0;
#endif

    { unsigned* bw = (unsigned*)(get_params()->ws + WS_BAR);
      if (blockIdx.x == 0) for (int i = threadIdx.x; i < XCD_BAR_WORDS; i += 512) bw[i] = 0u;
      if (threadIdx.x < 2) *(volatile LAS unsigned*)(lds + LDS_MAIN + threadIdx.x * 4) = 0u; }
    XcdBarrier xbar;
    { PH_BEGIN(0) p0_prologue(get_params(), lds, G);
    grid.sync();
    xbar = xcd_barrier_post((unsigned*)(get_params()->ws + WS_BAR), (volatile LAS unsigned*)(lds + LDS_MAIN));
    PH_END(0) }
    { PH_BEGIN(1) { KP P = get_params(); unsigned char* ws = P->ws;
      pg8::Gemm g{(const bf16_t*)(ws + WS_XB), (const bf16_t*)(ws + WS_WGU1), MTOK, NGU, D, D, D}; S.init(MTOK, NGU, G, blockIdx.x);
      EpiGU E{(const float*)(ws + WS_SSQ), (bf16_t*)(ws + WS_BIG)}; pg8::gemm_phase(lds, g, S, E); }
    GSYNC(); PH_END(1) }
    { PH_BEGIN(2) { KP P = get_params(); unsigned char* ws = P->ws;
      pg8::Gemm g{(const bf16_t*)(ws + WS_BIG), (const bf16_t*)(ws + WS_WD1), MTOK, D, DFF, DFF, DFF}; S.init(MTOK, D, G, blockIdx.x);
      EpiRes E{P->in[0], P->out, (bf16_t*)(ws + WS_XB), (float*)(ws + WS_SSQ) + MTOK, 0.5f}; pg8::gemm_phase(lds, g, S, E); }
    GSYNC(); PH_END(2) }
    for (int hf = 0; hf < 2; ++hf) {
        const size_t r0 = (size_t)hf * MH;
        { PH_BEGIN(3) { KP P = get_params(); unsigned char* ws = P->ws;
          pg8::Gemm g{(const bf16_t*)(ws + WS_XB) + r0 * D, (const bf16_t*)(ws + WS_WIN), MH, NIN, D, D, D}; S.init(MH, NIN, G, blockIdx.x);
          EpiIn E{(const float*)(ws + WS_SSQ) + MTOK + r0, ws + WS_BIG, (bf16_t*)(ws + WS_HALO), (float*)(ws + WS_SM)}; pg8::gemm_phase(lds, g, S, E); }
        GSYNC(); PH_END(3) }
        { PH_BEGIN(4) p4_prep(get_params(), lds, G);
        GSYNC(); PH_END(4) }
        { PH_BEGIN(5) p5_mixer(get_params(), lds, G);
        GSYNC(); PH_END(5) }
        { PH_BEGIN(6) { KP P = get_params(); unsigned char* ws = P->ws; unsigned char* T = ws + WS_BIG;
          pg8::Gemm g{(const bf16_t*)(T + T_V), (const bf16_t*)(ws + WS_WGO), MH, D, D, D, D}; S.init(MH, D, G, blockIdx.x);
          EpiGate E{(const bf16_t*)(T + T_GT), nullptr, (bf16_t*)(T + T_T1), 0}; pg8::gemm_phase(lds, g, S, E); }
        { KP P = get_params(); unsigned char* ws = P->ws; unsigned char* T = ws + WS_BIG;
          pg8::Gemm g{(const bf16_t*)(T + T_XBC), (const bf16_t*)(ws + WS_WSO), MH, D, 2048, 4096, 2048}; S.init(MH, D, G, blockIdx.x);
          EpiGate E{(const bf16_t*)(T + T_GT), (const bf16_t*)(T + T_T1), (bf16_t*)(T + T_MRG), 1}; pg8::gemm_phase(lds, g, S, E); }
        GSYNC(); PH_END(6) }
        { PH_BEGIN(7) { KP P = get_params(); unsigned char* ws = P->ws;
          pg8::Gemm g{(const bf16_t*)(ws + WS_BIG + T_MRG), (const bf16_t*)(ws + WS_WOUT), MH, D, D, D, D}; S.init(MH, D, G, blockIdx.x);
          EpiRes E{P->out + r0 * D, P->out + r0 * D, (bf16_t*)(ws + WS_XB) + r0 * D, (float*)(ws + WS_SSQ) + 2 * MTOK + r0, 1.0f}; pg8::gemm_phase(lds, g, S, E); }
        GSYNC(); PH_END(7) }
    }
    { PH_BEGIN(8) { KP P = get_params(); unsigned char* ws = P->ws;
      pg8::Gemm g{(const bf16_t*)(ws + WS_XB), (const bf16_t*)(ws + WS_WGU2), MTOK, NGU, D, D, D}; S.init(MTOK, NGU, G, blockIdx.x);
      EpiGU E{(const float*)(ws + WS_SSQ) + 2 * MTOK, (bf16_t*)(ws + WS_BIG)}; pg8::gemm_phase(lds, g, S, E); }
    GSYNC(); PH_END(8) }
    { PH_BEGIN(9) { KP P = get_params(); unsigned char* ws = P->ws;
      pg8::Gemm g{(const bf16_t*)(ws + WS_BIG), (const bf16_t*)(ws + WS_WD2), MTOK, D, DFF, DFF, DFF}; S.init(MTOK, D, G, blockIdx.x);
      EpiRes E{P->out, P->out, nullptr, (float*)(ws + WS_SSQ) + 3 * MTOK, 0.5f}; pg8::gemm_phase(lds, g, S, E); }
    GSYNC(); PH_END(9) }
    { PH_BEGIN(10)
    {
        KP P = get_params(); const float* ssq = (const float*)(P->ws + WS_SSQ) + 3 * MTOK;
        const int tid = tid_fresh(), lane = tid & 63, gw = blockIdx.x * 8 + (tid >> 6), NGW = G * 8;
        const float* fw = P->in[23]; float* outp = P->out;
        for (int m = gw; m < MTOK; m += NGW) {
            const float rstd = rsqrtf(ssq[m] * (1.f / D) + EPS);
            f32x4* xr = (f32x4*)(outp + (size_t)m * D) + lane;
#pragma unroll
            for (int jj = 0; jj < 4; ++jj) { const f32x4 wv = ((const f32x4*)fw)[lane + 64 * jj]; f32x4 v = xr[64 * jj]; v = v * rstd; v.x *= wv.x; v.y *= wv.y; v.z *= wv.z; v.w *= wv.w; xr[64 * jj] = v; }
        }
    }
    PH_END(10) }
#if PROBE_MASK
    if (blockIdx.x == 0) {
        const unsigned long long t0 = __builtin_amdgcn_s_memrealtime();
        while (__builtin_amdgcn_s_memrealtime() - t0 < probe_acc) __builtin_amdgcn_s_sleep(8);
    }
#endif
}

extern "C" void kernel_launch(void* const* d_in, const int* in_sizes, int n_in, void* d_out, int out_size, void* d_ws, size_t ws_size, hipStream_t stream) {
    static int grid = 0;
    if (grid == 0) {
        if (n_in != 24 || ws_size < WS_NEED) { fprintf(stderr, "kernel_launch: unexpected n_in %d or ws_size %zu (need %zu)\n", n_in, ws_size, (size_t)WS_NEED); grid = -1; return; }
        int dev = 0, cus = 0, per_cu = 0;
        hipGetDevice(&dev);
        hipDeviceGetAttribute(&cus, hipDeviceAttributeMultiprocessorCount, dev);
        hipFuncSetAttribute((const void*)fwd_megakernel, hipFuncAttributeMaxDynamicSharedMemorySize, LDS_BYTES);
        hipOccupancyMaxActiveBlocksPerMultiprocessor(&per_cu, (const void*)fwd_megakernel, 512, LDS_BYTES);
        if (per_cu < 1) { fprintf(stderr, "kernel_launch: occupancy query gave %d\n", per_cu); per_cu = 1; }
        grid = cus * per_cu;
        (void)hipGetLastError();
    }
    if (grid < 0) return;
    Params p{};
    for (int i = 0; i < 24; ++i) p.in[i] = (const float*)d_in[i];
    p.out = (float*)d_out; p.ws = (unsigned char*)d_ws;
    void* args[] = {&p};
    hipError_t e = hipLaunchCooperativeKernel((const void*)fwd_megakernel, dim3(grid), dim3(512), args, LDS_BYTES, stream);
    if (e != hipSuccess) fprintf(stderr, "cooperative launch failed: %s (grid %d)\n", hipGetErrorString(e), grid);
}
```

```cpp
#include <hip/hip_runtime.h>
#include <hip/hip_cooperative_groups.h>
#include <cstdio>
#include <cstdint>
namespace cg = cooperative_groups;

#define LAS __attribute__((address_space(3)))
typedef unsigned short bf16_t;
typedef short bf16x8 __attribute__((ext_vector_type(8)));
typedef short s16x4 __attribute__((ext_vector_type(4)));
typedef float f32x4 __attribute__((ext_vector_type(4)));
typedef float f32x16 __attribute__((ext_vector_type(16)));
typedef unsigned u32x4 __attribute__((ext_vector_type(4)));
typedef unsigned u32x2 __attribute__((ext_vector_type(2)));

constexpr int D = 1024, BATCH = 32, SEQ = 2048, MTOK = BATCH * SEQ;
constexpr int NCH = SEQ / 64;
constexpr int DFF = 2816, NGU = 2 * DFF;
constexpr int IN_DIM = 11312, NIN = 45 * 256;
constexpr int HB = 16, MH = HB * SEQ;
constexpr float EPS = 1e-6f;

constexpr size_t MiB = 1u << 20;
constexpr size_t WS_SSQ = 0;
constexpr size_t WS_WGU1 = 1 * MiB, WS_WD1 = 12 * MiB, WS_WIN = 18 * MiB, WS_WGO = 41 * MiB, WS_WSO = 43 * MiB, WS_WOUT = 47 * MiB, WS_WGU2 = 49 * MiB, WS_WD2 = 60 * MiB;
constexpr size_t WS_DEC = 66 * MiB, WS_DECS = 67 * MiB, WS_WG = 68 * MiB, WS_HALO = 72 * MiB, WS_SM = 84 * MiB;
constexpr size_t WS_BAR = 92 * MiB;
constexpr size_t WS_XB = 96 * MiB;
constexpr size_t WS_BIG = 224 * MiB;
constexpr size_t T_Q = 0, T_K = 32 * MiB, T_V = 64 * MiB, T_SG = 128 * MiB, T_SZ = 192 * MiB, T_XBC = 320 * MiB, T_GT = 576 * MiB, T_END = 704 * MiB;
constexpr size_t T_T1 = T_Q, T_MRG = T_SG;
constexpr size_t WS_NEED = WS_BIG + T_END;

constexpr int LDS_MAIN = 131072, LDS_BYTES = LDS_MAIN + 64;

__device__ __forceinline__ unsigned cvt_pk_bf16(float lo, float hi) { unsigned r; asm volatile("v_cvt_pk_bf16_f32 %0, %1, %2" : "=v"(r) : "v"(lo), "v"(hi)); return r; }
__device__ __forceinline__ float bf_lo(unsigned u) { return __uint_as_float(u << 16); }
__device__ __forceinline__ float bf_hi(unsigned u) { return __uint_as_float(u & 0xffff0000u); }
__device__ __forceinline__ float fast_rcp(float x) { return __builtin_amdgcn_rcpf(x); }
__device__ __forceinline__ float sigmoidf_(float x) { return fast_rcp(1.f + __expf(-x)); }
__device__ __forceinline__ float siluf_(float x) { return x * sigmoidf_(x); }
__device__ __forceinline__ float softplusf_(float x) { return fmaxf(x, 0.f) + __logf(1.f + __expf(-fabsf(x))); }
__device__ __forceinline__ float wave_sum(float v) {
#pragma unroll
    for (int o = 1; o < 64; o <<= 1) v += __shfl_xor(v, o);
    return v;
}

namespace pg8 {
constexpr int BM = 256, BK = 64, HALF = 128, HTB = HALF * BK * 2, STAGE_BYTES = 8 * HTB, NXCD = 8, WGM = 8;
__host__ __device__ __forceinline__ int lds_byte(int r, int c) { const int st = (r >> 4) * 2 + (c >> 5), rr = r & 15, cc = c & 31, ob = rr * 64 + cc * 2; return st * 1024 + (ob ^ (((ob >> 9) & 1) << 5)); }
__host__ __device__ __forceinline__ void stage_rc(int b, int& R, int& C) { const int st = b / 1024, sb = b % 1024, swz = sb ^ (((sb >> 9) & 1) << 5); R = (st >> 1) * 16 + swz / 64; C = (st & 1) * 32 + (swz % 64) / 2; }
__host__ __device__ __forceinline__ int perm32(int rho) { const int n = rho >> 4, i = rho & 15; return 8 * (i >> 2) + 4 * n + (i & 3); }

struct Unit { int pm, pn; };
struct Gemm { const bf16_t* A; const bf16_t* Bt; int M, N, K, lda, ldb; };

struct StaticOrder {
    int nM, nN, nwg, G, c;
    __device__ void init(int M, int N, int G_, int c_) { nM = M / BM; nN = N / BM; nwg = nM * nN; G = G_; c = c_; }
    __device__ bool next(int i, Unit& u) const {
        const long L = (long)i * G + c; if (L >= nwg) return false;
        int wgid = (int)L; { const int q = nwg / NXCD, r = nwg % NXCD, xcd = wgid % NXCD, off = wgid / NXCD; wgid = (xcd < r ? xcd * (q + 1) : r * (q + 1) + (xcd - r) * q) + off; }
        const int nig = WGM * nN, gid = wgid / nig, fm = gid * WGM, gsz = (nM - fm) < WGM ? (nM - fm) : WGM;
        u.pm = fm + ((wgid % nig) % gsz); u.pn = (wgid % nig) / gsz; return true;
    }
};

template <class Epi>
__device__ __forceinline__ void gemm_phase(LAS unsigned char* lds, const Gemm g, const StaticOrder& S, const Epi& E) {
    int tid = threadIdx.x; asm volatile("" : "+v"(tid));
    const int wid = __builtin_amdgcn_readfirstlane(tid >> 6), lane = tid & 63, wr = wid >> 2, wc = wid & 3, fr = lane & 15, fq = lane >> 4;
    const int K = g.K, nt = K / BK;
    unsigned voffA[2], voffB[2];
#pragma unroll
    for (int i = 0; i < 2; ++i) { int R, C; stage_rc(tid * 16 + i * 8192, R, C); const int Rb = (R & ~31) + perm32(R & 31);
        voffA[i] = (unsigned)(R * g.lda + C) * 2u; voffB[i] = (unsigned)(Rb * g.ldb + C) * 2u; }
    const size_t kstep = (size_t)(BK * 2);
    const size_t hstA = (size_t)HALF * g.lda * 2, hstB = (size_t)HALF * g.ldb * 2;
    const size_t tstA = 2 * hstA, tstB = 2 * hstB;
    const unsigned ldsw = (unsigned)wid * 1024u;
    const int aoff = lds_byte(wr * 64 + fr, fq * 8), boff = lds_byte(wc * 32 + fr, fq * 8);
#define PG8_SA(b, h) (((b) * 2 + (h)) * HTB)
#define PG8_SB(b, h) ((4 + (b) * 2 + (h)) * HTB)
#define PG8_STAGE(bufoff, gbase, voff) do { _Pragma("unroll") for (int _i = 0; _i < 2; ++_i) \
        __builtin_amdgcn_global_load_lds((const unsigned*)((const char*)(gbase) + (voff)[_i]), (LAS unsigned*)(lds + (bufoff) + ldsw + _i * 8192), 16, 0, 0); } while (0)
#define PG8_LDA(dst, b, h) do { _Pragma("unroll") for (int m = 0; m < 4; ++m) _Pragma("unroll") for (int k = 0; k < 2; ++k) dst[m][k] = *(const LAS bf16x8*)(lds + PG8_SA(b, h) + aoff + m * 2048 + k * 1024); } while (0)
#define PG8_LDB(dst, b, h) do { _Pragma("unroll") for (int n = 0; n < 2; ++n) _Pragma("unroll") for (int k = 0; k < 2; ++k) dst[n][k] = *(const LAS bf16x8*)(lds + PG8_SB(b, h) + boff + n * 2048 + k * 1024); } while (0)
#define PG8_MMA(ai, bj, At, Bt) do { __builtin_amdgcn_s_setprio(1); _Pragma("unroll") for (int m = 0; m < 4; ++m) _Pragma("unroll") for (int n = 0; n < 2; ++n) _Pragma("unroll") for (int k = 0; k < 2; ++k) \
        acc[ai][bj][m][n] = __builtin_amdgcn_mfma_f32_16x16x32_bf16(Bt[n][k], At[m][k], acc[ai][bj][m][n], 0, 0, 0); __builtin_amdgcn_s_setprio(0); } while (0)
#define PG8_WAIT_V(n) asm volatile("s_waitcnt vmcnt(" #n ")" ::: "memory")
#define PG8_WAIT_L(n) asm volatile("s_waitcnt lgkmcnt(" #n ")" ::: "memory")
#define PG8_BAR __builtin_amdgcn_s_barrier()
#define PG8_SCHED __builtin_amdgcn_sched_barrier(0)
    Unit cur, nxt; int ui = 0;
    if (!S.next(0, cur)) return;
    f32x4 acc[2][2][4][2];
#pragma unroll
    for (int a = 0; a < 2; ++a)
#pragma unroll
        for (int b = 0; b < 2; ++b)
#pragma unroll
            for (int m = 0; m < 4; ++m)
#pragma unroll
                for (int n = 0; n < 2; ++n) acc[a][b][m][n] = (f32x4){0.f, 0.f, 0.f, 0.f};
    bf16x8 At[4][2], B0[2][2], B1[2][2];
    const char* cA = (const char*)g.A + (size_t)cur.pm * tstA; const char* cB = (const char*)g.Bt + (size_t)cur.pn * tstB;
    PG8_STAGE(PG8_SB(0, 0), cB, voffB); PG8_STAGE(PG8_SA(0, 0), cA, voffA); PG8_STAGE(PG8_SB(0, 1), cB + hstB, voffB); PG8_STAGE(PG8_SA(0, 1), cA + hstA, voffA);
    if (wr == 1) PG8_BAR;
    PG8_WAIT_V(4); PG8_BAR;
    PG8_STAGE(PG8_SB(1, 0), cB + kstep, voffB); PG8_STAGE(PG8_SA(1, 0), cA + kstep, voffA); PG8_STAGE(PG8_SB(1, 1), cB + hstB + kstep, voffB);
    PG8_WAIT_V(6); PG8_BAR;
    for (;;) {
        const bool has_next = S.next(ui + 1, nxt);
        const char* nA = has_next ? (const char*)g.A + (size_t)nxt.pm * tstA : cA; const char* nB = has_next ? (const char*)g.Bt + (size_t)nxt.pn * tstB : cB;
        for (int t = 0; t < nt; t += 2) {
            const bool last = (t == nt - 2);
            const char* a1 = cA + (size_t)(t + 1) * kstep;
            const char* a2 = last ? nA : cA + (size_t)(t + 2) * kstep; const char* b2 = last ? nB : cB + (size_t)(t + 2) * kstep;
            const char* a3 = a2 + kstep; const char* b3 = b2 + kstep;
            PG8_LDB(B0, 0, 0); PG8_SCHED; PG8_LDA(At, 0, 0); PG8_STAGE(PG8_SA(1, 1), a1 + hstA, voffA);
            PG8_WAIT_L(8); PG8_BAR; PG8_WAIT_L(0); PG8_MMA(0, 0, At, B0); PG8_BAR; PG8_SCHED;
            PG8_LDB(B1, 0, 1); PG8_STAGE(PG8_SB(0, 0), b2, voffB);
            PG8_BAR; PG8_WAIT_L(0); PG8_MMA(0, 1, At, B1); PG8_BAR;
            PG8_LDA(At, 0, 1); PG8_STAGE(PG8_SA(0, 0), a2, voffA);
            PG8_BAR; PG8_WAIT_L(0); PG8_MMA(1, 0, At, B0); PG8_BAR; PG8_SCHED;
            PG8_STAGE(PG8_SB(0, 1), b2 + hstB, voffB);
            PG8_WAIT_V(6); PG8_BAR; PG8_MMA(1, 1, At, B1); PG8_BAR;
            PG8_LDB(B0, 1, 0); PG8_SCHED; PG8_LDA(At, 1, 0); PG8_STAGE(PG8_SA(0, 1), a2 + hstA, voffA);
            PG8_WAIT_L(8); PG8_BAR; PG8_WAIT_L(0); PG8_MMA(0, 0, At, B0); PG8_BAR; PG8_SCHED;
            PG8_LDB(B1, 1, 1); PG8_STAGE(PG8_SB(1, 0), b3, voffB);
            PG8_BAR; PG8_WAIT_L(0); PG8_MMA(0, 1, At, B1); PG8_BAR;
            PG8_LDA(At, 1, 1); PG8_STAGE(PG8_SA(1, 0), a3, voffA);
            PG8_BAR; PG8_WAIT_L(0); PG8_MMA(1, 0, At, B0); PG8_BAR; PG8_SCHED;
            PG8_STAGE(PG8_SB(1, 1), b3 + hstB, voffB);
            PG8_WAIT_V(6); PG8_BAR; PG8_MMA(1, 1, At, B1); PG8_BAR;
        }
        E(acc, cur, wr, wc, fr, fq);
        if (!has_next) break;
#pragma unroll
        for (int a = 0; a < 2; ++a)
#pragma unroll
            for (int b = 0; b < 2; ++b)
#pragma unroll
                for (int m = 0; m < 4; ++m)
#pragma unroll
                    for (int n = 0; n < 2; ++n) acc[a][b][m][n] = (f32x4){0.f, 0.f, 0.f, 0.f};
        cur = nxt; cA = nA; cB = nB; ++ui;
    }
    PG8_WAIT_V(0);
    if (wr == 0) PG8_BAR;
    PG8_BAR;
#undef PG8_SA
#undef PG8_SB
#undef PG8_STAGE
#undef PG8_LDA
#undef PG8_LDB
#undef PG8_MMA
#undef PG8_WAIT_V
#undef PG8_WAIT_L
#undef PG8_BAR
#undef PG8_SCHED
}
}

typedef f32x4 AccT[2][2][4][2];

struct EpiGU {
    const float* ssq; bf16_t* O;
    __device__ __forceinline__ void operator()(const AccT& acc, const pg8::Unit& u, int wr, int wc, int fr, int fq) const {
        const int row0 = u.pm * 256 + wr * 64 + fr, col0 = u.pn * 128 + wc * 32 + 8 * fq;
#pragma unroll
        for (int ai = 0; ai < 2; ++ai)
#pragma unroll
            for (int m = 0; m < 4; ++m) {
                const int row = row0 + ai * 128 + m * 16;
                const float rstd = rsqrtf(ssq[row] * (1.f / D) + EPS);
                float v[8];
#pragma unroll
                for (int n = 0; n < 2; ++n)
#pragma unroll
                    for (int j = 0; j < 4; ++j) { const float gg = acc[ai][0][m][n][j] * rstd, uu = acc[ai][1][m][n][j] * rstd; v[4 * n + j] = siluf_(gg) * uu; }
                u32x4 w; w.x = cvt_pk_bf16(v[0], v[1]); w.y = cvt_pk_bf16(v[2], v[3]); w.z = cvt_pk_bf16(v[4], v[5]); w.w = cvt_pk_bf16(v[6], v[7]);
                *(u32x4*)(O + (size_t)row * DFF + col0) = w;
            }
    }
};
struct EpiRes {
    const float* xin; float* xout; bf16_t* xb; float* ssq; float alpha;
    __device__ __forceinline__ void operator()(const AccT& acc, const pg8::Unit& u, int wr, int wc, int fr, int fq) const {
        const int row0 = u.pm * 256 + wr * 64 + fr, col0 = u.pn * 256 + wc * 32 + 8 * fq;
#pragma unroll
        for (int ai = 0; ai < 2; ++ai)
#pragma unroll
            for (int m = 0; m < 4; ++m) {
                const int row = row0 + ai * 128 + m * 16;
                float s = 0.f;
#pragma unroll
                for (int bj = 0; bj < 2; ++bj) {
                    const size_t o = (size_t)row * D + col0 + bj * 128;
                    const f32x4 x0 = *(const f32x4*)(xin + o), x1 = *(const f32x4*)(xin + o + 4);
                    f32x4 y0 = x0 + acc[ai][bj][m][0] * alpha, y1 = x1 + acc[ai][bj][m][1] * alpha;
                    *(f32x4*)(xout + o) = y0; *(f32x4*)(xout + o + 4) = y1;
                    s += y0.x * y0.x + y0.y * y0.y + y0.z * y0.z + y0.w * y0.w + y1.x * y1.x + y1.y * y1.y + y1.z * y1.z + y1.w * y1.w;
                    if (xb) { u32x4 w; w.x = cvt_pk_bf16(y0.x, y0.y); w.y = cvt_pk_bf16(y0.z, y0.w); w.z = cvt_pk_bf16(y1.x, y1.y); w.w = cvt_pk_bf16(y1.z, y1.w); *(u32x4*)(xb + o) = w; }
                }
                s += __shfl_xor(s, 16); s += __shfl_xor(s, 32);
                if (fq == 0) atomicAdd(ssq + row, s);
            }
    }
};
struct EpiIn {
    const float* ssq; unsigned char* T; bf16_t* halo; float* sm;
    __device__ __forceinline__ void operator()(const AccT& acc, const pg8::Unit& u, int wr, int wc, int fr, int fq) const {
        const int pn = u.pn;
        const int row0 = u.pm * 256 + wr * 64 + fr;
        int act = 0, ld, ct; bf16_t* base;
        if (pn < 2) { base = (bf16_t*)(T + T_Q); ld = 512; ct = pn; }
        else if (pn < 4) { base = (bf16_t*)(T + T_K); ld = 512; ct = pn - 2; }
        else if (pn < 8) { base = (bf16_t*)(T + T_V); ld = 1024; ct = pn - 4; }
        else if (pn < 12) { base = (bf16_t*)(T + T_SG); ld = 1024; ct = pn - 8; act = 1; }
        else if (pn < 20) { base = (bf16_t*)(T + T_SZ); ld = 2048; ct = pn - 12; act = 1; }
        else if (pn < 36) { base = (bf16_t*)(T + T_XBC); ld = 4096; ct = pn - 20; act = 3; }
        else if (pn < 44) { base = (bf16_t*)(T + T_GT); ld = 2048; ct = pn - 36; act = 2; }
        else { base = nullptr; ld = 0; ct = 0; act = 4; }
        if (act == 4) {
            if (wc < 2) {
#pragma unroll
                for (int ai = 0; ai < 2; ++ai)
#pragma unroll
                    for (int m = 0; m < 4; ++m) {
                        const int row = row0 + ai * 128 + m * 16;
                        const float rstd = rsqrtf(ssq[row] * (1.f / D) + EPS);
                        float* p = sm + (size_t)row * 64 + wc * 32 + 8 * fq;
                        *(f32x4*)p = acc[ai][0][m][0] * rstd; *(f32x4*)(p + 4) = acc[ai][0][m][1] * rstd;
                    }
            }
            return;
        }
        const int col0 = ct * 256 + wc * 32 + 8 * fq;
#pragma unroll
        for (int ai = 0; ai < 2; ++ai)
#pragma unroll
            for (int m = 0; m < 4; ++m) {
                const int row = row0 + ai * 128 + m * 16;
                const float rstd = rsqrtf(ssq[row] * (1.f / D) + EPS);
#pragma unroll
                for (int bj = 0; bj < 2; ++bj) {
                    float v[8];
#pragma unroll
                    for (int n = 0; n < 2; ++n)
#pragma unroll
                        for (int j = 0; j < 4; ++j) { float x = acc[ai][bj][m][n][j] * rstd; if (act == 1) x = siluf_(x); else if (act == 2) x = sigmoidf_(x); v[4 * n + j] = x; }
                    u32x4 w; w.x = cvt_pk_bf16(v[0], v[1]); w.y = cvt_pk_bf16(v[2], v[3]); w.z = cvt_pk_bf16(v[4], v[5]); w.w = cvt_pk_bf16(v[6], v[7]);
                    *(u32x4*)(base + (size_t)row * ld + col0 + bj * 128) = w;
                    if (act == 3 && (row & 63) >= 61) *(u32x4*)(halo + ((size_t)(row >> 6) * 3 + ((row & 63) - 61)) * 4096 + col0 + bj * 128) = w;
                }
            }
    }
};
struct EpiGate {
    const bf16_t* gt; const bf16_t* t1; bf16_t* out; int mode;
    __device__ __forceinline__ void operator()(const AccT& acc, const pg8::Unit& u, int wr, int wc, int fr, int fq) const {
        const int row0 = u.pm * 256 + wr * 64 + fr, col0 = u.pn * 256 + wc * 32 + 8 * fq;
#pragma unroll
        for (int ai = 0; ai < 2; ++ai)
#pragma unroll
            for (int m = 0; m < 4; ++m) {
                const int row = row0 + ai * 128 + m * 16;
#pragma unroll
                for (int bj = 0; bj < 2; ++bj) {
                    const int col = col0 + bj * 128;
                    const u32x4 gq = *(const u32x4*)(gt + (size_t)row * 2048 + mode * 1024 + col);
                    float v[8];
                    v[0] = acc[ai][bj][m][0].x * bf_lo(gq.x); v[1] = acc[ai][bj][m][0].y * bf_hi(gq.x); v[2] = acc[ai][bj][m][0].z * bf_lo(gq.y); v[3] = acc[ai][bj][m][0].w * bf_hi(gq.y);
                    v[4] = acc[ai][bj][m][1].x * bf_lo(gq.z); v[5] = acc[ai][bj][m][1].y * bf_hi(gq.z); v[6] = acc[ai][bj][m][1].z * bf_lo(gq.w); v[7] = acc[ai][bj][m][1].w * bf_hi(gq.w);
                    if (mode) { const u32x4 tq = *(const u32x4*)(t1 + (size_t)row * D + col);
                        v[0] += bf_lo(tq.x); v[1] += bf_hi(tq.x); v[2] += bf_lo(tq.y); v[3] += bf_hi(tq.y); v[4] += bf_lo(tq.z); v[5] += bf_hi(tq.z); v[6] += bf_lo(tq.w); v[7] += bf_hi(tq.w); }
                    u32x4 w; w.x = cvt_pk_bf16(v[0], v[1]); w.y = cvt_pk_bf16(v[2], v[3]); w.z = cvt_pk_bf16(v[4], v[5]); w.w = cvt_pk_bf16(v[6], v[7]);
                    *(u32x4*)(out + (size_t)row * D + col) = w;
                }
            }
    }
};

__device__ __forceinline__ void tr_item(const float* srcp, int ld, const float* sk, float mul, int k0, int K, bf16_t* dst, int n0, LAS float* scr, int lane) {
#pragma unroll 8
    for (int i = 0; i < 32; ++i) { const int kk = 2 * i + (lane >> 5);
        float v = 0.f; if (srcp) v = srcp[(size_t)(k0 + kk) * ld] * (sk ? sk[k0 + kk] : 1.f) * mul;
        scr[kk * 33 + (lane & 31)] = v; }
    asm volatile("s_waitcnt lgkmcnt(0)" ::: "memory");
    const int c = lane & 7;
#pragma unroll
    for (int j = 0; j < 4; ++j) { const int n = (lane >> 3) + 8 * j; const LAS float* s = scr + (8 * c) * 33 + n;
        u32x4 o; o.x = cvt_pk_bf16(s[0 * 33], s[1 * 33]); o.y = cvt_pk_bf16(s[2 * 33], s[3 * 33]); o.z = cvt_pk_bf16(s[4 * 33], s[5 * 33]); o.w = cvt_pk_bf16(s[6 * 33], s[7 * 33]);
        *(u32x4*)(dst + (size_t)(n0 + n) * K + k0 + 8 * c) = o; }
    asm volatile("s_waitcnt lgkmcnt(0)" ::: "memory");
}
__device__ __forceinline__ int win_src_col(int nd) {
    if (nd < 3072) return nd;
    if (nd < 5120) return 3088 + (nd - 3072);
    if (nd < 9216) return 5136 + (nd - 5120);
    if (nd < 11264) return 9264 + (nd - 9216);
    if (nd < 11280) return 3072 + (nd - 11264);
    if (nd < 11312) return 9232 + (nd - 11280);
    return -1;
}

struct Params {
    const float* in[24];
    float* out;
    unsigned char* ws;
};

typedef __attribute__((address_space(4))) const Params* KP;
__device__ __forceinline__ Params load_params(KP p) { Params r;
#pragma unroll
    for (int i = 0; i < 24; ++i) r.in[i] = p->in[i];
    r.out = p->out; r.ws = p->ws; return r; }
__device__ __forceinline__ int tid_fresh() { int t = threadIdx.x; asm volatile("" : "+v"(t)); return t; }
__device__ __forceinline__ void p0_prologue(KP Pp, LAS unsigned char* lds, int G) {
    const Params P = load_params(Pp);
    const int tid = tid_fresh(), lane = tid & 63, wave = tid >> 6;
    LAS float* scr = (LAS float*)(lds + wave * 16384);
    const int gw = blockIdx.x * 8 + wave, NGW = G * 8;
    unsigned char* ws = P.ws;
    constexpr int I_GU = (D / 64) * (NGU / 32), I_DN = (DFF / 64) * (D / 32), I_IN = (D / 64) * (NIN / 32), I_GO = (D / 64) * (D / 32), I_SO = (2048 / 64) * (D / 32);
    constexpr int NITEMS = 2 * I_GU + 2 * I_DN + I_IN + 2 * I_GO + I_SO;
    for (int it = gw; it < NITEMS; it += NGW) {
        int r = it; const int j = lane & 31;
        if (r < 2 * I_GU) { const int l2 = r >= I_GU; r -= l2 * I_GU; const int nb = r % (NGU / 32), kb = r / (NGU / 32); const int nd = nb * 32 + j, tile = nd >> 8, w = nd & 255;
            const float* Wg = P.in[l2 ? 20 : 2]; const float* Wu = P.in[l2 ? 21 : 3];
            const float* sp = (w < 128 ? Wg : Wu) + 128 * tile + (w & 127);
            tr_item(sp, DFF, P.in[l2 ? 19 : 1], 1.f, kb * 64, D, (bf16_t*)(ws + (l2 ? WS_WGU2 : WS_WGU1)), nb * 32, scr, lane); continue; }
        r -= 2 * I_GU;
        if (r < 2 * I_DN) { const int l2 = r >= I_DN; r -= l2 * I_DN; const int nb = r % (D / 32), kb = r / (D / 32);
            tr_item(P.in[l2 ? 22 : 4] + nb * 32 + j, D, nullptr, 1.f, kb * 64, DFF, (bf16_t*)(ws + (l2 ? WS_WD2 : WS_WD1)), nb * 32, scr, lane); continue; }
        r -= 2 * I_DN;
        if (r < I_IN) { const int nb = r % (NIN / 32), kb = r / (NIN / 32); const int nd = nb * 32 + j, sc = win_src_col(nd);
            tr_item(sc >= 0 ? P.in[6] + sc : nullptr, IN_DIM, P.in[5], nd < 512 ? 0.08838834764831845f : 1.f, kb * 64, D, (bf16_t*)(ws + WS_WIN), nb * 32, scr, lane); continue; }
        r -= I_IN;
        if (r < 2 * I_GO) { const int l2 = r >= I_GO; r -= l2 * I_GO; const int nb = r % (D / 32), kb = r / (D / 32);
            tr_item(P.in[l2 ? 18 : 10] + nb * 32 + j, D, nullptr, 1.f, kb * 64, D, (bf16_t*)(ws + (l2 ? WS_WOUT : WS_WGO)), nb * 32, scr, lane); continue; }
        r -= 2 * I_GO;
        { const int nb = r % (D / 32), kb = r / (D / 32);
            tr_item(P.in[17] + nb * 32 + j, D, nullptr, 1.f, kb * 64, 2048, (bf16_t*)(ws + WS_WSO), nb * 32, scr, lane); }
    }
    const float* x = P.in[0]; bf16_t* xb = (bf16_t*)(ws + WS_XB); float* ssq = (float*)(ws + WS_SSQ);
    for (int m = gw; m < MTOK; m += NGW) {
        const f32x4* xr = (const f32x4*)(x + (size_t)m * D) + lane;
        unsigned long long* o8 = (unsigned long long*)(xb + (size_t)m * D) + lane;
        float s = 0.f;
#pragma unroll
        for (int jj = 0; jj < 4; ++jj) { const f32x4 v = xr[64 * jj]; s += v.x * v.x + v.y * v.y + v.z * v.z + v.w * v.w;
            o8[64 * jj] = (unsigned long long)cvt_pk_bf16(v.x, v.y) | ((unsigned long long)cvt_pk_bf16(v.z, v.w) << 32); }
        s = wave_sum(s);
        if (lane == 0) { ssq[m] = s; ssq[MTOK + m] = 0.f; ssq[2 * MTOK + m] = 0.f; ssq[3 * MTOK + m] = 0.f; }
    }
}

__device__ __forceinline__ void p4_prep(KP Pp, LAS unsigned char* lds, int G) {
    const Params P = load_params(Pp);
    const int tid = tid_fresh();
    unsigned char* ws = P.ws; unsigned char* T = ws + WS_BIG;
    const float* sm = (const float*)(ws + WS_SM);
    for (int it = blockIdx.x; it < HB * NCH; it += G) {
        const int row0 = it * 64;
#pragma unroll
        for (int i = 0; i < 2; ++i) { const int idx = tid + 512 * i; *(LAS f32x4*)(lds + idx * 16) = *(const f32x4*)(sm + (size_t)row0 * 64 + idx * 4); }
        __syncthreads();
        {
            const int hc = tid;
            const float* wf = P.in[7]; float w[16];
#pragma unroll
            for (int j = 0; j < 16; ++j) w[j] = wf[j * 512 + hc];
            const float bfv = P.in[8][hc];
            float cum = 0.f;
#pragma unroll 4
            for (int t = 0; t < 64; ++t) { float z = bfv;
#pragma unroll
                for (int j4 = 0; j4 < 4; ++j4) { const f32x4 f = *(const LAS f32x4*)(lds + t * 256 + j4 * 16); z += f.x * w[4 * j4] + f.y * w[4 * j4 + 1] + f.z * w[4 * j4 + 2] + f.w * w[4 * j4 + 3]; }
                cum += (fminf(z, 0.f) - __logf(1.f + __expf(-fabsf(z)))) * (1.f / 16.f); }
            const float end = cum; cum = 0.f;
            bf16_t* kp = (bf16_t*)(T + T_K) + (size_t)row0 * 512 + hc;
            for (int tb = 0; tb < 4; ++tb) {
                bf16_t kk[16];
#pragma unroll
                for (int u = 0; u < 16; ++u) kk[u] = kp[(size_t)(tb * 16 + u) * 512];
#pragma unroll
                for (int u = 0; u < 16; ++u) { const int t = tb * 16 + u; float z = bfv;
#pragma unroll
                    for (int j4 = 0; j4 < 4; ++j4) { const f32x4 f = *(const LAS f32x4*)(lds + t * 256 + j4 * 16); z += f.x * w[4 * j4] + f.y * w[4 * j4 + 1] + f.z * w[4 * j4 + 2] + f.w * w[4 * j4 + 3]; }
                    cum += (fminf(z, 0.f) - __logf(1.f + __expf(-fabsf(z)))) * (1.f / 16.f);
                    const float kv = __uint_as_float((unsigned)kk[u] << 16) * __expf(end - cum);
                    kp[(size_t)t * 512] = (bf16_t)(cvt_pk_bf16(kv, 0.f) & 0xffffu); }
            }
            ((float*)(ws + WS_DEC))[(size_t)it * 512 + hc] = __expf(end);
        }
        if (tid < 32) {
            const float bias = P.in[13][tid], A = -__expf(P.in[14][tid]);
            float cum = 0.f;
#pragma unroll 4
            for (int t = 0; t < 64; ++t) cum += softplusf_(*(const LAS float*)(lds + t * 256 + (16 + tid) * 4) + bias) * A;
            const float end = cum; cum = 0.f;
            float* wg = (float*)(ws + WS_WG);
#pragma unroll 4
            for (int t = 0; t < 64; ++t) { const float dt = softplusf_(*(const LAS float*)(lds + t * 256 + (16 + tid) * 4) + bias); cum += dt * A; wg[(size_t)(row0 + t) * 32 + tid] = __expf(end - cum) * dt; }
            ((float*)(ws + WS_DECS))[it * 32 + tid] = __expf(end);
        }
        __syncthreads();
    }
    const int co = tid & 63, rg = tid >> 6;
    u32x4 raw[11];
#define CONV_LOAD(itx) do { const int _ci = (itx) >> 3, _col = ((itx) & 7) * 512 + co * 8; \
        const bf16_t* _xp = (const bf16_t*)(T + T_XBC) + (size_t)(_ci * 64 + rg * 8) * 4096 + _col; \
        _Pragma("unroll") for (int i = 0; i < 8; ++i) raw[3 + i] = *(const u32x4*)(_xp + (size_t)i * 4096); \
        if (rg > 0) { _Pragma("unroll") for (int i = 0; i < 3; ++i) raw[i] = *(const u32x4*)(_xp - (size_t)(3 - i) * 4096); } \
        else if ((_ci & (NCH - 1)) != 0) { const bf16_t* _hp = (const bf16_t*)(ws + WS_HALO) + (size_t)(_ci - 1) * 3 * 4096 + _col; \
            _Pragma("unroll") for (int i = 0; i < 3; ++i) raw[i] = *(const u32x4*)(_hp + (size_t)i * 4096); } \
        else { _Pragma("unroll") for (int i = 0; i < 3; ++i) raw[i] = (u32x4){0u, 0u, 0u, 0u}; } } while (0)
    if ((int)blockIdx.x < HB * NCH * 8) CONV_LOAD((int)blockIdx.x);
    for (int it = blockIdx.x; it < HB * NCH * 8; it += G) {
        const int ci = it >> 3, cb = it & 7, col = cb * 512 + co * 8, row0 = ci * 64 + rg * 8;
        bf16_t* xp = (bf16_t*)(T + T_XBC) + (size_t)row0 * 4096 + col;
        float cw[4][8], cbv[8];
#pragma unroll
        for (int k = 0; k < 4; ++k) { const f32x4 a = *(const f32x4*)(P.in[11] + k * 4096 + col), b = *(const f32x4*)(P.in[11] + k * 4096 + col + 4);
            cw[k][0] = a.x; cw[k][1] = a.y; cw[k][2] = a.z; cw[k][3] = a.w; cw[k][4] = b.x; cw[k][5] = b.y; cw[k][6] = b.z; cw[k][7] = b.w; }
        { const f32x4 a = *(const f32x4*)(P.in[12] + col), b = *(const f32x4*)(P.in[12] + col + 4);
            cbv[0] = a.x; cbv[1] = a.y; cbv[2] = a.z; cbv[3] = a.w; cbv[4] = b.x; cbv[5] = b.y; cbv[6] = b.z; cbv[7] = b.w; }
        asm volatile("s_waitcnt vmcnt(0)" ::: "memory");
        __syncthreads();
        u32x4 outv[8];
#pragma unroll
        for (int i = 0; i < 8; ++i) {
            float v[8];
#pragma unroll
            for (int e = 0; e < 8; ++e) v[e] = cbv[e];
#pragma unroll
            for (int k = 0; k < 4; ++k) { const u32x4 q = raw[i + k];
                v[0] += cw[k][0] * bf_lo(q.x); v[1] += cw[k][1] * bf_hi(q.x); v[2] += cw[k][2] * bf_lo(q.y); v[3] += cw[k][3] * bf_hi(q.y);
                v[4] += cw[k][4] * bf_lo(q.z); v[5] += cw[k][5] * bf_hi(q.z); v[6] += cw[k][6] * bf_lo(q.w); v[7] += cw[k][7] * bf_hi(q.w); }
#pragma unroll
            for (int e = 0; e < 8; ++e) v[e] = siluf_(v[e]);
            outv[i].x = cvt_pk_bf16(v[0], v[1]); outv[i].y = cvt_pk_bf16(v[2], v[3]); outv[i].z = cvt_pk_bf16(v[4], v[5]); outv[i].w = cvt_pk_bf16(v[6], v[7]);
        }
        if (it + G < HB * NCH * 8) CONV_LOAD(it + G);
#pragma unroll
        for (int i = 0; i < 8; ++i) *(u32x4*)(xp + (size_t)i * 4096) = outv[i];
    }
#undef CONV_LOAD
}

struct MixArgs {
    const bf16_t* ak; int ld_ak;
    const bf16_t* qq; int ld_q;
    const bf16_t* bv; int ld_bv;
    const bf16_t* gt; int ld_g;
    bf16_t* out; int ld_o;
    const float* dec;
    const float* wg;
    const float* nw;
    const float* dsk;
};
constexpr int RSA = 320, RSB = 576, RSQ = 264, RSG = 520;
constexpr int OFF_AK = 0, OFF_BV = 64 * RSA, OFF_QQ = OFF_BV + 64 * RSB, OFF_WGT = OFF_QQ + 64 * RSQ, OFF_DEC = OFF_WGT + 1024, OFF_RED = OFF_DEC + 512, OFF_NW = OFF_RED + 2048, OFF_GT = OFF_NW + 1024;
static_assert(OFF_GT + 64 * RSG <= LDS_MAIN, "mixer LDS");

#define LBAR() do { asm volatile("s_waitcnt lgkmcnt(0)" ::: "memory"); __builtin_amdgcn_s_barrier(); asm volatile("" ::: "memory"); } while (0)
template <bool SSD>
__device__ __forceinline__ void mixer_item(LAS unsigned char* lds, const MixArgs& a) {
    const int tid = tid_fresh(), lane = tid & 63, w = __builtin_amdgcn_readfirstlane(tid >> 6);
    const int r = lane & 31, h = lane >> 5, gg = lane >> 4, q = (lane & 15) >> 2, p = lane & 3;
    const int arow0 = tid >> 4, apc = tid & 15;
    const int brow0 = tid >> 5, bpc = tid & 31;
    u32x4 stA[2], stQ[2], stB[4], stG[4], stW, stD;
    stW = (u32x4){0u, 0u, 0u, 0u}; stD = stW;
#define MIX_LOAD(c) do { const size_t _r0 = (size_t)(c) * 64; \
        _Pragma("unroll") for (int i = 0; i < 2; ++i) { stA[i] = *(const u32x4*)(a.ak + (_r0 + arow0 + 32 * i) * a.ld_ak + apc * 8); stQ[i] = *(const u32x4*)(a.qq + (_r0 + arow0 + 32 * i) * a.ld_q + apc * 8); } \
        _Pragma("unroll") for (int i = 0; i < 4; ++i) { stB[i] = *(const u32x4*)(a.bv + (_r0 + brow0 + 16 * i) * a.ld_bv + bpc * 8); stG[i] = *(const u32x4*)(a.gt + (_r0 + brow0 + 16 * i) * a.ld_g + bpc * 8); } \
        if (SSD) { if (tid < 64) stW = *(const u32x4*)(a.wg + (_r0 + tid) * 32); } \
        else { if (tid < 32) stD = *(const u32x4*)(a.dec + (size_t)(c) * 512 + tid * 4); } } while (0)
#define MIX_STORE() do { \
        _Pragma("unroll") for (int i = 0; i < 2; ++i) { *(LAS u32x4*)(lds + OFF_AK + (arow0 + 32 * i) * RSA + apc * 16) = stA[i]; \
            *(LAS u32x2*)(lds + OFF_QQ + (arow0 + 32 * i) * RSQ + apc * 16) = (u32x2){stQ[i].x, stQ[i].y}; *(LAS u32x2*)(lds + OFF_QQ + (arow0 + 32 * i) * RSQ + apc * 16 + 8) = (u32x2){stQ[i].z, stQ[i].w}; } \
        _Pragma("unroll") for (int i = 0; i < 4; ++i) { *(LAS u32x4*)(lds + OFF_BV + (brow0 + 16 * i) * RSB + bpc * 16) = stB[i]; \
            *(LAS u32x2*)(lds + OFF_GT + (brow0 + 16 * i) * RSG + bpc * 16) = (u32x2){stG[i].x, stG[i].y}; *(LAS u32x2*)(lds + OFF_GT + (brow0 + 16 * i) * RSG + bpc * 16 + 8) = (u32x2){stG[i].z, stG[i].w}; } \
        if (SSD) { if (tid < 64) { *(LAS unsigned*)(lds + OFF_WGT + tid * 4) = stW.x; *(LAS unsigned*)(lds + OFF_WGT + 256 + tid * 4) = stW.y; *(LAS unsigned*)(lds + OFF_WGT + 512 + tid * 4) = stW.z; *(LAS unsigned*)(lds + OFF_WGT + 768 + tid * 4) = stW.w; } } \
        else { if (tid < 32) *(LAS u32x4*)(lds + OFF_DEC + tid * 16) = stD; } } while (0)

    if (tid < 256) *(LAS float*)(lds + OFF_NW + tid * 4) = a.nw[tid];
    MIX_LOAD(0);
    MIX_STORE();
    __syncthreads();

    f32x16 S[4];
#pragma unroll
    for (int i = 0; i < 4; ++i)
#pragma unroll
        for (int e = 0; e < 16; ++e) S[i][e] = 0.f;

    const int trA = OFF_AK + (8 * h + q) * RSA + (16 * (gg & 1) + 4 * p) * 2;
    const int trB = OFF_BV + (8 * h + q) * RSB + (32 * w + 16 * (gg & 1) + 4 * p) * 2;
    const int qB = OFF_QQ + r * RSQ + 8 * h;
    const int gB = OFF_GT + r * RSG + (32 * w + 4 * h) * 2;
    const float dsk = SSD ? a.dsk[w >> 1] : 0.f;

    for (int c = 0; c < NCH; ++c) {
        if (c + 1 < NCH) MIX_LOAD(c + 1);
        if (SSD) {
            const float dc = a.dec[(size_t)c * 32 + (w >> 1)];
#pragma unroll
            for (int i = 0; i < 4; ++i)
#pragma unroll
                for (int e = 0; e < 16; ++e) S[i][e] *= dc;
        } else {
#pragma unroll
            for (int i = 0; i < 4; ++i)
#pragma unroll
                for (int g = 0; g < 4; ++g) { const f32x4 d4 = *(const LAS f32x4*)(lds + OFF_DEC + (32 * i + 8 * g + 4 * h) * 4);
                    S[i][4 * g + 0] *= d4.x; S[i][4 * g + 1] *= d4.y; S[i][4 * g + 2] *= d4.z; S[i][4 * g + 3] *= d4.w; }
        }
#define TRR(addr) __builtin_bit_cast(s16x4, __builtin_amdgcn_ds_read_tr16_b64_v4i16((LAS s16x4*)(lds + (addr))))
#define UPD_LOAD(s, B0, B1, A0, A1, W0, W1) do { B0 = TRR(trB + (16 * (s)) * RSB); B1 = TRR(trB + (16 * (s) + 4) * RSB); \
        _Pragma("unroll") for (int i = 0; i < 4; ++i) { A0[i] = TRR(trA + (16 * (s)) * RSA + 64 * i); A1[i] = TRR(trA + (16 * (s) + 4) * RSA + 64 * i); } \
        if (SSD) { W0 = *(const LAS f32x4*)(lds + OFF_WGT + (w >> 1) * 256 + (16 * (s) + 8 * h) * 4); W1 = *(const LAS f32x4*)(lds + OFF_WGT + (w >> 1) * 256 + (16 * (s) + 8 * h + 4) * 4); } } while (0)
#define UPD_MMA(B0, B1, A0, A1, W0, W1) do { bf16x8 bfr = __builtin_shufflevector(B0, B1, 0, 1, 2, 3, 4, 5, 6, 7); \
        if (SSD) { u32x4 bu = __builtin_bit_cast(u32x4, bfr); \
            bu.x = cvt_pk_bf16(bf_lo(bu.x) * W0.x, bf_hi(bu.x) * W0.y); bu.y = cvt_pk_bf16(bf_lo(bu.y) * W0.z, bf_hi(bu.y) * W0.w); \
            bu.z = cvt_pk_bf16(bf_lo(bu.z) * W1.x, bf_hi(bu.z) * W1.y); bu.w = cvt_pk_bf16(bf_lo(bu.w) * W1.z, bf_hi(bu.w) * W1.w); bfr = __builtin_bit_cast(bf16x8, bu); } \
        _Pragma("unroll") for (int i = 0; i < 4; ++i) S[i] = __builtin_amdgcn_mfma_f32_32x32x16_bf16(__builtin_shufflevector(A0[i], A1[i], 0, 1, 2, 3, 4, 5, 6, 7), bfr, S[i], 0, 0, 0); } while (0)
        {
            s16x4 xb0, xb1, xa0[4], xa1[4], yb0, yb1, ya0[4], ya1[4]; f32x4 xw0, xw1, yw0, yw1;
            xw0 = xw1 = yw0 = yw1 = (f32x4){0.f, 0.f, 0.f, 0.f};
            UPD_LOAD(0, xb0, xb1, xa0, xa1, xw0, xw1);
            UPD_LOAD(1, yb0, yb1, ya0, ya1, yw0, yw1);
            __builtin_amdgcn_sched_barrier(0);
            UPD_MMA(xb0, xb1, xa0, xa1, xw0, xw1);
            __builtin_amdgcn_sched_barrier(0);
            UPD_LOAD(2, xb0, xb1, xa0, xa1, xw0, xw1);
            __builtin_amdgcn_sched_barrier(0);
            UPD_MMA(yb0, yb1, ya0, ya1, yw0, yw1);
            __builtin_amdgcn_sched_barrier(0);
            UPD_LOAD(3, yb0, yb1, ya0, ya1, yw0, yw1);
            __builtin_amdgcn_sched_barrier(0);
            UPD_MMA(xb0, xb1, xa0, xa1, xw0, xw1);
            __builtin_amdgcn_sched_barrier(0);
            UPD_MMA(yb0, yb1, ya0, ya1, yw0, yw1);
        }
#undef UPD_LOAD
#undef UPD_MMA
        f32x16 OT[2];
#pragma unroll
        for (int j2 = 0; j2 < 2; ++j2)
#pragma unroll
            for (int e = 0; e < 16; ++e) OT[j2][e] = 0.f;
        {
            u32x2 qf[3][2][2];
#define Q_LOAD(sp, buf) do { _Pragma("unroll") for (int j2 = 0; j2 < 2; ++j2) { qf[buf][j2][0] = *(const LAS u32x2*)(lds + qB + 32 * j2 * RSQ + (16 * (sp)) * 2); qf[buf][j2][1] = *(const LAS u32x2*)(lds + qB + 32 * j2 * RSQ + (16 * (sp) + 8) * 2); } } while (0)
            Q_LOAD(0, 0); Q_LOAD(1, 1);
#pragma unroll
            for (int sp = 0; sp < 8; ++sp) {
                const int i = sp >> 1, o8 = 8 * (sp & 1);
                if (sp + 2 < 8) Q_LOAD(sp + 2, (sp + 2) % 3);
                u32x4 pk;
                pk.x = cvt_pk_bf16(S[i][o8 + 0], S[i][o8 + 1]); pk.y = cvt_pk_bf16(S[i][o8 + 2], S[i][o8 + 3]);
                pk.z = cvt_pk_bf16(S[i][o8 + 4], S[i][o8 + 5]); pk.w = cvt_pk_bf16(S[i][o8 + 6], S[i][o8 + 7]);
                const bf16x8 sfr = __builtin_bit_cast(bf16x8, pk);
                __builtin_amdgcn_sched_barrier(0);
#pragma unroll
                for (int j2 = 0; j2 < 2; ++j2) {
                    const bf16x8 qfr = __builtin_bit_cast(bf16x8, (u32x4){qf[sp % 3][j2][0].x, qf[sp % 3][j2][0].y, qf[sp % 3][j2][1].x, qf[sp % 3][j2][1].y});
                    OT[j2] = __builtin_amdgcn_mfma_f32_32x32x16_bf16(sfr, qfr, OT[j2], 0, 0, 0);
                }
                __builtin_amdgcn_sched_barrier(0);
            }
#undef Q_LOAD
        }
#undef TRR
        u32x2 gv[2][4];
#pragma unroll
        for (int j2 = 0; j2 < 2; ++j2)
#pragma unroll
            for (int g = 0; g < 4; ++g) gv[j2][g] = *(const LAS u32x2*)(lds + gB + 32 * j2 * RSG + 16 * g);
        float part[2] = {0.f, 0.f};
#pragma unroll
        for (int j2 = 0; j2 < 2; ++j2)
#pragma unroll
            for (int g = 0; g < 4; ++g) {
                if (SSD) {
                    const u32x2 xs = *(const LAS u32x2*)(lds + OFF_BV + (32 * j2 + r) * RSB + (32 * w + 8 * g + 4 * h) * 2);
                    OT[j2][4 * g + 0] = (OT[j2][4 * g + 0] + dsk * bf_lo(xs.x)) * bf_lo(gv[j2][g].x);
                    OT[j2][4 * g + 1] = (OT[j2][4 * g + 1] + dsk * bf_hi(xs.x)) * bf_hi(gv[j2][g].x);
                    OT[j2][4 * g + 2] = (OT[j2][4 * g + 2] + dsk * bf_lo(xs.y)) * bf_lo(gv[j2][g].y);
                    OT[j2][4 * g + 3] = (OT[j2][4 * g + 3] + dsk * bf_hi(xs.y)) * bf_hi(gv[j2][g].y);
                }
#pragma unroll
                for (int k = 0; k < 4; ++k) part[j2] += OT[j2][4 * g + k] * OT[j2][4 * g + k];
            }
        part[0] += __shfl_xor(part[0], 32); part[1] += __shfl_xor(part[1], 32);
        if (h == 0) { *(LAS float*)(lds + OFF_RED + (w * 64 + r) * 4) = part[0]; *(LAS float*)(lds + OFF_RED + (w * 64 + 32 + r) * 4) = part[1]; }
        LBAR();
#pragma unroll
        for (int j2 = 0; j2 < 2; ++j2) {
            float tot = 0.f;
#pragma unroll
            for (int ww = 0; ww < 8; ++ww) tot += *(const LAS float*)(lds + OFF_RED + (ww * 64 + 32 * j2 + r) * 4);
            const float rstd = rsqrtf(tot * (1.f / 256.f) + EPS);
#pragma unroll
            for (int g = 0; g < 4; ++g) {
                const f32x4 n4 = *(const LAS f32x4*)(lds + OFF_NW + (32 * w + 8 * g + 4 * h) * 4);
                float v0 = OT[j2][4 * g + 0] * rstd * n4.x, v1 = OT[j2][4 * g + 1] * rstd * n4.y, v2 = OT[j2][4 * g + 2] * rstd * n4.z, v3 = OT[j2][4 * g + 3] * rstd * n4.w;
                if (!SSD) { v0 *= bf_lo(gv[j2][g].x); v1 *= bf_hi(gv[j2][g].x); v2 *= bf_lo(gv[j2][g].y); v3 *= bf_hi(gv[j2][g].y); }
                *(LAS u32x2*)(lds + gB + 32 * j2 * RSG + 16 * g) = (u32x2){cvt_pk_bf16(v0, v1), cvt_pk_bf16(v2, v3)};
            }
        }
        LBAR();
#pragma unroll
        for (int i = 0; i < 4; ++i) {
            const u32x2 o0 = *(const LAS u32x2*)(lds + OFF_GT + (brow0 + 16 * i) * RSG + bpc * 16), o1 = *(const LAS u32x2*)(lds + OFF_GT + (brow0 + 16 * i) * RSG + bpc * 16 + 8);
            *(u32x4*)(a.out + ((size_t)c * 64 + brow0 + 16 * i) * a.ld_o + bpc * 8) = (u32x4){o0.x, o0.y, o1.x, o1.y};
        }
        if (c + 1 < NCH) MIX_STORE();
        LBAR();
    }
#undef MIX_LOAD
#undef MIX_STORE
}

__device__ __forceinline__ void p5_mixer(KP Pp, LAS unsigned char* lds, int G) {
    const Params P = load_params(Pp);
    unsigned char* ws = P.ws; unsigned char* T = ws + WS_BIG;
    for (int it = blockIdx.x; it < HB * 12; it += G) {
        const int b = it / 12, k = it % 12;
        const size_t row0 = (size_t)b * SEQ;
        MixArgs a;
        if (k < 4) {
            const int hd = k;
            a.ak = (const bf16_t*)(T + T_K) + row0 * 512 + hd * 128; a.ld_ak = 512;
            a.qq = (const bf16_t*)(T + T_Q) + row0 * 512 + hd * 128; a.ld_q = 512;
            a.bv = (const bf16_t*)(T + T_V) + row0 * 1024 + hd * 256; a.ld_bv = 1024;
            a.gt = (const bf16_t*)(T + T_SG) + row0 * 1024 + hd * 256; a.ld_g = 1024;
            a.out = (bf16_t*)(T + T_V) + row0 * 1024 + hd * 256; a.ld_o = 1024;
            a.dec = (const float*)(ws + WS_DEC) + (size_t)b * NCH * 512 + hd * 128;
            a.wg = nullptr; a.nw = P.in[9]; a.dsk = nullptr;
            mixer_item<false>(lds, a);
        } else {
            const int g = k - 4;
            const bf16_t* X = (const bf16_t*)(T + T_XBC) + row0 * 4096;
            a.ak = X + 2048 + g * 128; a.ld_ak = 4096;
            a.qq = X + 3072 + g * 128; a.ld_q = 4096;
            a.bv = X + g * 256; a.ld_bv = 4096;
            a.gt = (const bf16_t*)(T + T_SZ) + row0 * 2048 + g * 256; a.ld_g = 2048;
            a.out = (bf16_t*)(T + T_XBC) + row0 * 4096 + g * 256; a.ld_o = 4096;
            a.dec = (const float*)(ws + WS_DECS) + (size_t)b * NCH * 32 + g * 4;
            a.wg = (const float*)(ws + WS_WG) + row0 * 32 + g * 4;
            a.nw = P.in[16] + g * 256; a.dsk = P.in[15] + g * 4;
            mixer_item<true>(lds, a);
        }
        __syncthreads();
    }
}

__device__ __forceinline__ KP get_params() {
    KP p = (KP)__builtin_amdgcn_kernarg_segment_ptr(); asm volatile("" : "+s"(p)); return p;
}

#define XB_TMO      128
#define XB_XCNT(j)  (256  + 64 * (j))
#define XB_XSUB(j)  (1280 + 64 * (j))
#define XB_XGEN(j)  (2304 + 64 * (j))
#define XB_TOP      3328
#define XB_TOPGEN   3392
#define XCD_BAR_WORDS 3456
#define XB_SPIN_CAP (1u << 18)
__device__ __forceinline__ unsigned xb_ld(unsigned* p)              { return __hip_atomic_load(p, __ATOMIC_RELAXED, __HIP_MEMORY_SCOPE_AGENT); }
__device__ __forceinline__ unsigned xb_add(unsigned* p, unsigned v) { return __hip_atomic_fetch_add(p, v, __ATOMIC_RELAXED, __HIP_MEMORY_SCOPE_AGENT); }
__device__ __forceinline__ unsigned xb_xcc_id() { return (unsigned)__builtin_amdgcn_s_getreg((3 << 11) | 20) & 0xFu; }
#define XB_SPIN(cond, bar) do { unsigned _sp = 0; while (cond) { __builtin_amdgcn_s_sleep(1); \
    if ((++_sp & 255u) == 0u) { if (xb_ld(&(bar)[XB_TMO])) break; if (_sp > XB_SPIN_CAP) { atomicAdd(&(bar)[XB_TMO], 1u); break; } } } } while (0)
struct XcdBarrier { unsigned* bar; unsigned x; volatile LAS unsigned* st; };
__device__ __forceinline__ XcdBarrier xcd_barrier_post(unsigned* bar, volatile LAS unsigned* st) {
    XcdBarrier b; b.bar = bar; b.x = xb_xcc_id(); b.st = st;
    if (threadIdx.x == 0) (void)xb_add(&bar[XB_XCNT(b.x)], 1u);
    return b;
}
__device__ __forceinline__ void xcd_barrier_complete(unsigned* bar, unsigned x, unsigned& nloc, unsigned& nx) {
    const unsigned G = gridDim.x * gridDim.y * gridDim.z;
    unsigned sum, cnt, mine, sp = 0u;
    for (;;) {
        sum = 0u; cnt = 0u; mine = 0u;
#pragma unroll
        for (unsigned j = 0; j < 16; ++j) { const unsigned c = xb_ld(&bar[XB_XCNT(j)]); sum += c; cnt += (c > 0u) ? 1u : 0u; mine = (j == x) ? c : mine; }
        if (sum == G) break;
        __builtin_amdgcn_s_sleep(1);
        if ((++sp & 255u) == 0u) { if (xb_ld(&bar[XB_TMO])) break; if (sp > XB_SPIN_CAP) { atomicAdd(&bar[XB_TMO], 1u); break; } }
    }
    nloc = mine > 0u ? mine : 1u; nx = cnt > 0u ? cnt : 1u;
}
__device__ __forceinline__ void xcd_barrier(const XcdBarrier& b) {
    asm volatile("s_waitcnt vmcnt(0)" ::: "memory");
    __syncthreads();
    if (threadIdx.x == 0) {
        unsigned* bar = b.bar;
        __builtin_amdgcn_s_waitcnt(0);
        unsigned nloc = b.st[0], nx = b.st[1];
        if (nloc == 0u) { xcd_barrier_complete(bar, b.x, nloc, nx); b.st[0] = nloc; b.st[1] = nx; }
        const unsigned old = xb_add(&bar[XB_XSUB(b.x)], 1u);
        const unsigned gen = old / nloc;
        if (old + 1u == (gen + 1u) * nloc) {
            __builtin_amdgcn_fence(__ATOMIC_RELEASE, "agent");
            asm volatile("s_waitcnt vmcnt(0)" ::: "memory");
            const unsigned og = xb_add(&bar[XB_TOP], 1u);
            const unsigned tg = og / nx;
            if (og + 1u == (tg + 1u) * nx) xb_add(&bar[XB_TOPGEN], 1u);
            else XB_SPIN(xb_ld(&bar[XB_TOPGEN]) == tg, bar);
            __builtin_amdgcn_fence(__ATOMIC_ACQUIRE, "agent");
            xb_add(&bar[XB_XGEN(b.x)], 1u);
            asm volatile("s_waitcnt vmcnt(0)" ::: "memory");
        } else {
            XB_SPIN(xb_ld(&bar[XB_XGEN(b.x)]) == gen, bar);
            __builtin_amdgcn_fence(__ATOMIC_ACQUIRE, "agent");
            asm volatile("s_waitcnt vmcnt(0)" ::: "memory");
        }
    }
    __syncthreads();
}

#define PROBE_MASK 0x0
#define PROBE_DSYNC 0
#if PROBE_MASK
#define PH_BEGIN(i) const unsigned long long _t##i = __builtin_amdgcn_s_memrealtime();
#define PH_END(i) if ((PROBE_MASK >> (i)) & 1) probe_acc += __builtin_amdgcn_s_memrealtime() - _t##i;
#else
#define PH_BEGIN(i)
#define PH_END(i)
#endif
#if PROBE_DSYNC
#define GSYNC() do { xcd_barrier(xbar); xcd_barrier(xbar); } while (0)
#else
#define GSYNC() xcd_barrier(xbar)
#endif
__global__ void __launch_bounds__(512, 2) fwd_megakernel(Params Parg) {
    extern __shared__ __attribute__((aligned(16))) unsigned char lds_raw[];
    LAS unsigned char* lds = (LAS unsigned char*)lds_raw;
    cg::grid_group grid = cg::this_grid();
    const int G = gridDim.x;
    pg8::StaticOrder S;
#if PROBE_MASK
    unsigned long long probe_acc = 0;
#endif

    { unsigned* bw = (unsigned*)(get_params()->ws + WS_BAR);
      if (blockIdx.x == 0) for (int i = threadIdx.x; i < XCD_BAR_WORDS; i += 512) bw[i] = 0u;
      if (threadIdx.x < 2) *(volatile LAS unsigned*)(lds + LDS_MAIN + threadIdx.x * 4) = 0u; }
    XcdBarrier xbar;
    { PH_BEGIN(0) p0_prologue(get_params(), lds, G);
    grid.sync();
    xbar = xcd_barrier_post((unsigned*)(get_params()->ws + WS_BAR), (volatile LAS unsigned*)(lds + LDS_MAIN));
    PH_END(0) }
    { PH_BEGIN(1) { KP P = get_params(); unsigned char* ws = P->ws;
      pg8::Gemm g{(const bf16_t*)(ws + WS_XB), (const bf16_t*)(ws + WS_WGU1), MTOK, NGU, D, D, D}; S.init(MTOK, NGU, G, blockIdx.x);
      EpiGU E{(const float*)(ws + WS_SSQ), (bf16_t*)(ws + WS_BIG)}; pg8::gemm_phase(lds, g, S, E); }
    GSYNC(); PH_END(1) }
    { PH_BEGIN(2) { KP P = get_params(); unsigned char* ws = P->ws;
      pg8::Gemm g{(const bf16_t*)(ws + WS_BIG), (const bf16_t*)(ws + WS_WD1), MTOK, D, DFF, DFF, DFF}; S.init(MTOK, D, G, blockIdx.x);
      EpiRes E{P->in[0], P->out, (bf16_t*)(ws + WS_XB), (float*)(ws + WS_SSQ) + MTOK, 0.5f}; pg8::gemm_phase(lds, g, S, E); }
    GSYNC(); PH_END(2) }
    for (int hf = 0; hf < 2; ++hf) {
        const size_t r0 = (size_t)hf * MH;
        { PH_BEGIN(3) { KP P = get_params(); unsigned char* ws = P->ws;
          pg8::Gemm g{(const bf16_t*)(ws + WS_XB) + r0 * D, (const bf16_t*)(ws + WS_WIN), MH, NIN, D, D, D}; S.init(MH, NIN, G, blockIdx.x);
          EpiIn E{(const float*)(ws + WS_SSQ) + MTOK + r0, ws + WS_BIG, (bf16_t*)(ws + WS_HALO), (float*)(ws + WS_SM)}; pg8::gemm_phase(lds, g, S, E); }
        GSYNC(); PH_END(3) }
        { PH_BEGIN(4) p4_prep(get_params(), lds, G);
        GSYNC(); PH_END(4) }
        { PH_BEGIN(5) p5_mixer(get_params(), lds, G);
        GSYNC(); PH_END(5) }
        { PH_BEGIN(6) { KP P = get_params(); unsigned char* ws = P->ws; unsigned char* T = ws + WS_BIG;
          pg8::Gemm g{(const bf16_t*)(T + T_V), (const bf16_t*)(ws + WS_WGO), MH, D, D, D, D}; S.init(MH, D, G, blockIdx.x);
          EpiGate E{(const bf16_t*)(T + T_GT), nullptr, (bf16_t*)(T + T_T1), 0}; pg8::gemm_phase(lds, g, S, E); }
        { KP P = get_params(); unsigned char* ws = P->ws; unsigned char* T = ws + WS_BIG;
          pg8::Gemm g{(const bf16_t*)(T + T_XBC), (const bf16_t*)(ws + WS_WSO), MH, D, 2048, 4096, 2048}; S.init(MH, D, G, blockIdx.x);
          EpiGate E{(const bf16_t*)(T + T_GT), (const bf16_t*)(T + T_T1), (bf16_t*)(T + T_MRG), 1}; pg8::gemm_phase(lds, g, S, E); }
        GSYNC(); PH_END(6) }
        { PH_BEGIN(7) { KP P = get_params(); unsigned char* ws = P->ws;
          pg8::Gemm g{(const bf16_t*)(ws + WS_BIG + T_MRG), (const bf16_t*)(ws + WS_WOUT), MH, D, D, D, D}; S.init(MH, D, G, blockIdx.x);
          EpiRes E{P->out + r0 * D, P->out + r0 * D, (bf16_t*)(ws + WS_XB) + r0 * D, (float*)(ws + WS_SSQ) + 2 * MTOK + r0, 1.0f}; pg8::gemm_phase(lds, g, S, E); }
        GSYNC(); PH_END(7) }
    }
    { PH_BEGIN(8) { KP P = get_params(); unsigned char* ws = P->ws;
      pg8::Gemm g{(const bf16_t*)(ws + WS_XB), (const bf16_t*)(ws + WS_WGU2), MTOK, NGU, D, D, D}; S.init(MTOK, NGU, G, blockIdx.x);
      EpiGU E{(const float*)(ws + WS_SSQ) + 2 * MTOK, (bf16_t*)(ws + WS_BIG)}; pg8::gemm_phase(lds, g, S, E); }
    GSYNC(); PH_END(8) }
    { PH_BEGIN(9) { KP P = get_params(); unsigned char* ws = P->ws;
      pg8::Gemm g{(const bf16_t*)(ws + WS_BIG), (const bf16_t*)(ws + WS_WD2), MTOK, D, DFF, DFF, DFF}; S.init(MTOK, D, G, blockIdx.x);
      EpiRes E{P->out, P->out, nullptr, (float*)(ws + WS_SSQ) + 3 * MTOK, 0.5f}; pg8::gemm_phase(lds, g, S, E); }
    GSYNC(); PH_END(9) }
    { PH_BEGIN(10)
    {
        KP P = get_params(); const float* ssq = (const float*)(P->ws + WS_SSQ) + 3 * MTOK;
        const int tid = tid_fresh(), lane = tid & 63, gw = blockIdx.x * 8 + (tid >> 6), NGW = G * 8;
        const float* fw = P->in[23]; float* outp = P->out;
        for (int m = gw; m < MTOK; m += NGW) {
            const float rstd = rsqrtf(ssq[m] * (1.f / D) + EPS);
            f32x4* xr = (f32x4*)(outp + (size_t)m * D) + lane;
#pragma unroll
            for (int jj = 0; jj < 4; ++jj) { const f32x4 wv = ((const f32x4*)fw)[lane + 64 * jj]; f32x4 v = xr[64 * jj]; v = v * rstd; v.x *= wv.x; v.y *= wv.y; v.z *= wv.z; v.w *= wv.w; xr[64 * jj] = v; }
        }
    }
    PH_END(10) }
#if PROBE_MASK
    if (blockIdx.x == 0) {
        const unsigned long long t0 = __builtin_amdgcn_s_memrealtime();
        while (__builtin_amdgcn_s_memrealtime() - t0 < probe_acc) __builtin_amdgcn_s_sleep(8);
    }
#endif
}

extern "C" void kernel_launch(void* const* d_in, const int* in_sizes, int n_in, void* d_out, int out_size, void* d_ws, size_t ws_size, hipStream_t stream) {
    static int grid = 0;
    if (grid == 0) {
        if (n_in != 24 || ws_size < WS_NEED) { fprintf(stderr, "kernel_launch: unexpected n_in %d or ws_size %zu (need %zu)\n", n_in, ws_size, (size_t)WS_NEED); grid = -1; return; }
        int dev = 0, cus = 0, per_cu = 0;
        hipGetDevice(&dev);
        hipDeviceGetAttribute(&cus, hipDeviceAttributeMultiprocessorCount, dev);
        hipFuncSetAttribute((const void*)fwd_megakernel, hipFuncAttributeMaxDynamicSharedMemorySize, LDS_BYTES);
        hipOccupancyMaxActiveBlocksPerMultiprocessor(&per_cu, (const void*)fwd_megakernel, 512, LDS_BYTES);
        if (per_cu < 1) { fprintf(stderr, "kernel_launch: occupancy query gave %d\n", per_cu); per_cu = 1; }
        grid = cus * per_cu;
        (void)hipGetLastError();
    }
    if (grid < 0) return;
    Params p{};
    for (int i = 0; i < 24; ++i) p.in[i] = (const float*)d_in[i];
    p.out = (float*)d_out; p.ws = (unsigned char*)d_ws;
    void* args[] = {&p};
    hipError_t e = hipLaunchCooperativeKernel((const void*)fwd_megakernel, dim3(grid), dim3(512), args, LDS_BYTES, stream);
    if (e != hipSuccess) fprintf(stderr, "cooperative launch failed: %s (grid %d)\n", hipGetErrorString(e), grid);
}
```

```cpp
#include <hip/hip_runtime.h>
#include <hip/hip_cooperative_groups.h>
#include <cstdio>
#include <cstdint>
namespace cg = cooperative_groups;

#define LAS __attribute__((address_space(3)))
typedef unsigned short bf16_t;
typedef short bf16x8 __attribute__((ext_vector_type(8)));
typedef short s16x4 __attribute__((ext_vector_type(4)));
typedef float f32x4 __attribute__((ext_vector_type(4)));
typedef float f32x16 __attribute__((ext_vector_type(16)));
typedef unsigned u32x4 __attribute__((ext_vector_type(4)));
typedef unsigned u32x2 __attribute__((ext_vector_type(2)));

constexpr int D = 1024, BATCH = 32, SEQ = 2048, MTOK = BATCH * SEQ;
constexpr int NCH = SEQ / 64;
constexpr int DFF = 2816, NGU = 2 * DFF;
constexpr int IN_DIM = 11312, NIN = 45 * 256;
constexpr int HB = 16, MH = HB * SEQ;
constexpr float EPS = 1e-6f;

constexpr size_t MiB = 1u << 20;
constexpr size_t WS_SSQ = 0;
constexpr size_t WS_WGU1 = 1 * MiB, WS_WD1 = 12 * MiB, WS_WIN = 18 * MiB, WS_WGO = 41 * MiB, WS_WSO = 43 * MiB, WS_WOUT = 47 * MiB, WS_WGU2 = 49 * MiB, WS_WD2 = 60 * MiB;
constexpr size_t WS_DEC = 66 * MiB, WS_DECS = 67 * MiB, WS_WG = 68 * MiB, WS_HALO = 72 * MiB, WS_SM = 84 * MiB;
constexpr size_t WS_BAR = 92 * MiB;
constexpr size_t WS_XB = 96 * MiB;
constexpr size_t WS_BIG = 224 * MiB;
constexpr size_t T_Q = 0, T_K = 32 * MiB, T_V = 64 * MiB, T_SG = 128 * MiB, T_SZ = 192 * MiB, T_XBC = 320 * MiB, T_GT = 576 * MiB, T_END = 704 * MiB;
constexpr size_t T_T1 = T_Q, T_MRG = T_SG;
constexpr size_t WS_NEED = WS_BIG + T_END;

constexpr int LDS_MAIN = 131072, LDS_BYTES = LDS_MAIN + 64;

__device__ __forceinline__ unsigned cvt_pk_bf16(float lo, float hi) { unsigned r; asm volatile("v_cvt_pk_bf16_f32 %0, %1, %2" : "=v"(r) : "v"(lo), "v"(hi)); return r; }
__device__ __forceinline__ float bf_lo(unsigned u) { return __uint_as_float(u << 16); }
__device__ __forceinline__ float bf_hi(unsigned u) { return __uint_as_float(u & 0xffff0000u); }
__device__ __forceinline__ float fast_rcp(float x) { return __builtin_amdgcn_rcpf(x); }
__device__ __forceinline__ float sigmoidf_(float x) { return fast_rcp(1.f + __expf(-x)); }
__device__ __forceinline__ float siluf_(float x) { return x * sigmoidf_(x); }
__device__ __forceinline__ float softplusf_(float x) { return fmaxf(x, 0.f) + __logf(1.f + __expf(-fabsf(x))); }
__device__ __forceinline__ float wave_sum(float v) {
#pragma unroll
    for (int o = 1; o < 64; o <<= 1) v += __shfl_xor(v, o);
    return v;
}

namespace pg8 {
constexpr int BM = 256, BK = 64, HALF = 128, HTB = HALF * BK * 2, STAGE_BYTES = 8 * HTB, NXCD = 8, WGM = 8;
__host__ __device__ __forceinline__ int lds_byte(int r, int c) { const int st = (r >> 4) * 2 + (c >> 5), rr = r & 15, cc = c & 31, ob = rr * 64 + cc * 2; return st * 1024 + (ob ^ (((ob >> 9) & 1) << 5)); }
__host__ __device__ __forceinline__ void stage_rc(int b, int& R, int& C) { const int st = b / 1024, sb = b % 1024, swz = sb ^ (((sb >> 9) & 1) << 5); R = (st >> 1) * 16 + swz / 64; C = (st & 1) * 32 + (swz % 64) / 2; }
__host__ __device__ __forceinline__ int perm32(int rho) { const int n = rho >> 4, i = rho & 15; return 8 * (i >> 2) + 4 * n + (i & 3); }

struct Unit { int pm, pn; };
struct Gemm { const bf16_t* A; const bf16_t* Bt; int M, N, K, lda, ldb; };

struct StaticOrder {
    int nM, nN, nwg, G, c;
    __device__ void init(int M, int N, int G_, int c_) { nM = M / BM; nN = N / BM; nwg = nM * nN; G = G_; c = c_; }
    __device__ bool next(int i, Unit& u) const {
        const long L = (long)i * G + c; if (L >= nwg) return false;
        int wgid = (int)L; { const int q = nwg / NXCD, r = nwg % NXCD, xcd = wgid % NXCD, off = wgid / NXCD; wgid = (xcd < r ? xcd * (q + 1) : r * (q + 1) + (xcd - r) * q) + off; }
        const int nig = WGM * nN, gid = wgid / nig, fm = gid * WGM, gsz = (nM - fm) < WGM ? (nM - fm) : WGM;
        u.pm = fm + ((wgid % nig) % gsz); u.pn = (wgid % nig) / gsz; return true;
    }
};

template <class Epi>
__device__ __forceinline__ void gemm_phase(LAS unsigned char* lds, const Gemm g, const StaticOrder& S, const Epi& E) {
    int tid = threadIdx.x; asm volatile("" : "+v"(tid));
    const int wid = __builtin_amdgcn_readfirstlane(tid >> 6), lane = tid & 63, wr = wid >> 2, wc = wid & 3, fr = lane & 15, fq = lane >> 4;
    const int K = g.K, nt = K / BK;
    unsigned voffA[2], voffB[2];
#pragma unroll
    for (int i = 0; i < 2; ++i) { int R, C; stage_rc(tid * 16 + i * 8192, R, C); const int Rb = (R & ~31) + perm32(R & 31);
        voffA[i] = (unsigned)(R * g.lda + C) * 2u; voffB[i] = (unsigned)(Rb * g.ldb + C) * 2u; }
    const size_t kstep = (size_t)(BK * 2);
    const size_t hstA = (size_t)HALF * g.lda * 2, hstB = (size_t)HALF * g.ldb * 2;
    const size_t tstA = 2 * hstA, tstB = 2 * hstB;
    const unsigned ldsw = (unsigned)wid * 1024u;
    const int aoff = lds_byte(wr * 64 + fr, fq * 8), boff = lds_byte(wc * 32 + fr, fq * 8);
#define PG8_SA(b, h) (((b) * 2 + (h)) * HTB)
#define PG8_SB(b, h) ((4 + (b) * 2 + (h)) * HTB)
#define PG8_STAGE(bufoff, gbase, voff) do { _Pragma("unroll") for (int _i = 0; _i < 2; ++_i) \
        __builtin_amdgcn_global_load_lds((const unsigned*)((const char*)(gbase) + (voff)[_i]), (LAS unsigned*)(lds + (bufoff) + ldsw + _i * 8192), 16, 0, 0); } while (0)
#define PG8_LDA(dst, b, h) do { _Pragma("unroll") for (int m = 0; m < 4; ++m) _Pragma("unroll") for (int k = 0; k < 2; ++k) dst[m][k] = *(const LAS bf16x8*)(lds + PG8_SA(b, h) + aoff + m * 2048 + k * 1024); } while (0)
#define PG8_LDB(dst, b, h) do { _Pragma("unroll") for (int n = 0; n < 2; ++n) _Pragma("unroll") for (int k = 0; k < 2; ++k) dst[n][k] = *(const LAS bf16x8*)(lds + PG8_SB(b, h) + boff + n * 2048 + k * 1024); } while (0)
#define PG8_MMA(ai, bj, At, Bt) do { __builtin_amdgcn_s_setprio(1); _Pragma("unroll") for (int m = 0; m < 4; ++m) _Pragma("unroll") for (int n = 0; n < 2; ++n) _Pragma("unroll") for (int k = 0; k < 2; ++k) \
        acc[ai][bj][m][n] = __builtin_amdgcn_mfma_f32_16x16x32_bf16(Bt[n][k], At[m][k], acc[ai][bj][m][n], 0, 0, 0); __builtin_amdgcn_s_setprio(0); } while (0)
#define PG8_WAIT_V(n) asm volatile("s_waitcnt vmcnt(" #n ")" ::: "memory")
#define PG8_WAIT_L(n) asm volatile("s_waitcnt lgkmcnt(" #n ")" ::: "memory")
#define PG8_BAR __builtin_amdgcn_s_barrier()
#define PG8_SCHED __builtin_amdgcn_sched_barrier(0)
    Unit cur, nxt; int ui = 0;
    if (!S.next(0, cur)) return;
    f32x4 acc[2][2][4][2];
#pragma unroll
    for (int a = 0; a < 2; ++a)
#pragma unroll
        for (int b = 0; b < 2; ++b)
#pragma unroll
            for (int m = 0; m < 4; ++m)
#pragma unroll
                for (int n = 0; n < 2; ++n) acc[a][b][m][n] = (f32x4){0.f, 0.f, 0.f, 0.f};
    bf16x8 At[4][2], B0[2][2], B1[2][2];
    const char* cA = (const char*)g.A + (size_t)cur.pm * tstA; const char* cB = (const char*)g.Bt + (size_t)cur.pn * tstB;
    PG8_STAGE(PG8_SB(0, 0), cB, voffB); PG8_STAGE(PG8_SA(0, 0), cA, voffA); PG8_STAGE(PG8_SB(0, 1), cB + hstB, voffB); PG8_STAGE(PG8_SA(0, 1), cA + hstA, voffA);
    if (wr == 1) PG8_BAR;
    PG8_WAIT_V(4); PG8_BAR;
    PG8_STAGE(PG8_SB(1, 0), cB + kstep, voffB); PG8_STAGE(PG8_SA(1, 0), cA + kstep, voffA); PG8_STAGE(PG8_SB(1, 1), cB + hstB + kstep, voffB);
    PG8_WAIT_V(6); PG8_BAR;
    for (;;) {
        const bool has_next = S.next(ui + 1, nxt);
        const char* nA = has_next ? (const char*)g.A + (size_t)nxt.pm * tstA : cA; const char* nB = has_next ? (const char*)g.Bt + (size_t)nxt.pn * tstB : cB;
        for (int t = 0; t < nt; t += 2) {
            const bool last = (t == nt - 2);
            const char* a1 = cA + (size_t)(t + 1) * kstep;
            const char* a2 = last ? nA : cA + (size_t)(t + 2) * kstep; const char* b2 = last ? nB : cB + (size_t)(t + 2) * kstep;
            const char* a3 = a2 + kstep; const char* b3 = b2 + kstep;
            PG8_LDB(B0, 0, 0); PG8_SCHED; PG8_LDA(At, 0, 0); PG8_STAGE(PG8_SA(1, 1), a1 + hstA, voffA);
            PG8_WAIT_L(8); PG8_BAR; PG8_WAIT_L(0); PG8_MMA(0, 0, At, B0); PG8_BAR; PG8_SCHED;
            PG8_LDB(B1, 0, 1); PG8_STAGE(PG8_SB(0, 0), b2, voffB);
            PG8_BAR; PG8_WAIT_L(0); PG8_MMA(0, 1, At, B1); PG8_BAR;
            PG8_LDA(At, 0, 1); PG8_STAGE(PG8_SA(0, 0), a2, voffA);
            PG8_BAR; PG8_WAIT_L(0); PG8_MMA(1, 0, At, B0); PG8_BAR; PG8_SCHED;
            PG8_STAGE(PG8_SB(0, 1), b2 + hstB, voffB);
            PG8_WAIT_V(6); PG8_BAR; PG8_MMA(1, 1, At, B1); PG8_BAR;
            PG8_LDB(B0, 1, 0); PG8_SCHED; PG8_LDA(At, 1, 0); PG8_STAGE(PG8_SA(0, 1), a2 + hstA, voffA);
            PG8_WAIT_L(8); PG8_BAR; PG8_WAIT_L(0); PG8_MMA(0, 0, At, B0); PG8_BAR; PG8_SCHED;
            PG8_LDB(B1, 1, 1); PG8_STAGE(PG8_SB(1, 0), b3, voffB);
            PG8_BAR; PG8_WAIT_L(0); PG8_MMA(0, 1, At, B1); PG8_BAR;
            PG8_LDA(At, 1, 1); PG8_STAGE(PG8_SA(1, 0), a3, voffA);
            PG8_BAR; PG8_WAIT_L(0); PG8_MMA(1, 0, At, B0); PG8_BAR; PG8_SCHED;
            PG8_STAGE(PG8_SB(1, 1), b3 + hstB, voffB);
            PG8_WAIT_V(6); PG8_BAR; PG8_MMA(1, 1, At, B1); PG8_BAR;
        }
        E(acc, cur, wr, wc, fr, fq);
        if (!has_next) break;
#pragma unroll
        for (int a = 0; a < 2; ++a)
#pragma unroll
            for (int b = 0; b < 2; ++b)
#pragma unroll
                for (int m = 0; m < 4; ++m)
#pragma unroll
                    for (int n = 0; n < 2; ++n) acc[a][b][m][n] = (f32x4){0.f, 0.f, 0.f, 0.f};
        cur = nxt; cA = nA; cB = nB; ++ui;
    }
    PG8_WAIT_V(0);
    if (wr == 0) PG8_BAR;
    PG8_BAR;
#undef PG8_SA
#undef PG8_SB
#undef PG8_STAGE
#undef PG8_LDA
#undef PG8_LDB
#undef PG8_MMA
#undef PG8_WAIT_V
#undef PG8_WAIT_L
#undef PG8_BAR
#undef PG8_SCHED
}
}

typedef f32x4 AccT[2][2][4][2];

struct EpiGU {
    const float* ssq; bf16_t* O;
    __device__ __forceinline__ void operator()(const AccT& acc, const pg8::Unit& u, int wr, int wc, int fr, int fq) const {
        const int row0 = u.pm * 256 + wr * 64 + fr, col0 = u.pn * 128 + wc * 32 + 8 * fq;
        float rs[2][4];
#pragma unroll
        for (int ai = 0; ai < 2; ++ai)
#pragma unroll
            for (int m = 0; m < 4; ++m) rs[ai][m] = ssq[row0 + ai * 128 + m * 16];
        __builtin_amdgcn_sched_barrier(0);
#pragma unroll
        for (int ai = 0; ai < 2; ++ai)
#pragma unroll
            for (int m = 0; m < 4; ++m) {
                const int row = row0 + ai * 128 + m * 16;
                const float rstd = rsqrtf(rs[ai][m] * (1.f / D) + EPS);
                float v[8];
#pragma unroll
                for (int n = 0; n < 2; ++n)
#pragma unroll
                    for (int j = 0; j < 4; ++j) { const float gg = acc[ai][0][m][n][j] * rstd, uu = acc[ai][1][m][n][j] * rstd; v[4 * n + j] = siluf_(gg) * uu; }
                u32x4 w; w.x = cvt_pk_bf16(v[0], v[1]); w.y = cvt_pk_bf16(v[2], v[3]); w.z = cvt_pk_bf16(v[4], v[5]); w.w = cvt_pk_bf16(v[6], v[7]);
                *(u32x4*)(O + (size_t)row * DFF + col0) = w;
            }
    }
};
struct EpiRes {
    const float* xin; float* xout; bf16_t* xb; float* ssq; float alpha;
    __device__ __forceinline__ void operator()(const AccT& acc, const pg8::Unit& u, int wr, int wc, int fr, int fq) const {
        const int row0 = u.pm * 256 + wr * 64 + fr, col0 = u.pn * 256 + wc * 32 + 8 * fq;
#pragma unroll
        for (int ai = 0; ai < 2; ++ai) {
            f32x4 xv[4][2][2];
#pragma unroll
            for (int m = 0; m < 4; ++m)
#pragma unroll
                for (int bj = 0; bj < 2; ++bj) { const size_t o = (size_t)(row0 + ai * 128 + m * 16) * D + col0 + bj * 128; xv[m][bj][0] = *(const f32x4*)(xin + o); xv[m][bj][1] = *(const f32x4*)(xin + o + 4); }
            __builtin_amdgcn_sched_barrier(0);
#pragma unroll
            for (int m = 0; m < 4; ++m) {
                const int row = row0 + ai * 128 + m * 16;
                float s = 0.f;
#pragma unroll
                for (int bj = 0; bj < 2; ++bj) {
                    const size_t o = (size_t)row * D + col0 + bj * 128;
                    const f32x4 y0 = xv[m][bj][0] + acc[ai][bj][m][0] * alpha, y1 = xv[m][bj][1] + acc[ai][bj][m][1] * alpha;
                    *(f32x4*)(xout + o) = y0; *(f32x4*)(xout + o + 4) = y1;
                    s += y0.x * y0.x + y0.y * y0.y + y0.z * y0.z + y0.w * y0.w + y1.x * y1.x + y1.y * y1.y + y1.z * y1.z + y1.w * y1.w;
                    if (xb) { u32x4 w; w.x = cvt_pk_bf16(y0.x, y0.y); w.y = cvt_pk_bf16(y0.z, y0.w); w.z = cvt_pk_bf16(y1.x, y1.y); w.w = cvt_pk_bf16(y1.z, y1.w); *(u32x4*)(xb + o) = w; }
                }
                s += __shfl_xor(s, 16); s += __shfl_xor(s, 32);
                if (fq == 0) atomicAdd(ssq + row, s);
            }
        }
    }
};
struct EpiIn {
    const float* ssq; unsigned char* T; bf16_t* halo; float* sm;
    __device__ __forceinline__ void operator()(const AccT& acc, const pg8::Unit& u, int wr, int wc, int fr, int fq) const {
        const int pn = u.pn;
        const int row0 = u.pm * 256 + wr * 64 + fr;
        float rs[2][4];
#pragma unroll
        for (int ai = 0; ai < 2; ++ai)
#pragma unroll
            for (int m = 0; m < 4; ++m) rs[ai][m] = ssq[row0 + ai * 128 + m * 16];
        __builtin_amdgcn_sched_barrier(0);
        int act = 0, ld, ct; bf16_t* base;
        if (pn < 2) { base = (bf16_t*)(T + T_Q); ld = 512; ct = pn; }
        else if (pn < 4) { base = (bf16_t*)(T + T_K); ld = 512; ct = pn - 2; }
        else if (pn < 8) { base = (bf16_t*)(T + T_V); ld = 1024; ct = pn - 4; }
        else if (pn < 12) { base = (bf16_t*)(T + T_SG); ld = 1024; ct = pn - 8; act = 1; }
        else if (pn < 20) { base = (bf16_t*)(T + T_SZ); ld = 2048; ct = pn - 12; act = 1; }
        else if (pn < 36) { base = (bf16_t*)(T + T_XBC); ld = 4096; ct = pn - 20; act = 3; }
        else if (pn < 44) { base = (bf16_t*)(T + T_GT); ld = 2048; ct = pn - 36; act = 2; }
        else { base = nullptr; ld = 0; ct = 0; act = 4; }
        if (act == 4) {
            if (wc < 2) {
#pragma unroll
                for (int ai = 0; ai < 2; ++ai)
#pragma unroll
                    for (int m = 0; m < 4; ++m) {
                        const int row = row0 + ai * 128 + m * 16;
                        const float rstd = rsqrtf(rs[ai][m] * (1.f / D) + EPS);
                        float* p = sm + (size_t)row * 64 + wc * 32 + 8 * fq;
                        *(f32x4*)p = acc[ai][0][m][0] * rstd; *(f32x4*)(p + 4) = acc[ai][0][m][1] * rstd;
                    }
            }
            return;
        }
        const int col0 = ct * 256 + wc * 32 + 8 * fq;
#pragma unroll
        for (int ai = 0; ai < 2; ++ai)
#pragma unroll
            for (int m = 0; m < 4; ++m) {
                const int row = row0 + ai * 128 + m * 16;
                const float rstd = rsqrtf(rs[ai][m] * (1.f / D) + EPS);
#pragma unroll
                for (int bj = 0; bj < 2; ++bj) {
                    float v[8];
#pragma unroll
                    for (int n = 0; n < 2; ++n)
#pragma unroll
                        for (int j = 0; j < 4; ++j) { float x = acc[ai][bj][m][n][j] * rstd; if (act == 1) x = siluf_(x); else if (act == 2) x = sigmoidf_(x); v[4 * n + j] = x; }
                    u32x4 w; w.x = cvt_pk_bf16(v[0], v[1]); w.y = cvt_pk_bf16(v[2], v[3]); w.z = cvt_pk_bf16(v[4], v[5]); w.w = cvt_pk_bf16(v[6], v[7]);
                    *(u32x4*)(base + (size_t)row * ld + col0 + bj * 128) = w;
                    if (act == 3 && (row & 63) >= 61) *(u32x4*)(halo + ((size_t)(row >> 6) * 3 + ((row & 63) - 61)) * 4096 + col0 + bj * 128) = w;
                }
            }
    }
};
struct EpiGate {
    const bf16_t* gt; const bf16_t* t1; bf16_t* out; int mode;
    __device__ __forceinline__ void operator()(const AccT& acc, const pg8::Unit& u, int wr, int wc, int fr, int fq) const {
        const int row0 = u.pm * 256 + wr * 64 + fr, col0 = u.pn * 256 + wc * 32 + 8 * fq;
#pragma unroll
        for (int ai = 0; ai < 2; ++ai) {
            u32x4 gq[4][2], tq[4][2];
#pragma unroll
            for (int m = 0; m < 4; ++m)
#pragma unroll
                for (int bj = 0; bj < 2; ++bj) { const int row = row0 + ai * 128 + m * 16, col = col0 + bj * 128;
                    gq[m][bj] = *(const u32x4*)(gt + (size_t)row * 2048 + mode * 1024 + col);
                    tq[m][bj] = mode ? *(const u32x4*)(t1 + (size_t)row * D + col) : (u32x4){0u, 0u, 0u, 0u}; }
            __builtin_amdgcn_sched_barrier(0);
#pragma unroll
            for (int m = 0; m < 4; ++m)
#pragma unroll
                for (int bj = 0; bj < 2; ++bj) {
                    const int row = row0 + ai * 128 + m * 16, col = col0 + bj * 128;
                    const u32x4 g4 = gq[m][bj], t4 = tq[m][bj];
                    float v[8];
                    v[0] = acc[ai][bj][m][0].x * bf_lo(g4.x); v[1] = acc[ai][bj][m][0].y * bf_hi(g4.x); v[2] = acc[ai][bj][m][0].z * bf_lo(g4.y); v[3] = acc[ai][bj][m][0].w * bf_hi(g4.y);
                    v[4] = acc[ai][bj][m][1].x * bf_lo(g4.z); v[5] = acc[ai][bj][m][1].y * bf_hi(g4.z); v[6] = acc[ai][bj][m][1].z * bf_lo(g4.w); v[7] = acc[ai][bj][m][1].w * bf_hi(g4.w);
                    if (mode) { v[0] += bf_lo(t4.x); v[1] += bf_hi(t4.x); v[2] += bf_lo(t4.y); v[3] += bf_hi(t4.y); v[4] += bf_lo(t4.z); v[5] += bf_hi(t4.z); v[6] += bf_lo(t4.w); v[7] += bf_hi(t4.w); }
                    u32x4 w; w.x = cvt_pk_bf16(v[0], v[1]); w.y = cvt_pk_bf16(v[2], v[3]); w.z = cvt_pk_bf16(v[4], v[5]); w.w = cvt_pk_bf16(v[6], v[7]);
                    *(u32x4*)(out + (size_t)row * D + col) = w;
                }
        }
    }
};

__device__ __forceinline__ void tr_item(const float* srcp, int ld, const float* sk, float mul, int k0, int K, bf16_t* dst, int n0, LAS float* scr, int lane) {
#pragma unroll 8
    for (int i = 0; i < 32; ++i) { const int kk = 2 * i + (lane >> 5);
        float v = 0.f; if (srcp) v = srcp[(size_t)(k0 + kk) * ld] * (sk ? sk[k0 + kk] : 1.f) * mul;
        scr[kk * 33 + (lane & 31)] = v; }
    asm volatile("s_waitcnt lgkmcnt(0)" ::: "memory");
    const int c = lane & 7;
#pragma unroll
    for (int j = 0; j < 4; ++j) { const int n = (lane >> 3) + 8 * j; const LAS float* s = scr + (8 * c) * 33 + n;
        u32x4 o; o.x = cvt_pk_bf16(s[0 * 33], s[1 * 33]); o.y = cvt_pk_bf16(s[2 * 33], s[3 * 33]); o.z = cvt_pk_bf16(s[4 * 33], s[5 * 33]); o.w = cvt_pk_bf16(s[6 * 33], s[7 * 33]);
        *(u32x4*)(dst + (size_t)(n0 + n) * K + k0 + 8 * c) = o; }
    asm volatile("s_waitcnt lgkmcnt(0)" ::: "memory");
}
__device__ __forceinline__ int win_src_col(int nd) {
    if (nd < 3072) return nd;
    if (nd < 5120) return 3088 + (nd - 3072);
    if (nd < 9216) return 5136 + (nd - 5120);
    if (nd < 11264) return 9264 + (nd - 9216);
    if (nd < 11280) return 3072 + (nd - 11264);
    if (nd < 11312) return 9232 + (nd - 11280);
    return -1;
}

struct Params {
    const float* in[24];
    float* out;
    unsigned char* ws;
};

typedef __attribute__((address_space(4))) const Params* KP;
__device__ __forceinline__ Params load_params(KP p) { Params r;
#pragma unroll
    for (int i = 0; i < 24; ++i) r.in[i] = p->in[i];
    r.out = p->out; r.ws = p->ws; return r; }
__device__ __forceinline__ int tid_fresh() { int t = threadIdx.x; asm volatile("" : "+v"(t)); return t; }
__device__ __forceinline__ void p0_prologue(KP Pp, LAS unsigned char* lds, int G) {
    const Params P = load_params(Pp);
    const int tid = tid_fresh(), lane = tid & 63, wave = tid >> 6;
    LAS float* scr = (LAS float*)(lds + wave * 16384);
    const int gw = blockIdx.x * 8 + wave, NGW = G * 8;
    unsigned char* ws = P.ws;
    constexpr int I_GU = (D / 64) * (NGU / 32), I_DN = (DFF / 64) * (D / 32), I_IN = (D / 64) * (NIN / 32), I_GO = (D / 64) * (D / 32), I_SO = (2048 / 64) * (D / 32);
    constexpr int NITEMS = 2 * I_GU + 2 * I_DN + I_IN + 2 * I_GO + I_SO;
    for (int it = gw; it < NITEMS; it += NGW) {
        int r = it; const int j = lane & 31;
        if (r < 2 * I_GU) { const int l2 = r >= I_GU; r -= l2 * I_GU; const int nb = r % (NGU / 32), kb = r / (NGU / 32); const int nd = nb * 32 + j, tile = nd >> 8, w = nd & 255;
            const float* Wg = P.in[l2 ? 20 : 2]; const float* Wu = P.in[l2 ? 21 : 3];
            const float* sp = (w < 128 ? Wg : Wu) + 128 * tile + (w & 127);
            tr_item(sp, DFF, P.in[l2 ? 19 : 1], 1.f, kb * 64, D, (bf16_t*)(ws + (l2 ? WS_WGU2 : WS_WGU1)), nb * 32, scr, lane); continue; }
        r -= 2 * I_GU;
        if (r < 2 * I_DN) { const int l2 = r >= I_DN; r -= l2 * I_DN; const int nb = r % (D / 32), kb = r / (D / 32);
            tr_item(P.in[l2 ? 22 : 4] + nb * 32 + j, D, nullptr, 1.f, kb * 64, DFF, (bf16_t*)(ws + (l2 ? WS_WD2 : WS_WD1)), nb * 32, scr, lane); continue; }
        r -= 2 * I_DN;
        if (r < I_IN) { const int nb = r % (NIN / 32), kb = r / (NIN / 32); const int nd = nb * 32 + j, sc = win_src_col(nd);
            tr_item(sc >= 0 ? P.in[6] + sc : nullptr, IN_DIM, P.in[5], nd < 512 ? 0.08838834764831845f : 1.f, kb * 64, D, (bf16_t*)(ws + WS_WIN), nb * 32, scr, lane); continue; }
        r -= I_IN;
        if (r < 2 * I_GO) { const int l2 = r >= I_GO; r -= l2 * I_GO; const int nb = r % (D / 32), kb = r / (D / 32);
            tr_item(P.in[l2 ? 18 : 10] + nb * 32 + j, D, nullptr, 1.f, kb * 64, D, (bf16_t*)(ws + (l2 ? WS_WOUT : WS_WGO)), nb * 32, scr, lane); continue; }
        r -= 2 * I_GO;
        { const int nb = r % (D / 32), kb = r / (D / 32);
            tr_item(P.in[17] + nb * 32 + j, D, nullptr, 1.f, kb * 64, 2048, (bf16_t*)(ws + WS_WSO), nb * 32, scr, lane); }
    }
    const float* x = P.in[0]; bf16_t* xb = (bf16_t*)(ws + WS_XB); float* ssq = (float*)(ws + WS_SSQ);
    for (int m = gw; m < MTOK; m += NGW) {
        const f32x4* xr = (const f32x4*)(x + (size_t)m * D) + lane;
        unsigned long long* o8 = (unsigned long long*)(xb + (size_t)m * D) + lane;
        float s = 0.f;
#pragma unroll
        for (int jj = 0; jj < 4; ++jj) { const f32x4 v = xr[64 * jj]; s += v.x * v.x + v.y * v.y + v.z * v.z + v.w * v.w;
            o8[64 * jj] = (unsigned long long)cvt_pk_bf16(v.x, v.y) | ((unsigned long long)cvt_pk_bf16(v.z, v.w) << 32); }
        s = wave_sum(s);
        if (lane == 0) { ssq[m] = s; ssq[MTOK + m] = 0.f; ssq[2 * MTOK + m] = 0.f; ssq[3 * MTOK + m] = 0.f; }
    }
}

__device__ __forceinline__ void p4_prep(KP Pp, LAS unsigned char* lds, int G) {
    const Params P = load_params(Pp);
    const int tid = tid_fresh();
    unsigned char* ws = P.ws; unsigned char* T = ws + WS_BIG;
    const float* sm = (const float*)(ws + WS_SM);
    for (int it = blockIdx.x; it < HB * NCH; it += G) {
        const int row0 = it * 64;
#pragma unroll
        for (int i = 0; i < 2; ++i) { const int idx = tid + 512 * i; *(LAS f32x4*)(lds + idx * 16) = *(const f32x4*)(sm + (size_t)row0 * 64 + idx * 4); }
        __syncthreads();
        {
            const int hc = tid;
            const float* wf = P.in[7]; float w[16];
#pragma unroll
            for (int j = 0; j < 16; ++j) w[j] = wf[j * 512 + hc];
            const float bfv = P.in[8][hc];
            float cum = 0.f;
#pragma unroll 4
            for (int t = 0; t < 64; ++t) { float z = bfv;
#pragma unroll
                for (int j4 = 0; j4 < 4; ++j4) { const f32x4 f = *(const LAS f32x4*)(lds + t * 256 + j4 * 16); z += f.x * w[4 * j4] + f.y * w[4 * j4 + 1] + f.z * w[4 * j4 + 2] + f.w * w[4 * j4 + 3]; }
                cum += (fminf(z, 0.f) - __logf(1.f + __expf(-fabsf(z)))) * (1.f / 16.f); }
            const float end = cum; cum = 0.f;
            bf16_t* kp = (bf16_t*)(T + T_K) + (size_t)row0 * 512 + hc;
            for (int tb = 0; tb < 4; ++tb) {
                bf16_t kk[16];
#pragma unroll
                for (int u = 0; u < 16; ++u) kk[u] = kp[(size_t)(tb * 16 + u) * 512];
#pragma unroll
                for (int u = 0; u < 16; ++u) { const int t = tb * 16 + u; float z = bfv;
#pragma unroll
                    for (int j4 = 0; j4 < 4; ++j4) { const f32x4 f = *(const LAS f32x4*)(lds + t * 256 + j4 * 16); z += f.x * w[4 * j4] + f.y * w[4 * j4 + 1] + f.z * w[4 * j4 + 2] + f.w * w[4 * j4 + 3]; }
                    cum += (fminf(z, 0.f) - __logf(1.f + __expf(-fabsf(z)))) * (1.f / 16.f);
                    const float kv = __uint_as_float((unsigned)kk[u] << 16) * __expf(end - cum);
                    kp[(size_t)t * 512] = (bf16_t)(cvt_pk_bf16(kv, 0.f) & 0xffffu); }
            }
            ((float*)(ws + WS_DEC))[(size_t)it * 512 + hc] = __expf(end);
        }
        if (tid < 32) {
            const float bias = P.in[13][tid], A = -__expf(P.in[14][tid]);
            float cum = 0.f;
#pragma unroll 4
            for (int t = 0; t < 64; ++t) cum += softplusf_(*(const LAS float*)(lds + t * 256 + (16 + tid) * 4) + bias) * A;
            const float end = cum; cum = 0.f;
            float* wg = (float*)(ws + WS_WG);
#pragma unroll 4
            for (int t = 0; t < 64; ++t) { const float dt = softplusf_(*(const LAS float*)(lds + t * 256 + (16 + tid) * 4) + bias); cum += dt * A; wg[(size_t)(row0 + t) * 32 + tid] = __expf(end - cum) * dt; }
            ((float*)(ws + WS_DECS))[it * 32 + tid] = __expf(end);
        }
        __syncthreads();
    }
    const int co = tid & 63, rg = tid >> 6;
    u32x4 raw[11];
#define CONV_LOAD(itx) do { const int _ci = (itx) >> 3, _col = ((itx) & 7) * 512 + co * 8; \
        const bf16_t* _xp = (const bf16_t*)(T + T_XBC) + (size_t)(_ci * 64 + rg * 8) * 4096 + _col; \
        _Pragma("unroll") for (int i = 0; i < 8; ++i) raw[3 + i] = *(const u32x4*)(_xp + (size_t)i * 4096); \
        if (rg > 0) { _Pragma("unroll") for (int i = 0; i < 3; ++i) raw[i] = *(const u32x4*)(_xp - (size_t)(3 - i) * 4096); } \
        else if ((_ci & (NCH - 1)) != 0) { const bf16_t* _hp = (const bf16_t*)(ws + WS_HALO) + (size_t)(_ci - 1) * 3 * 4096 + _col; \
            _Pragma("unroll") for (int i = 0; i < 3; ++i) raw[i] = *(const u32x4*)(_hp + (size_t)i * 4096); } \
        else { _Pragma("unroll") for (int i = 0; i < 3; ++i) raw[i] = (u32x4){0u, 0u, 0u, 0u}; } } while (0)
    if ((int)blockIdx.x < HB * NCH * 8) CONV_LOAD((int)blockIdx.x);
    for (int it = blockIdx.x; it < HB * NCH * 8; it += G) {
        const int ci = it >> 3, cb = it & 7, col = cb * 512 + co * 8, row0 = ci * 64 + rg * 8;
        bf16_t* xp = (bf16_t*)(T + T_XBC) + (size_t)row0 * 4096 + col;
        float cw[4][8], cbv[8];
#pragma unroll
        for (int k = 0; k < 4; ++k) { const f32x4 a = *(const f32x4*)(P.in[11] + k * 4096 + col), b = *(const f32x4*)(P.in[11] + k * 4096 + col + 4);
            cw[k][0] = a.x; cw[k][1] = a.y; cw[k][2] = a.z; cw[k][3] = a.w; cw[k][4] = b.x; cw[k][5] = b.y; cw[k][6] = b.z; cw[k][7] = b.w; }
        { const f32x4 a = *(const f32x4*)(P.in[12] + col), b = *(const f32x4*)(P.in[12] + col + 4);
            cbv[0] = a.x; cbv[1] = a.y; cbv[2] = a.z; cbv[3] = a.w; cbv[4] = b.x; cbv[5] = b.y; cbv[6] = b.z; cbv[7] = b.w; }
        asm volatile("s_waitcnt vmcnt(0)" ::: "memory");
        __syncthreads();
        u32x4 outv[8];
#pragma unroll
        for (int i = 0; i < 8; ++i) {
            float v[8];
#pragma unroll
            for (int e = 0; e < 8; ++e) v[e] = cbv[e];
#pragma unroll
            for (int k = 0; k < 4; ++k) { const u32x4 q = raw[i + k];
                v[0] += cw[k][0] * bf_lo(q.x); v[1] += cw[k][1] * bf_hi(q.x); v[2] += cw[k][2] * bf_lo(q.y); v[3] += cw[k][3] * bf_hi(q.y);
                v[4] += cw[k][4] * bf_lo(q.z); v[5] += cw[k][5] * bf_hi(q.z); v[6] += cw[k][6] * bf_lo(q.w); v[7] += cw[k][7] * bf_hi(q.w); }
#pragma unroll
            for (int e = 0; e < 8; ++e) v[e] = siluf_(v[e]);
            outv[i].x = cvt_pk_bf16(v[0], v[1]); outv[i].y = cvt_pk_bf16(v[2], v[3]); outv[i].z = cvt_pk_bf16(v[4], v[5]); outv[i].w = cvt_pk_bf16(v[6], v[7]);
        }
        if (it + G < HB * NCH * 8) CONV_LOAD(it + G);
#pragma unroll
        for (int i = 0; i < 8; ++i) *(u32x4*)(xp + (size_t)i * 4096) = outv[i];
    }
#undef CONV_LOAD
}

struct MixArgs {
    const bf16_t* ak; int ld_ak;
    const bf16_t* qq; int ld_q;
    const bf16_t* bv; int ld_bv;
    const bf16_t* gt; int ld_g;
    bf16_t* out; int ld_o;
    const float* dec;
    const float* wg;
    const float* nw;
    const float* dsk;
};
constexpr int RSA = 320, RSB = 576, RSQ = 264, RSG = 520;
constexpr int OFF_AK = 0, OFF_BV = 64 * RSA, OFF_QQ = OFF_BV + 64 * RSB, OFF_WGT = OFF_QQ + 64 * RSQ, OFF_DEC = OFF_WGT + 1024, OFF_RED = OFF_DEC + 512, OFF_NW = OFF_RED + 2048, OFF_GT = OFF_NW + 1024;
static_assert(OFF_GT + 64 * RSG <= LDS_MAIN, "mixer LDS");

#define LBAR() do { asm volatile("s_waitcnt lgkmcnt(0)" ::: "memory"); __builtin_amdgcn_s_barrier(); asm volatile("" ::: "memory"); } while (0)
template <bool SSD>
__device__ __forceinline__ void mixer_item(LAS unsigned char* lds, const MixArgs& a) {
    const int tid = tid_fresh(), lane = tid & 63, w = __builtin_amdgcn_readfirstlane(tid >> 6);
    const int r = lane & 31, h = lane >> 5, gg = lane >> 4, q = (lane & 15) >> 2, p = lane & 3;
    const int arow0 = tid >> 4, apc = tid & 15;
    const int brow0 = tid >> 5, bpc = tid & 31;
    u32x4 stA[2], stQ[2], stB[4], stG[4], stW, stD;
    stW = (u32x4){0u, 0u, 0u, 0u}; stD = stW;
#define MIX_LOAD(c) do { const size_t _r0 = (size_t)(c) * 64; \
        _Pragma("unroll") for (int i = 0; i < 2; ++i) { stA[i] = *(const u32x4*)(a.ak + (_r0 + arow0 + 32 * i) * a.ld_ak + apc * 8); stQ[i] = *(const u32x4*)(a.qq + (_r0 + arow0 + 32 * i) * a.ld_q + apc * 8); } \
        _Pragma("unroll") for (int i = 0; i < 4; ++i) { stB[i] = *(const u32x4*)(a.bv + (_r0 + brow0 + 16 * i) * a.ld_bv + bpc * 8); stG[i] = *(const u32x4*)(a.gt + (_r0 + brow0 + 16 * i) * a.ld_g + bpc * 8); } \
        if (SSD) { if (tid < 64) stW = *(const u32x4*)(a.wg + (_r0 + tid) * 32); } \
        else { if (tid < 32) stD = *(const u32x4*)(a.dec + (size_t)(c) * 512 + tid * 4); } } while (0)
#define MIX_STORE() do { \
        _Pragma("unroll") for (int i = 0; i < 2; ++i) { *(LAS u32x4*)(lds + OFF_AK + (arow0 + 32 * i) * RSA + apc * 16) = stA[i]; \
            *(LAS u32x2*)(lds + OFF_QQ + (arow0 + 32 * i) * RSQ + apc * 16) = (u32x2){stQ[i].x, stQ[i].y}; *(LAS u32x2*)(lds + OFF_QQ + (arow0 + 32 * i) * RSQ + apc * 16 + 8) = (u32x2){stQ[i].z, stQ[i].w}; } \
        _Pragma("unroll") for (int i = 0; i < 4; ++i) { *(LAS u32x4*)(lds + OFF_BV + (brow0 + 16 * i) * RSB + bpc * 16) = stB[i]; \
            *(LAS u32x2*)(lds + OFF_GT + (brow0 + 16 * i) * RSG + bpc * 16) = (u32x2){stG[i].x, stG[i].y}; *(LAS u32x2*)(lds + OFF_GT + (brow0 + 16 * i) * RSG + bpc * 16 + 8) = (u32x2){stG[i].z, stG[i].w}; } \
        if (SSD) { if (tid < 64) { *(LAS unsigned*)(lds + OFF_WGT + tid * 4) = stW.x; *(LAS unsigned*)(lds + OFF_WGT + 256 + tid * 4) = stW.y; *(LAS unsigned*)(lds + OFF_WGT + 512 + tid * 4) = stW.z; *(LAS unsigned*)(lds + OFF_WGT + 768 + tid * 4) = stW.w; } } \
        else { if (tid < 32) *(LAS u32x4*)(lds + OFF_DEC + tid * 16) = stD; } } while (0)

    if (tid < 256) *(LAS float*)(lds + OFF_NW + tid * 4) = a.nw[tid];
    MIX_LOAD(0);
    MIX_STORE();
    __syncthreads();

    f32x16 S[4];
#pragma unroll
    for (int i = 0; i < 4; ++i)
#pragma unroll
        for (int e = 0; e < 16; ++e) S[i][e] = 0.f;

    const int trA = OFF_AK + (8 * h + q) * RSA + (16 * (gg & 1) + 4 * p) * 2;
    const int trB = OFF_BV + (8 * h + q) * RSB + (32 * w + 16 * (gg & 1) + 4 * p) * 2;
    const int qB = OFF_QQ + r * RSQ + 8 * h;
    const int gB = OFF_GT + r * RSG + (32 * w + 4 * h) * 2;
    const float dsk = SSD ? a.dsk[w >> 1] : 0.f;

    for (int c = 0; c < NCH; ++c) {
        if (c + 1 < NCH) MIX_LOAD(c + 1);
        if (SSD) {
            const float dc = a.dec[(size_t)c * 32 + (w >> 1)];
#pragma unroll
            for (int i = 0; i < 4; ++i)
#pragma unroll
                for (int e = 0; e < 16; ++e) S[i][e] *= dc;
        } else {
#pragma unroll
            for (int i = 0; i < 4; ++i)
#pragma unroll
                for (int g = 0; g < 4; ++g) { const f32x4 d4 = *(const LAS f32x4*)(lds + OFF_DEC + (32 * i + 8 * g + 4 * h) * 4);
                    S[i][4 * g + 0] *= d4.x; S[i][4 * g + 1] *= d4.y; S[i][4 * g + 2] *= d4.z; S[i][4 * g + 3] *= d4.w; }
        }
#define TRR(addr) __builtin_bit_cast(s16x4, __builtin_amdgcn_ds_read_tr16_b64_v4i16((LAS s16x4*)(lds + (addr))))
#define UPD_LOAD(s, B0, B1, A0, A1, W0, W1) do { B0 = TRR(trB + (16 * (s)) * RSB); B1 = TRR(trB + (16 * (s) + 4) * RSB); \
        _Pragma("unroll") for (int i = 0; i < 4; ++i) { A0[i] = TRR(trA + (16 * (s)) * RSA + 64 * i); A1[i] = TRR(trA + (16 * (s) + 4) * RSA + 64 * i); } \
        if (SSD) { W0 = *(const LAS f32x4*)(lds + OFF_WGT + (w >> 1) * 256 + (16 * (s) + 8 * h) * 4); W1 = *(const LAS f32x4*)(lds + OFF_WGT + (w >> 1) * 256 + (16 * (s) + 8 * h + 4) * 4); } } while (0)
#define UPD_MMA(B0, B1, A0, A1, W0, W1) do { bf16x8 bfr = __builtin_shufflevector(B0, B1, 0, 1, 2, 3, 4, 5, 6, 7); \
        if (SSD) { u32x4 bu = __builtin_bit_cast(u32x4, bfr); \
            bu.x = cvt_pk_bf16(bf_lo(bu.x) * W0.x, bf_hi(bu.x) * W0.y); bu.y = cvt_pk_bf16(bf_lo(bu.y) * W0.z, bf_hi(bu.y) * W0.w); \
            bu.z = cvt_pk_bf16(bf_lo(bu.z) * W1.x, bf_hi(bu.z) * W1.y); bu.w = cvt_pk_bf16(bf_lo(bu.w) * W1.z, bf_hi(bu.w) * W1.w); bfr = __builtin_bit_cast(bf16x8, bu); } \
        _Pragma("unroll") for (int i = 0; i < 4; ++i) S[i] = __builtin_amdgcn_mfma_f32_32x32x16_bf16(__builtin_shufflevector(A0[i], A1[i], 0, 1, 2, 3, 4, 5, 6, 7), bfr, S[i], 0, 0, 0); } while (0)
        {
            s16x4 xb0, xb1, xa0[4], xa1[4], yb0, yb1, ya0[4], ya1[4]; f32x4 xw0, xw1, yw0, yw1;
            xw0 = xw1 = yw0 = yw1 = (f32x4){0.f, 0.f, 0.f, 0.f};
            UPD_LOAD(0, xb0, xb1, xa0, xa1, xw0, xw1);
            UPD_LOAD(1, yb0, yb1, ya0, ya1, yw0, yw1);
            __builtin_amdgcn_sched_barrier(0);
            UPD_MMA(xb0, xb1, xa0, xa1, xw0, xw1);
            __builtin_amdgcn_sched_barrier(0);
            UPD_LOAD(2, xb0, xb1, xa0, xa1, xw0, xw1);
            __builtin_amdgcn_sched_barrier(0);
            UPD_MMA(yb0, yb1, ya0, ya1, yw0, yw1);
            __builtin_amdgcn_sched_barrier(0);
            UPD_LOAD(3, yb0, yb1, ya0, ya1, yw0, yw1);
            __builtin_amdgcn_sched_barrier(0);
            UPD_MMA(xb0, xb1, xa0, xa1, xw0, xw1);
            __builtin_amdgcn_sched_barrier(0);
            UPD_MMA(yb0, yb1, ya0, ya1, yw0, yw1);
        }
#undef UPD_LOAD
#undef UPD_MMA
        f32x16 OT[2];
#pragma unroll
        for (int j2 = 0; j2 < 2; ++j2)
#pragma unroll
            for (int e = 0; e < 16; ++e) OT[j2][e] = 0.f;
        {
            u32x2 qf[3][2][2];
#define Q_LOAD(sp, buf) do { _Pragma("unroll") for (int j2 = 0; j2 < 2; ++j2) { qf[buf][j2][0] = *(const LAS u32x2*)(lds + qB + 32 * j2 * RSQ + (16 * (sp)) * 2); qf[buf][j2][1] = *(const LAS u32x2*)(lds + qB + 32 * j2 * RSQ + (16 * (sp) + 8) * 2); } } while (0)
            Q_LOAD(0, 0); Q_LOAD(1, 1);
#pragma unroll
            for (int sp = 0; sp < 8; ++sp) {
                const int i = sp >> 1, o8 = 8 * (sp & 1);
                if (sp + 2 < 8) Q_LOAD(sp + 2, (sp + 2) % 3);
                u32x4 pk;
                pk.x = cvt_pk_bf16(S[i][o8 + 0], S[i][o8 + 1]); pk.y = cvt_pk_bf16(S[i][o8 + 2], S[i][o8 + 3]);
                pk.z = cvt_pk_bf16(S[i][o8 + 4], S[i][o8 + 5]); pk.w = cvt_pk_bf16(S[i][o8 + 6], S[i][o8 + 7]);
                const bf16x8 sfr = __builtin_bit_cast(bf16x8, pk);
                __builtin_amdgcn_sched_barrier(0);
#pragma unroll
                for (int j2 = 0; j2 < 2; ++j2) {
                    const bf16x8 qfr = __builtin_bit_cast(bf16x8, (u32x4){qf[sp % 3][j2][0].x, qf[sp % 3][j2][0].y, qf[sp % 3][j2][1].x, qf[sp % 3][j2][1].y});
                    OT[j2] = __builtin_amdgcn_mfma_f32_32x32x16_bf16(sfr, qfr, OT[j2], 0, 0, 0);
                }
                __builtin_amdgcn_sched_barrier(0);
            }
#undef Q_LOAD
        }
#undef TRR
        u32x2 gv[2][4];
#pragma unroll
        for (int j2 = 0; j2 < 2; ++j2)
#pragma unroll
            for (int g = 0; g < 4; ++g) gv[j2][g] = *(const LAS u32x2*)(lds + gB + 32 * j2 * RSG + 16 * g);
        float part[2] = {0.f, 0.f};
#pragma unroll
        for (int j2 = 0; j2 < 2; ++j2)
#pragma unroll
            for (int g = 0; g < 4; ++g) {
                if (SSD) {
                    const u32x2 xs = *(const LAS u32x2*)(lds + OFF_BV + (32 * j2 + r) * RSB + (32 * w + 8 * g + 4 * h) * 2);
                    OT[j2][4 * g + 0] = (OT[j2][4 * g + 0] + dsk * bf_lo(xs.x)) * bf_lo(gv[j2][g].x);
                    OT[j2][4 * g + 1] = (OT[j2][4 * g + 1] + dsk * bf_hi(xs.x)) * bf_hi(gv[j2][g].x);
                    OT[j2][4 * g + 2] = (OT[j2][4 * g + 2] + dsk * bf_lo(xs.y)) * bf_lo(gv[j2][g].y);
                    OT[j2][4 * g + 3] = (OT[j2][4 * g + 3] + dsk * bf_hi(xs.y)) * bf_hi(gv[j2][g].y);
                }
#pragma unroll
                for (int k = 0; k < 4; ++k) part[j2] += OT[j2][4 * g + k] * OT[j2][4 * g + k];
            }
        part[0] += __shfl_xor(part[0], 32); part[1] += __shfl_xor(part[1], 32);
        if (h == 0) { *(LAS float*)(lds + OFF_RED + (w * 64 + r) * 4) = part[0]; *(LAS float*)(lds + OFF_RED + (w * 64 + 32 + r) * 4) = part[1]; }
        LBAR();
#pragma unroll
        for (int j2 = 0; j2 < 2; ++j2) {
            float tot = 0.f;
#pragma unroll
            for (int ww = 0; ww < 8; ++ww) tot += *(const LAS float*)(lds + OFF_RED + (ww * 64 + 32 * j2 + r) * 4);
            const float rstd = rsqrtf(tot * (1.f / 256.f) + EPS);
#pragma unroll
            for (int g = 0; g < 4; ++g) {
                const f32x4 n4 = *(const LAS f32x4*)(lds + OFF_NW + (32 * w + 8 * g + 4 * h) * 4);
                float v0 = OT[j2][4 * g + 0] * rstd * n4.x, v1 = OT[j2][4 * g + 1] * rstd * n4.y, v2 = OT[j2][4 * g + 2] * rstd * n4.z, v3 = OT[j2][4 * g + 3] * rstd * n4.w;
                if (!SSD) { v0 *= bf_lo(gv[j2][g].x); v1 *= bf_hi(gv[j2][g].x); v2 *= bf_lo(gv[j2][g].y); v3 *= bf_hi(gv[j2][g].y); }
                *(LAS u32x2*)(lds + gB + 32 * j2 * RSG + 16 * g) = (u32x2){cvt_pk_bf16(v0, v1), cvt_pk_bf16(v2, v3)};
            }
        }
        LBAR();
#pragma unroll
        for (int i = 0; i < 4; ++i) {
            const u32x2 o0 = *(const LAS u32x2*)(lds + OFF_GT + (brow0 + 16 * i) * RSG + bpc * 16), o1 = *(const LAS u32x2*)(lds + OFF_GT + (brow0 + 16 * i) * RSG + bpc * 16 + 8);
            *(u32x4*)(a.out + ((size_t)c * 64 + brow0 + 16 * i) * a.ld_o + bpc * 8) = (u32x4){o0.x, o0.y, o1.x, o1.y};
        }
        if (c + 1 < NCH) MIX_STORE();
        LBAR();
    }
#undef MIX_LOAD
#undef MIX_STORE
}

__device__ __forceinline__ void p5_mixer(KP Pp, LAS unsigned char* lds, int G) {
    const Params P = load_params(Pp);
    unsigned char* ws = P.ws; unsigned char* T = ws + WS_BIG;
    for (int it = blockIdx.x; it < HB * 12; it += G) {
        const int b = it / 12, k = it % 12;
        const size_t row0 = (size_t)b * SEQ;
        MixArgs a;
        if (k < 4) {
            const int hd = k;
            a.ak = (const bf16_t*)(T + T_K) + row0 * 512 + hd * 128; a.ld_ak = 512;
            a.qq = (const bf16_t*)(T + T_Q) + row0 * 512 + hd * 128; a.ld_q = 512;
            a.bv = (const bf16_t*)(T + T_V) + row0 * 1024 + hd * 256; a.ld_bv = 1024;
            a.gt = (const bf16_t*)(T + T_SG) + row0 * 1024 + hd * 256; a.ld_g = 1024;
            a.out = (bf16_t*)(T + T_V) + row0 * 1024 + hd * 256; a.ld_o = 1024;
            a.dec = (const float*)(ws + WS_DEC) + (size_t)b * NCH * 512 + hd * 128;
            a.wg = nullptr; a.nw = P.in[9]; a.dsk = nullptr;
            mixer_item<false>(lds, a);
        } else {
            const int g = k - 4;
            const bf16_t* X = (const bf16_t*)(T + T_XBC) + row0 * 4096;
            a.ak = X + 2048 + g * 128; a.ld_ak = 4096;
            a.qq = X + 3072 + g * 128; a.ld_q = 4096;
            a.bv = X + g * 256; a.ld_bv = 4096;
            a.gt = (const bf16_t*)(T + T_SZ) + row0 * 2048 + g * 256; a.ld_g = 2048;
            a.out = (bf16_t*)(T + T_XBC) + row0 * 4096 + g * 256; a.ld_o = 4096;
            a.dec = (const float*)(ws + WS_DECS) + (size_t)b * NCH * 32 + g * 4;
            a.wg = (const float*)(ws + WS_WG) + row0 * 32 + g * 4;
            a.nw = P.in[16] + g * 256; a.dsk = P.in[15] + g * 4;
            mixer_item<true>(lds, a);
        }
        __syncthreads();
    }
}

__device__ __forceinline__ KP get_params() {
    KP p = (KP)__builtin_amdgcn_kernarg_segment_ptr(); asm volatile("" : "+s"(p)); return p;
}

#define XB_TMO      128
#define XB_XCNT(j)  (256  + 64 * (j))
#define XB_XSUB(j)  (1280 + 64 * (j))
#define XB_XGEN(j)  (2304 + 64 * (j))
#define XB_TOP      3328
#define XB_TOPGEN   3392
#define XCD_BAR_WORDS 3456
#define XB_SPIN_CAP (1u << 18)
__device__ __forceinline__ unsigned xb_ld(unsigned* p)              { return __hip_atomic_load(p, __ATOMIC_RELAXED, __HIP_MEMORY_SCOPE_AGENT); }
__device__ __forceinline__ unsigned xb_add(unsigned* p, unsigned v) { return __hip_atomic_fetch_add(p, v, __ATOMIC_RELAXED, __HIP_MEMORY_SCOPE_AGENT); }
__device__ __forceinline__ unsigned xb_xcc_id() { return (unsigned)__builtin_amdgcn_s_getreg((3 << 11) | 20) & 0xFu; }
#define XB_SPIN(cond, bar) do { unsigned _sp = 0; while (cond) { __builtin_amdgcn_s_sleep(1); \
    if ((++_sp & 255u) == 0u) { if (xb_ld(&(bar)[XB_TMO])) break; if (_sp > XB_SPIN_CAP) { atomicAdd(&(bar)[XB_TMO], 1u); break; } } } } while (0)
struct XcdBarrier { unsigned* bar; unsigned x; volatile LAS unsigned* st; };
__device__ __forceinline__ XcdBarrier xcd_barrier_post(unsigned* bar, volatile LAS unsigned* st) {
    XcdBarrier b; b.bar = bar; b.x = xb_xcc_id(); b.st = st;
    if (threadIdx.x == 0) (void)xb_add(&bar[XB_XCNT(b.x)], 1u);
    return b;
}
__device__ __forceinline__ void xcd_barrier_complete(unsigned* bar, unsigned x, unsigned& nloc, unsigned& nx) {
    const unsigned G = gridDim.x * gridDim.y * gridDim.z;
    unsigned sum, cnt, mine, sp = 0u;
    for (;;) {
        sum = 0u; cnt = 0u; mine = 0u;
#pragma unroll
        for (unsigned j = 0; j < 16; ++j) { const unsigned c = xb_ld(&bar[XB_XCNT(j)]); sum += c; cnt += (c > 0u) ? 1u : 0u; mine = (j == x) ? c : mine; }
        if (sum == G) break;
        __builtin_amdgcn_s_sleep(1);
        if ((++sp & 255u) == 0u) { if (xb_ld(&bar[XB_TMO])) break; if (sp > XB_SPIN_CAP) { atomicAdd(&bar[XB_TMO], 1u); break; } }
    }
    nloc = mine > 0u ? mine : 1u; nx = cnt > 0u ? cnt : 1u;
}
__device__ __forceinline__ void xcd_barrier(const XcdBarrier& b) {
    asm volatile("s_waitcnt vmcnt(0)" ::: "memory");
    __syncthreads();
    if (threadIdx.x == 0) {
        unsigned* bar = b.bar;
        __builtin_amdgcn_s_waitcnt(0);
        unsigned nloc = b.st[0], nx = b.st[1];
        if (nloc == 0u) { xcd_barrier_complete(bar, b.x, nloc, nx); b.st[0] = nloc; b.st[1] = nx; }
        const unsigned old = xb_add(&bar[XB_XSUB(b.x)], 1u);
        const unsigned gen = old / nloc;
        if (old + 1u == (gen + 1u) * nloc) {
            __builtin_amdgcn_fence(__ATOMIC_RELEASE, "agent");
            asm volatile("s_waitcnt vmcnt(0)" ::: "memory");
            const unsigned og = xb_add(&bar[XB_TOP], 1u);
            const unsigned tg = og / nx;
            if (og + 1u == (tg + 1u) * nx) xb_add(&bar[XB_TOPGEN], 1u);
            else XB_SPIN(xb_ld(&bar[XB_TOPGEN]) == tg, bar);
            __builtin_amdgcn_fence(__ATOMIC_ACQUIRE, "agent");
            xb_add(&bar[XB_XGEN(b.x)], 1u);
            asm volatile("s_waitcnt vmcnt(0)" ::: "memory");
        } else {
            XB_SPIN(xb_ld(&bar[XB_XGEN(b.x)]) == gen, bar);
            __builtin_amdgcn_fence(__ATOMIC_ACQUIRE, "agent");
            asm volatile("s_waitcnt vmcnt(0)" ::: "memory");
        }
    }
    __syncthreads();
}

#define PROBE_MASK 0x0
#define PROBE_DSYNC 0
#if PROBE_MASK
#define PH_BEGIN(i) const unsigned long long _t##i = __builtin_amdgcn_s_memrealtime();
#define PH_END(i) if ((PROBE_MASK >> (i)) & 1) probe_acc += __builtin_amdgcn_s_memrealtime() - _t##i;
#else
#define PH_BEGIN(i)
#define PH_END(i)
#endif
#if PROBE_DSYNC
#define GSYNC() do { xcd_barrier(xbar); xcd_barrier(xbar); } while (0)
#else
#define GSYNC() xcd_barrier(xbar)
#endif
__global__ void __launch_bounds__(512, 2) fwd_megakernel(Params Parg) {
    extern __shared__ __attribute__((aligned(16))) unsigned char lds_raw[];
    LAS unsigned char* lds = (LAS unsigned char*)lds_raw;
    cg::grid_group grid = cg::this_grid();
    const int G = gridDim.x;
    pg8::StaticOrder S;
#if PROBE_MASK
    unsigned long long probe_acc = 0;
#endif

    { unsigned* bw = (unsigned*)(get_params()->ws + WS_BAR);
      if (blockIdx.x == 0) for (int i = threadIdx.x; i < XCD_BAR_WORDS; i += 512) bw[i] = 0u;
      if (threadIdx.x < 2) *(volatile LAS unsigned*)(lds + LDS_MAIN + threadIdx.x * 4) = 0u; }
    XcdBarrier xbar;
    { PH_BEGIN(0) p0_prologue(get_params(), lds, G);
    grid.sync();
    xbar = xcd_barrier_post((unsigned*)(get_params()->ws + WS_BAR), (volatile LAS unsigned*)(lds + LDS_MAIN));
    PH_END(0) }
    { PH_BEGIN(1) { KP P = get_params(); unsigned char* ws = P->ws;
      pg8::Gemm g{(const bf16_t*)(ws + WS_XB), (const bf16_t*)(ws + WS_WGU1), MTOK, NGU, D, D, D}; S.init(MTOK, NGU, G, blockIdx.x);
      EpiGU E{(const float*)(ws + WS_SSQ), (bf16_t*)(ws + WS_BIG)}; pg8::gemm_phase(lds, g, S, E); }
    GSYNC(); PH_END(1) }
    { PH_BEGIN(2) { KP P = get_params(); unsigned char* ws = P->ws;
      pg8::Gemm g{(const bf16_t*)(ws + WS_BIG), (const bf16_t*)(ws + WS_WD1), MTOK, D, DFF, DFF, DFF}; S.init(MTOK, D, G, blockIdx.x);
      EpiRes E{P->in[0], P->out, (bf16_t*)(ws + WS_XB), (float*)(ws + WS_SSQ) + MTOK, 0.5f}; pg8::gemm_phase(lds, g, S, E); }
    GSYNC(); PH_END(2) }
    for (int hf = 0; hf < 2; ++hf) {
        const size_t r0 = (size_t)hf * MH;
        { PH_BEGIN(3) { KP P = get_params(); unsigned char* ws = P->ws;
          pg8::Gemm g{(const bf16_t*)(ws + WS_XB) + r0 * D, (const bf16_t*)(ws + WS_WIN), MH, NIN, D, D, D}; S.init(MH, NIN, G, blockIdx.x);
          EpiIn E{(const float*)(ws + WS_SSQ) + MTOK + r0, ws + WS_BIG, (bf16_t*)(ws + WS_HALO), (float*)(ws + WS_SM)}; pg8::gemm_phase(lds, g, S, E); }
        GSYNC(); PH_END(3) }
        { PH_BEGIN(4) p4_prep(get_params(), lds, G);
        GSYNC(); PH_END(4) }
        { PH_BEGIN(5) p5_mixer(get_params(), lds, G);
        GSYNC(); PH_END(5) }
        { PH_BEGIN(6) { KP P = get_params(); unsigned char* ws = P->ws; unsigned char* T = ws + WS_BIG;
          pg8::Gemm g{(const bf16_t*)(T + T_V), (const bf16_t*)(ws + WS_WGO), MH, D, D, D, D}; S.init(MH, D, G, blockIdx.x);
          EpiGate E{(const bf16_t*)(T + T_GT), nullptr, (bf16_t*)(T + T_T1), 0}; pg8::gemm_phase(lds, g, S, E); }
        { KP P = get_params(); unsigned char* ws = P->ws; unsigned char* T = ws + WS_BIG;
          pg8::Gemm g{(const bf16_t*)(T + T_XBC), (const bf16_t*)(ws + WS_WSO), MH, D, 2048, 4096, 2048}; S.init(MH, D, G, blockIdx.x);
          EpiGate E{(const bf16_t*)(T + T_GT), (const bf16_t*)(T + T_T1), (bf16_t*)(T + T_MRG), 1}; pg8::gemm_phase(lds, g, S, E); }
        GSYNC(); PH_END(6) }
        { PH_BEGIN(7) { KP P = get_params(); unsigned char* ws = P->ws;
          pg8::Gemm g{(const bf16_t*)(ws + WS_BIG + T_MRG), (const bf16_t*)(ws + WS_WOUT), MH, D, D, D, D}; S.init(MH, D, G, blockIdx.x);
          EpiRes E{P->out + r0 * D, P->out + r0 * D, (bf16_t*)(ws + WS_XB) + r0 * D, (float*)(ws + WS_SSQ) + 2 * MTOK + r0, 1.0f}; pg8::gemm_phase(lds, g, S, E); }
        GSYNC(); PH_END(7) }
    }
    { PH_BEGIN(8) { KP P = get_params(); unsigned char* ws = P->ws;
      pg8::Gemm g{(const bf16_t*)(ws + WS_XB), (const bf16_t*)(ws + WS_WGU2), MTOK, NGU, D, D, D}; S.init(MTOK, NGU, G, blockIdx.x);
      EpiGU E{(const float*)(ws + WS_SSQ) + 2 * MTOK, (bf16_t*)(ws + WS_BIG)}; pg8::gemm_phase(lds, g, S, E); }
    GSYNC(); PH_END(8) }
    { PH_BEGIN(9) { KP P = get_params(); unsigned char* ws = P->ws;
      pg8::Gemm g{(const bf16_t*)(ws + WS_BIG), (const bf16_t*)(ws + WS_WD2), MTOK, D, DFF, DFF, DFF}; S.init(MTOK, D, G, blockIdx.x);
      EpiRes E{P->out, P->out, nullptr, (float*)(ws + WS_SSQ) + 3 * MTOK, 0.5f}; pg8::gemm_phase(lds, g, S, E); }
    GSYNC(); PH_END(9) }
    { PH_BEGIN(10)
    {
        KP P = get_params(); const float* ssq = (const float*)(P->ws + WS_SSQ) + 3 * MTOK;
        const int tid = tid_fresh(), lane = tid & 63, gw = blockIdx.x * 8 + (tid >> 6), NGW = G * 8;
        const float* fw = P->in[23]; float* outp = P->out;
        for (int m = gw; m < MTOK; m += NGW) {
            const float rstd = rsqrtf(ssq[m] * (1.f / D) + EPS);
            f32x4* xr = (f32x4*)(outp + (size_t)m * D) + lane;
#pragma unroll
            for (int jj = 0; jj < 4; ++jj) { const f32x4 wv = ((const f32x4*)fw)[lane + 64 * jj]; f32x4 v = xr[64 * jj]; v = v * rstd; v.x *= wv.x; v.y *= wv.y; v.z *= wv.z; v.w *= wv.w; xr[64 * jj] = v; }
        }
    }
    PH_END(10) }
#if PROBE_MASK
    if (blockIdx.x == 0) {
        const unsigned long long t0 = __builtin_amdgcn_s_memrealtime();
        while (__builtin_amdgcn_s_memrealtime() - t0 < probe_acc) __builtin_amdgcn_s_sleep(8);
    }
#endif
}

extern "C" void kernel_launch(void* const* d_in, const int* in_sizes, int n_in, void* d_out, int out_size, void* d_ws, size_t ws_size, hipStream_t stream) {
    static int grid = 0;
    if (grid == 0) {
        if (n_in != 24 || ws_size < WS_NEED) { fprintf(stderr, "kernel_launch: unexpected n_in %d or ws_size %zu (need %zu)\n", n_in, ws_size, (size_t)WS_NEED); grid = -1; return; }
        int dev = 0, cus = 0, per_cu = 0;
        hipGetDevice(&dev);
        hipDeviceGetAttribute(&cus, hipDeviceAttributeMultiprocessorCount, dev);
        hipFuncSetAttribute((const void*)fwd_megakernel, hipFuncAttributeMaxDynamicSharedMemorySize, LDS_BYTES);
        hipOccupancyMaxActiveBlocksPerMultiprocessor(&per_cu, (const void*)fwd_megakernel, 512, LDS_BYTES);
        if (per_cu < 1) { fprintf(stderr, "kernel_launch: occupancy query gave %d\n", per_cu); per_cu = 1; }
        grid = cus * per_cu;
        (void)hipGetLastError();
    }
    if (grid < 0) return;
    Params p{};
    for (int i = 0; i < 24; ++i) p.in[i] = (const float*)d_in[i];
    p.out = (float*)d_out; p.ws = (unsigned char*)d_ws;
    void* args[] = {&p};
    hipError_t e = hipLaunchCooperativeKernel((const void*)fwd_megakernel, dim3(grid), dim3(512), args, LDS_BYTES, stream);
    if (e != hipSuccess) fprintf(stderr, "cooperative launch failed: %s (grid %d)\n", hipGetErrorString(e), grid);
}
```

```cpp
#include <hip/hip_runtime.h>
#include <hip/hip_cooperative_groups.h>
#include <cstdio>
#include <cstdint>
namespace cg = cooperative_groups;

#define LAS __attribute__((address_space(3)))
typedef unsigned short bf16_t;
typedef short bf16x8 __attribute__((ext_vector_type(8)));
typedef short s16x4 __attribute__((ext_vector_type(4)));
typedef float f32x4 __attribute__((ext_vector_type(4)));
typedef float f32x16 __attribute__((ext_vector_type(16)));
typedef unsigned u32x4 __attribute__((ext_vector_type(4)));
typedef unsigned u32x2 __attribute__((ext_vector_type(2)));

constexpr int D = 1024, BATCH = 32, SEQ = 2048, MTOK = BATCH * SEQ;
constexpr int NCH = SEQ / 64;
constexpr int DFF = 2816, NGU = 2 * DFF;
constexpr int IN_DIM = 11312, NIN = 45 * 256;
constexpr int HB = 16, MH = HB * SEQ;
constexpr float EPS = 1e-6f;

constexpr size_t MiB = 1u << 20;
constexpr size_t WS_SSQ = 0;
constexpr size_t WS_WGU1 = 1 * MiB, WS_WD1 = 12 * MiB, WS_WIN = 18 * MiB, WS_WGO = 41 * MiB, WS_WSO = 43 * MiB, WS_WOUT = 47 * MiB, WS_WGU2 = 49 * MiB, WS_WD2 = 60 * MiB;
constexpr size_t WS_DEC = 66 * MiB, WS_DECS = 67 * MiB, WS_WG = 68 * MiB, WS_HALO = 72 * MiB, WS_SM = 84 * MiB;
constexpr size_t WS_BAR = 92 * MiB;
constexpr size_t WS_XB = 96 * MiB;
constexpr size_t WS_BIG = 224 * MiB;
constexpr size_t T_Q = 0, T_K = 32 * MiB, T_V = 64 * MiB, T_SG = 128 * MiB, T_SZ = 192 * MiB, T_XBC = 320 * MiB, T_GT = 576 * MiB, T_END = 704 * MiB;
constexpr size_t T_T1 = T_Q, T_MRG = T_SG;
constexpr size_t WS_NEED = WS_BIG + T_END;

constexpr int LDS_MAIN = 131072, LDS_BYTES = LDS_MAIN + 64;

__device__ __forceinline__ unsigned cvt_pk_bf16(float lo, float hi) { unsigned r; asm volatile("v_cvt_pk_bf16_f32 %0, %1, %2" : "=v"(r) : "v"(lo), "v"(hi)); return r; }
__device__ __forceinline__ float bf_lo(unsigned u) { return __uint_as_float(u << 16); }
__device__ __forceinline__ float bf_hi(unsigned u) { return __uint_as_float(u & 0xffff0000u); }
__device__ __forceinline__ float fast_rcp(float x) { return __builtin_amdgcn_rcpf(x); }
__device__ __forceinline__ float sigmoidf_(float x) { return fast_rcp(1.f + __expf(-x)); }
__device__ __forceinline__ float siluf_(float x) { return x * sigmoidf_(x); }
__device__ __forceinline__ float softplusf_(float x) { return fmaxf(x, 0.f) + __logf(1.f + __expf(-fabsf(x))); }
__device__ __forceinline__ float wave_sum(float v) {
#pragma unroll
    for (int o = 1; o < 64; o <<= 1) v += __shfl_xor(v, o);
    return v;
}

namespace pg8 {
constexpr int BM = 256, BK = 64, HALF = 128, HTB = HALF * BK * 2, STAGE_BYTES = 8 * HTB, NXCD = 8, WGM = 8;
__host__ __device__ __forceinline__ int lds_byte(int r, int c) { const int st = (r >> 4) * 2 + (c >> 5), rr = r & 15, cc = c & 31, ob = rr * 64 + cc * 2; return st * 1024 + (ob ^ (((ob >> 9) & 1) << 5)); }
__host__ __device__ __forceinline__ void stage_rc(int b, int& R, int& C) { const int st = b / 1024, sb = b % 1024, swz = sb ^ (((sb >> 9) & 1) << 5); R = (st >> 1) * 16 + swz / 64; C = (st & 1) * 32 + (swz % 64) / 2; }
__host__ __device__ __forceinline__ int perm32(int rho) { const int n = rho >> 4, i = rho & 15; return 8 * (i >> 2) + 4 * n + (i & 3); }

struct Unit { int pm, pn; };
struct Gemm { const bf16_t* A; const bf16_t* Bt; int M, N, K, lda, ldb; };

struct StaticOrder {
    int nM, nN, nwg, G, c;
    __device__ void init(int M, int N, int G_, int c_) { nM = M / BM; nN = N / BM; nwg = nM * nN; G = G_; c = c_; }
    __device__ bool next(int i, Unit& u) const {
        const long L = (long)i * G + c; if (L >= nwg) return false;
        int wgid = (int)L; { const int q = nwg / NXCD, r = nwg % NXCD, xcd = wgid % NXCD, off = wgid / NXCD; wgid = (xcd < r ? xcd * (q + 1) : r * (q + 1) + (xcd - r) * q) + off; }
        const int nig = WGM * nN, gid = wgid / nig, fm = gid * WGM, gsz = (nM - fm) < WGM ? (nM - fm) : WGM;
        u.pm = fm + ((wgid % nig) % gsz); u.pn = (wgid % nig) / gsz; return true;
    }
};

template <class Epi, bool ALIGN_EPI = true, bool SP2 = true>
__device__ __forceinline__ void gemm_phase(LAS unsigned char* lds, const Gemm g, const StaticOrder& S, const Epi& E) {
    int tid = threadIdx.x; asm volatile("" : "+v"(tid));
    const int wid = __builtin_amdgcn_readfirstlane(tid >> 6), lane = tid & 63, wr = wid >> 2, wc = wid & 3, fr = lane & 15, fq = lane >> 4;
    const int K = g.K, nt = K / BK;
    unsigned voffA[2], voffB[2];
#pragma unroll
    for (int i = 0; i < 2; ++i) { int R, C; stage_rc(tid * 16 + i * 8192, R, C); const int Rb = (R & ~31) + perm32(R & 31);
        voffA[i] = (unsigned)(R * g.lda + C) * 2u; voffB[i] = (unsigned)(Rb * g.ldb + C) * 2u; }
    const size_t kstep = (size_t)(BK * 2);
    const size_t hstA = (size_t)HALF * g.lda * 2, hstB = (size_t)HALF * g.ldb * 2;
    const size_t tstA = 2 * hstA, tstB = 2 * hstB;
    const unsigned ldsw = (unsigned)wid * 1024u;
    const int aoff = lds_byte(wr * 64 + fr, fq * 8), boff = lds_byte(wc * 32 + fr, fq * 8);
#define PG8_SA(b, h) (((b) * 2 + (h)) * HTB)
#define PG8_SB(b, h) ((4 + (b) * 2 + (h)) * HTB)
#define PG8_STAGE(bufoff, gbase, voff) do { _Pragma("unroll") for (int _i = 0; _i < 2; ++_i) \
        __builtin_amdgcn_global_load_lds((const unsigned*)((const char*)(gbase) + (voff)[_i]), (LAS unsigned*)(lds + (bufoff) + ldsw + _i * 8192), 16, 0, 0); } while (0)
#define PG8_LDA(dst, b, h) do { _Pragma("unroll") for (int m = 0; m < 4; ++m) _Pragma("unroll") for (int k = 0; k < 2; ++k) dst[m][k] = *(const LAS bf16x8*)(lds + PG8_SA(b, h) + aoff + m * 2048 + k * 1024); } while (0)
#define PG8_LDB(dst, b, h) do { _Pragma("unroll") for (int n = 0; n < 2; ++n) _Pragma("unroll") for (int k = 0; k < 2; ++k) dst[n][k] = *(const LAS bf16x8*)(lds + PG8_SB(b, h) + boff + n * 2048 + k * 1024); } while (0)
#define PG8_MMA(ai, bj, At, Bt) do { __builtin_amdgcn_s_setprio(1); _Pragma("unroll") for (int m = 0; m < 4; ++m) _Pragma("unroll") for (int n = 0; n < 2; ++n) _Pragma("unroll") for (int k = 0; k < 2; ++k) \
        acc[ai][bj][m][n] = __builtin_amdgcn_mfma_f32_16x16x32_bf16(Bt[n][k], At[m][k], acc[ai][bj][m][n], 0, 0, 0); __builtin_amdgcn_s_setprio(0); } while (0)
#define PG8_WAIT_V(n) asm volatile("s_waitcnt vmcnt(" #n ")" ::: "memory")
#define PG8_WAIT_L(n) asm volatile("s_waitcnt lgkmcnt(" #n ")" ::: "memory")
#define PG8_BAR __builtin_amdgcn_s_barrier()
#define PG8_SCHED __builtin_amdgcn_sched_barrier(0)
    Unit cur, nxt; int ui = 0;
    if (!S.next(0, cur)) return;
    f32x4 acc[2][2][4][2];
#pragma unroll
    for (int a = 0; a < 2; ++a)
#pragma unroll
        for (int b = 0; b < 2; ++b)
#pragma unroll
            for (int m = 0; m < 4; ++m)
#pragma unroll
                for (int n = 0; n < 2; ++n) acc[a][b][m][n] = (f32x4){0.f, 0.f, 0.f, 0.f};
    bf16x8 At[4][2], B0[2][2], B1[2][2];
    const char* cA = (const char*)g.A + (size_t)cur.pm * tstA; const char* cB = (const char*)g.Bt + (size_t)cur.pn * tstB;
    if constexpr (SP2) {
        PG8_STAGE(PG8_SB(0, 0), cB, voffB); PG8_STAGE(PG8_SB(0, 1), cB + hstB, voffB); PG8_STAGE(PG8_SA(0, 0), cA, voffA); PG8_STAGE(PG8_SA(0, 1), cA + hstA, voffA);
        if (wr == 1) PG8_BAR;
        PG8_WAIT_V(2); PG8_BAR;
        PG8_STAGE(PG8_SB(1, 0), cB + kstep, voffB); PG8_STAGE(PG8_SA(1, 0), cA + kstep, voffA); PG8_STAGE(PG8_SB(1, 1), cB + hstB + kstep, voffB);
        PG8_WAIT_V(6); PG8_BAR;
    } else {
    PG8_STAGE(PG8_SB(0, 0), cB, voffB); PG8_STAGE(PG8_SA(0, 0), cA, voffA); PG8_STAGE(PG8_SB(0, 1), cB + hstB, voffB); PG8_STAGE(PG8_SA(0, 1), cA + hstA, voffA);
    if (wr == 1) PG8_BAR;
    PG8_WAIT_V(4); PG8_BAR;
    PG8_STAGE(PG8_SB(1, 0), cB + kstep, voffB); PG8_STAGE(PG8_SA(1, 0), cA + kstep, voffA); PG8_STAGE(PG8_SB(1, 1), cB + hstB + kstep, voffB);
    PG8_WAIT_V(6); PG8_BAR;
    }
    for (;;) {
        const bool has_next = S.next(ui + 1, nxt);
        const char* nA = has_next ? (const char*)g.A + (size_t)nxt.pm * tstA : cA; const char* nB = has_next ? (const char*)g.Bt + (size_t)nxt.pn * tstB : cB;
        for (int t = 0; t < nt; t += 2) {
            const bool last = (t == nt - 2);
            const char* a1 = cA + (size_t)(t + 1) * kstep;
            const char* a2 = last ? nA : cA + (size_t)(t + 2) * kstep; const char* b2 = last ? nB : cB + (size_t)(t + 2) * kstep;
            const char* a3 = a2 + kstep; const char* b3 = b2 + kstep;
            if constexpr (SP2) {
            PG8_LDB(B0, 0, 0); PG8_LDB(B1, 0, 1); PG8_SCHED; PG8_LDA(At, 0, 0); PG8_STAGE(PG8_SA(1, 1), a1 + hstA, voffA);
            PG8_WAIT_V(8); PG8_WAIT_L(0); PG8_BAR; PG8_MMA(0, 0, At, B0); PG8_MMA(0, 1, At, B1); PG8_BAR; PG8_SCHED;
            PG8_LDA(At, 0, 1); PG8_STAGE(PG8_SB(0, 0), b2, voffB); PG8_STAGE(PG8_SB(0, 1), b2 + hstB, voffB); PG8_STAGE(PG8_SA(0, 0), a2, voffA);
            PG8_WAIT_V(8); PG8_WAIT_L(0); PG8_BAR; PG8_MMA(1, 0, At, B0); PG8_MMA(1, 1, At, B1); PG8_BAR; PG8_SCHED;
            PG8_LDB(B0, 1, 0); PG8_LDB(B1, 1, 1); PG8_SCHED; PG8_LDA(At, 1, 0); PG8_STAGE(PG8_SA(0, 1), a2 + hstA, voffA);
            PG8_WAIT_V(8); PG8_WAIT_L(0); PG8_BAR; PG8_MMA(0, 0, At, B0); PG8_MMA(0, 1, At, B1); PG8_BAR; PG8_SCHED;
            PG8_LDA(At, 1, 1); PG8_STAGE(PG8_SB(1, 0), b3, voffB); PG8_STAGE(PG8_SB(1, 1), b3 + hstB, voffB); PG8_STAGE(PG8_SA(1, 0), a3, voffA);
            PG8_WAIT_V(8); PG8_WAIT_L(0); PG8_BAR; PG8_MMA(1, 0, At, B0); PG8_MMA(1, 1, At, B1); PG8_BAR; PG8_SCHED;
            } else {
            PG8_LDB(B0, 0, 0); PG8_SCHED; PG8_LDA(At, 0, 0); PG8_STAGE(PG8_SA(1, 1), a1 + hstA, voffA);
            PG8_WAIT_L(8); PG8_BAR; PG8_WAIT_L(0); PG8_MMA(0, 0, At, B0); PG8_BAR; PG8_SCHED;
            PG8_LDB(B1, 0, 1); PG8_STAGE(PG8_SB(0, 0), b2, voffB);
            PG8_BAR; PG8_WAIT_L(0); PG8_MMA(0, 1, At, B1); PG8_BAR;
            PG8_LDA(At, 0, 1); PG8_STAGE(PG8_SA(0, 0), a2, voffA);
            PG8_BAR; PG8_WAIT_L(0); PG8_MMA(1, 0, At, B0); PG8_BAR; PG8_SCHED;
            PG8_STAGE(PG8_SB(0, 1), b2 + hstB, voffB);
            PG8_WAIT_V(6); PG8_BAR; PG8_MMA(1, 1, At, B1); PG8_BAR;
            PG8_LDB(B0, 1, 0); PG8_SCHED; PG8_LDA(At, 1, 0); PG8_STAGE(PG8_SA(0, 1), a2 + hstA, voffA);
            PG8_WAIT_L(8); PG8_BAR; PG8_WAIT_L(0); PG8_MMA(0, 0, At, B0); PG8_BAR; PG8_SCHED;
            PG8_LDB(B1, 1, 1); PG8_STAGE(PG8_SB(1, 0), b3, voffB);
            PG8_BAR; PG8_WAIT_L(0); PG8_MMA(0, 1, At, B1); PG8_BAR;
            PG8_LDA(At, 1, 1); PG8_STAGE(PG8_SA(1, 0), a3, voffA);
            PG8_BAR; PG8_WAIT_L(0); PG8_MMA(1, 0, At, B0); PG8_BAR; PG8_SCHED;
            PG8_STAGE(PG8_SB(1, 1), b3 + hstB, voffB);
            PG8_WAIT_V(6); PG8_BAR; PG8_MMA(1, 1, At, B1); PG8_BAR;
            }
        }
        if constexpr (ALIGN_EPI) { if (wr == 0) PG8_BAR; }
        E(acc, cur, wr, wc, fr, fq);
        if (!has_next) break;
#pragma unroll
        for (int a = 0; a < 2; ++a)
#pragma unroll
            for (int b = 0; b < 2; ++b)
#pragma unroll
                for (int m = 0; m < 4; ++m)
#pragma unroll
                    for (int n = 0; n < 2; ++n) acc[a][b][m][n] = (f32x4){0.f, 0.f, 0.f, 0.f};
        cur = nxt; cA = nA; cB = nB; ++ui;
        if constexpr (ALIGN_EPI) { if (wr == 1) PG8_BAR; }
    }
    PG8_WAIT_V(0);
    if constexpr (!ALIGN_EPI) { if (wr == 0) PG8_BAR; }
    PG8_BAR;
#undef PG8_SA
#undef PG8_SB
#undef PG8_STAGE
#undef PG8_LDA
#undef PG8_LDB
#undef PG8_MMA
#undef PG8_WAIT_V
#undef PG8_WAIT_L
#undef PG8_BAR
#undef PG8_SCHED
}
}

typedef f32x4 AccT[2][2][4][2];

struct EpiGU {
    const float* ssq; bf16_t* O;
    __device__ __forceinline__ void operator()(const AccT& acc, const pg8::Unit& u, int wr, int wc, int fr, int fq) const {
        const int row0 = u.pm * 256 + wr * 64 + fr, col0 = u.pn * 128 + wc * 32 + 8 * fq;
        float rs[2][4];
#pragma unroll
        for (int ai = 0; ai < 2; ++ai)
#pragma unroll
            for (int m = 0; m < 4; ++m) rs[ai][m] = ssq[row0 + ai * 128 + m * 16];
        __builtin_amdgcn_sched_barrier(0);
#pragma unroll
        for (int ai = 0; ai < 2; ++ai)
#pragma unroll
            for (int m = 0; m < 4; ++m) {
                const int row = row0 + ai * 128 + m * 16;
                const float rstd = rsqrtf(rs[ai][m] * (1.f / D) + EPS);
                float v[8];
#pragma unroll
                for (int n = 0; n < 2; ++n)
#pragma unroll
                    for (int j = 0; j < 4; ++j) { const float gg = acc[ai][0][m][n][j] * rstd, uu = acc[ai][1][m][n][j] * rstd; v[4 * n + j] = siluf_(gg) * uu; }
                u32x4 w; w.x = cvt_pk_bf16(v[0], v[1]); w.y = cvt_pk_bf16(v[2], v[3]); w.z = cvt_pk_bf16(v[4], v[5]); w.w = cvt_pk_bf16(v[6], v[7]);
                *(u32x4*)(O + (size_t)row * DFF + col0) = w;
            }
    }
};
struct EpiRes {
    const float* xin; float* xout; bf16_t* xb; float* ssq; float alpha;
    __device__ __forceinline__ void operator()(const AccT& acc, const pg8::Unit& u, int wr, int wc, int fr, int fq) const {
        const int row0 = u.pm * 256 + wr * 64 + fr, col0 = u.pn * 256 + wc * 32 + 8 * fq;
#pragma unroll
        for (int ai = 0; ai < 2; ++ai) {
            f32x4 xv[4][2][2];
#pragma unroll
            for (int m = 0; m < 4; ++m)
#pragma unroll
                for (int bj = 0; bj < 2; ++bj) { const size_t o = (size_t)(row0 + ai * 128 + m * 16) * D + col0 + bj * 128; xv[m][bj][0] = *(const f32x4*)(xin + o); xv[m][bj][1] = *(const f32x4*)(xin + o + 4); }
            __builtin_amdgcn_sched_barrier(0);
#pragma unroll
            for (int m = 0; m < 4; ++m) {
                const int row = row0 + ai * 128 + m * 16;
                float s = 0.f;
#pragma unroll
                for (int bj = 0; bj < 2; ++bj) {
                    const size_t o = (size_t)row * D + col0 + bj * 128;
                    const f32x4 y0 = xv[m][bj][0] + acc[ai][bj][m][0] * alpha, y1 = xv[m][bj][1] + acc[ai][bj][m][1] * alpha;
                    *(f32x4*)(xout + o) = y0; *(f32x4*)(xout + o + 4) = y1;
                    s += y0.x * y0.x + y0.y * y0.y + y0.z * y0.z + y0.w * y0.w + y1.x * y1.x + y1.y * y1.y + y1.z * y1.z + y1.w * y1.w;
                    if (xb) { u32x4 w; w.x = cvt_pk_bf16(y0.x, y0.y); w.y = cvt_pk_bf16(y0.z, y0.w); w.z = cvt_pk_bf16(y1.x, y1.y); w.w = cvt_pk_bf16(y1.z, y1.w); *(u32x4*)(xb + o) = w; }
                }
                s += __shfl_xor(s, 16); s += __shfl_xor(s, 32);
                if (fq == 0) atomicAdd(ssq + row, s);
            }
        }
    }
};
struct EpiIn {
    const float* ssq; unsigned char* T; bf16_t* halo; float* sm;
    __device__ __forceinline__ void operator()(const AccT& acc, const pg8::Unit& u, int wr, int wc, int fr, int fq) const {
        const int pn = u.pn;
        const int row0 = u.pm * 256 + wr * 64 + fr;
        float rs[2][4];
#pragma unroll
        for (int ai = 0; ai < 2; ++ai)
#pragma unroll
            for (int m = 0; m < 4; ++m) rs[ai][m] = ssq[row0 + ai * 128 + m * 16];
        __builtin_amdgcn_sched_barrier(0);
        int act = 0, ld, ct; bf16_t* base;
        if (pn < 2) { base = (bf16_t*)(T + T_Q); ld = 512; ct = pn; }
        else if (pn < 4) { base = (bf16_t*)(T + T_K); ld = 512; ct = pn - 2; }
        else if (pn < 8) { base = (bf16_t*)(T + T_V); ld = 1024; ct = pn - 4; }
        else if (pn < 12) { base = (bf16_t*)(T + T_SG); ld = 1024; ct = pn - 8; act = 1; }
        else if (pn < 20) { base = (bf16_t*)(T + T_SZ); ld = 2048; ct = pn - 12; act = 1; }
        else if (pn < 36) { base = (bf16_t*)(T + T_XBC); ld = 4096; ct = pn - 20; act = 3; }
        else if (pn < 44) { base = (bf16_t*)(T + T_GT); ld = 2048; ct = pn - 36; act = 2; }
        else { base = nullptr; ld = 0; ct = 0; act = 4; }
        if (act == 4) {
            if (wc < 2) {
#pragma unroll
                for (int ai = 0; ai < 2; ++ai)
#pragma unroll
                    for (int m = 0; m < 4; ++m) {
                        const int row = row0 + ai * 128 + m * 16;
                        const float rstd = rsqrtf(rs[ai][m] * (1.f / D) + EPS);
                        float* p = sm + (size_t)row * 64 + wc * 32 + 8 * fq;
                        *(f32x4*)p = acc[ai][0][m][0] * rstd; *(f32x4*)(p + 4) = acc[ai][0][m][1] * rstd;
                    }
            }
            return;
        }
        const int col0 = ct * 256 + wc * 32 + 8 * fq;
#pragma unroll
        for (int ai = 0; ai < 2; ++ai)
#pragma unroll
            for (int m = 0; m < 4; ++m) {
                const int row = row0 + ai * 128 + m * 16;
                const float rstd = rsqrtf(rs[ai][m] * (1.f / D) + EPS);
#pragma unroll
                for (int bj = 0; bj < 2; ++bj) {
                    float v[8];
#pragma unroll
                    for (int n = 0; n < 2; ++n)
#pragma unroll
                        for (int j = 0; j < 4; ++j) { float x = acc[ai][bj][m][n][j] * rstd; if (act == 1) x = siluf_(x); else if (act == 2) x = sigmoidf_(x); v[4 * n + j] = x; }
                    u32x4 w; w.x = cvt_pk_bf16(v[0], v[1]); w.y = cvt_pk_bf16(v[2], v[3]); w.z = cvt_pk_bf16(v[4], v[5]); w.w = cvt_pk_bf16(v[6], v[7]);
                    *(u32x4*)(base + (size_t)row * ld + col0 + bj * 128) = w;
                    if (act == 3 && (row & 63) >= 61) *(u32x4*)(halo + ((size_t)(row >> 6) * 3 + ((row & 63) - 61)) * 4096 + col0 + bj * 128) = w;
                }
            }
    }
};
struct EpiGate {
    const bf16_t* gt; const bf16_t* t1; bf16_t* out; int mode;
    __device__ __forceinline__ void operator()(const AccT& acc, const pg8::Unit& u, int wr, int wc, int fr, int fq) const {
        const int row0 = u.pm * 256 + wr * 64 + fr, col0 = u.pn * 256 + wc * 32 + 8 * fq;
#pragma unroll
        for (int ai = 0; ai < 2; ++ai) {
            u32x4 gq[4][2], tq[4][2];
#pragma unroll
            for (int m = 0; m < 4; ++m)
#pragma unroll
                for (int bj = 0; bj < 2; ++bj) { const int row = row0 + ai * 128 + m * 16, col = col0 + bj * 128;
                    gq[m][bj] = *(const u32x4*)(gt + (size_t)row * 2048 + mode * 1024 + col);
                    tq[m][bj] = mode ? *(const u32x4*)(t1 + (size_t)row * D + col) : (u32x4){0u, 0u, 0u, 0u}; }
            __builtin_amdgcn_sched_barrier(0);
#pragma unroll
            for (int m = 0; m < 4; ++m)
#pragma unroll
                for (int bj = 0; bj < 2; ++bj) {
                    const int row = row0 + ai * 128 + m * 16, col = col0 + bj * 128;
                    const u32x4 g4 = gq[m][bj], t4 = tq[m][bj];
                    float v[8];
                    v[0] = acc[ai][bj][m][0].x * bf_lo(g4.x); v[1] = acc[ai][bj][m][0].y * bf_hi(g4.x); v[2] = acc[ai][bj][m][0].z * bf_lo(g4.y); v[3] = acc[ai][bj][m][0].w * bf_hi(g4.y);
                    v[4] = acc[ai][bj][m][1].x * bf_lo(g4.z); v[5] = acc[ai][bj][m][1].y * bf_hi(g4.z); v[6] = acc[ai][bj][m][1].z * bf_lo(g4.w); v[7] = acc[ai][bj][m][1].w * bf_hi(g4.w);
                    if (mode) { v[0] += bf_lo(t4.x); v[1] += bf_hi(t4.x); v[2] += bf_lo(t4.y); v[3] += bf_hi(t4.y); v[4] += bf_lo(t4.z); v[5] += bf_hi(t4.z); v[6] += bf_lo(t4.w); v[7] += bf_hi(t4.w); }
                    u32x4 w; w.x = cvt_pk_bf16(v[0], v[1]); w.y = cvt_pk_bf16(v[2], v[3]); w.z = cvt_pk_bf16(v[4], v[5]); w.w = cvt_pk_bf16(v[6], v[7]);
                    *(u32x4*)(out + (size_t)row * D + col) = w;
                }
        }
    }
};

__device__ __forceinline__ void tr_item(const float* srcp, int ld, const float* sk, float mul, int k0, int K, bf16_t* dst, int n0, LAS float* scr, int lane) {
#pragma unroll 8
    for (int i = 0; i < 32; ++i) { const int kk = 2 * i + (lane >> 5);
        float v = 0.f; if (srcp) v = srcp[(size_t)(k0 + kk) * ld] * (sk ? sk[k0 + kk] : 1.f) * mul;
        scr[kk * 33 + (lane & 31)] = v; }
    asm volatile("s_waitcnt lgkmcnt(0)" ::: "memory");
    const int c = lane & 7;
#pragma unroll
    for (int j = 0; j < 4; ++j) { const int n = (lane >> 3) + 8 * j; const LAS float* s = scr + (8 * c) * 33 + n;
        u32x4 o; o.x = cvt_pk_bf16(s[0 * 33], s[1 * 33]); o.y = cvt_pk_bf16(s[2 * 33], s[3 * 33]); o.z = cvt_pk_bf16(s[4 * 33], s[5 * 33]); o.w = cvt_pk_bf16(s[6 * 33], s[7 * 33]);
        *(u32x4*)(dst + (size_t)(n0 + n) * K + k0 + 8 * c) = o; }
    asm volatile("s_waitcnt lgkmcnt(0)" ::: "memory");
}
__device__ __forceinline__ int win_src_col(int nd) {
    if (nd < 3072) return nd;
    if (nd < 5120) return 3088 + (nd - 3072);
    if (nd < 9216) return 5136 + (nd - 5120);
    if (nd < 11264) return 9264 + (nd - 9216);
    if (nd < 11280) return 3072 + (nd - 11264);
    if (nd < 11312) return 9232 + (nd - 11280);
    return -1;
}

struct Params {
    const float* in[24];
    float* out;
    unsigned char* ws;
};

typedef __attribute__((address_space(4))) const Params* KP;
__device__ __forceinline__ Params load_params(KP p) { Params r;
#pragma unroll
    for (int i = 0; i < 24; ++i) r.in[i] = p->in[i];
    r.out = p->out; r.ws = p->ws; return r; }
__device__ __forceinline__ int tid_fresh() { int t = threadIdx.x; asm volatile("" : "+v"(t)); return t; }
__device__ __forceinline__ void p0_prologue(KP Pp, LAS unsigned char* lds, int G) {
    const Params P = load_params(Pp);
    const int tid = tid_fresh(), lane = tid & 63, wave = tid >> 6;
    LAS float* scr = (LAS float*)(lds + wave * 16384);
    const int gw = blockIdx.x * 8 + wave, NGW = G * 8;
    unsigned char* ws = P.ws;
    constexpr int I_GU = (D / 64) * (NGU / 32), I_DN = (DFF / 64) * (D / 32), I_IN = (D / 64) * (NIN / 32), I_GO = (D / 64) * (D / 32), I_SO = (2048 / 64) * (D / 32);
    constexpr int NITEMS = 2 * I_GU + 2 * I_DN + I_IN + 2 * I_GO + I_SO;
    for (int it = gw; it < NITEMS; it += NGW) {
        int r = it; const int j = lane & 31;
        if (r < 2 * I_GU) { const int l2 = r >= I_GU; r -= l2 * I_GU; const int nb = r % (NGU / 32), kb = r / (NGU / 32); const int nd = nb * 32 + j, tile = nd >> 8, w = nd & 255;
            const float* Wg = P.in[l2 ? 20 : 2]; const float* Wu = P.in[l2 ? 21 : 3];
            const float* sp = (w < 128 ? Wg : Wu) + 128 * tile + (w & 127);
            tr_item(sp, DFF, P.in[l2 ? 19 : 1], 1.f, kb * 64, D, (bf16_t*)(ws + (l2 ? WS_WGU2 : WS_WGU1)), nb * 32, scr, lane); continue; }
        r -= 2 * I_GU;
        if (r < 2 * I_DN) { const int l2 = r >= I_DN; r -= l2 * I_DN; const int nb = r % (D / 32), kb = r / (D / 32);
            tr_item(P.in[l2 ? 22 : 4] + nb * 32 + j, D, nullptr, 1.f, kb * 64, DFF, (bf16_t*)(ws + (l2 ? WS_WD2 : WS_WD1)), nb * 32, scr, lane); continue; }
        r -= 2 * I_DN;
        if (r < I_IN) { const int nb = r % (NIN / 32), kb = r / (NIN / 32); const int nd = nb * 32 + j, sc = win_src_col(nd);
            tr_item(sc >= 0 ? P.in[6] + sc : nullptr, IN_DIM, P.in[5], nd < 512 ? 0.08838834764831845f : 1.f, kb * 64, D, (bf16_t*)(ws + WS_WIN), nb * 32, scr, lane); continue; }
        r -= I_IN;
        if (r < 2 * I_GO) { const int l2 = r >= I_GO; r -= l2 * I_GO; const int nb = r % (D / 32), kb = r / (D / 32);
            tr_item(P.in[l2 ? 18 : 10] + nb * 32 + j, D, nullptr, 1.f, kb * 64, D, (bf16_t*)(ws + (l2 ? WS_WOUT : WS_WGO)), nb * 32, scr, lane); continue; }
        r -= 2 * I_GO;
        { const int nb = r % (D / 32), kb = r / (D / 32);
            tr_item(P.in[17] + nb * 32 + j, D, nullptr, 1.f, kb * 64, 2048, (bf16_t*)(ws + WS_WSO), nb * 32, scr, lane); }
    }
    const float* x = P.in[0]; bf16_t* xb = (bf16_t*)(ws + WS_XB); float* ssq = (float*)(ws + WS_SSQ);
    for (int m = gw; m < MTOK; m += NGW) {
        const f32x4* xr = (const f32x4*)(x + (size_t)m * D) + lane;
        unsigned long long* o8 = (unsigned long long*)(xb + (size_t)m * D) + lane;
        float s = 0.f;
#pragma unroll
        for (int jj = 0; jj < 4; ++jj) { const f32x4 v = xr[64 * jj]; s += v.x * v.x + v.y * v.y + v.z * v.z + v.w * v.w;
            o8[64 * jj] = (unsigned long long)cvt_pk_bf16(v.x, v.y) | ((unsigned long long)cvt_pk_bf16(v.z, v.w) << 32); }
        s = wave_sum(s);
        if (lane == 0) { ssq[m] = s; ssq[MTOK + m] = 0.f; ssq[2 * MTOK + m] = 0.f; ssq[3 * MTOK + m] = 0.f; }
    }
}

__device__ __forceinline__ void p4_prep(KP Pp, LAS unsigned char* lds, int G) {
    const Params P = load_params(Pp);
    const int tid = tid_fresh();
    unsigned char* ws = P.ws; unsigned char* T = ws + WS_BIG;
    const float* sm = (const float*)(ws + WS_SM);
    for (int it = blockIdx.x; it < HB * NCH; it += G) {
        const int row0 = it * 64;
#pragma unroll
        for (int i = 0; i < 2; ++i) { const int idx = tid + 512 * i; *(LAS f32x4*)(lds + idx * 16) = *(const f32x4*)(sm + (size_t)row0 * 64 + idx * 4); }
        __syncthreads();
        {
            const int hc = tid;
            const float* wf = P.in[7]; float w[16];
#pragma unroll
            for (int j = 0; j < 16; ++j) w[j] = wf[j * 512 + hc];
            const float bfv = P.in[8][hc];
            float cum = 0.f;
#pragma unroll 4
            for (int t = 0; t < 64; ++t) { float z = bfv;
#pragma unroll
                for (int j4 = 0; j4 < 4; ++j4) { const f32x4 f = *(const LAS f32x4*)(lds + t * 256 + j4 * 16); z += f.x * w[4 * j4] + f.y * w[4 * j4 + 1] + f.z * w[4 * j4 + 2] + f.w * w[4 * j4 + 3]; }
                cum += (fminf(z, 0.f) - __logf(1.f + __expf(-fabsf(z)))) * (1.f / 16.f); }
            const float end = cum; cum = 0.f;
            bf16_t* kp = (bf16_t*)(T + T_K) + (size_t)row0 * 512 + hc;
            for (int tb = 0; tb < 4; ++tb) {
                bf16_t kk[16];
#pragma unroll
                for (int u = 0; u < 16; ++u) kk[u] = kp[(size_t)(tb * 16 + u) * 512];
#pragma unroll
                for (int u = 0; u < 16; ++u) { const int t = tb * 16 + u; float z = bfv;
#pragma unroll
                    for (int j4 = 0; j4 < 4; ++j4) { const f32x4 f = *(const LAS f32x4*)(lds + t * 256 + j4 * 16); z += f.x * w[4 * j4] + f.y * w[4 * j4 + 1] + f.z * w[4 * j4 + 2] + f.w * w[4 * j4 + 3]; }
                    cum += (fminf(z, 0.f) - __logf(1.f + __expf(-fabsf(z)))) * (1.f / 16.f);
                    const float kv = __uint_as_float((unsigned)kk[u] << 16) * __expf(end - cum);
                    kp[(size_t)t * 512] = (bf16_t)(cvt_pk_bf16(kv, 0.f) & 0xffffu); }
            }
            ((float*)(ws + WS_DEC))[(size_t)it * 512 + hc] = __expf(end);
        }
        if (tid < 32) {
            const float bias = P.in[13][tid], A = -__expf(P.in[14][tid]);
            float cum = 0.f;
#pragma unroll 4
            for (int t = 0; t < 64; ++t) cum += softplusf_(*(const LAS float*)(lds + t * 256 + (16 + tid) * 4) + bias) * A;
            const float end = cum; cum = 0.f;
            float* wg = (float*)(ws + WS_WG);
#pragma unroll 4
            for (int t = 0; t < 64; ++t) { const float dt = softplusf_(*(const LAS float*)(lds + t * 256 + (16 + tid) * 4) + bias); cum += dt * A; wg[(size_t)(row0 + t) * 32 + tid] = __expf(end - cum) * dt; }
            ((float*)(ws + WS_DECS))[it * 32 + tid] = __expf(end);
        }
        __syncthreads();
    }
    const int co = tid & 63, rg = tid >> 6;
    u32x4 raw[11];
#define CONV_LOAD(itx) do { const int _ci = (itx) >> 3, _col = ((itx) & 7) * 512 + co * 8; \
        const bf16_t* _xp = (const bf16_t*)(T + T_XBC) + (size_t)(_ci * 64 + rg * 8) * 4096 + _col; \
        _Pragma("unroll") for (int i = 0; i < 8; ++i) raw[3 + i] = *(const u32x4*)(_xp + (size_t)i * 4096); \
        if (rg > 0) { _Pragma("unroll") for (int i = 0; i < 3; ++i) raw[i] = *(const u32x4*)(_xp - (size_t)(3 - i) * 4096); } \
        else if ((_ci & (NCH - 1)) != 0) { const bf16_t* _hp = (const bf16_t*)(ws + WS_HALO) + (size_t)(_ci - 1) * 3 * 4096 + _col; \
            _Pragma("unroll") for (int i = 0; i < 3; ++i) raw[i] = *(const u32x4*)(_hp + (size_t)i * 4096); } \
        else { _Pragma("unroll") for (int i = 0; i < 3; ++i) raw[i] = (u32x4){0u, 0u, 0u, 0u}; } } while (0)
    if ((int)blockIdx.x < HB * NCH * 8) CONV_LOAD((int)blockIdx.x);
    for (int it = blockIdx.x; it < HB * NCH * 8; it += G) {
        const int ci = it >> 3, cb = it & 7, col = cb * 512 + co * 8, row0 = ci * 64 + rg * 8;
        bf16_t* xp = (bf16_t*)(T + T_XBC) + (size_t)row0 * 4096 + col;
        float cw[4][8], cbv[8];
#pragma unroll
        for (int k = 0; k < 4; ++k) { const f32x4 a = *(const f32x4*)(P.in[11] + k * 4096 + col), b = *(const f32x4*)(P.in[11] + k * 4096 + col + 4);
            cw[k][0] = a.x; cw[k][1] = a.y; cw[k][2] = a.z; cw[k][3] = a.w; cw[k][4] = b.x; cw[k][5] = b.y; cw[k][6] = b.z; cw[k][7] = b.w; }
        { const f32x4 a = *(const f32x4*)(P.in[12] + col), b = *(const f32x4*)(P.in[12] + col + 4);
            cbv[0] = a.x; cbv[1] = a.y; cbv[2] = a.z; cbv[3] = a.w; cbv[4] = b.x; cbv[5] = b.y; cbv[6] = b.z; cbv[7] = b.w; }
        asm volatile("s_waitcnt vmcnt(0)" ::: "memory");
        __syncthreads();
        u32x4 outv[8];
#pragma unroll
        for (int i = 0; i < 8; ++i) {
            float v[8];
#pragma unroll
            for (int e = 0; e < 8; ++e) v[e] = cbv[e];
#pragma unroll
            for (int k = 0; k < 4; ++k) { const u32x4 q = raw[i + k];
                v[0] += cw[k][0] * bf_lo(q.x); v[1] += cw[k][1] * bf_hi(q.x); v[2] += cw[k][2] * bf_lo(q.y); v[3] += cw[k][3] * bf_hi(q.y);
                v[4] += cw[k][4] * bf_lo(q.z); v[5] += cw[k][5] * bf_hi(q.z); v[6] += cw[k][6] * bf_lo(q.w); v[7] += cw[k][7] * bf_hi(q.w); }
#pragma unroll
            for (int e = 0; e < 8; ++e) v[e] = siluf_(v[e]);
            outv[i].x = cvt_pk_bf16(v[0], v[1]); outv[i].y = cvt_pk_bf16(v[2], v[3]); outv[i].z = cvt_pk_bf16(v[4], v[5]); outv[i].w = cvt_pk_bf16(v[6], v[7]);
        }
        if (it + G < HB * NCH * 8) CONV_LOAD(it + G);
#pragma unroll
        for (int i = 0; i < 8; ++i) *(u32x4*)(xp + (size_t)i * 4096) = outv[i];
    }
#undef CONV_LOAD
}

struct MixArgs {
    const bf16_t* ak; int ld_ak;
    const bf16_t* qq; int ld_q;
    const bf16_t* bv; int ld_bv;
    const bf16_t* gt; int ld_g;
    bf16_t* out; int ld_o;
    const float* dec;
    const float* wg;
    const float* nw;
    const float* dsk;
};
constexpr int RSA = 320, RSB = 576, RSQ = 264, RSG = 520;
constexpr int OFF_AK = 0, OFF_BV = 64 * RSA, OFF_QQ = OFF_BV + 64 * RSB, OFF_WGT = OFF_QQ + 64 * RSQ, OFF_DEC = OFF_WGT + 1024, OFF_RED = OFF_DEC + 512, OFF_NW = OFF_RED + 2048, OFF_GT = OFF_NW + 1024;
static_assert(OFF_GT + 64 * RSG <= LDS_MAIN, "mixer LDS");

#define LBAR() do { asm volatile("s_waitcnt lgkmcnt(0)" ::: "memory"); __builtin_amdgcn_s_barrier(); asm volatile("" ::: "memory"); } while (0)
template <bool SSD>
__device__ __forceinline__ void mixer_item(LAS unsigned char* lds, const MixArgs& a) {
    const int tid = tid_fresh(), lane = tid & 63, w = __builtin_amdgcn_readfirstlane(tid >> 6);
    const int r = lane & 31, h = lane >> 5, gg = lane >> 4, q = (lane & 15) >> 2, p = lane & 3;
    const int arow0 = tid >> 4, apc = tid & 15;
    const int brow0 = tid >> 5, bpc = tid & 31;
    u32x4 stA[2], stQ[2], stB[4], stG[4], stW, stD;
    stW = (u32x4){0u, 0u, 0u, 0u}; stD = stW;
#define MIX_LOAD(c) do { const size_t _r0 = (size_t)(c) * 64; \
        _Pragma("unroll") for (int i = 0; i < 2; ++i) { stA[i] = *(const u32x4*)(a.ak + (_r0 + arow0 + 32 * i) * a.ld_ak + apc * 8); stQ[i] = *(const u32x4*)(a.qq + (_r0 + arow0 + 32 * i) * a.ld_q + apc * 8); } \
        _Pragma("unroll") for (int i = 0; i < 4; ++i) { stB[i] = *(const u32x4*)(a.bv + (_r0 + brow0 + 16 * i) * a.ld_bv + bpc * 8); stG[i] = *(const u32x4*)(a.gt + (_r0 + brow0 + 16 * i) * a.ld_g + bpc * 8); } \
        if (SSD) { if (tid < 64) stW = *(const u32x4*)(a.wg + (_r0 + tid) * 32); } \
        else { if (tid < 32) stD = *(const u32x4*)(a.dec + (size_t)(c) * 512 + tid * 4); } } while (0)
#define MIX_STORE() do { \
        _Pragma("unroll") for (int i = 0; i < 2; ++i) { *(LAS u32x4*)(lds + OFF_AK + (arow0 + 32 * i) * RSA + apc * 16) = stA[i]; \
            *(LAS u32x2*)(lds + OFF_QQ + (arow0 + 32 * i) * RSQ + apc * 16) = (u32x2){stQ[i].x, stQ[i].y}; *(LAS u32x2*)(lds + OFF_QQ + (arow0 + 32 * i) * RSQ + apc * 16 + 8) = (u32x2){stQ[i].z, stQ[i].w}; } \
        _Pragma("unroll") for (int i = 0; i < 4; ++i) { *(LAS u32x4*)(lds + OFF_BV + (brow0 + 16 * i) * RSB + bpc * 16) = stB[i]; \
            *(LAS u32x2*)(lds + OFF_GT + (brow0 + 16 * i) * RSG + bpc * 16) = (u32x2){stG[i].x, stG[i].y}; *(LAS u32x2*)(lds + OFF_GT + (brow0 + 16 * i) * RSG + bpc * 16 + 8) = (u32x2){stG[i].z, stG[i].w}; } \
        if (SSD) { if (tid < 64) { *(LAS unsigned*)(lds + OFF_WGT + tid * 4) = stW.x; *(LAS unsigned*)(lds + OFF_WGT + 256 + tid * 4) = stW.y; *(LAS unsigned*)(lds + OFF_WGT + 512 + tid * 4) = stW.z; *(LAS unsigned*)(lds + OFF_WGT + 768 + tid * 4) = stW.w; } } \
        else { if (tid < 32) *(LAS u32x4*)(lds + OFF_DEC + tid * 16) = stD; } } while (0)

    if (tid < 256) *(LAS float*)(lds + OFF_NW + tid * 4) = a.nw[tid];
    MIX_LOAD(0);
    MIX_STORE();
    __syncthreads();

    f32x16 S[4];
#pragma unroll
    for (int i = 0; i < 4; ++i)
#pragma unroll
        for (int e = 0; e < 16; ++e) S[i][e] = 0.f;

    const int trA = OFF_AK + (8 * h + q) * RSA + (16 * (gg & 1) + 4 * p) * 2;
    const int trB = OFF_BV + (8 * h + q) * RSB + (32 * w + 16 * (gg & 1) + 4 * p) * 2;
    const int qB = OFF_QQ + r * RSQ + 8 * h;
    const int gB = OFF_GT + r * RSG + (32 * w + 4 * h) * 2;
    const float dsk = SSD ? a.dsk[w >> 1] : 0.f;

    for (int c = 0; c < NCH; ++c) {
        if (c + 1 < NCH) MIX_LOAD(c + 1);
        if (SSD) {
            const float dc = a.dec[(size_t)c * 32 + (w >> 1)];
#pragma unroll
            for (int i = 0; i < 4; ++i)
#pragma unroll
                for (int e = 0; e < 16; ++e) S[i][e] *= dc;
        } else {
#pragma unroll
            for (int i = 0; i < 4; ++i)
#pragma unroll
                for (int g = 0; g < 4; ++g) { const f32x4 d4 = *(const LAS f32x4*)(lds + OFF_DEC + (32 * i + 8 * g + 4 * h) * 4);
                    S[i][4 * g + 0] *= d4.x; S[i][4 * g + 1] *= d4.y; S[i][4 * g + 2] *= d4.z; S[i][4 * g + 3] *= d4.w; }
        }
#define TRR(addr) __builtin_bit_cast(s16x4, __builtin_amdgcn_ds_read_tr16_b64_v4i16((LAS s16x4*)(lds + (addr))))
#define UPD_LOAD(s, B0, B1, A0, A1, W0, W1) do { B0 = TRR(trB + (16 * (s)) * RSB); B1 = TRR(trB + (16 * (s) + 4) * RSB); \
        _Pragma("unroll") for (int i = 0; i < 4; ++i) { A0[i] = TRR(trA + (16 * (s)) * RSA + 64 * i); A1[i] = TRR(trA + (16 * (s) + 4) * RSA + 64 * i); } \
        if (SSD) { W0 = *(const LAS f32x4*)(lds + OFF_WGT + (w >> 1) * 256 + (16 * (s) + 8 * h) * 4); W1 = *(const LAS f32x4*)(lds + OFF_WGT + (w >> 1) * 256 + (16 * (s) + 8 * h + 4) * 4); } } while (0)
#define UPD_MMA(B0, B1, A0, A1, W0, W1) do { bf16x8 bfr = __builtin_shufflevector(B0, B1, 0, 1, 2, 3, 4, 5, 6, 7); \
        if (SSD) { u32x4 bu = __builtin_bit_cast(u32x4, bfr); \
            bu.x = cvt_pk_bf16(bf_lo(bu.x) * W0.x, bf_hi(bu.x) * W0.y); bu.y = cvt_pk_bf16(bf_lo(bu.y) * W0.z, bf_hi(bu.y) * W0.w); \
            bu.z = cvt_pk_bf16(bf_lo(bu.z) * W1.x, bf_hi(bu.z) * W1.y); bu.w = cvt_pk_bf16(bf_lo(bu.w) * W1.z, bf_hi(bu.w) * W1.w); bfr = __builtin_bit_cast(bf16x8, bu); } \
        _Pragma("unroll") for (int i = 0; i < 4; ++i) S[i] = __builtin_amdgcn_mfma_f32_32x32x16_bf16(__builtin_shufflevector(A0[i], A1[i], 0, 1, 2, 3, 4, 5, 6, 7), bfr, S[i], 0, 0, 0); } while (0)
        {
            s16x4 xb0, xb1, xa0[4], xa1[4], yb0, yb1, ya0[4], ya1[4]; f32x4 xw0, xw1, yw0, yw1;
            xw0 = xw1 = yw0 = yw1 = (f32x4){0.f, 0.f, 0.f, 0.f};
            UPD_LOAD(0, xb0, xb1, xa0, xa1, xw0, xw1);
            UPD_LOAD(1, yb0, yb1, ya0, ya1, yw0, yw1);
            __builtin_amdgcn_sched_barrier(0);
            UPD_MMA(xb0, xb1, xa0, xa1, xw0, xw1);
            __builtin_amdgcn_sched_barrier(0);
            UPD_LOAD(2, xb0, xb1, xa0, xa1, xw0, xw1);
            __builtin_amdgcn_sched_barrier(0);
            UPD_MMA(yb0, yb1, ya0, ya1, yw0, yw1);
            __builtin_amdgcn_sched_barrier(0);
            UPD_LOAD(3, yb0, yb1, ya0, ya1, yw0, yw1);
            __builtin_amdgcn_sched_barrier(0);
            UPD_MMA(xb0, xb1, xa0, xa1, xw0, xw1);
            __builtin_amdgcn_sched_barrier(0);
            UPD_MMA(yb0, yb1, ya0, ya1, yw0, yw1);
        }
#undef UPD_LOAD
#undef UPD_MMA
        f32x16 OT[2];
#pragma unroll
        for (int j2 = 0; j2 < 2; ++j2)
#pragma unroll
            for (int e = 0; e < 16; ++e) OT[j2][e] = 0.f;
        {
            u32x2 qf[3][2][2];
#define Q_LOAD(sp, buf) do { _Pragma("unroll") for (int j2 = 0; j2 < 2; ++j2) { qf[buf][j2][0] = *(const LAS u32x2*)(lds + qB + 32 * j2 * RSQ + (16 * (sp)) * 2); qf[buf][j2][1] = *(const LAS u32x2*)(lds + qB + 32 * j2 * RSQ + (16 * (sp) + 8) * 2); } } while (0)
            Q_LOAD(0, 0); Q_LOAD(1, 1);
#pragma unroll
            for (int sp = 0; sp < 8; ++sp) {
                const int i = sp >> 1, o8 = 8 * (sp & 1);
                if (sp + 2 < 8) Q_LOAD(sp + 2, (sp + 2) % 3);
                u32x4 pk;
                pk.x = cvt_pk_bf16(S[i][o8 + 0], S[i][o8 + 1]); pk.y = cvt_pk_bf16(S[i][o8 + 2], S[i][o8 + 3]);
                pk.z = cvt_pk_bf16(S[i][o8 + 4], S[i][o8 + 5]); pk.w = cvt_pk_bf16(S[i][o8 + 6], S[i][o8 + 7]);
                const bf16x8 sfr = __builtin_bit_cast(bf16x8, pk);
                __builtin_amdgcn_sched_barrier(0);
#pragma unroll
                for (int j2 = 0; j2 < 2; ++j2) {
                    const bf16x8 qfr = __builtin_bit_cast(bf16x8, (u32x4){qf[sp % 3][j2][0].x, qf[sp % 3][j2][0].y, qf[sp % 3][j2][1].x, qf[sp % 3][j2][1].y});
                    OT[j2] = __builtin_amdgcn_mfma_f32_32x32x16_bf16(sfr, qfr, OT[j2], 0, 0, 0);
                }
                __builtin_amdgcn_sched_barrier(0);
            }
#undef Q_LOAD
        }
#undef TRR
        u32x2 gv[2][4];
#pragma unroll
        for (int j2 = 0; j2 < 2; ++j2)
#pragma unroll
            for (int g = 0; g < 4; ++g) gv[j2][g] = *(const LAS u32x2*)(lds + gB + 32 * j2 * RSG + 16 * g);
        float part[2] = {0.f, 0.f};
#pragma unroll
        for (int j2 = 0; j2 < 2; ++j2)
#pragma unroll
            for (int g = 0; g < 4; ++g) {
                if (SSD) {
                    const u32x2 xs = *(const LAS u32x2*)(lds + OFF_BV + (32 * j2 + r) * RSB + (32 * w + 8 * g + 4 * h) * 2);
                    OT[j2][4 * g + 0] = (OT[j2][4 * g + 0] + dsk * bf_lo(xs.x)) * bf_lo(gv[j2][g].x);
                    OT[j2][4 * g + 1] = (OT[j2][4 * g + 1] + dsk * bf_hi(xs.x)) * bf_hi(gv[j2][g].x);
                    OT[j2][4 * g + 2] = (OT[j2][4 * g + 2] + dsk * bf_lo(xs.y)) * bf_lo(gv[j2][g].y);
                    OT[j2][4 * g + 3] = (OT[j2][4 * g + 3] + dsk * bf_hi(xs.y)) * bf_hi(gv[j2][g].y);
                }
#pragma unroll
                for (int k = 0; k < 4; ++k) part[j2] += OT[j2][4 * g + k] * OT[j2][4 * g + k];
            }
        part[0] += __shfl_xor(part[0], 32); part[1] += __shfl_xor(part[1], 32);
        if (h == 0) { *(LAS float*)(lds + OFF_RED + (w * 64 + r) * 4) = part[0]; *(LAS float*)(lds + OFF_RED + (w * 64 + 32 + r) * 4) = part[1]; }
        LBAR();
#pragma unroll
        for (int j2 = 0; j2 < 2; ++j2) {
            float tot = 0.f;
#pragma unroll
            for (int ww = 0; ww < 8; ++ww) tot += *(const LAS float*)(lds + OFF_RED + (ww * 64 + 32 * j2 + r) * 4);
            const float rstd = rsqrtf(tot * (1.f / 256.f) + EPS);
#pragma unroll
            for (int g = 0; g < 4; ++g) {
                const f32x4 n4 = *(const LAS f32x4*)(lds + OFF_NW + (32 * w + 8 * g + 4 * h) * 4);
                float v0 = OT[j2][4 * g + 0] * rstd * n4.x, v1 = OT[j2][4 * g + 1] * rstd * n4.y, v2 = OT[j2][4 * g + 2] * rstd * n4.z, v3 = OT[j2][4 * g + 3] * rstd * n4.w;
                if (!SSD) { v0 *= bf_lo(gv[j2][g].x); v1 *= bf_hi(gv[j2][g].x); v2 *= bf_lo(gv[j2][g].y); v3 *= bf_hi(gv[j2][g].y); }
                *(LAS u32x2*)(lds + gB + 32 * j2 * RSG + 16 * g) = (u32x2){cvt_pk_bf16(v0, v1), cvt_pk_bf16(v2, v3)};
            }
        }
        LBAR();
#pragma unroll
        for (int i = 0; i < 4; ++i) {
            const u32x2 o0 = *(const LAS u32x2*)(lds + OFF_GT + (brow0 + 16 * i) * RSG + bpc * 16), o1 = *(const LAS u32x2*)(lds + OFF_GT + (brow0 + 16 * i) * RSG + bpc * 16 + 8);
            *(u32x4*)(a.out + ((size_t)c * 64 + brow0 + 16 * i) * a.ld_o + bpc * 8) = (u32x4){o0.x, o0.y, o1.x, o1.y};
        }
        if (c + 1 < NCH) MIX_STORE();
        LBAR();
    }
#undef MIX_LOAD
#undef MIX_STORE
}

__device__ __forceinline__ void p5_mixer(KP Pp, LAS unsigned char* lds, int G) {
    const Params P = load_params(Pp);
    unsigned char* ws = P.ws; unsigned char* T = ws + WS_BIG;
    for (int it = blockIdx.x; it < HB * 12; it += G) {
        const int b = it / 12, k = it % 12;
        const size_t row0 = (size_t)b * SEQ;
        MixArgs a;
        if (k < 4) {
            const int hd = k;
            a.ak = (const bf16_t*)(T + T_K) + row0 * 512 + hd * 128; a.ld_ak = 512;
            a.qq = (const bf16_t*)(T + T_Q) + row0 * 512 + hd * 128; a.ld_q = 512;
            a.bv = (const bf16_t*)(T + T_V) + row0 * 1024 + hd * 256; a.ld_bv = 1024;
            a.gt = (const bf16_t*)(T + T_SG) + row0 * 1024 + hd * 256; a.ld_g = 1024;
            a.out = (bf16_t*)(T + T_V) + row0 * 1024 + hd * 256; a.ld_o = 1024;
            a.dec = (const float*)(ws + WS_DEC) + (size_t)b * NCH * 512 + hd * 128;
            a.wg = nullptr; a.nw = P.in[9]; a.dsk = nullptr;
            mixer_item<false>(lds, a);
        } else {
            const int g = k - 4;
            const bf16_t* X = (const bf16_t*)(T + T_XBC) + row0 * 4096;
            a.ak = X + 2048 + g * 128; a.ld_ak = 4096;
            a.qq = X + 3072 + g * 128; a.ld_q = 4096;
            a.bv = X + g * 256; a.ld_bv = 4096;
            a.gt = (const bf16_t*)(T + T_SZ) + row0 * 2048 + g * 256; a.ld_g = 2048;
            a.out = (bf16_t*)(T + T_XBC) + row0 * 4096 + g * 256; a.ld_o = 4096;
            a.dec = (const float*)(ws + WS_DECS) + (size_t)b * NCH * 32 + g * 4;
            a.wg = (const float*)(ws + WS_WG) + row0 * 32 + g * 4;
            a.nw = P.in[16] + g * 256; a.dsk = P.in[15] + g * 4;
            mixer_item<true>(lds, a);
        }
        __syncthreads();
    }
}

__device__ __forceinline__ KP get_params() {
    KP p = (KP)__builtin_amdgcn_kernarg_segment_ptr(); asm volatile("" : "+s"(p)); return p;
}

#define XB_TMO      128
#define XB_XCNT(j)  (256  + 64 * (j))
#define XB_XSUB(j)  (1280 + 64 * (j))
#define XB_XGEN(j)  (2304 + 64 * (j))
#define XB_TOP      3328
#define XB_TOPGEN   3392
#define XCD_BAR_WORDS 3456
#define XB_SPIN_CAP (1u << 18)
__device__ __forceinline__ unsigned xb_ld(unsigned* p)              { return __hip_atomic_load(p, __ATOMIC_RELAXED, __HIP_MEMORY_SCOPE_AGENT); }
__device__ __forceinline__ unsigned xb_add(unsigned* p, unsigned v) { return __hip_atomic_fetch_add(p, v, __ATOMIC_RELAXED, __HIP_MEMORY_SCOPE_AGENT); }
__device__ __forceinline__ unsigned xb_xcc_id() { return (unsigned)__builtin_amdgcn_s_getreg((3 << 11) | 20) & 0xFu; }
#define XB_SPIN(cond, bar) do { unsigned _sp = 0; while (cond) { __builtin_amdgcn_s_sleep(1); \
    if ((++_sp & 255u) == 0u) { if (xb_ld(&(bar)[XB_TMO])) break; if (_sp > XB_SPIN_CAP) { atomicAdd(&(bar)[XB_TMO], 1u); break; } } } } while (0)
struct XcdBarrier { unsigned* bar; unsigned x; volatile LAS unsigned* st; };
__device__ __forceinline__ XcdBarrier xcd_barrier_post(unsigned* bar, volatile LAS unsigned* st) {
    XcdBarrier b; b.bar = bar; b.x = xb_xcc_id(); b.st = st;
    if (threadIdx.x == 0) (void)xb_add(&bar[XB_XCNT(b.x)], 1u);
    return b;
}
__device__ __forceinline__ void xcd_barrier_complete(unsigned* bar, unsigned x, unsigned& nloc, unsigned& nx) {
    const unsigned G = gridDim.x * gridDim.y * gridDim.z;
    unsigned sum, cnt, mine, sp = 0u;
    for (;;) {
        sum = 0u; cnt = 0u; mine = 0u;
#pragma unroll
        for (unsigned j = 0; j < 16; ++j) { const unsigned c = xb_ld(&bar[XB_XCNT(j)]); sum += c; cnt += (c > 0u) ? 1u : 0u; mine = (j == x) ? c : mine; }
        if (sum == G) break;
        __builtin_amdgcn_s_sleep(1);
        if ((++sp & 255u) == 0u) { if (xb_ld(&bar[XB_TMO])) break; if (sp > XB_SPIN_CAP) { atomicAdd(&bar[XB_TMO], 1u); break; } }
    }
    nloc = mine > 0u ? mine : 1u; nx = cnt > 0u ? cnt : 1u;
}
__device__ __forceinline__ void xcd_barrier(const XcdBarrier& b) {
    asm volatile("s_waitcnt vmcnt(0)" ::: "memory");
    __syncthreads();
    if (threadIdx.x == 0) {
        unsigned* bar = b.bar;
        __builtin_amdgcn_s_waitcnt(0);
        unsigned nloc = b.st[0], nx = b.st[1];
        if (nloc == 0u) { xcd_barrier_complete(bar, b.x, nloc, nx); b.st[0] = nloc; b.st[1] = nx; }
        const unsigned old = xb_add(&bar[XB_XSUB(b.x)], 1u);
        const unsigned gen = old / nloc;
        if (old + 1u == (gen + 1u) * nloc) {
            __builtin_amdgcn_fence(__ATOMIC_RELEASE, "agent");
            asm volatile("s_waitcnt vmcnt(0)" ::: "memory");
            const unsigned og = xb_add(&bar[XB_TOP], 1u);
            const unsigned tg = og / nx;
            if (og + 1u == (tg + 1u) * nx) xb_add(&bar[XB_TOPGEN], 1u);
            else XB_SPIN(xb_ld(&bar[XB_TOPGEN]) == tg, bar);
            __builtin_amdgcn_fence(__ATOMIC_ACQUIRE, "agent");
            xb_add(&bar[XB_XGEN(b.x)], 1u);
            asm volatile("s_waitcnt vmcnt(0)" ::: "memory");
        } else {
            XB_SPIN(xb_ld(&bar[XB_XGEN(b.x)]) == gen, bar);
            __builtin_amdgcn_fence(__ATOMIC_ACQUIRE, "agent");
            asm volatile("s_waitcnt vmcnt(0)" ::: "memory");
        }
    }
    __syncthreads();
}

#define PROBE_MASK 0x0
#define PROBE_DSYNC 0
#if PROBE_MASK
#define PH_BEGIN(i) const unsigned long long _t##i = __builtin_amdgcn_s_memrealtime();
#define PH_END(i) if ((PROBE_MASK >> (i)) & 1) probe_acc += __builtin_amdgcn_s_memrealtime() - _t##i;
#else
#define PH_BEGIN(i)
#define PH_END(i)
#endif
#if PROBE_DSYNC
#define GSYNC() do { xcd_barrier(xbar); xcd_barrier(xbar); } while (0)
#else
#define GSYNC() xcd_barrier(xbar)
#endif
__global__ void __launch_bounds__(512, 2) fwd_megakernel(Params Parg) {
    extern __shared__ __attribute__((aligned(16))) unsigned char lds_raw[];
    LAS unsigned char* lds = (LAS unsigned char*)lds_raw;
    cg::grid_group grid = cg::this_grid();
    const int G = gridDim.x;
    pg8::StaticOrder S;
#if PROBE_MASK
    unsigned long long probe_acc = 0;
#endif

    { unsigned* bw = (unsigned*)(get_params()->ws + WS_BAR);
      if (blockIdx.x == 0) for (int i = threadIdx.x; i < XCD_BAR_WORDS; i += 512) bw[i] = 0u;
      if (threadIdx.x < 2) *(volatile LAS unsigned*)(lds + LDS_MAIN + threadIdx.x * 4) = 0u; }
    XcdBarrier xbar;
    { PH_BEGIN(0) p0_prologue(get_params(), lds, G);
    grid.sync();
    xbar = xcd_barrier_post((unsigned*)(get_params()->ws + WS_BAR), (volatile LAS unsigned*)(lds + LDS_MAIN));
    PH_END(0) }
    { PH_BEGIN(1) { KP P = get_params(); unsigned char* ws = P->ws;
      pg8::Gemm g{(const bf16_t*)(ws + WS_XB), (const bf16_t*)(ws + WS_WGU1), MTOK, NGU, D, D, D}; S.init(MTOK, NGU, G, blockIdx.x);
      EpiGU E{(const float*)(ws + WS_SSQ), (bf16_t*)(ws + WS_BIG)}; pg8::gemm_phase(lds, g, S, E); }
    GSYNC(); PH_END(1) }
    { PH_BEGIN(2) { KP P = get_params(); unsigned char* ws = P->ws;
      pg8::Gemm g{(const bf16_t*)(ws + WS_BIG), (const bf16_t*)(ws + WS_WD1), MTOK, D, DFF, DFF, DFF}; S.init(MTOK, D, G, blockIdx.x);
      EpiRes E{P->in[0], P->out, (bf16_t*)(ws + WS_XB), (float*)(ws + WS_SSQ) + MTOK, 0.5f}; pg8::gemm_phase(lds, g, S, E); }
    GSYNC(); PH_END(2) }
    for (int hf = 0; hf < 2; ++hf) {
        const size_t r0 = (size_t)hf * MH;
        { PH_BEGIN(3) { KP P = get_params(); unsigned char* ws = P->ws;
          pg8::Gemm g{(const bf16_t*)(ws + WS_XB) + r0 * D, (const bf16_t*)(ws + WS_WIN), MH, NIN, D, D, D}; S.init(MH, NIN, G, blockIdx.x);
          EpiIn E{(const float*)(ws + WS_SSQ) + MTOK + r0, ws + WS_BIG, (bf16_t*)(ws + WS_HALO), (float*)(ws + WS_SM)}; pg8::gemm_phase(lds, g, S, E); }
        GSYNC(); PH_END(3) }
        { PH_BEGIN(4) p4_prep(get_params(), lds, G);
        GSYNC(); PH_END(4) }
        { PH_BEGIN(5) p5_mixer(get_params(), lds, G);
        GSYNC(); PH_END(5) }
        { PH_BEGIN(6) { KP P = get_params(); unsigned char* ws = P->ws; unsigned char* T = ws + WS_BIG;
          pg8::Gemm g{(const bf16_t*)(T + T_V), (const bf16_t*)(ws + WS_WGO), MH, D, D, D, D}; S.init(MH, D, G, blockIdx.x);
          EpiGate E{(const bf16_t*)(T + T_GT), nullptr, (bf16_t*)(T + T_T1), 0}; pg8::gemm_phase(lds, g, S, E); }
        { KP P = get_params(); unsigned char* ws = P->ws; unsigned char* T = ws + WS_BIG;
          pg8::Gemm g{(const bf16_t*)(T + T_XBC), (const bf16_t*)(ws + WS_WSO), MH, D, 2048, 4096, 2048}; S.init(MH, D, G, blockIdx.x);
          EpiGate E{(const bf16_t*)(T + T_GT), (const bf16_t*)(T + T_T1), (bf16_t*)(T + T_MRG), 1}; pg8::gemm_phase(lds, g, S, E); }
        GSYNC(); PH_END(6) }
        { PH_BEGIN(7) { KP P = get_params(); unsigned char* ws = P->ws;
          pg8::Gemm g{(const bf16_t*)(ws + WS_BIG + T_MRG), (const bf16_t*)(ws + WS_WOUT), MH, D, D, D, D}; S.init(MH, D, G, blockIdx.x);
          EpiRes E{P->out + r0 * D, P->out + r0 * D, (bf16_t*)(ws + WS_XB) + r0 * D, (float*)(ws + WS_SSQ) + 2 * MTOK + r0, 1.0f}; pg8::gemm_phase(lds, g, S, E); }
        GSYNC(); PH_END(7) }
    }
    { PH_BEGIN(8) { KP P = get_params(); unsigned char* ws = P->ws;
      pg8::Gemm g{(const bf16_t*)(ws + WS_XB), (const bf16_t*)(ws + WS_WGU2), MTOK, NGU, D, D, D}; S.init(MTOK, NGU, G, blockIdx.x);
      EpiGU E{(const float*)(ws + WS_SSQ) + 2 * MTOK, (bf16_t*)(ws + WS_BIG)}; pg8::gemm_phase(lds, g, S, E); }
    GSYNC(); PH_END(8) }
    { PH_BEGIN(9) { KP P = get_params(); unsigned char* ws = P->ws;
      pg8::Gemm g{(const bf16_t*)(ws + WS_BIG), (const bf16_t*)(ws + WS_WD2), MTOK, D, DFF, DFF, DFF}; S.init(MTOK, D, G, blockIdx.x);
      EpiRes E{P->out, P->out, nullptr, (float*)(ws + WS_SSQ) + 3 * MTOK, 0.5f}; pg8::gemm_phase(lds, g, S, E); }
    GSYNC(); PH_END(9) }
    { PH_BEGIN(10)
    {
        KP P = get_params(); const float* ssq = (const float*)(P->ws + WS_SSQ) + 3 * MTOK;
        const int tid = tid_fresh(), lane = tid & 63, gw = blockIdx.x * 8 + (tid >> 6), NGW = G * 8;
        const float* fw = P->in[23]; float* outp = P->out;
        for (int m = gw; m < MTOK; m += NGW) {
            const float rstd = rsqrtf(ssq[m] * (1.f / D) + EPS);
            f32x4* xr = (f32x4*)(outp + (size_t)m * D) + lane;
#pragma unroll
            for (int jj = 0; jj < 4; ++jj) { const f32x4 wv = ((const f32x4*)fw)[lane + 64 * jj]; f32x4 v = xr[64 * jj]; v = v * rstd; v.x *= wv.x; v.y *= wv.y; v.z *= wv.z; v.w *= wv.w; xr[64 * jj] = v; }
        }
    }
    PH_END(10) }
#if PROBE_MASK
    if (blockIdx.x == 0) {
        const unsigned long long t0 = __builtin_amdgcn_s_memrealtime();
        while (__builtin_amdgcn_s_memrealtime() - t0 < probe_acc) __builtin_amdgcn_s_sleep(8);
    }
#endif
}

extern "C" void kernel_launch(void* const* d_in, const int* in_sizes, int n_in, void* d_out, int out_size, void* d_ws, size_t ws_size, hipStream_t stream) {
    static int grid = 0;
    if (grid == 0) {
        if (n_in != 24 || ws_size < WS_NEED) { fprintf(stderr, "kernel_launch: unexpected n_in %d or ws_size %zu (need %zu)\n", n_in, ws_size, (size_t)WS_NEED); grid = -1; return; }
        int dev = 0, cus = 0, per_cu = 0;
        hipGetDevice(&dev);
        hipDeviceGetAttribute(&cus, hipDeviceAttributeMultiprocessorCount, dev);
        hipFuncSetAttribute((const void*)fwd_megakernel, hipFuncAttributeMaxDynamicSharedMemorySize, LDS_BYTES);
        hipOccupancyMaxActiveBlocksPerMultiprocessor(&per_cu, (const void*)fwd_megakernel, 512, LDS_BYTES);
        if (per_cu < 1) { fprintf(stderr, "kernel_launch: occupancy query gave %d\n", per_cu); per_cu = 1; }
        grid = cus * per_cu;
        (void)hipGetLastError();
    }
    if (grid < 0) return;
    Params p{};
    for (int i = 0; i < 24; ++i) p.in[i] = (const float*)d_in[i];
    p.out = (float*)d_out; p.ws = (unsigned char*)d_ws;
    void* args[] = {&p};
    hipError_t e = hipLaunchCooperativeKernel((const void*)fwd_megakernel, dim3(grid), dim3(512), args, LDS_BYTES, stream);
    if (e != hipSuccess) fprintf(stderr, "cooperative launch failed: %s (grid %d)\n", hipGetErrorString(e), grid);
}
```

```cpp
#include <hip/hip_runtime.h>
#include <hip/hip_cooperative_groups.h>
#include <cstdio>
#include <cstdint>
namespace cg = cooperative_groups;

#define LAS __attribute__((address_space(3)))
typedef unsigned short bf16_t;
typedef short bf16x8 __attribute__((ext_vector_type(8)));
typedef short s16x4 __attribute__((ext_vector_type(4)));
typedef float f32x4 __attribute__((ext_vector_type(4)));
typedef float f32x16 __attribute__((ext_vector_type(16)));
typedef unsigned u32x4 __attribute__((ext_vector_type(4)));
typedef unsigned u32x2 __attribute__((ext_vector_type(2)));

constexpr int D = 1024, BATCH = 32, SEQ = 2048, MTOK = BATCH * SEQ;
constexpr int NCH = SEQ / 64;
constexpr int DFF = 2816, NGU = 2 * DFF;
constexpr int IN_DIM = 11312, NIN = 45 * 256;
constexpr int HB = 16, MH = HB * SEQ;
constexpr float EPS = 1e-6f;

constexpr size_t MiB = 1u << 20;
constexpr size_t WS_SSQ = 0;
constexpr size_t WS_WGU1 = 1 * MiB, WS_WD1 = 12 * MiB, WS_WIN = 18 * MiB, WS_WGO = 41 * MiB, WS_WSO = 43 * MiB, WS_WOUT = 47 * MiB, WS_WGU2 = 49 * MiB, WS_WD2 = 60 * MiB;
constexpr size_t WS_DEC = 66 * MiB, WS_DECS = 67 * MiB, WS_WG = 68 * MiB, WS_HALO = 72 * MiB, WS_SM = 84 * MiB;
constexpr size_t WS_BAR = 92 * MiB;
constexpr size_t WS_XB = 96 * MiB;
constexpr size_t WS_BIG = 224 * MiB;
constexpr size_t T_Q = 0, T_K = 32 * MiB, T_V = 64 * MiB, T_SG = 128 * MiB, T_SZ = 192 * MiB, T_XBC = 320 * MiB, T_GT = 576 * MiB, T_END = 704 * MiB;
constexpr size_t T_T1 = T_Q, T_MRG = T_SG;
constexpr size_t WS_NEED = WS_BIG + T_END;

constexpr int LDS_MAIN = 131072, LDS_XB = 149504, LDS_BYTES = LDS_XB + 64;

__device__ __forceinline__ unsigned cvt_pk_bf16(float lo, float hi) { unsigned r; asm volatile("v_cvt_pk_bf16_f32 %0, %1, %2" : "=v"(r) : "v"(lo), "v"(hi)); return r; }
__device__ __forceinline__ float bf_lo(unsigned u) { return __uint_as_float(u << 16); }
__device__ __forceinline__ float bf_hi(unsigned u) { return __uint_as_float(u & 0xffff0000u); }
__device__ __forceinline__ float fast_rcp(float x) { return __builtin_amdgcn_rcpf(x); }
__device__ __forceinline__ float sigmoidf_(float x) { return fast_rcp(1.f + __expf(-x)); }
__device__ __forceinline__ float siluf_(float x) { return x * sigmoidf_(x); }
__device__ __forceinline__ float softplusf_(float x) { return fmaxf(x, 0.f) + __logf(1.f + __expf(-fabsf(x))); }
__device__ __forceinline__ float wave_sum(float v) {
#pragma unroll
    for (int o = 1; o < 64; o <<= 1) v += __shfl_xor(v, o);
    return v;
}

namespace pg8 {
constexpr int BM = 256, BK = 64, HALF = 128, HTB = HALF * BK * 2, STAGE_BYTES = 8 * HTB, NXCD = 8, WGM = 8;
__host__ __device__ __forceinline__ int lds_byte(int r, int c) { const int st = (r >> 4) * 2 + (c >> 5), rr = r & 15, cc = c & 31, ob = rr * 64 + cc * 2; return st * 1024 + (ob ^ (((ob >> 9) & 1) << 5)); }
__host__ __device__ __forceinline__ void stage_rc(int b, int& R, int& C) { const int st = b / 1024, sb = b % 1024, swz = sb ^ (((sb >> 9) & 1) << 5); R = (st >> 1) * 16 + swz / 64; C = (st & 1) * 32 + (swz % 64) / 2; }
__host__ __device__ __forceinline__ int perm32(int rho) { const int n = rho >> 4, i = rho & 15; return 8 * (i >> 2) + 4 * n + (i & 3); }

struct Unit { int pm, pn; };
struct Gemm { const bf16_t* A; const bf16_t* Bt; int M, N, K, lda, ldb; };

struct StaticOrder {
    int nM, nN, nwg, G, c;
    __device__ void init(int M, int N, int G_, int c_) { nM = M / BM; nN = N / BM; nwg = nM * nN; G = G_; c = c_; }
    __device__ bool next(int i, Unit& u) const {
        const long L = (long)i * G + c; if (L >= nwg) return false;
        int wgid = (int)L; { const int q = nwg / NXCD, r = nwg % NXCD, xcd = wgid % NXCD, off = wgid / NXCD; wgid = (xcd < r ? xcd * (q + 1) : r * (q + 1) + (xcd - r) * q) + off; }
        const int nig = WGM * nN, gid = wgid / nig, fm = gid * WGM, gsz = (nM - fm) < WGM ? (nM - fm) : WGM;
        u.pm = fm + ((wgid % nig) % gsz); u.pn = (wgid % nig) / gsz; return true;
    }
};

template <class Epi, bool ALIGN_EPI = true, bool SP2 = true>
__device__ __forceinline__ void gemm_phase(LAS unsigned char* lds, const Gemm g, const StaticOrder& S, const Epi& E) {
    int tid = threadIdx.x; asm volatile("" : "+v"(tid));
    const int wid = __builtin_amdgcn_readfirstlane(tid >> 6), lane = tid & 63, wr = wid >> 2, wc = wid & 3, fr = lane & 15, fq = lane >> 4;
    const int K = g.K, nt = K / BK;
    unsigned voffA[2], voffB[2];
#pragma unroll
    for (int i = 0; i < 2; ++i) { int R, C; stage_rc(tid * 16 + i * 8192, R, C); const int Rb = (R & ~31) + perm32(R & 31);
        voffA[i] = (unsigned)(R * g.lda + C) * 2u; voffB[i] = (unsigned)(Rb * g.ldb + C) * 2u; }
    const size_t kstep = (size_t)(BK * 2);
    const size_t hstA = (size_t)HALF * g.lda * 2, hstB = (size_t)HALF * g.ldb * 2;
    const size_t tstA = 2 * hstA, tstB = 2 * hstB;
    const unsigned ldsw = (unsigned)wid * 1024u;
    const int aoff = lds_byte(wr * 64 + fr, fq * 8), boff = lds_byte(wc * 32 + fr, fq * 8);
#define PG8_SA(b, h) (((b) * 2 + (h)) * HTB)
#define PG8_SB(b, h) ((4 + (b) * 2 + (h)) * HTB)
#define PG8_STAGE(bufoff, gbase, voff) do { _Pragma("unroll") for (int _i = 0; _i < 2; ++_i) \
        __builtin_amdgcn_global_load_lds((const unsigned*)((const char*)(gbase) + (voff)[_i]), (LAS unsigned*)(lds + (bufoff) + ldsw + _i * 8192), 16, 0, 0); } while (0)
#define PG8_LDA(dst, b, h) do { _Pragma("unroll") for (int m = 0; m < 4; ++m) _Pragma("unroll") for (int k = 0; k < 2; ++k) dst[m][k] = *(const LAS bf16x8*)(lds + PG8_SA(b, h) + aoff + m * 2048 + k * 1024); } while (0)
#define PG8_LDB(dst, b, h) do { _Pragma("unroll") for (int n = 0; n < 2; ++n) _Pragma("unroll") for (int k = 0; k < 2; ++k) dst[n][k] = *(const LAS bf16x8*)(lds + PG8_SB(b, h) + boff + n * 2048 + k * 1024); } while (0)
#define PG8_MMA(ai, bj, At, Bt) do { __builtin_amdgcn_s_setprio(1); _Pragma("unroll") for (int m = 0; m < 4; ++m) _Pragma("unroll") for (int n = 0; n < 2; ++n) _Pragma("unroll") for (int k = 0; k < 2; ++k) \
        acc[ai][bj][m][n] = __builtin_amdgcn_mfma_f32_16x16x32_bf16(Bt[n][k], At[m][k], acc[ai][bj][m][n], 0, 0, 0); __builtin_amdgcn_s_setprio(0); } while (0)
#define PG8_WAIT_V(n) asm volatile("s_waitcnt vmcnt(" #n ")" ::: "memory")
#define PG8_WAIT_L(n) asm volatile("s_waitcnt lgkmcnt(" #n ")" ::: "memory")
#define PG8_BAR __builtin_amdgcn_s_barrier()
#define PG8_SCHED __builtin_amdgcn_sched_barrier(0)
    Unit cur, nxt; int ui = 0;
    if (!S.next(0, cur)) return;
    f32x4 acc[2][2][4][2];
#pragma unroll
    for (int a = 0; a < 2; ++a)
#pragma unroll
        for (int b = 0; b < 2; ++b)
#pragma unroll
            for (int m = 0; m < 4; ++m)
#pragma unroll
                for (int n = 0; n < 2; ++n) acc[a][b][m][n] = (f32x4){0.f, 0.f, 0.f, 0.f};
    bf16x8 At[4][2], B0[2][2], B1[2][2];
    const char* cA = (const char*)g.A + (size_t)cur.pm * tstA; const char* cB = (const char*)g.Bt + (size_t)cur.pn * tstB;
    if constexpr (SP2) {
        PG8_STAGE(PG8_SB(0, 0), cB, voffB); PG8_STAGE(PG8_SB(0, 1), cB + hstB, voffB); PG8_STAGE(PG8_SA(0, 0), cA, voffA); PG8_STAGE(PG8_SA(0, 1), cA + hstA, voffA);
        if (wr == 1) PG8_BAR;
        PG8_WAIT_V(2); PG8_BAR;
        PG8_STAGE(PG8_SB(1, 0), cB + kstep, voffB); PG8_STAGE(PG8_SA(1, 0), cA + kstep, voffA); PG8_STAGE(PG8_SB(1, 1), cB + hstB + kstep, voffB);
        PG8_WAIT_V(6); PG8_BAR;
    } else {
    PG8_STAGE(PG8_SB(0, 0), cB, voffB); PG8_STAGE(PG8_SA(0, 0), cA, voffA); PG8_STAGE(PG8_SB(0, 1), cB + hstB, voffB); PG8_STAGE(PG8_SA(0, 1), cA + hstA, voffA);
    if (wr == 1) PG8_BAR;
    PG8_WAIT_V(4); PG8_BAR;
    PG8_STAGE(PG8_SB(1, 0), cB + kstep, voffB); PG8_STAGE(PG8_SA(1, 0), cA + kstep, voffA); PG8_STAGE(PG8_SB(1, 1), cB + hstB + kstep, voffB);
    PG8_WAIT_V(6); PG8_BAR;
    }
    for (;;) {
        const bool has_next = S.next(ui + 1, nxt);
        const char* nA = has_next ? (const char*)g.A + (size_t)nxt.pm * tstA : cA; const char* nB = has_next ? (const char*)g.Bt + (size_t)nxt.pn * tstB : cB;
        for (int t = 0; t < nt; t += 2) {
            const bool last = (t == nt - 2);
            const char* a1 = cA + (size_t)(t + 1) * kstep;
            const char* a2 = last ? nA : cA + (size_t)(t + 2) * kstep; const char* b2 = last ? nB : cB + (size_t)(t + 2) * kstep;
            const char* a3 = a2 + kstep; const char* b3 = b2 + kstep;
            if constexpr (SP2) {
            PG8_LDB(B0, 0, 0); PG8_LDB(B1, 0, 1); PG8_SCHED; PG8_LDA(At, 0, 0); PG8_STAGE(PG8_SA(1, 1), a1 + hstA, voffA);
            PG8_WAIT_V(8); PG8_WAIT_L(0); PG8_BAR; PG8_MMA(0, 0, At, B0); PG8_MMA(0, 1, At, B1); PG8_BAR; PG8_SCHED;
            PG8_LDA(At, 0, 1); PG8_STAGE(PG8_SB(0, 0), b2, voffB); PG8_STAGE(PG8_SB(0, 1), b2 + hstB, voffB); PG8_STAGE(PG8_SA(0, 0), a2, voffA);
            PG8_WAIT_V(8); PG8_WAIT_L(0); PG8_BAR; PG8_MMA(1, 0, At, B0); PG8_MMA(1, 1, At, B1); PG8_BAR; PG8_SCHED;
            PG8_LDB(B0, 1, 0); PG8_LDB(B1, 1, 1); PG8_SCHED; PG8_LDA(At, 1, 0); PG8_STAGE(PG8_SA(0, 1), a2 + hstA, voffA);
            PG8_WAIT_V(8); PG8_WAIT_L(0); PG8_BAR; PG8_MMA(0, 0, At, B0); PG8_MMA(0, 1, At, B1); PG8_BAR; PG8_SCHED;
            PG8_LDA(At, 1, 1); PG8_STAGE(PG8_SB(1, 0), b3, voffB); PG8_STAGE(PG8_SB(1, 1), b3 + hstB, voffB); PG8_STAGE(PG8_SA(1, 0), a3, voffA);
            PG8_WAIT_V(8); PG8_WAIT_L(0); PG8_BAR; PG8_MMA(1, 0, At, B0); PG8_MMA(1, 1, At, B1); PG8_BAR; PG8_SCHED;
            } else {
            PG8_LDB(B0, 0, 0); PG8_SCHED; PG8_LDA(At, 0, 0); PG8_STAGE(PG8_SA(1, 1), a1 + hstA, voffA);
            PG8_WAIT_L(8); PG8_BAR; PG8_WAIT_L(0); PG8_MMA(0, 0, At, B0); PG8_BAR; PG8_SCHED;
            PG8_LDB(B1, 0, 1); PG8_STAGE(PG8_SB(0, 0), b2, voffB);
            PG8_BAR; PG8_WAIT_L(0); PG8_MMA(0, 1, At, B1); PG8_BAR;
            PG8_LDA(At, 0, 1); PG8_STAGE(PG8_SA(0, 0), a2, voffA);
            PG8_BAR; PG8_WAIT_L(0); PG8_MMA(1, 0, At, B0); PG8_BAR; PG8_SCHED;
            PG8_STAGE(PG8_SB(0, 1), b2 + hstB, voffB);
            PG8_WAIT_V(6); PG8_BAR; PG8_MMA(1, 1, At, B1); PG8_BAR;
            PG8_LDB(B0, 1, 0); PG8_SCHED; PG8_LDA(At, 1, 0); PG8_STAGE(PG8_SA(0, 1), a2 + hstA, voffA);
            PG8_WAIT_L(8); PG8_BAR; PG8_WAIT_L(0); PG8_MMA(0, 0, At, B0); PG8_BAR; PG8_SCHED;
            PG8_LDB(B1, 1, 1); PG8_STAGE(PG8_SB(1, 0), b3, voffB);
            PG8_BAR; PG8_WAIT_L(0); PG8_MMA(0, 1, At, B1); PG8_BAR;
            PG8_LDA(At, 1, 1); PG8_STAGE(PG8_SA(1, 0), a3, voffA);
            PG8_BAR; PG8_WAIT_L(0); PG8_MMA(1, 0, At, B0); PG8_BAR; PG8_SCHED;
            PG8_STAGE(PG8_SB(1, 1), b3 + hstB, voffB);
            PG8_WAIT_V(6); PG8_BAR; PG8_MMA(1, 1, At, B1); PG8_BAR;
            }
        }
        if constexpr (ALIGN_EPI) { if (wr == 0) PG8_BAR; }
        E(acc, cur, wr, wc, fr, fq);
        if (!has_next) break;
#pragma unroll
        for (int a = 0; a < 2; ++a)
#pragma unroll
            for (int b = 0; b < 2; ++b)
#pragma unroll
                for (int m = 0; m < 4; ++m)
#pragma unroll
                    for (int n = 0; n < 2; ++n) acc[a][b][m][n] = (f32x4){0.f, 0.f, 0.f, 0.f};
        cur = nxt; cA = nA; cB = nB; ++ui;
        if constexpr (ALIGN_EPI) { if (wr == 1) PG8_BAR; }
    }
    PG8_WAIT_V(0);
    if constexpr (!ALIGN_EPI) { if (wr == 0) PG8_BAR; }
    PG8_BAR;
#undef PG8_SA
#undef PG8_SB
#undef PG8_STAGE
#undef PG8_LDA
#undef PG8_LDB
#undef PG8_MMA
#undef PG8_WAIT_V
#undef PG8_WAIT_L
#undef PG8_BAR
#undef PG8_SCHED
}
}

typedef f32x4 AccT[2][2][4][2];

struct EpiGU {
    const float* ssq; bf16_t* O;
    __device__ __forceinline__ void operator()(const AccT& acc, const pg8::Unit& u, int wr, int wc, int fr, int fq) const {
        const int row0 = u.pm * 256 + wr * 64 + fr, col0 = u.pn * 128 + wc * 32 + 8 * fq;
        float rs[2][4];
#pragma unroll
        for (int ai = 0; ai < 2; ++ai)
#pragma unroll
            for (int m = 0; m < 4; ++m) rs[ai][m] = ssq[row0 + ai * 128 + m * 16];
        __builtin_amdgcn_sched_barrier(0);
#pragma unroll
        for (int ai = 0; ai < 2; ++ai)
#pragma unroll
            for (int m = 0; m < 4; ++m) {
                const int row = row0 + ai * 128 + m * 16;
                const float rstd = rsqrtf(rs[ai][m] * (1.f / D) + EPS);
                float v[8];
#pragma unroll
                for (int n = 0; n < 2; ++n)
#pragma unroll
                    for (int j = 0; j < 4; ++j) { const float gg = acc[ai][0][m][n][j] * rstd, uu = acc[ai][1][m][n][j] * rstd; v[4 * n + j] = siluf_(gg) * uu; }
                u32x4 w; w.x = cvt_pk_bf16(v[0], v[1]); w.y = cvt_pk_bf16(v[2], v[3]); w.z = cvt_pk_bf16(v[4], v[5]); w.w = cvt_pk_bf16(v[6], v[7]);
                *(u32x4*)(O + (size_t)row * DFF + col0) = w;
            }
    }
};
struct EpiRes {
    const float* xin; float* xout; bf16_t* xb; float* ssq; float alpha;
    __device__ __forceinline__ void operator()(const AccT& acc, const pg8::Unit& u, int wr, int wc, int fr, int fq) const {
        const int row0 = u.pm * 256 + wr * 64 + fr, col0 = u.pn * 256 + wc * 32 + 8 * fq;
#pragma unroll
        for (int ai = 0; ai < 2; ++ai) {
            f32x4 xv[4][2][2];
#pragma unroll
            for (int m = 0; m < 4; ++m)
#pragma unroll
                for (int bj = 0; bj < 2; ++bj) { const size_t o = (size_t)(row0 + ai * 128 + m * 16) * D + col0 + bj * 128; xv[m][bj][0] = *(const f32x4*)(xin + o); xv[m][bj][1] = *(const f32x4*)(xin + o + 4); }
            __builtin_amdgcn_sched_barrier(0);
#pragma unroll
            for (int m = 0; m < 4; ++m) {
                const int row = row0 + ai * 128 + m * 16;
                float s = 0.f;
#pragma unroll
                for (int bj = 0; bj < 2; ++bj) {
                    const size_t o = (size_t)row * D + col0 + bj * 128;
                    const f32x4 y0 = xv[m][bj][0] + acc[ai][bj][m][0] * alpha, y1 = xv[m][bj][1] + acc[ai][bj][m][1] * alpha;
                    *(f32x4*)(xout + o) = y0; *(f32x4*)(xout + o + 4) = y1;
                    s += y0.x * y0.x + y0.y * y0.y + y0.z * y0.z + y0.w * y0.w + y1.x * y1.x + y1.y * y1.y + y1.z * y1.z + y1.w * y1.w;
                    if (xb) { u32x4 w; w.x = cvt_pk_bf16(y0.x, y0.y); w.y = cvt_pk_bf16(y0.z, y0.w); w.z = cvt_pk_bf16(y1.x, y1.y); w.w = cvt_pk_bf16(y1.z, y1.w); *(u32x4*)(xb + o) = w; }
                }
                s += __shfl_xor(s, 16); s += __shfl_xor(s, 32);
                if (fq == 0) atomicAdd(ssq + row, s);
            }
        }
    }
};
struct EpiIn {
    const float* ssq; unsigned char* T; bf16_t* halo; float* sm;
    __device__ __forceinline__ void operator()(const AccT& acc, const pg8::Unit& u, int wr, int wc, int fr, int fq) const {
        const int pn = u.pn;
        const int row0 = u.pm * 256 + wr * 64 + fr;
        float rs[2][4];
#pragma unroll
        for (int ai = 0; ai < 2; ++ai)
#pragma unroll
            for (int m = 0; m < 4; ++m) rs[ai][m] = ssq[row0 + ai * 128 + m * 16];
        __builtin_amdgcn_sched_barrier(0);
        int act = 0, ld, ct; bf16_t* base;
        if (pn < 2) { base = (bf16_t*)(T + T_Q); ld = 512; ct = pn; }
        else if (pn < 4) { base = (bf16_t*)(T + T_K); ld = 512; ct = pn - 2; }
        else if (pn < 8) { base = (bf16_t*)(T + T_V); ld = 1024; ct = pn - 4; }
        else if (pn < 12) { base = (bf16_t*)(T + T_SG); ld = 1024; ct = pn - 8; act = 1; }
        else if (pn < 20) { base = (bf16_t*)(T + T_SZ); ld = 2048; ct = pn - 12; act = 1; }
        else if (pn < 36) { base = (bf16_t*)(T + T_XBC); ld = 4096; ct = pn - 20; act = 3; }
        else if (pn < 44) { base = (bf16_t*)(T + T_GT); ld = 2048; ct = pn - 36; act = 2; }
        else { base = nullptr; ld = 0; ct = 0; act = 4; }
        if (act == 4) {
            if (wc < 2) {
#pragma unroll
                for (int ai = 0; ai < 2; ++ai)
#pragma unroll
                    for (int m = 0; m < 4; ++m) {
                        const int row = row0 + ai * 128 + m * 16;
                        const float rstd = rsqrtf(rs[ai][m] * (1.f / D) + EPS);
                        float* p = sm + (size_t)row * 64 + wc * 32 + 8 * fq;
                        *(f32x4*)p = acc[ai][0][m][0] * rstd; *(f32x4*)(p + 4) = acc[ai][0][m][1] * rstd;
                    }
            }
            return;
        }
        const int col0 = ct * 256 + wc * 32 + 8 * fq;
#pragma unroll
        for (int ai = 0; ai < 2; ++ai)
#pragma unroll
            for (int m = 0; m < 4; ++m) {
                const int row = row0 + ai * 128 + m * 16;
                const float rstd = rsqrtf(rs[ai][m] * (1.f / D) + EPS);
#pragma unroll
                for (int bj = 0; bj < 2; ++bj) {
                    float v[8];
#pragma unroll
                    for (int n = 0; n < 2; ++n)
#pragma unroll
                        for (int j = 0; j < 4; ++j) { float x = acc[ai][bj][m][n][j] * rstd; if (act == 1) x = siluf_(x); else if (act == 2) x = sigmoidf_(x); v[4 * n + j] = x; }
                    u32x4 w; w.x = cvt_pk_bf16(v[0], v[1]); w.y = cvt_pk_bf16(v[2], v[3]); w.z = cvt_pk_bf16(v[4], v[5]); w.w = cvt_pk_bf16(v[6], v[7]);
                    *(u32x4*)(base + (size_t)row * ld + col0 + bj * 128) = w;
                    if (act == 3 && (row & 63) >= 61) *(u32x4*)(halo + ((size_t)(row >> 6) * 3 + ((row & 63) - 61)) * 4096 + col0 + bj * 128) = w;
                }
            }
    }
};
struct EpiGate {
    const bf16_t* gt; const bf16_t* t1; bf16_t* out; int mode;
    __device__ __forceinline__ void operator()(const AccT& acc, const pg8::Unit& u, int wr, int wc, int fr, int fq) const {
        const int row0 = u.pm * 256 + wr * 64 + fr, col0 = u.pn * 256 + wc * 32 + 8 * fq;
#pragma unroll
        for (int ai = 0; ai < 2; ++ai) {
            u32x4 gq[4][2], tq[4][2];
#pragma unroll
            for (int m = 0; m < 4; ++m)
#pragma unroll
                for (int bj = 0; bj < 2; ++bj) { const int row = row0 + ai * 128 + m * 16, col = col0 + bj * 128;
                    gq[m][bj] = *(const u32x4*)(gt + (size_t)row * 2048 + mode * 1024 + col);
                    tq[m][bj] = mode ? *(const u32x4*)(t1 + (size_t)row * D + col) : (u32x4){0u, 0u, 0u, 0u}; }
            __builtin_amdgcn_sched_barrier(0);
#pragma unroll
            for (int m = 0; m < 4; ++m)
#pragma unroll
                for (int bj = 0; bj < 2; ++bj) {
                    const int row = row0 + ai * 128 + m * 16, col = col0 + bj * 128;
                    const u32x4 g4 = gq[m][bj], t4 = tq[m][bj];
                    float v[8];
                    v[0] = acc[ai][bj][m][0].x * bf_lo(g4.x); v[1] = acc[ai][bj][m][0].y * bf_hi(g4.x); v[2] = acc[ai][bj][m][0].z * bf_lo(g4.y); v[3] = acc[ai][bj][m][0].w * bf_hi(g4.y);
                    v[4] = acc[ai][bj][m][1].x * bf_lo(g4.z); v[5] = acc[ai][bj][m][1].y * bf_hi(g4.z); v[6] = acc[ai][bj][m][1].z * bf_lo(g4.w); v[7] = acc[ai][bj][m][1].w * bf_hi(g4.w);
                    if (mode) { v[0] += bf_lo(t4.x); v[1] += bf_hi(t4.x); v[2] += bf_lo(t4.y); v[3] += bf_hi(t4.y); v[4] += bf_lo(t4.z); v[5] += bf_hi(t4.z); v[6] += bf_lo(t4.w); v[7] += bf_hi(t4.w); }
                    u32x4 w; w.x = cvt_pk_bf16(v[0], v[1]); w.y = cvt_pk_bf16(v[2], v[3]); w.z = cvt_pk_bf16(v[4], v[5]); w.w = cvt_pk_bf16(v[6], v[7]);
                    *(u32x4*)(out + (size_t)row * D + col) = w;
                }
        }
    }
};

__device__ __forceinline__ void tr_item(const float* srcp, int ld, const float* sk, float mul, int k0, int K, bf16_t* dst, int n0, LAS float* scr, int lane) {
#pragma unroll 16
    for (int i = 0; i < 32; ++i) { const int kk = 2 * i + (lane >> 5);
        float v = 0.f; if (srcp) v = srcp[(size_t)(k0 + kk) * ld] * (sk ? sk[k0 + kk] : 1.f) * mul;
        scr[kk * 33 + (lane & 31)] = v; }
    asm volatile("s_waitcnt lgkmcnt(0)" ::: "memory");
    const int c = lane & 7;
#pragma unroll
    for (int j = 0; j < 4; ++j) { const int n = (lane >> 3) + 8 * j; const LAS float* s = scr + (8 * c) * 33 + n;
        u32x4 o; o.x = cvt_pk_bf16(s[0 * 33], s[1 * 33]); o.y = cvt_pk_bf16(s[2 * 33], s[3 * 33]); o.z = cvt_pk_bf16(s[4 * 33], s[5 * 33]); o.w = cvt_pk_bf16(s[6 * 33], s[7 * 33]);
        *(u32x4*)(dst + (size_t)(n0 + n) * K + k0 + 8 * c) = o; }
    asm volatile("s_waitcnt lgkmcnt(0)" ::: "memory");
}
__device__ __forceinline__ int win_src_col(int nd) {
    if (nd < 3072) return nd;
    if (nd < 5120) return 3088 + (nd - 3072);
    if (nd < 9216) return 5136 + (nd - 5120);
    if (nd < 11264) return 9264 + (nd - 9216);
    if (nd < 11280) return 3072 + (nd - 11264);
    if (nd < 11312) return 9232 + (nd - 11280);
    return -1;
}

struct Params {
    const float* in[24];
    float* out;
    unsigned char* ws;
};

typedef __attribute__((address_space(4))) const Params* KP;
__device__ __forceinline__ Params load_params(KP p) { Params r;
#pragma unroll
    for (int i = 0; i < 24; ++i) r.in[i] = p->in[i];
    r.out = p->out; r.ws = p->ws; return r; }
__device__ __forceinline__ int tid_fresh() { int t = threadIdx.x; asm volatile("" : "+v"(t)); return t; }
__device__ __forceinline__ void p0_prologue(KP Pp, LAS unsigned char* lds, int G) {
    const Params P = load_params(Pp);
    const int tid = tid_fresh(), lane = tid & 63, wave = tid >> 6;
    LAS float* scr = (LAS float*)(lds + wave * 16384);
    const int gw = blockIdx.x * 8 + wave, NGW = G * 8;
    unsigned char* ws = P.ws;
    constexpr int I_GU = (D / 64) * (NGU / 32), I_DN = (DFF / 64) * (D / 32), I_IN = (D / 64) * (NIN / 32), I_GO = (D / 64) * (D / 32), I_SO = (2048 / 64) * (D / 32);
    constexpr int NITEMS = 2 * I_GU + 2 * I_DN + I_IN + 2 * I_GO + I_SO;
    for (int it = gw; it < NITEMS; it += NGW) {
        int r = it; const int j = lane & 31;
        if (r < 2 * I_GU) { const int l2 = r >= I_GU; r -= l2 * I_GU; const int nb = r % (NGU / 32), kb = r / (NGU / 32); const int nd = nb * 32 + j, tile = nd >> 8, w = nd & 255;
            const float* Wg = P.in[l2 ? 20 : 2]; const float* Wu = P.in[l2 ? 21 : 3];
            const float* sp = (w < 128 ? Wg : Wu) + 128 * tile + (w & 127);
            tr_item(sp, DFF, P.in[l2 ? 19 : 1], 1.f, kb * 64, D, (bf16_t*)(ws + (l2 ? WS_WGU2 : WS_WGU1)), nb * 32, scr, lane); continue; }
        r -= 2 * I_GU;
        if (r < 2 * I_DN) { const int l2 = r >= I_DN; r -= l2 * I_DN; const int nb = r % (D / 32), kb = r / (D / 32);
            tr_item(P.in[l2 ? 22 : 4] + nb * 32 + j, D, nullptr, 1.f, kb * 64, DFF, (bf16_t*)(ws + (l2 ? WS_WD2 : WS_WD1)), nb * 32, scr, lane); continue; }
        r -= 2 * I_DN;
        if (r < I_IN) { const int nb = r % (NIN / 32), kb = r / (NIN / 32); const int nd = nb * 32 + j, sc = win_src_col(nd);
            tr_item(sc >= 0 ? P.in[6] + sc : nullptr, IN_DIM, P.in[5], nd < 512 ? 0.08838834764831845f : 1.f, kb * 64, D, (bf16_t*)(ws + WS_WIN), nb * 32, scr, lane); continue; }
        r -= I_IN;
        if (r < 2 * I_GO) { const int l2 = r >= I_GO; r -= l2 * I_GO; const int nb = r % (D / 32), kb = r / (D / 32);
            tr_item(P.in[l2 ? 18 : 10] + nb * 32 + j, D, nullptr, 1.f, kb * 64, D, (bf16_t*)(ws + (l2 ? WS_WOUT : WS_WGO)), nb * 32, scr, lane); continue; }
        r -= 2 * I_GO;
        { const int nb = r % (D / 32), kb = r / (D / 32);
            tr_item(P.in[17] + nb * 32 + j, D, nullptr, 1.f, kb * 64, 2048, (bf16_t*)(ws + WS_WSO), nb * 32, scr, lane); }
    }
    const float* x = P.in[0]; bf16_t* xb = (bf16_t*)(ws + WS_XB); float* ssq = (float*)(ws + WS_SSQ);
    for (int m0 = gw; m0 < MTOK; m0 += 4 * NGW) {
        f32x4 v[4][4];
#pragma unroll
        for (int u = 0; u < 4; ++u) { const int m = m0 + u * NGW; if (m < MTOK) { const f32x4* xr = (const f32x4*)(x + (size_t)m * D) + lane;
#pragma unroll
            for (int jj = 0; jj < 4; ++jj) v[u][jj] = xr[64 * jj]; } }
#pragma unroll
        for (int u = 0; u < 4; ++u) { const int m = m0 + u * NGW; if (m < MTOK) {
            unsigned long long* o8 = (unsigned long long*)(xb + (size_t)m * D) + lane;
            float s = 0.f;
#pragma unroll
            for (int jj = 0; jj < 4; ++jj) { const f32x4 q = v[u][jj]; s += q.x * q.x + q.y * q.y + q.z * q.z + q.w * q.w;
                o8[64 * jj] = (unsigned long long)cvt_pk_bf16(q.x, q.y) | ((unsigned long long)cvt_pk_bf16(q.z, q.w) << 32); }
            s = wave_sum(s);
            if (lane == 0) { ssq[m] = s; ssq[MTOK + m] = 0.f; ssq[2 * MTOK + m] = 0.f; ssq[3 * MTOK + m] = 0.f; } } }
    }
}

__device__ __forceinline__ void p4_prep(KP Pp, LAS unsigned char* lds, int G) {
    const Params P = load_params(Pp);
    const int tid = tid_fresh();
    unsigned char* ws = P.ws; unsigned char* T = ws + WS_BIG;
    const float* sm = (const float*)(ws + WS_SM);
    for (int it = blockIdx.x; it < HB * NCH; it += G) {
        const int row0 = it * 64;
#pragma unroll
        for (int i = 0; i < 2; ++i) { const int idx = tid + 512 * i; *(LAS f32x4*)(lds + idx * 16) = *(const f32x4*)(sm + (size_t)row0 * 64 + idx * 4); }
        __syncthreads();
        {
            const int hc = tid;
            const float* wf = P.in[7]; float w[16];
#pragma unroll
            for (int j = 0; j < 16; ++j) w[j] = wf[j * 512 + hc];
            const float bfv = P.in[8][hc];
            float la[64]; float cum = 0.f;
#pragma unroll
            for (int t = 0; t < 64; ++t) { float z = bfv;
#pragma unroll
                for (int j4 = 0; j4 < 4; ++j4) { const f32x4 f = *(const LAS f32x4*)(lds + t * 256 + j4 * 16); z += f.x * w[4 * j4] + f.y * w[4 * j4 + 1] + f.z * w[4 * j4 + 2] + f.w * w[4 * j4 + 3]; }
                la[t] = (fminf(z, 0.f) - __logf(1.f + __expf(-fabsf(z)))) * (1.f / 16.f); cum += la[t]; }
            const float end = cum; cum = 0.f;
            bf16_t* kp = (bf16_t*)(T + T_K) + (size_t)row0 * 512 + hc;
#pragma unroll
            for (int tb = 0; tb < 4; ++tb) {
                bf16_t kk[16];
#pragma unroll
                for (int u = 0; u < 16; ++u) kk[u] = kp[(size_t)(tb * 16 + u) * 512];
#pragma unroll
                for (int u = 0; u < 16; ++u) { const int t = tb * 16 + u;
                    cum += la[t];
                    const float kv = __uint_as_float((unsigned)kk[u] << 16) * __expf(end - cum);
                    kp[(size_t)t * 512] = (bf16_t)(cvt_pk_bf16(kv, 0.f) & 0xffffu); }
            }
            ((float*)(ws + WS_DEC))[(size_t)it * 512 + hc] = __expf(end);
        }
        if (tid < 32) {
            const float bias = P.in[13][tid], A = -__expf(P.in[14][tid]);
            float cum = 0.f;
#pragma unroll 4
            for (int t = 0; t < 64; ++t) cum += softplusf_(*(const LAS float*)(lds + t * 256 + (16 + tid) * 4) + bias) * A;
            const float end = cum; cum = 0.f;
            float* wg = (float*)(ws + WS_WG);
#pragma unroll 4
            for (int t = 0; t < 64; ++t) { const float dt = softplusf_(*(const LAS float*)(lds + t * 256 + (16 + tid) * 4) + bias); cum += dt * A; wg[(size_t)(row0 + t) * 32 + tid] = __expf(end - cum) * dt; }
            ((float*)(ws + WS_DECS))[it * 32 + tid] = __expf(end);
        }
        __syncthreads();
    }
    const int co = tid & 63, rg = tid >> 6;
    u32x4 raw[11];
#define CONV_LOAD(itx) do { const int _ci = (itx) >> 3, _col = ((itx) & 7) * 512 + co * 8; \
        const bf16_t* _xp = (const bf16_t*)(T + T_XBC) + (size_t)(_ci * 64 + rg * 8) * 4096 + _col; \
        _Pragma("unroll") for (int i = 0; i < 8; ++i) raw[3 + i] = *(const u32x4*)(_xp + (size_t)i * 4096); \
        if (rg > 0) { _Pragma("unroll") for (int i = 0; i < 3; ++i) raw[i] = *(const u32x4*)(_xp - (size_t)(3 - i) * 4096); } \
        else if ((_ci & (NCH - 1)) != 0) { const bf16_t* _hp = (const bf16_t*)(ws + WS_HALO) + (size_t)(_ci - 1) * 3 * 4096 + _col; \
            _Pragma("unroll") for (int i = 0; i < 3; ++i) raw[i] = *(const u32x4*)(_hp + (size_t)i * 4096); } \
        else { _Pragma("unroll") for (int i = 0; i < 3; ++i) raw[i] = (u32x4){0u, 0u, 0u, 0u}; } } while (0)
    float cw[4][8], cbv[8];
    { const int colw = ((G & 7) == 0 ? ((int)blockIdx.x & 7) : 0) * 512 + co * 8;
#pragma unroll
      for (int k = 0; k < 4; ++k) { const f32x4 a = *(const f32x4*)(P.in[11] + k * 4096 + colw), b = *(const f32x4*)(P.in[11] + k * 4096 + colw + 4);
          cw[k][0] = a.x; cw[k][1] = a.y; cw[k][2] = a.z; cw[k][3] = a.w; cw[k][4] = b.x; cw[k][5] = b.y; cw[k][6] = b.z; cw[k][7] = b.w; }
      { const f32x4 a = *(const f32x4*)(P.in[12] + colw), b = *(const f32x4*)(P.in[12] + colw + 4);
          cbv[0] = a.x; cbv[1] = a.y; cbv[2] = a.z; cbv[3] = a.w; cbv[4] = b.x; cbv[5] = b.y; cbv[6] = b.z; cbv[7] = b.w; } }
    if ((int)blockIdx.x < HB * NCH * 8) CONV_LOAD((int)blockIdx.x);
    for (int it = blockIdx.x; it < HB * NCH * 8; it += G) {
        const int ci = it >> 3, cb = it & 7, col = cb * 512 + co * 8, row0 = ci * 64 + rg * 8;
        bf16_t* xp = (bf16_t*)(T + T_XBC) + (size_t)row0 * 4096 + col;
        if ((G & 7) != 0) {
#pragma unroll
            for (int k = 0; k < 4; ++k) { const f32x4 a = *(const f32x4*)(P.in[11] + k * 4096 + col), b = *(const f32x4*)(P.in[11] + k * 4096 + col + 4);
                cw[k][0] = a.x; cw[k][1] = a.y; cw[k][2] = a.z; cw[k][3] = a.w; cw[k][4] = b.x; cw[k][5] = b.y; cw[k][6] = b.z; cw[k][7] = b.w; }
            { const f32x4 a = *(const f32x4*)(P.in[12] + col), b = *(const f32x4*)(P.in[12] + col + 4);
                cbv[0] = a.x; cbv[1] = a.y; cbv[2] = a.z; cbv[3] = a.w; cbv[4] = b.x; cbv[5] = b.y; cbv[6] = b.z; cbv[7] = b.w; }
        }
        asm volatile("s_waitcnt vmcnt(0)" ::: "memory");
        __syncthreads();
        u32x4 outv[8];
#pragma unroll
        for (int i = 0; i < 8; ++i) {
            float v[8];
#pragma unroll
            for (int e = 0; e < 8; ++e) v[e] = cbv[e];
#pragma unroll
            for (int k = 0; k < 4; ++k) { const u32x4 q = raw[i + k];
                v[0] += cw[k][0] * bf_lo(q.x); v[1] += cw[k][1] * bf_hi(q.x); v[2] += cw[k][2] * bf_lo(q.y); v[3] += cw[k][3] * bf_hi(q.y);
                v[4] += cw[k][4] * bf_lo(q.z); v[5] += cw[k][5] * bf_hi(q.z); v[6] += cw[k][6] * bf_lo(q.w); v[7] += cw[k][7] * bf_hi(q.w); }
#pragma unroll
            for (int e = 0; e < 8; ++e) v[e] = siluf_(v[e]);
            outv[i].x = cvt_pk_bf16(v[0], v[1]); outv[i].y = cvt_pk_bf16(v[2], v[3]); outv[i].z = cvt_pk_bf16(v[4], v[5]); outv[i].w = cvt_pk_bf16(v[6], v[7]);
        }
        if (it + G < HB * NCH * 8) CONV_LOAD(it + G);
#pragma unroll
        for (int i = 0; i < 8; ++i) *(u32x4*)(xp + (size_t)i * 4096) = outv[i];
    }
#undef CONV_LOAD
}

struct MixArgs {
    const bf16_t* ak; int ld_ak;
    const bf16_t* qq; int ld_q;
    const bf16_t* bv; int ld_bv;
    const bf16_t* gt; int ld_g;
    bf16_t* out; int ld_o;
    const float* dec;
    const float* wg;
    const float* nw;
    const float* dsk;
};
constexpr int RSA = 320, RSB = 576, RSQ = 264, RSG = 520, RSX = 520;
constexpr int OFF_AK = 0, OFF_BV = 64 * RSA, OFF_QQ = OFF_BV + 64 * RSB, OFF_WGT = OFF_QQ + 64 * RSQ, OFF_DEC = OFF_WGT + 1024, OFF_RED = OFF_DEC + 512, OFF_NW = OFF_RED + 2048, OFF_GT = OFF_NW + 1024, OFF_XS2 = OFF_GT + 64 * RSG;
static_assert(OFF_XS2 + 64 * RSX <= LDS_XB, "mixer LDS");

#define LBAR() do { asm volatile("s_waitcnt lgkmcnt(0)" ::: "memory"); __builtin_amdgcn_s_barrier(); asm volatile("" ::: "memory"); } while (0)
template <bool SSD>
__device__ __forceinline__ void mixer_item(LAS unsigned char* lds, const MixArgs& a) {
    const int tid = tid_fresh(), lane = tid & 63, w = __builtin_amdgcn_readfirstlane(tid >> 6);
    const int r = lane & 31, h = lane >> 5, gg = lane >> 4, q = (lane & 15) >> 2, p = lane & 3;
    const int arow0 = tid >> 4, apc = tid & 15;
    const int brow0 = tid >> 5, bpc = tid & 31;
    u32x4 stA[2], stQ[2], stB[4], stG[4], stD; float stWp[4];
    stD = (u32x4){0u, 0u, 0u, 0u}; stWp[0] = stWp[1] = stWp[2] = stWp[3] = 0.f;
#define MIX_LOAD(c) do { const size_t _r0 = (size_t)(c) * 64; \
        _Pragma("unroll") for (int i = 0; i < 2; ++i) { stA[i] = *(const u32x4*)(a.ak + (_r0 + arow0 + 32 * i) * a.ld_ak + apc * 8); stQ[i] = *(const u32x4*)(a.qq + (_r0 + arow0 + 32 * i) * a.ld_q + apc * 8); } \
        _Pragma("unroll") for (int i = 0; i < 4; ++i) { stB[i] = *(const u32x4*)(a.bv + (_r0 + brow0 + 16 * i) * a.ld_bv + bpc * 8); stG[i] = *(const u32x4*)(a.gt + (_r0 + brow0 + 16 * i) * a.ld_g + bpc * 8); } \
        if (SSD) { _Pragma("unroll") for (int i = 0; i < 4; ++i) stWp[i] = a.wg[(_r0 + brow0 + 16 * i) * 32 + (bpc >> 3)]; }     \
        else { if (tid < 32) stD = *(const u32x4*)(a.dec + (size_t)(c) * 512 + tid * 4); } } while (0)
#define MIX_STORE() do { \
        _Pragma("unroll") for (int i = 0; i < 2; ++i) { *(LAS u32x4*)(lds + OFF_AK + (arow0 + 32 * i) * RSA + apc * 16) = stA[i]; \
            *(LAS u32x2*)(lds + OFF_QQ + (arow0 + 32 * i) * RSQ + apc * 16) = (u32x2){stQ[i].x, stQ[i].y}; *(LAS u32x2*)(lds + OFF_QQ + (arow0 + 32 * i) * RSQ + apc * 16 + 8) = (u32x2){stQ[i].z, stQ[i].w}; } \
        _Pragma("unroll") for (int i = 0; i < 4; ++i) { \
            if (SSD) { *(LAS u32x2*)(lds + OFF_XS2 + (brow0 + 16 * i) * RSX + bpc * 16) = (u32x2){stB[i].x, stB[i].y}; *(LAS u32x2*)(lds + OFF_XS2 + (brow0 + 16 * i) * RSX + bpc * 16 + 8) = (u32x2){stB[i].z, stB[i].w}; \
                const float _w = stWp[i]; u32x4 _b; _b.x = cvt_pk_bf16(bf_lo(stB[i].x) * _w, bf_hi(stB[i].x) * _w); _b.y = cvt_pk_bf16(bf_lo(stB[i].y) * _w, bf_hi(stB[i].y) * _w); \
                _b.z = cvt_pk_bf16(bf_lo(stB[i].z) * _w, bf_hi(stB[i].z) * _w); _b.w = cvt_pk_bf16(bf_lo(stB[i].w) * _w, bf_hi(stB[i].w) * _w); \
                *(LAS u32x4*)(lds + OFF_BV + (brow0 + 16 * i) * RSB + bpc * 16) = _b; } \
            else *(LAS u32x4*)(lds + OFF_BV + (brow0 + 16 * i) * RSB + bpc * 16) = stB[i]; \
            *(LAS u32x2*)(lds + OFF_GT + (brow0 + 16 * i) * RSG + bpc * 16) = (u32x2){stG[i].x, stG[i].y}; *(LAS u32x2*)(lds + OFF_GT + (brow0 + 16 * i) * RSG + bpc * 16 + 8) = (u32x2){stG[i].z, stG[i].w}; } \
        if (!SSD) { if (tid < 32) *(LAS u32x4*)(lds + OFF_DEC + tid * 16) = stD; } } while (0)

    if (tid < 256) *(LAS float*)(lds + OFF_NW + tid * 4) = a.nw[tid];
    MIX_LOAD(0);
    MIX_STORE();
    __syncthreads();

    f32x16 S[4];
#pragma unroll
    for (int i = 0; i < 4; ++i)
#pragma unroll
        for (int e = 0; e < 16; ++e) S[i][e] = 0.f;

    const int trA = OFF_AK + (8 * h + q) * RSA + (16 * (gg & 1) + 4 * p) * 2;
    const int trB = OFF_BV + (8 * h + q) * RSB + (32 * w + 16 * (gg & 1) + 4 * p) * 2;
    const int qB = OFF_QQ + r * RSQ + 8 * h;
    const int gB = OFF_GT + r * RSG + (32 * w + 4 * h) * 2;
    const float dsk = SSD ? a.dsk[w >> 1] : 0.f;
    float dc_next = SSD ? a.dec[w >> 1] : 0.f;

    for (int c = 0; c < NCH; ++c) {
        if (c + 1 < NCH) MIX_LOAD(c + 1);
        if (SSD) {
            const float dc = dc_next;
            if (c + 1 < NCH) dc_next = a.dec[(size_t)(c + 1) * 32 + (w >> 1)];
#pragma unroll
            for (int i = 0; i < 4; ++i)
#pragma unroll
                for (int e = 0; e < 16; ++e) S[i][e] *= dc;
        } else {
#pragma unroll
            for (int i = 0; i < 4; ++i)
#pragma unroll
                for (int g = 0; g < 4; ++g) { const f32x4 d4 = *(const LAS f32x4*)(lds + OFF_DEC + (32 * i + 8 * g + 4 * h) * 4);
                    S[i][4 * g + 0] *= d4.x; S[i][4 * g + 1] *= d4.y; S[i][4 * g + 2] *= d4.z; S[i][4 * g + 3] *= d4.w; }
        }
#define TRR(addr) __builtin_bit_cast(s16x4, __builtin_amdgcn_ds_read_tr16_b64_v4i16((LAS s16x4*)(lds + (addr))))
#define UPD_LOAD(s, B0, B1, A0, A1, W0, W1) do { B0 = TRR(trB + (16 * (s)) * RSB); B1 = TRR(trB + (16 * (s) + 4) * RSB); \
        _Pragma("unroll") for (int i = 0; i < 4; ++i) { A0[i] = TRR(trA + (16 * (s)) * RSA + 64 * i); A1[i] = TRR(trA + (16 * (s) + 4) * RSA + 64 * i); } \
        } while (0)
#define UPD_MMA(B0, B1, A0, A1, W0, W1) do { bf16x8 bfr = __builtin_shufflevector(B0, B1, 0, 1, 2, 3, 4, 5, 6, 7); \
        _Pragma("unroll") for (int i = 0; i < 4; ++i) S[i] = __builtin_amdgcn_mfma_f32_32x32x16_bf16(__builtin_shufflevector(A0[i], A1[i], 0, 1, 2, 3, 4, 5, 6, 7), bfr, S[i], 0, 0, 0); } while (0)
        {
            s16x4 xb0, xb1, xa0[4], xa1[4], yb0, yb1, ya0[4], ya1[4]; f32x4 xw0, xw1, yw0, yw1;
            xw0 = xw1 = yw0 = yw1 = (f32x4){0.f, 0.f, 0.f, 0.f};
            UPD_LOAD(0, xb0, xb1, xa0, xa1, xw0, xw1);
            UPD_LOAD(1, yb0, yb1, ya0, ya1, yw0, yw1);
            __builtin_amdgcn_sched_barrier(0);
            UPD_MMA(xb0, xb1, xa0, xa1, xw0, xw1);
            __builtin_amdgcn_sched_barrier(0);
            UPD_LOAD(2, xb0, xb1, xa0, xa1, xw0, xw1);
            __builtin_amdgcn_sched_barrier(0);
            UPD_MMA(yb0, yb1, ya0, ya1, yw0, yw1);
            __builtin_amdgcn_sched_barrier(0);
            UPD_LOAD(3, yb0, yb1, ya0, ya1, yw0, yw1);
            __builtin_amdgcn_sched_barrier(0);
            UPD_MMA(xb0, xb1, xa0, xa1, xw0, xw1);
            __builtin_amdgcn_sched_barrier(0);
            UPD_MMA(yb0, yb1, ya0, ya1, yw0, yw1);
        }
#undef UPD_LOAD
#undef UPD_MMA
        f32x16 OT[2];
#pragma unroll
        for (int j2 = 0; j2 < 2; ++j2)
#pragma unroll
            for (int e = 0; e < 16; ++e) OT[j2][e] = 0.f;
        {
            u32x2 qf[3][2][2];
#define Q_LOAD(sp, buf) do { _Pragma("unroll") for (int j2 = 0; j2 < 2; ++j2) { qf[buf][j2][0] = *(const LAS u32x2*)(lds + qB + 32 * j2 * RSQ + (16 * (sp)) * 2); qf[buf][j2][1] = *(const LAS u32x2*)(lds + qB + 32 * j2 * RSQ + (16 * (sp) + 8) * 2); } } while (0)
            Q_LOAD(0, 0); Q_LOAD(1, 1);
#pragma unroll
            for (int sp = 0; sp < 8; ++sp) {
                const int i = sp >> 1, o8 = 8 * (sp & 1);
                if (sp + 2 < 8) Q_LOAD(sp + 2, (sp + 2) % 3);
                u32x4 pk;
                pk.x = cvt_pk_bf16(S[i][o8 + 0], S[i][o8 + 1]); pk.y = cvt_pk_bf16(S[i][o8 + 2], S[i][o8 + 3]);
                pk.z = cvt_pk_bf16(S[i][o8 + 4], S[i][o8 + 5]); pk.w = cvt_pk_bf16(S[i][o8 + 6], S[i][o8 + 7]);
                const bf16x8 sfr = __builtin_bit_cast(bf16x8, pk);
                __builtin_amdgcn_sched_barrier(0);
#pragma unroll
                for (int j2 = 0; j2 < 2; ++j2) {
                    const bf16x8 qfr = __builtin_bit_cast(bf16x8, (u32x4){qf[sp % 3][j2][0].x, qf[sp % 3][j2][0].y, qf[sp % 3][j2][1].x, qf[sp % 3][j2][1].y});
                    OT[j2] = __builtin_amdgcn_mfma_f32_32x32x16_bf16(sfr, qfr, OT[j2], 0, 0, 0);
                }
                __builtin_amdgcn_sched_barrier(0);
            }
#undef Q_LOAD
        }
#undef TRR
        u32x2 gv[2][4];
#pragma unroll
        for (int j2 = 0; j2 < 2; ++j2)
#pragma unroll
            for (int g = 0; g < 4; ++g) gv[j2][g] = *(const LAS u32x2*)(lds + gB + 32 * j2 * RSG + 16 * g);
        float part[2] = {0.f, 0.f};
#pragma unroll
        for (int j2 = 0; j2 < 2; ++j2)
#pragma unroll
            for (int g = 0; g < 4; ++g) {
                if (SSD) {
                    const u32x2 xs = *(const LAS u32x2*)(lds + OFF_XS2 + (32 * j2 + r) * RSX + (32 * w + 8 * g + 4 * h) * 2);
                    OT[j2][4 * g + 0] = (OT[j2][4 * g + 0] + dsk * bf_lo(xs.x)) * bf_lo(gv[j2][g].x);
                    OT[j2][4 * g + 1] = (OT[j2][4 * g + 1] + dsk * bf_hi(xs.x)) * bf_hi(gv[j2][g].x);
                    OT[j2][4 * g + 2] = (OT[j2][4 * g + 2] + dsk * bf_lo(xs.y)) * bf_lo(gv[j2][g].y);
                    OT[j2][4 * g + 3] = (OT[j2][4 * g + 3] + dsk * bf_hi(xs.y)) * bf_hi(gv[j2][g].y);
                }
#pragma unroll
                for (int k = 0; k < 4; ++k) part[j2] += OT[j2][4 * g + k] * OT[j2][4 * g + k];
            }
        part[0] += __shfl_xor(part[0], 32); part[1] += __shfl_xor(part[1], 32);
        if (h == 0) { *(LAS float*)(lds + OFF_RED + (w * 64 + r) * 4) = part[0]; *(LAS float*)(lds + OFF_RED + (w * 64 + 32 + r) * 4) = part[1]; }
        LBAR();
#pragma unroll
        for (int j2 = 0; j2 < 2; ++j2) {
            float tot = 0.f;
#pragma unroll
            for (int ww = 0; ww < 8; ++ww) tot += *(const LAS float*)(lds + OFF_RED + (ww * 64 + 32 * j2 + r) * 4);
            const float rstd = rsqrtf(tot * (1.f / 256.f) + EPS);
#pragma unroll
            for (int g = 0; g < 4; ++g) {
                const f32x4 n4 = *(const LAS f32x4*)(lds + OFF_NW + (32 * w + 8 * g + 4 * h) * 4);
                float v0 = OT[j2][4 * g + 0] * rstd * n4.x, v1 = OT[j2][4 * g + 1] * rstd * n4.y, v2 = OT[j2][4 * g + 2] * rstd * n4.z, v3 = OT[j2][4 * g + 3] * rstd * n4.w;
                if (!SSD) { v0 *= bf_lo(gv[j2][g].x); v1 *= bf_hi(gv[j2][g].x); v2 *= bf_lo(gv[j2][g].y); v3 *= bf_hi(gv[j2][g].y); }
                *(LAS u32x2*)(lds + gB + 32 * j2 * RSG + 16 * g) = (u32x2){cvt_pk_bf16(v0, v1), cvt_pk_bf16(v2, v3)};
            }
        }
        LBAR();
#pragma unroll
        for (int i = 0; i < 4; ++i) {
            const u32x2 o0 = *(const LAS u32x2*)(lds + OFF_GT + (brow0 + 16 * i) * RSG + bpc * 16), o1 = *(const LAS u32x2*)(lds + OFF_GT + (brow0 + 16 * i) * RSG + bpc * 16 + 8);
            *(u32x4*)(a.out + ((size_t)c * 64 + brow0 + 16 * i) * a.ld_o + bpc * 8) = (u32x4){o0.x, o0.y, o1.x, o1.y};
        }
        if (c + 1 < NCH) MIX_STORE();
        LBAR();
    }
#undef MIX_LOAD
#undef MIX_STORE
}

__device__ __forceinline__ void p5_mixer(KP Pp, LAS unsigned char* lds, int G) {
    const Params P = load_params(Pp);
    unsigned char* ws = P.ws; unsigned char* T = ws + WS_BIG;
    for (int it = blockIdx.x; it < HB * 12; it += G) {
        const int b = it / 12, k = it % 12;
        const size_t row0 = (size_t)b * SEQ;
        MixArgs a;
        if (k < 4) {
            const int hd = k;
            a.ak = (const bf16_t*)(T + T_K) + row0 * 512 + hd * 128; a.ld_ak = 512;
            a.qq = (const bf16_t*)(T + T_Q) + row0 * 512 + hd * 128; a.ld_q = 512;
            a.bv = (const bf16_t*)(T + T_V) + row0 * 1024 + hd * 256; a.ld_bv = 1024;
            a.gt = (const bf16_t*)(T + T_SG) + row0 * 1024 + hd * 256; a.ld_g = 1024;
            a.out = (bf16_t*)(T + T_V) + row0 * 1024 + hd * 256; a.ld_o = 1024;
            a.dec = (const float*)(ws + WS_DEC) + (size_t)b * NCH * 512 + hd * 128;
            a.wg = nullptr; a.nw = P.in[9]; a.dsk = nullptr;
            mixer_item<false>(lds, a);
        } else {
            const int g = k - 4;
            const bf16_t* X = (const bf16_t*)(T + T_XBC) + row0 * 4096;
            a.ak = X + 2048 + g * 128; a.ld_ak = 4096;
            a.qq = X + 3072 + g * 128; a.ld_q = 4096;
            a.bv = X + g * 256; a.ld_bv = 4096;
            a.gt = (const bf16_t*)(T + T_SZ) + row0 * 2048 + g * 256; a.ld_g = 2048;
            a.out = (bf16_t*)(T + T_XBC) + row0 * 4096 + g * 256; a.ld_o = 4096;
            a.dec = (const float*)(ws + WS_DECS) + (size_t)b * NCH * 32 + g * 4;
            a.wg = (const float*)(ws + WS_WG) + row0 * 32 + g * 4;
            a.nw = P.in[16] + g * 256; a.dsk = P.in[15] + g * 4;
            mixer_item<true>(lds, a);
        }
        __syncthreads();
    }
}

__device__ __forceinline__ KP get_params() {
    KP p = (KP)__builtin_amdgcn_kernarg_segment_ptr(); asm volatile("" : "+s"(p)); return p;
}

#define XB_TMO      128
#define XB_XCNT(j)  (256  + 64 * (j))
#define XB_XSUB(j)  (1280 + 64 * (j))
#define XB_XGEN(j)  (2304 + 64 * (j))
#define XB_TOP      3328
#define XB_TOPGEN   3392
#define XCD_BAR_WORDS 3456
#define XB_SPIN_CAP (1u << 18)
__device__ __forceinline__ unsigned xb_ld(unsigned* p)              { return __hip_atomic_load(p, __ATOMIC_RELAXED, __HIP_MEMORY_SCOPE_AGENT); }
__device__ __forceinline__ unsigned xb_add(unsigned* p, unsigned v) { return __hip_atomic_fetch_add(p, v, __ATOMIC_RELAXED, __HIP_MEMORY_SCOPE_AGENT); }
__device__ __forceinline__ unsigned xb_xcc_id() { return (unsigned)__builtin_amdgcn_s_getreg((3 << 11) | 20) & 0xFu; }
#define XB_SPIN(cond, bar) do { unsigned _sp = 0; while (cond) { __builtin_amdgcn_s_sleep(1); \
    if ((++_sp & 255u) == 0u) { if (xb_ld(&(bar)[XB_TMO])) break; if (_sp > XB_SPIN_CAP) { atomicAdd(&(bar)[XB_TMO], 1u); break; } } } } while (0)
struct XcdBarrier { unsigned* bar; unsigned x; volatile LAS unsigned* st; };
__device__ __forceinline__ XcdBarrier xcd_barrier_post(unsigned* bar, volatile LAS unsigned* st) {
    XcdBarrier b; b.bar = bar; b.x = xb_xcc_id(); b.st = st;
    if (threadIdx.x == 0) (void)xb_add(&bar[XB_XCNT(b.x)], 1u);
    return b;
}
__device__ __forceinline__ void xcd_barrier_complete(unsigned* bar, unsigned x, unsigned& nloc, unsigned& nx) {
    const unsigned G = gridDim.x * gridDim.y * gridDim.z;
    unsigned sum, cnt, mine, sp = 0u;
    for (;;) {
        sum = 0u; cnt = 0u; mine = 0u;
#pragma unroll
        for (unsigned j = 0; j < 16; ++j) { const unsigned c = xb_ld(&bar[XB_XCNT(j)]); sum += c; cnt += (c > 0u) ? 1u : 0u; mine = (j == x) ? c : mine; }
        if (sum == G) break;
        __builtin_amdgcn_s_sleep(1);
        if ((++sp & 255u) == 0u) { if (xb_ld(&bar[XB_TMO])) break; if (sp > XB_SPIN_CAP) { atomicAdd(&bar[XB_TMO], 1u); break; } }
    }
    nloc = mine > 0u ? mine : 1u; nx = cnt > 0u ? cnt : 1u;
}
__device__ __forceinline__ void xcd_barrier(const XcdBarrier& b) {
    asm volatile("s_waitcnt vmcnt(0)" ::: "memory");
    __syncthreads();
    if (threadIdx.x == 0) {
        unsigned* bar = b.bar;
        __builtin_amdgcn_s_waitcnt(0);
        unsigned nloc = b.st[0], nx = b.st[1];
        if (nloc == 0u) { xcd_barrier_complete(bar, b.x, nloc, nx); b.st[0] = nloc; b.st[1] = nx; }
        const unsigned old = xb_add(&bar[XB_XSUB(b.x)], 1u);
        const unsigned gen = old / nloc;
        if (old + 1u == (gen + 1u) * nloc) {
            __builtin_amdgcn_fence(__ATOMIC_RELEASE, "agent");
            asm volatile("s_waitcnt vmcnt(0)" ::: "memory");
            const unsigned og = xb_add(&bar[XB_TOP], 1u);
            const unsigned tg = og / nx;
            if (og + 1u == (tg + 1u) * nx) xb_add(&bar[XB_TOPGEN], 1u);
            else XB_SPIN(xb_ld(&bar[XB_TOPGEN]) == tg, bar);
            __builtin_amdgcn_fence(__ATOMIC_ACQUIRE, "agent");
            xb_add(&bar[XB_XGEN(b.x)], 1u);
            asm volatile("s_waitcnt vmcnt(0)" ::: "memory");
        } else {
            XB_SPIN(xb_ld(&bar[XB_XGEN(b.x)]) == gen, bar);
            __builtin_amdgcn_fence(__ATOMIC_ACQUIRE, "agent");
            asm volatile("s_waitcnt vmcnt(0)" ::: "memory");
        }
    }
    __syncthreads();
}

#define PROBE_MASK 0x0
#define PROBE_DSYNC 0
#if PROBE_MASK
#define PH_BEGIN(i) const unsigned long long _t##i = __builtin_amdgcn_s_memrealtime();
#define PH_END(i) if ((PROBE_MASK >> (i)) & 1) probe_acc += __builtin_amdgcn_s_memrealtime() - _t##i;
#else
#define PH_BEGIN(i)
#define PH_END(i)
#endif
#if PROBE_DSYNC
#define GSYNC() do { xcd_barrier(xbar); xcd_barrier(xbar); } while (0)
#else
#define GSYNC() xcd_barrier(xbar)
#endif
__global__ void __launch_bounds__(512, 2) fwd_megakernel(Params Parg) {
    extern __shared__ __attribute__((aligned(16))) unsigned char lds_raw[];
    LAS unsigned char* lds = (LAS unsigned char*)lds_raw;
    cg::grid_group grid = cg::this_grid();
    const int G = gridDim.x;
    pg8::StaticOrder S;
#if PROBE_MASK
    unsigned long long probe_acc = 0;
#endif

    { unsigned* bw = (unsigned*)(get_params()->ws + WS_BAR);
      if (blockIdx.x == 0) for (int i = threadIdx.x; i < XCD_BAR_WORDS; i += 512) bw[i] = 0u;
      if (threadIdx.x < 2) *(volatile LAS unsigned*)(lds + LDS_XB + threadIdx.x * 4) = 0u; }
    XcdBarrier xbar;
    { PH_BEGIN(0) p0_prologue(get_params(), lds, G);
    grid.sync();
    xbar = xcd_barrier_post((unsigned*)(get_params()->ws + WS_BAR), (volatile LAS unsigned*)(lds + LDS_XB));
    PH_END(0) }
    { PH_BEGIN(1) { KP P = get_params(); unsigned char* ws = P->ws;
      pg8::Gemm g{(const bf16_t*)(ws + WS_XB), (const bf16_t*)(ws + WS_WGU1), MTOK, NGU, D, D, D}; S.init(MTOK, NGU, G, blockIdx.x);
      EpiGU E{(const float*)(ws + WS_SSQ), (bf16_t*)(ws + WS_BIG)}; pg8::gemm_phase(lds, g, S, E); }
    GSYNC(); PH_END(1) }
    { PH_BEGIN(2) { KP P = get_params(); unsigned char* ws = P->ws;
      pg8::Gemm g{(const bf16_t*)(ws + WS_BIG), (const bf16_t*)(ws + WS_WD1), MTOK, D, DFF, DFF, DFF}; S.init(MTOK, D, G, blockIdx.x);
      EpiRes E{P->in[0], P->out, (bf16_t*)(ws + WS_XB), (float*)(ws + WS_SSQ) + MTOK, 0.5f}; pg8::gemm_phase(lds, g, S, E); }
    GSYNC(); PH_END(2) }
    for (int hf = 0; hf < 2; ++hf) {
        const size_t r0 = (size_t)hf * MH;
        { PH_BEGIN(3) { KP P = get_params(); unsigned char* ws = P->ws;
          pg8::Gemm g{(const bf16_t*)(ws + WS_XB) + r0 * D, (const bf16_t*)(ws + WS_WIN), MH, NIN, D, D, D}; S.init(MH, NIN, G, blockIdx.x);
          EpiIn E{(const float*)(ws + WS_SSQ) + MTOK + r0, ws + WS_BIG, (bf16_t*)(ws + WS_HALO), (float*)(ws + WS_SM)}; pg8::gemm_phase(lds, g, S, E); }
        GSYNC(); PH_END(3) }
        { PH_BEGIN(4) p4_prep(get_params(), lds, G);
        GSYNC(); PH_END(4) }
        { PH_BEGIN(5) p5_mixer(get_params(), lds, G);
        GSYNC(); PH_END(5) }
        { PH_BEGIN(6) { KP P = get_params(); unsigned char* ws = P->ws; unsigned char* T = ws + WS_BIG;
          pg8::Gemm g{(const bf16_t*)(T + T_V), (const bf16_t*)(ws + WS_WGO), MH, D, D, D, D}; S.init(MH, D, G, blockIdx.x);
          EpiGate E{(const bf16_t*)(T + T_GT), nullptr, (bf16_t*)(T + T_T1), 0}; pg8::gemm_phase(lds, g, S, E); }
        { KP P = get_params(); unsigned char* ws = P->ws; unsigned char* T = ws + WS_BIG;
          pg8::Gemm g{(const bf16_t*)(T + T_XBC), (const bf16_t*)(ws + WS_WSO), MH, D, 2048, 4096, 2048}; S.init(MH, D, G, blockIdx.x);
          EpiGate E{(const bf16_t*)(T + T_GT), (const bf16_t*)(T + T_T1), (bf16_t*)(T + T_MRG), 1}; pg8::gemm_phase(lds, g, S, E); }
        GSYNC(); PH_END(6) }
        { PH_BEGIN(7) { KP P = get_params(); unsigned char* ws = P->ws;
          pg8::Gemm g{(const bf16_t*)(ws + WS_BIG + T_MRG), (const bf16_t*)(ws + WS_WOUT), MH, D, D, D, D}; S.init(MH, D, G, blockIdx.x);
          EpiRes E{P->out + r0 * D, P->out + r0 * D, (bf16_t*)(ws + WS_XB) + r0 * D, (float*)(ws + WS_SSQ) + 2 * MTOK + r0, 1.0f}; pg8::gemm_phase(lds, g, S, E); }
        GSYNC(); PH_END(7) }
    }
    { PH_BEGIN(8) { KP P = get_params(); unsigned char* ws = P->ws;
      pg8::Gemm g{(const bf16_t*)(ws + WS_XB), (const bf16_t*)(ws + WS_WGU2), MTOK, NGU, D, D, D}; S.init(MTOK, NGU, G, blockIdx.x);
      EpiGU E{(const float*)(ws + WS_SSQ) + 2 * MTOK, (bf16_t*)(ws + WS_BIG)}; pg8::gemm_phase(lds, g, S, E); }
    GSYNC(); PH_END(8) }
    { PH_BEGIN(9) { KP P = get_params(); unsigned char* ws = P->ws;
      pg8::Gemm g{(const bf16_t*)(ws + WS_BIG), (const bf16_t*)(ws + WS_WD2), MTOK, D, DFF, DFF, DFF}; S.init(MTOK, D, G, blockIdx.x);
      EpiRes E{P->out, P->out, nullptr, (float*)(ws + WS_SSQ) + 3 * MTOK, 0.5f}; pg8::gemm_phase(lds, g, S, E); }
    GSYNC(); PH_END(9) }
    { PH_BEGIN(10)
    {
        KP P = get_params(); const float* ssq = (const float*)(P->ws + WS_SSQ) + 3 * MTOK;
        const int tid = tid_fresh(), lane = tid & 63, gw = blockIdx.x * 8 + (tid >> 6), NGW = G * 8;
        const float* fw = P->in[23]; float* outp = P->out;
        for (int m = gw; m < MTOK; m += NGW) {
            const float rstd = rsqrtf(ssq[m] * (1.f / D) + EPS);
            f32x4* xr = (f32x4*)(outp + (size_t)m * D) + lane;
#pragma unroll
            for (int jj = 0; jj < 4; ++jj) { const f32x4 wv = ((const f32x4*)fw)[lane + 64 * jj]; f32x4 v = xr[64 * jj]; v = v * rstd; v.x *= wv.x; v.y *= wv.y; v.z *= wv.z; v.w *= wv.w; xr[64 * jj] = v; }
        }
    }
    PH_END(10) }
#if PROBE_MASK
    if (blockIdx.x == 0) {
        const unsigned long long t0 = __builtin_amdgcn_s_memrealtime();
        while (__builtin_amdgcn_s_memrealtime() - t0 < probe_acc) __builtin_amdgcn_s_sleep(8);
    }
#endif
}

extern "C" void kernel_launch(void* const* d_in, const int* in_sizes, int n_in, void* d_out, int out_size, void* d_ws, size_t ws_size, hipStream_t stream) {
    static int grid = 0;
    if (grid == 0) {
        if (n_in != 24 || ws_size < WS_NEED) { fprintf(stderr, "kernel_launch: unexpected n_in %d or ws_size %zu (need %zu)\n", n_in, ws_size, (size_t)WS_NEED); grid = -1; return; }
        int dev = 0, cus = 0, per_cu = 0;
        hipGetDevice(&dev);
        hipDeviceGetAttribute(&cus, hipDeviceAttributeMultiprocessorCount, dev);
        hipFuncSetAttribute((const void*)fwd_megakernel, hipFuncAttributeMaxDynamicSharedMemorySize, LDS_BYTES);
        hipOccupancyMaxActiveBlocksPerMultiprocessor(&per_cu, (const void*)fwd_megakernel, 512, LDS_BYTES);
        if (per_cu < 1) { fprintf(stderr, "kernel_launch: occupancy query gave %d\n", per_cu); per_cu = 1; }
        grid = cus * per_cu;
        (void)hipGetLastError();
    }
    if (grid < 0) return;
    Params p{};
    for (int i = 0; i < 24; ++i) p.in[i] = (const float*)d_in[i];
    p.out = (float*)d_out; p.ws = (unsigned char*)d_ws;
    void* args[] = {&p};
    hipError_t e = hipLaunchCooperativeKernel((const void*)fwd_megakernel, dim3(grid), dim3(512), args, LDS_BYTES, stream);
    if (e != hipSuccess) fprintf(stderr, "cooperative launch failed: %s (grid %d)\n", hipGetErrorString(e), grid);
}
```

```cpp
#include <hip/hip_runtime.h>
#include <hip/hip_cooperative_groups.h>
#include <cstdio>
#include <cstdint>
namespace cg = cooperative_groups;

#define LAS __attribute__((address_space(3)))
typedef unsigned short bf16_t;
typedef short bf16x8 __attribute__((ext_vector_type(8)));
typedef short s16x4 __attribute__((ext_vector_type(4)));
typedef float f32x4 __attribute__((ext_vector_type(4)));
typedef float f32x16 __attribute__((ext_vector_type(16)));
typedef unsigned u32x4 __attribute__((ext_vector_type(4)));
typedef unsigned u32x2 __attribute__((ext_vector_type(2)));

constexpr int D = 1024, BATCH = 32, SEQ = 2048, MTOK = BATCH * SEQ;
constexpr int NCH = SEQ / 64;
constexpr int DFF = 2816, NGU = 2 * DFF;
constexpr int IN_DIM = 11312, NIN = 45 * 256;
constexpr int HB = 16, MH = HB * SEQ;
constexpr float EPS = 1e-6f;

constexpr size_t MiB = 1u << 20;
constexpr size_t WS_SSQ = 0;
constexpr size_t WS_WGU1 = 1 * MiB, WS_WD1 = 12 * MiB, WS_WIN = 18 * MiB, WS_WGO = 41 * MiB, WS_WSO = 43 * MiB, WS_WOUT = 47 * MiB, WS_WGU2 = 49 * MiB, WS_WD2 = 60 * MiB;
constexpr size_t WS_DEC = 66 * MiB, WS_DECS = 67 * MiB, WS_WG = 68 * MiB, WS_HALO = 72 * MiB, WS_SM = 84 * MiB;
constexpr size_t WS_BAR = 92 * MiB;
constexpr size_t WS_XB = 96 * MiB;
constexpr size_t WS_BIG = 224 * MiB;
constexpr size_t T_Q = 0, T_K = 32 * MiB, T_V = 64 * MiB, T_SG = 128 * MiB, T_SZ = 192 * MiB, T_XBC = 320 * MiB, T_GT = 576 * MiB, T_END = 704 * MiB;
constexpr size_t T_T1 = T_Q, T_MRG = T_SG;
constexpr size_t WS_NEED = WS_BIG + T_END;

constexpr int LDS_MAIN = 131072, LDS_XB = 149504, LDS_BYTES = LDS_XB + 64;

__device__ __forceinline__ unsigned cvt_pk_bf16(float lo, float hi) { unsigned r; asm volatile("v_cvt_pk_bf16_f32 %0, %1, %2" : "=v"(r) : "v"(lo), "v"(hi)); return r; }
__device__ __forceinline__ float bf_lo(unsigned u) { return __uint_as_float(u << 16); }
__device__ __forceinline__ float bf_hi(unsigned u) { return __uint_as_float(u & 0xffff0000u); }
__device__ __forceinline__ float fast_rcp(float x) { return __builtin_amdgcn_rcpf(x); }
__device__ __forceinline__ float sigmoidf_(float x) { return fast_rcp(1.f + __expf(-x)); }
__device__ __forceinline__ float siluf_(float x) { return x * sigmoidf_(x); }
__device__ __forceinline__ float softplusf_(float x) { return fmaxf(x, 0.f) + __logf(1.f + __expf(-fabsf(x))); }
__device__ __forceinline__ float wave_sum(float v) {
#pragma unroll
    for (int o = 1; o < 64; o <<= 1) v += __shfl_xor(v, o);
    return v;
}

namespace pg8 {
constexpr int BM = 256, BK = 64, HALF = 128, HTB = HALF * BK * 2, STAGE_BYTES = 8 * HTB, NXCD = 8, WGM = 8;
__host__ __device__ __forceinline__ int lds_byte(int r, int c) { const int st = (r >> 4) * 2 + (c >> 5), rr = r & 15, cc = c & 31, ob = rr * 64 + cc * 2; return st * 1024 + (ob ^ (((ob >> 9) & 1) << 5)); }
__host__ __device__ __forceinline__ void stage_rc(int b, int& R, int& C) { const int st = b / 1024, sb = b % 1024, swz = sb ^ (((sb >> 9) & 1) << 5); R = (st >> 1) * 16 + swz / 64; C = (st & 1) * 32 + (swz % 64) / 2; }
__host__ __device__ __forceinline__ int perm32(int rho) { const int n = rho >> 4, i = rho & 15; return 8 * (i >> 2) + 4 * n + (i & 3); }

struct Unit { int pm, pn; };
struct Gemm { const bf16_t* A; const bf16_t* Bt; int M, N, K, lda, ldb; };

struct StaticOrder {
    int nM, nN, nwg, G, c;
    __device__ void init(int M, int N, int G_, int c_) { nM = M / BM; nN = N / BM; nwg = nM * nN; G = G_; c = c_; }
    __device__ bool next(int i, Unit& u) const {
        const long L = (long)i * G + c; if (L >= nwg) return false;
        int wgid = (int)L; { const int q = nwg / NXCD, r = nwg % NXCD, xcd = wgid % NXCD, off = wgid / NXCD; wgid = (xcd < r ? xcd * (q + 1) : r * (q + 1) + (xcd - r) * q) + off; }
        const int nig = WGM * nN, gid = wgid / nig, fm = gid * WGM, gsz = (nM - fm) < WGM ? (nM - fm) : WGM;
        u.pm = fm + ((wgid % nig) % gsz); u.pn = (wgid % nig) / gsz; return true;
    }
};

template <class Epi, bool ALIGN_EPI = true, bool SP2 = true>
__device__ __forceinline__ void gemm_phase(LAS unsigned char* lds, const Gemm g, const StaticOrder& S, const Epi& E) {
    int tid = threadIdx.x; asm volatile("" : "+v"(tid));
    const int wid = __builtin_amdgcn_readfirstlane(tid >> 6), lane = tid & 63, wr = wid >> 2, wc = wid & 3, fr = lane & 15, fq = lane >> 4;
    const int K = g.K, nt = K / BK;
    unsigned voffA[2], voffB[2];
#pragma unroll
    for (int i = 0; i < 2; ++i) { int R, C; stage_rc(tid * 16 + i * 8192, R, C); const int Rb = (R & ~31) + perm32(R & 31);
        voffA[i] = (unsigned)(R * g.lda + C) * 2u; voffB[i] = (unsigned)(Rb * g.ldb + C) * 2u; }
    const size_t kstep = (size_t)(BK * 2);
    const size_t hstA = (size_t)HALF * g.lda * 2, hstB = (size_t)HALF * g.ldb * 2;
    const size_t tstA = 2 * hstA, tstB = 2 * hstB;
    const unsigned ldsw = (unsigned)wid * 1024u;
    const int aoff = lds_byte(wr * 64 + fr, fq * 8), boff = lds_byte(wc * 32 + fr, fq * 8);
#define PG8_SA(b, h) (((b) * 2 + (h)) * HTB)
#define PG8_SB(b, h) ((4 + (b) * 2 + (h)) * HTB)
#define PG8_STAGE(bufoff, gbase, voff) do { _Pragma("unroll") for (int _i = 0; _i < 2; ++_i) \
        __builtin_amdgcn_global_load_lds((const unsigned*)((const char*)(gbase) + (voff)[_i]), (LAS unsigned*)(lds + (bufoff) + ldsw + _i * 8192), 16, 0, 0); } while (0)
#define PG8_LDA(dst, b, h) do { _Pragma("unroll") for (int m = 0; m < 4; ++m) _Pragma("unroll") for (int k = 0; k < 2; ++k) dst[m][k] = *(const LAS bf16x8*)(lds + PG8_SA(b, h) + aoff + m * 2048 + k * 1024); } while (0)
#define PG8_LDB(dst, b, h) do { _Pragma("unroll") for (int n = 0; n < 2; ++n) _Pragma("unroll") for (int k = 0; k < 2; ++k) dst[n][k] = *(const LAS bf16x8*)(lds + PG8_SB(b, h) + boff + n * 2048 + k * 1024); } while (0)
#define PG8_MMA(ai, bj, At, Bt) do { __builtin_amdgcn_s_setprio(1); _Pragma("unroll") for (int m = 0; m < 4; ++m) _Pragma("unroll") for (int n = 0; n < 2; ++n) _Pragma("unroll") for (int k = 0; k < 2; ++k) \
        acc[ai][bj][m][n] = __builtin_amdgcn_mfma_f32_16x16x32_bf16(Bt[n][k], At[m][k], acc[ai][bj][m][n], 0, 0, 0); __builtin_amdgcn_s_setprio(0); } while (0)
#define PG8_WAIT_V(n) asm volatile("s_waitcnt vmcnt(" #n ")" ::: "memory")
#define PG8_WAIT_L(n) asm volatile("s_waitcnt lgkmcnt(" #n ")" ::: "memory")
#define PG8_BAR __builtin_amdgcn_s_barrier()
#define PG8_SCHED __builtin_amdgcn_sched_barrier(0)
    Unit cur, nxt; int ui = 0;
    if (!S.next(0, cur)) return;
    f32x4 acc[2][2][4][2];
#pragma unroll
    for (int a = 0; a < 2; ++a)
#pragma unroll
        for (int b = 0; b < 2; ++b)
#pragma unroll
            for (int m = 0; m < 4; ++m)
#pragma unroll
                for (int n = 0; n < 2; ++n) acc[a][b][m][n] = (f32x4){0.f, 0.f, 0.f, 0.f};
    bf16x8 At[4][2], B0[2][2], B1[2][2];
    const char* cA = (const char*)g.A + (size_t)cur.pm * tstA; const char* cB = (const char*)g.Bt + (size_t)cur.pn * tstB;
    if constexpr (SP2) {
        PG8_STAGE(PG8_SB(0, 0), cB, voffB); PG8_STAGE(PG8_SB(0, 1), cB + hstB, voffB); PG8_STAGE(PG8_SA(0, 0), cA, voffA); PG8_STAGE(PG8_SA(0, 1), cA + hstA, voffA);
        if (wr == 1) PG8_BAR;
        PG8_WAIT_V(2); PG8_BAR;
        PG8_STAGE(PG8_SB(1, 0), cB + kstep, voffB); PG8_STAGE(PG8_SA(1, 0), cA + kstep, voffA); PG8_STAGE(PG8_SB(1, 1), cB + hstB + kstep, voffB);
        PG8_WAIT_V(6); PG8_BAR;
    } else {
    PG8_STAGE(PG8_SB(0, 0), cB, voffB); PG8_STAGE(PG8_SA(0, 0), cA, voffA); PG8_STAGE(PG8_SB(0, 1), cB + hstB, voffB); PG8_STAGE(PG8_SA(0, 1), cA + hstA, voffA);
    if (wr == 1) PG8_BAR;
    PG8_WAIT_V(4); PG8_BAR;
    PG8_STAGE(PG8_SB(1, 0), cB + kstep, voffB); PG8_STAGE(PG8_SA(1, 0), cA + kstep, voffA); PG8_STAGE(PG8_SB(1, 1), cB + hstB + kstep, voffB);
    PG8_WAIT_V(6); PG8_BAR;
    }
    for (;;) {
        const bool has_next = S.next(ui + 1, nxt);
        const char* nA = has_next ? (const char*)g.A + (size_t)nxt.pm * tstA : cA; const char* nB = has_next ? (const char*)g.Bt + (size_t)nxt.pn * tstB : cB;
        for (int t = 0; t < nt; t += 2) {
            const bool last = (t == nt - 2);
            const char* a1 = cA + (size_t)(t + 1) * kstep;
            const char* a2 = last ? nA : cA + (size_t)(t + 2) * kstep; const char* b2 = last ? nB : cB + (size_t)(t + 2) * kstep;
            const char* a3 = a2 + kstep; const char* b3 = b2 + kstep;
            if constexpr (SP2) {
            PG8_LDB(B0, 0, 0); PG8_LDB(B1, 0, 1); PG8_SCHED; PG8_LDA(At, 0, 0); PG8_STAGE(PG8_SA(1, 1), a1 + hstA, voffA);
            PG8_WAIT_V(8); PG8_WAIT_L(0); PG8_BAR; PG8_MMA(0, 0, At, B0); PG8_MMA(0, 1, At, B1); PG8_BAR; PG8_SCHED;
            PG8_LDA(At, 0, 1); PG8_STAGE(PG8_SB(0, 0), b2, voffB); PG8_STAGE(PG8_SB(0, 1), b2 + hstB, voffB); PG8_STAGE(PG8_SA(0, 0), a2, voffA);
            PG8_WAIT_V(8); PG8_WAIT_L(0); PG8_BAR; PG8_MMA(1, 0, At, B0); PG8_MMA(1, 1, At, B1); PG8_BAR; PG8_SCHED;
            PG8_LDB(B0, 1, 0); PG8_LDB(B1, 1, 1); PG8_SCHED; PG8_LDA(At, 1, 0); PG8_STAGE(PG8_SA(0, 1), a2 + hstA, voffA);
            PG8_WAIT_V(8); PG8_WAIT_L(0); PG8_BAR; PG8_MMA(0, 0, At, B0); PG8_MMA(0, 1, At, B1); PG8_BAR; PG8_SCHED;
            PG8_LDA(At, 1, 1); PG8_STAGE(PG8_SB(1, 0), b3, voffB); PG8_STAGE(PG8_SB(1, 1), b3 + hstB, voffB); PG8_STAGE(PG8_SA(1, 0), a3, voffA);
            PG8_WAIT_V(8); PG8_WAIT_L(0); PG8_BAR; PG8_MMA(1, 0, At, B0); PG8_MMA(1, 1, At, B1); PG8_BAR; PG8_SCHED;
            } else {
            PG8_LDB(B0, 0, 0); PG8_SCHED; PG8_LDA(At, 0, 0); PG8_STAGE(PG8_SA(1, 1), a1 + hstA, voffA);
            PG8_WAIT_L(8); PG8_BAR; PG8_WAIT_L(0); PG8_MMA(0, 0, At, B0); PG8_BAR; PG8_SCHED;
            PG8_LDB(B1, 0, 1); PG8_STAGE(PG8_SB(0, 0), b2, voffB);
            PG8_BAR; PG8_WAIT_L(0); PG8_MMA(0, 1, At, B1); PG8_BAR;
            PG8_LDA(At, 0, 1); PG8_STAGE(PG8_SA(0, 0), a2, voffA);
            PG8_BAR; PG8_WAIT_L(0); PG8_MMA(1, 0, At, B0); PG8_BAR; PG8_SCHED;
            PG8_STAGE(PG8_SB(0, 1), b2 + hstB, voffB);
            PG8_WAIT_V(6); PG8_BAR; PG8_MMA(1, 1, At, B1); PG8_BAR;
            PG8_LDB(B0, 1, 0); PG8_SCHED; PG8_LDA(At, 1, 0); PG8_STAGE(PG8_SA(0, 1), a2 + hstA, voffA);
            PG8_WAIT_L(8); PG8_BAR; PG8_WAIT_L(0); PG8_MMA(0, 0, At, B0); PG8_BAR; PG8_SCHED;
            PG8_LDB(B1, 1, 1); PG8_STAGE(PG8_SB(1, 0), b3, voffB);
            PG8_BAR; PG8_WAIT_L(0); PG8_MMA(0, 1, At, B1); PG8_BAR;
            PG8_LDA(At, 1, 1); PG8_STAGE(PG8_SA(1, 0), a3, voffA);
            PG8_BAR; PG8_WAIT_L(0); PG8_MMA(1, 0, At, B0); PG8_BAR; PG8_SCHED;
            PG8_STAGE(PG8_SB(1, 1), b3 + hstB, voffB);
            PG8_WAIT_V(6); PG8_BAR; PG8_MMA(1, 1, At, B1); PG8_BAR;
            }
        }
        if constexpr (ALIGN_EPI) { if (wr == 0) PG8_BAR; }
        E(acc, cur, wr, wc, fr, fq);
        if (!has_next) break;
#pragma unroll
        for (int a = 0; a < 2; ++a)
#pragma unroll
            for (int b = 0; b < 2; ++b)
#pragma unroll
                for (int m = 0; m < 4; ++m)
#pragma unroll
                    for (int n = 0; n < 2; ++n) acc[a][b][m][n] = (f32x4){0.f, 0.f, 0.f, 0.f};
        cur = nxt; cA = nA; cB = nB; ++ui;
        if constexpr (ALIGN_EPI) { if (wr == 1) PG8_BAR; }
    }
    PG8_WAIT_V(0);
    if constexpr (!ALIGN_EPI) { if (wr == 0) PG8_BAR; }
    PG8_BAR;
#undef PG8_SA
#undef PG8_SB
#undef PG8_STAGE
#undef PG8_LDA
#undef PG8_LDB
#undef PG8_MMA
#undef PG8_WAIT_V
#undef PG8_WAIT_L
#undef PG8_BAR
#undef PG8_SCHED
}
}

typedef f32x4 AccT[2][2][4][2];

struct EpiGU {
    const float* ssq; bf16_t* O;
    __device__ __forceinline__ void operator()(const AccT& acc, const pg8::Unit& u, int wr, int wc, int fr, int fq) const {
        const int row0 = u.pm * 256 + wr * 64 + fr, col0 = u.pn * 128 + wc * 32 + 8 * fq;
        float rs[2][4];
#pragma unroll
        for (int ai = 0; ai < 2; ++ai)
#pragma unroll
            for (int m = 0; m < 4; ++m) rs[ai][m] = ssq[row0 + ai * 128 + m * 16];
        __builtin_amdgcn_sched_barrier(0);
#pragma unroll
        for (int ai = 0; ai < 2; ++ai)
#pragma unroll
            for (int m = 0; m < 4; ++m) {
                const int row = row0 + ai * 128 + m * 16;
                const float rstd = rsqrtf(rs[ai][m] * (1.f / D) + EPS);
                float v[8];
#pragma unroll
                for (int n = 0; n < 2; ++n)
#pragma unroll
                    for (int j = 0; j < 4; ++j) { const float gg = acc[ai][0][m][n][j] * rstd, uu = acc[ai][1][m][n][j] * rstd; v[4 * n + j] = siluf_(gg) * uu; }
                u32x4 w; w.x = cvt_pk_bf16(v[0], v[1]); w.y = cvt_pk_bf16(v[2], v[3]); w.z = cvt_pk_bf16(v[4], v[5]); w.w = cvt_pk_bf16(v[6], v[7]);
                *(u32x4*)(O + (size_t)row * DFF + col0) = w;
            }
    }
};
struct EpiRes {
    bf16_t* xb; float* ssq; float alpha;
    __device__ __forceinline__ void operator()(const AccT& acc, const pg8::Unit& u, int wr, int wc, int fr, int fq) const {
        const int row0 = u.pm * 256 + wr * 64 + fr, col0 = u.pn * 256 + wc * 32 + 8 * fq;
        u32x4 xv[2][4][2];
#pragma unroll
        for (int ai = 0; ai < 2; ++ai)
#pragma unroll
            for (int m = 0; m < 4; ++m)
#pragma unroll
                for (int bj = 0; bj < 2; ++bj) xv[ai][m][bj] = *(const u32x4*)(xb + (size_t)(row0 + ai * 128 + m * 16) * D + col0 + bj * 128);
        __builtin_amdgcn_sched_barrier(0);
#pragma unroll
        for (int ai = 0; ai < 2; ++ai)
#pragma unroll
            for (int m = 0; m < 4; ++m) {
                const int row = row0 + ai * 128 + m * 16;
                float s = 0.f;
#pragma unroll
                for (int bj = 0; bj < 2; ++bj) {
                    const u32x4 q = xv[ai][m][bj];
                    float y[8];
                    y[0] = bf_lo(q.x) + acc[ai][bj][m][0].x * alpha; y[1] = bf_hi(q.x) + acc[ai][bj][m][0].y * alpha; y[2] = bf_lo(q.y) + acc[ai][bj][m][0].z * alpha; y[3] = bf_hi(q.y) + acc[ai][bj][m][0].w * alpha;
                    y[4] = bf_lo(q.z) + acc[ai][bj][m][1].x * alpha; y[5] = bf_hi(q.z) + acc[ai][bj][m][1].y * alpha; y[6] = bf_lo(q.w) + acc[ai][bj][m][1].z * alpha; y[7] = bf_hi(q.w) + acc[ai][bj][m][1].w * alpha;
#pragma unroll
                    for (int e = 0; e < 8; ++e) s += y[e] * y[e];
                    u32x4 w; w.x = cvt_pk_bf16(y[0], y[1]); w.y = cvt_pk_bf16(y[2], y[3]); w.z = cvt_pk_bf16(y[4], y[5]); w.w = cvt_pk_bf16(y[6], y[7]);
                    *(u32x4*)(xb + (size_t)row * D + col0 + bj * 128) = w;
                }
                s += __shfl_xor(s, 16); s += __shfl_xor(s, 32);
                if (fq == 0) atomicAdd(ssq + row, s);
            }
    }
};
struct EpiIn {
    const float* ssq; unsigned char* T; bf16_t* halo; float* sm;
    __device__ __forceinline__ void operator()(const AccT& acc, const pg8::Unit& u, int wr, int wc, int fr, int fq) const {
        const int pn = u.pn;
        const int row0 = u.pm * 256 + wr * 64 + fr;
        float rs[2][4];
#pragma unroll
        for (int ai = 0; ai < 2; ++ai)
#pragma unroll
            for (int m = 0; m < 4; ++m) rs[ai][m] = ssq[row0 + ai * 128 + m * 16];
        __builtin_amdgcn_sched_barrier(0);
        int act = 0, ld, ct; bf16_t* base;
        if (pn < 2) { base = (bf16_t*)(T + T_Q); ld = 512; ct = pn; }
        else if (pn < 4) { base = (bf16_t*)(T + T_K); ld = 512; ct = pn - 2; }
        else if (pn < 8) { base = (bf16_t*)(T + T_V); ld = 1024; ct = pn - 4; }
        else if (pn < 12) { base = (bf16_t*)(T + T_SG); ld = 1024; ct = pn - 8; act = 1; }
        else if (pn < 20) { base = (bf16_t*)(T + T_SZ); ld = 2048; ct = pn - 12; act = 1; }
        else if (pn < 36) { base = (bf16_t*)(T + T_XBC); ld = 4096; ct = pn - 20; act = 3; }
        else if (pn < 44) { base = (bf16_t*)(T + T_GT); ld = 2048; ct = pn - 36; act = 2; }
        else { base = nullptr; ld = 0; ct = 0; act = 4; }
        if (act == 4) {
            if (wc < 2) {
#pragma unroll
                for (int ai = 0; ai < 2; ++ai)
#pragma unroll
                    for (int m = 0; m < 4; ++m) {
                        const int row = row0 + ai * 128 + m * 16;
                        const float rstd = rsqrtf(rs[ai][m] * (1.f / D) + EPS);
                        float* p = sm + (size_t)row * 64 + wc * 32 + 8 * fq;
                        *(f32x4*)p = acc[ai][0][m][0] * rstd; *(f32x4*)(p + 4) = acc[ai][0][m][1] * rstd;
                    }
            }
            return;
        }
        const int col0 = ct * 256 + wc * 32 + 8 * fq;
#pragma unroll
        for (int ai = 0; ai < 2; ++ai)
#pragma unroll
            for (int m = 0; m < 4; ++m) {
                const int row = row0 + ai * 128 + m * 16;
                const float rstd = rsqrtf(rs[ai][m] * (1.f / D) + EPS);
#pragma unroll
                for (int bj = 0; bj < 2; ++bj) {
                    float v[8];
#pragma unroll
                    for (int n = 0; n < 2; ++n)
#pragma unroll
                        for (int j = 0; j < 4; ++j) { float x = acc[ai][bj][m][n][j] * rstd; if (act == 1) x = siluf_(x); else if (act == 2) x = sigmoidf_(x); v[4 * n + j] = x; }
                    u32x4 w; w.x = cvt_pk_bf16(v[0], v[1]); w.y = cvt_pk_bf16(v[2], v[3]); w.z = cvt_pk_bf16(v[4], v[5]); w.w = cvt_pk_bf16(v[6], v[7]);
                    *(u32x4*)(base + (size_t)row * ld + col0 + bj * 128) = w;
                    if (act == 3 && (row & 63) >= 61) *(u32x4*)(halo + ((size_t)(row >> 6) * 3 + ((row & 63) - 61)) * 4096 + col0 + bj * 128) = w;
                }
            }
    }
};
struct EpiGate {
    const bf16_t* gt; const bf16_t* t1; bf16_t* out; int mode;
    __device__ __forceinline__ void operator()(const AccT& acc, const pg8::Unit& u, int wr, int wc, int fr, int fq) const {
        const int row0 = u.pm * 256 + wr * 64 + fr, col0 = u.pn * 256 + wc * 32 + 8 * fq;
#pragma unroll
        for (int ai = 0; ai < 2; ++ai) {
            u32x4 gq[4][2], tq[4][2];
#pragma unroll
            for (int m = 0; m < 4; ++m)
#pragma unroll
                for (int bj = 0; bj < 2; ++bj) { const int row = row0 + ai * 128 + m * 16, col = col0 + bj * 128;
                    gq[m][bj] = *(const u32x4*)(gt + (size_t)row * 2048 + mode * 1024 + col);
                    tq[m][bj] = mode ? *(const u32x4*)(t1 + (size_t)row * D + col) : (u32x4){0u, 0u, 0u, 0u}; }
            __builtin_amdgcn_sched_barrier(0);
#pragma unroll
            for (int m = 0; m < 4; ++m)
#pragma unroll
                for (int bj = 0; bj < 2; ++bj) {
                    const int row = row0 + ai * 128 + m * 16, col = col0 + bj * 128;
                    const u32x4 g4 = gq[m][bj], t4 = tq[m][bj];
                    float v[8];
                    v[0] = acc[ai][bj][m][0].x * bf_lo(g4.x); v[1] = acc[ai][bj][m][0].y * bf_hi(g4.x); v[2] = acc[ai][bj][m][0].z * bf_lo(g4.y); v[3] = acc[ai][bj][m][0].w * bf_hi(g4.y);
                    v[4] = acc[ai][bj][m][1].x * bf_lo(g4.z); v[5] = acc[ai][bj][m][1].y * bf_hi(g4.z); v[6] = acc[ai][bj][m][1].z * bf_lo(g4.w); v[7] = acc[ai][bj][m][1].w * bf_hi(g4.w);
                    if (mode) { v[0] += bf_lo(t4.x); v[1] += bf_hi(t4.x); v[2] += bf_lo(t4.y); v[3] += bf_hi(t4.y); v[4] += bf_lo(t4.z); v[5] += bf_hi(t4.z); v[6] += bf_lo(t4.w); v[7] += bf_hi(t4.w); }
                    u32x4 w; w.x = cvt_pk_bf16(v[0], v[1]); w.y = cvt_pk_bf16(v[2], v[3]); w.z = cvt_pk_bf16(v[4], v[5]); w.w = cvt_pk_bf16(v[6], v[7]);
                    *(u32x4*)(out + (size_t)row * D + col) = w;
                }
        }
    }
};

__device__ __forceinline__ void tr_item(const float* srcp, int ld, const float* sk, float mul, int k0, int K, bf16_t* dst, int n0, LAS float* scr, int lane) {
#pragma unroll 16
    for (int i = 0; i < 32; ++i) { const int kk = 2 * i + (lane >> 5);
        float v = 0.f; if (srcp) v = srcp[(size_t)(k0 + kk) * ld] * (sk ? sk[k0 + kk] : 1.f) * mul;
        scr[kk * 33 + (lane & 31)] = v; }
    asm volatile("s_waitcnt lgkmcnt(0)" ::: "memory");
    const int c = lane & 7;
#pragma unroll
    for (int j = 0; j < 4; ++j) { const int n = (lane >> 3) + 8 * j; const LAS float* s = scr + (8 * c) * 33 + n;
        u32x4 o; o.x = cvt_pk_bf16(s[0 * 33], s[1 * 33]); o.y = cvt_pk_bf16(s[2 * 33], s[3 * 33]); o.z = cvt_pk_bf16(s[4 * 33], s[5 * 33]); o.w = cvt_pk_bf16(s[6 * 33], s[7 * 33]);
        *(u32x4*)(dst + (size_t)(n0 + n) * K + k0 + 8 * c) = o; }
    asm volatile("s_waitcnt lgkmcnt(0)" ::: "memory");
}
__device__ __forceinline__ int win_src_col(int nd) {
    if (nd < 3072) return nd;
    if (nd < 5120) return 3088 + (nd - 3072);
    if (nd < 9216) return 5136 + (nd - 5120);
    if (nd < 11264) return 9264 + (nd - 9216);
    if (nd < 11280) return 3072 + (nd - 11264);
    if (nd < 11312) return 9232 + (nd - 11280);
    return -1;
}

struct Params {
    const float* in[24];
    float* out;
    unsigned char* ws;
};

typedef __attribute__((address_space(4))) const Params* KP;
__device__ __forceinline__ Params load_params(KP p) { Params r;
#pragma unroll
    for (int i = 0; i < 24; ++i) r.in[i] = p->in[i];
    r.out = p->out; r.ws = p->ws; return r; }
__device__ __forceinline__ int tid_fresh() { int t = threadIdx.x; asm volatile("" : "+v"(t)); return t; }
__device__ __forceinline__ void p0_prologue(KP Pp, LAS unsigned char* lds, int G) {
    const Params P = load_params(Pp);
    const int tid = tid_fresh(), lane = tid & 63, wave = tid >> 6;
    LAS float* scr = (LAS float*)(lds + wave * 16384);
    const int gw = blockIdx.x * 8 + wave, NGW = G * 8;
    unsigned char* ws = P.ws;
    constexpr int I_GU = (D / 64) * (NGU / 32), I_DN = (DFF / 64) * (D / 32), I_IN = (D / 64) * (NIN / 32), I_GO = (D / 64) * (D / 32), I_SO = (2048 / 64) * (D / 32);
    constexpr int NITEMS = 2 * I_GU + 2 * I_DN + I_IN + 2 * I_GO + I_SO;
    for (int it = gw; it < NITEMS; it += NGW) {
        int r = it; const int j = lane & 31;
        if (r < 2 * I_GU) { const int l2 = r >= I_GU; r -= l2 * I_GU; const int nb = r % (NGU / 32), kb = r / (NGU / 32); const int nd = nb * 32 + j, tile = nd >> 8, w = nd & 255;
            const float* Wg = P.in[l2 ? 20 : 2]; const float* Wu = P.in[l2 ? 21 : 3];
            const float* sp = (w < 128 ? Wg : Wu) + 128 * tile + (w & 127);
            tr_item(sp, DFF, P.in[l2 ? 19 : 1], 1.f, kb * 64, D, (bf16_t*)(ws + (l2 ? WS_WGU2 : WS_WGU1)), nb * 32, scr, lane); continue; }
        r -= 2 * I_GU;
        if (r < 2 * I_DN) { const int l2 = r >= I_DN; r -= l2 * I_DN; const int nb = r % (D / 32), kb = r / (D / 32);
            tr_item(P.in[l2 ? 22 : 4] + nb * 32 + j, D, nullptr, 1.f, kb * 64, DFF, (bf16_t*)(ws + (l2 ? WS_WD2 : WS_WD1)), nb * 32, scr, lane); continue; }
        r -= 2 * I_DN;
        if (r < I_IN) { const int nb = r % (NIN / 32), kb = r / (NIN / 32); const int nd = nb * 32 + j, sc = win_src_col(nd);
            tr_item(sc >= 0 ? P.in[6] + sc : nullptr, IN_DIM, P.in[5], nd < 512 ? 0.08838834764831845f : 1.f, kb * 64, D, (bf16_t*)(ws + WS_WIN), nb * 32, scr, lane); continue; }
        r -= I_IN;
        if (r < 2 * I_GO) { const int l2 = r >= I_GO; r -= l2 * I_GO; const int nb = r % (D / 32), kb = r / (D / 32);
            tr_item(P.in[l2 ? 18 : 10] + nb * 32 + j, D, nullptr, 1.f, kb * 64, D, (bf16_t*)(ws + (l2 ? WS_WOUT : WS_WGO)), nb * 32, scr, lane); continue; }
        r -= 2 * I_GO;
        { const int nb = r % (D / 32), kb = r / (D / 32);
            tr_item(P.in[17] + nb * 32 + j, D, nullptr, 1.f, kb * 64, 2048, (bf16_t*)(ws + WS_WSO), nb * 32, scr, lane); }
    }
    const float* x = P.in[0]; bf16_t* xb = (bf16_t*)(ws + WS_XB); float* ssq = (float*)(ws + WS_SSQ);
    for (int m0 = gw; m0 < MTOK; m0 += 4 * NGW) {
        f32x4 v[4][4];
#pragma unroll
        for (int u = 0; u < 4; ++u) { const int m = m0 + u * NGW; if (m < MTOK) { const f32x4* xr = (const f32x4*)(x + (size_t)m * D) + lane;
#pragma unroll
            for (int jj = 0; jj < 4; ++jj) v[u][jj] = xr[64 * jj]; } }
#pragma unroll
        for (int u = 0; u < 4; ++u) { const int m = m0 + u * NGW; if (m < MTOK) {
            unsigned long long* o8 = (unsigned long long*)(xb + (size_t)m * D) + lane;
            float s = 0.f;
#pragma unroll
            for (int jj = 0; jj < 4; ++jj) { const f32x4 q = v[u][jj]; s += q.x * q.x + q.y * q.y + q.z * q.z + q.w * q.w;
                o8[64 * jj] = (unsigned long long)cvt_pk_bf16(q.x, q.y) | ((unsigned long long)cvt_pk_bf16(q.z, q.w) << 32); }
            s = wave_sum(s);
            if (lane == 0) { ssq[m] = s; ssq[MTOK + m] = 0.f; ssq[2 * MTOK + m] = 0.f; ssq[3 * MTOK + m] = 0.f; } } }
    }
}

__device__ __forceinline__ void p4_prep(KP Pp, LAS unsigned char* lds, int G) {
    const Params P = load_params(Pp);
    const int tid = tid_fresh();
    unsigned char* ws = P.ws; unsigned char* T = ws + WS_BIG;
    const float* sm = (const float*)(ws + WS_SM);
    for (int it = blockIdx.x; it < HB * NCH; it += G) {
        const int row0 = it * 64;
#pragma unroll
        for (int i = 0; i < 2; ++i) { const int idx = tid + 512 * i; *(LAS f32x4*)(lds + idx * 16) = *(const f32x4*)(sm + (size_t)row0 * 64 + idx * 4); }
        __syncthreads();
        {
            const int hc = tid;
            const float* wf = P.in[7]; float w[16];
#pragma unroll
            for (int j = 0; j < 16; ++j) w[j] = wf[j * 512 + hc];
            const float bfv = P.in[8][hc];
            float la[64]; float cum = 0.f;
#pragma unroll
            for (int t = 0; t < 64; ++t) { float z = bfv;
#pragma unroll
                for (int j4 = 0; j4 < 4; ++j4) { const f32x4 f = *(const LAS f32x4*)(lds + t * 256 + j4 * 16); z += f.x * w[4 * j4] + f.y * w[4 * j4 + 1] + f.z * w[4 * j4 + 2] + f.w * w[4 * j4 + 3]; }
                la[t] = (fminf(z, 0.f) - __logf(1.f + __expf(-fabsf(z)))) * (1.f / 16.f); cum += la[t]; }
            const float end = cum; cum = 0.f;
            bf16_t* kp = (bf16_t*)(T + T_K) + (size_t)row0 * 512 + hc;
#pragma unroll
            for (int tb = 0; tb < 4; ++tb) {
                bf16_t kk[16];
#pragma unroll
                for (int u = 0; u < 16; ++u) kk[u] = kp[(size_t)(tb * 16 + u) * 512];
#pragma unroll
                for (int u = 0; u < 16; ++u) { const int t = tb * 16 + u;
                    cum += la[t];
                    const float kv = __uint_as_float((unsigned)kk[u] << 16) * __expf(end - cum);
                    kp[(size_t)t * 512] = (bf16_t)(cvt_pk_bf16(kv, 0.f) & 0xffffu); }
            }
            ((float*)(ws + WS_DEC))[(size_t)it * 512 + hc] = __expf(end);
        }
        if (tid < 32) {
            const float bias = P.in[13][tid], A = -__expf(P.in[14][tid]);
            float cum = 0.f;
#pragma unroll 4
            for (int t = 0; t < 64; ++t) cum += softplusf_(*(const LAS float*)(lds + t * 256 + (16 + tid) * 4) + bias) * A;
            const float end = cum; cum = 0.f;
            float* wg = (float*)(ws + WS_WG);
#pragma unroll 4
            for (int t = 0; t < 64; ++t) { const float dt = softplusf_(*(const LAS float*)(lds + t * 256 + (16 + tid) * 4) + bias); cum += dt * A; wg[(size_t)(row0 + t) * 32 + tid] = __expf(end - cum) * dt; }
            ((float*)(ws + WS_DECS))[it * 32 + tid] = __expf(end);
        }
        __syncthreads();
    }
    const int co = tid & 63, rg = tid >> 6;
    u32x4 raw[11];
#define CONV_LOAD(itx) do { const int _ci = (itx) >> 3, _col = ((itx) & 7) * 512 + co * 8; \
        const bf16_t* _xp = (const bf16_t*)(T + T_XBC) + (size_t)(_ci * 64 + rg * 8) * 4096 + _col; \
        _Pragma("unroll") for (int i = 0; i < 8; ++i) raw[3 + i] = *(const u32x4*)(_xp + (size_t)i * 4096); \
        if (rg > 0) { _Pragma("unroll") for (int i = 0; i < 3; ++i) raw[i] = *(const u32x4*)(_xp - (size_t)(3 - i) * 4096); } \
        else if ((_ci & (NCH - 1)) != 0) { const bf16_t* _hp = (const bf16_t*)(ws + WS_HALO) + (size_t)(_ci - 1) * 3 * 4096 + _col; \
            _Pragma("unroll") for (int i = 0; i < 3; ++i) raw[i] = *(const u32x4*)(_hp + (size_t)i * 4096); } \
        else { _Pragma("unroll") for (int i = 0; i < 3; ++i) raw[i] = (u32x4){0u, 0u, 0u, 0u}; } } while (0)
    float cw[4][8], cbv[8];
    { const int colw = ((G & 7) == 0 ? ((int)blockIdx.x & 7) : 0) * 512 + co * 8;
#pragma unroll
      for (int k = 0; k < 4; ++k) { const f32x4 a = *(const f32x4*)(P.in[11] + k * 4096 + colw), b = *(const f32x4*)(P.in[11] + k * 4096 + colw + 4);
          cw[k][0] = a.x; cw[k][1] = a.y; cw[k][2] = a.z; cw[k][3] = a.w; cw[k][4] = b.x; cw[k][5] = b.y; cw[k][6] = b.z; cw[k][7] = b.w; }
      { const f32x4 a = *(const f32x4*)(P.in[12] + colw), b = *(const f32x4*)(P.in[12] + colw + 4);
          cbv[0] = a.x; cbv[1] = a.y; cbv[2] = a.z; cbv[3] = a.w; cbv[4] = b.x; cbv[5] = b.y; cbv[6] = b.z; cbv[7] = b.w; } }
    if ((int)blockIdx.x < HB * NCH * 8) CONV_LOAD((int)blockIdx.x);
    for (int it = blockIdx.x; it < HB * NCH * 8; it += G) {
        const int ci = it >> 3, cb = it & 7, col = cb * 512 + co * 8, row0 = ci * 64 + rg * 8;
        bf16_t* xp = (bf16_t*)(T + T_XBC) + (size_t)row0 * 4096 + col;
        if ((G & 7) != 0) {
#pragma unroll
            for (int k = 0; k < 4; ++k) { const f32x4 a = *(const f32x4*)(P.in[11] + k * 4096 + col), b = *(const f32x4*)(P.in[11] + k * 4096 + col + 4);
                cw[k][0] = a.x; cw[k][1] = a.y; cw[k][2] = a.z; cw[k][3] = a.w; cw[k][4] = b.x; cw[k][5] = b.y; cw[k][6] = b.z; cw[k][7] = b.w; }
            { const f32x4 a = *(const f32x4*)(P.in[12] + col), b = *(const f32x4*)(P.in[12] + col + 4);
                cbv[0] = a.x; cbv[1] = a.y; cbv[2] = a.z; cbv[3] = a.w; cbv[4] = b.x; cbv[5] = b.y; cbv[6] = b.z; cbv[7] = b.w; }
        }
        asm volatile("s_waitcnt vmcnt(0)" ::: "memory");
        __syncthreads();
        u32x4 outv[8];
#pragma unroll
        for (int i = 0; i < 8; ++i) {
            float v[8];
#pragma unroll
            for (int e = 0; e < 8; ++e) v[e] = cbv[e];
#pragma unroll
            for (int k = 0; k < 4; ++k) { const u32x4 q = raw[i + k];
                v[0] += cw[k][0] * bf_lo(q.x); v[1] += cw[k][1] * bf_hi(q.x); v[2] += cw[k][2] * bf_lo(q.y); v[3] += cw[k][3] * bf_hi(q.y);
                v[4] += cw[k][4] * bf_lo(q.z); v[5] += cw[k][5] * bf_hi(q.z); v[6] += cw[k][6] * bf_lo(q.w); v[7] += cw[k][7] * bf_hi(q.w); }
#pragma unroll
            for (int e = 0; e < 8; ++e) v[e] = siluf_(v[e]);
            outv[i].x = cvt_pk_bf16(v[0], v[1]); outv[i].y = cvt_pk_bf16(v[2], v[3]); outv[i].z = cvt_pk_bf16(v[4], v[5]); outv[i].w = cvt_pk_bf16(v[6], v[7]);
        }
        if (it + G < HB * NCH * 8) CONV_LOAD(it + G);
#pragma unroll
        for (int i = 0; i < 8; ++i) *(u32x4*)(xp + (size_t)i * 4096) = outv[i];
    }
#undef CONV_LOAD
}

struct MixArgs {
    const bf16_t* ak; int ld_ak;
    const bf16_t* qq; int ld_q;
    const bf16_t* bv; int ld_bv;
    const bf16_t* gt; int ld_g;
    bf16_t* out; int ld_o;
    const float* dec;
    const float* wg;
    const float* nw;
    const float* dsk;
};
constexpr int RSA = 320, RSB = 576, RSQ = 264, RSG = 520, RSX = 520;
constexpr int OFF_AK = 0, OFF_BV = 64 * RSA, OFF_QQ = OFF_BV + 64 * RSB, OFF_WGT = OFF_QQ + 64 * RSQ, OFF_DEC = OFF_WGT + 1024, OFF_RED = OFF_DEC + 512, OFF_NW = OFF_RED + 2048, OFF_GT = OFF_NW + 1024, OFF_XS2 = OFF_GT + 64 * RSG;
static_assert(OFF_XS2 + 64 * RSX <= LDS_XB, "mixer LDS");

#define LBAR() do { asm volatile("s_waitcnt lgkmcnt(0)" ::: "memory"); __builtin_amdgcn_s_barrier(); asm volatile("" ::: "memory"); } while (0)
template <bool SSD>
__device__ __forceinline__ void mixer_item(LAS unsigned char* lds, const MixArgs& a) {
    const int tid = tid_fresh(), lane = tid & 63, w = __builtin_amdgcn_readfirstlane(tid >> 6);
    const int r = lane & 31, h = lane >> 5, gg = lane >> 4, q = (lane & 15) >> 2, p = lane & 3;
    const int arow0 = tid >> 4, apc = tid & 15;
    const int brow0 = tid >> 5, bpc = tid & 31;
    u32x4 stA[2], stQ[2], stB[4], stG[4], stD; float stWp[4];
    stD = (u32x4){0u, 0u, 0u, 0u}; stWp[0] = stWp[1] = stWp[2] = stWp[3] = 0.f;
#define MIX_LOAD(c) do { const size_t _r0 = (size_t)(c) * 64; \
        _Pragma("unroll") for (int i = 0; i < 2; ++i) { stA[i] = *(const u32x4*)(a.ak + (_r0 + arow0 + 32 * i) * a.ld_ak + apc * 8); stQ[i] = *(const u32x4*)(a.qq + (_r0 + arow0 + 32 * i) * a.ld_q + apc * 8); } \
        _Pragma("unroll") for (int i = 0; i < 4; ++i) { stB[i] = *(const u32x4*)(a.bv + (_r0 + brow0 + 16 * i) * a.ld_bv + bpc * 8); stG[i] = *(const u32x4*)(a.gt + (_r0 + brow0 + 16 * i) * a.ld_g + bpc * 8); } \
        if (SSD) { _Pragma("unroll") for (int i = 0; i < 4; ++i) stWp[i] = a.wg[(_r0 + brow0 + 16 * i) * 32 + (bpc >> 3)]; }     \
        else { if (tid < 32) stD = *(const u32x4*)(a.dec + (size_t)(c) * 512 + tid * 4); } } while (0)
#define MIX_STORE() do { \
        _Pragma("unroll") for (int i = 0; i < 2; ++i) { *(LAS u32x4*)(lds + OFF_AK + (arow0 + 32 * i) * RSA + apc * 16) = stA[i]; \
            *(LAS u32x2*)(lds + OFF_QQ + (arow0 + 32 * i) * RSQ + apc * 16) = (u32x2){stQ[i].x, stQ[i].y}; *(LAS u32x2*)(lds + OFF_QQ + (arow0 + 32 * i) * RSQ + apc * 16 + 8) = (u32x2){stQ[i].z, stQ[i].w}; } \
        _Pragma("unroll") for (int i = 0; i < 4; ++i) { \
            if (SSD) { *(LAS u32x2*)(lds + OFF_XS2 + (brow0 + 16 * i) * RSX + bpc * 16) = (u32x2){stB[i].x, stB[i].y}; *(LAS u32x2*)(lds + OFF_XS2 + (brow0 + 16 * i) * RSX + bpc * 16 + 8) = (u32x2){stB[i].z, stB[i].w}; \
                const float _w = stWp[i]; u32x4 _b; _b.x = cvt_pk_bf16(bf_lo(stB[i].x) * _w, bf_hi(stB[i].x) * _w); _b.y = cvt_pk_bf16(bf_lo(stB[i].y) * _w, bf_hi(stB[i].y) * _w); \
                _b.z = cvt_pk_bf16(bf_lo(stB[i].z) * _w, bf_hi(stB[i].z) * _w); _b.w = cvt_pk_bf16(bf_lo(stB[i].w) * _w, bf_hi(stB[i].w) * _w); \
                *(LAS u32x4*)(lds + OFF_BV + (brow0 + 16 * i) * RSB + bpc * 16) = _b; } \
            else *(LAS u32x4*)(lds + OFF_BV + (brow0 + 16 * i) * RSB + bpc * 16) = stB[i]; \
            *(LAS u32x2*)(lds + OFF_GT + (brow0 + 16 * i) * RSG + bpc * 16) = (u32x2){stG[i].x, stG[i].y}; *(LAS u32x2*)(lds + OFF_GT + (brow0 + 16 * i) * RSG + bpc * 16 + 8) = (u32x2){stG[i].z, stG[i].w}; } \
        if (!SSD) { if (tid < 32) *(LAS u32x4*)(lds + OFF_DEC + tid * 16) = stD; } } while (0)

    if (tid < 256) *(LAS float*)(lds + OFF_NW + tid * 4) = a.nw[tid];
    MIX_LOAD(0);
    MIX_STORE();
    __syncthreads();

    f32x16 S[4];
#pragma unroll
    for (int i = 0; i < 4; ++i)
#pragma unroll
        for (int e = 0; e < 16; ++e) S[i][e] = 0.f;

    const int trA = OFF_AK + (8 * h + q) * RSA + (16 * (gg & 1) + 4 * p) * 2;
    const int trB = OFF_BV + (8 * h + q) * RSB + (32 * w + 16 * (gg & 1) + 4 * p) * 2;
    const int qB = OFF_QQ + r * RSQ + 8 * h;
    const int gB = OFF_GT + r * RSG + (32 * w + 4 * h) * 2;
    const float dsk = SSD ? a.dsk[w >> 1] : 0.f;
    float dc_next = SSD ? a.dec[w >> 1] : 0.f;

    for (int c = 0; c < NCH; ++c) {
        if (c + 1 < NCH) MIX_LOAD(c + 1);
        if (SSD) {
            const float dc = dc_next;
            if (c + 1 < NCH) dc_next = a.dec[(size_t)(c + 1) * 32 + (w >> 1)];
#pragma unroll
            for (int i = 0; i < 4; ++i)
#pragma unroll
                for (int e = 0; e < 16; ++e) S[i][e] *= dc;
        } else {
#pragma unroll
            for (int i = 0; i < 4; ++i)
#pragma unroll
                for (int g = 0; g < 4; ++g) { const f32x4 d4 = *(const LAS f32x4*)(lds + OFF_DEC + (32 * i + 8 * g + 4 * h) * 4);
                    S[i][4 * g + 0] *= d4.x; S[i][4 * g + 1] *= d4.y; S[i][4 * g + 2] *= d4.z; S[i][4 * g + 3] *= d4.w; }
        }
#define TRR(addr) __builtin_bit_cast(s16x4, __builtin_amdgcn_ds_read_tr16_b64_v4i16((LAS s16x4*)(lds + (addr))))
#define UPD_LOAD(s, B0, B1, A0, A1, W0, W1) do { B0 = TRR(trB + (16 * (s)) * RSB); B1 = TRR(trB + (16 * (s) + 4) * RSB); \
        _Pragma("unroll") for (int i = 0; i < 4; ++i) { A0[i] = TRR(trA + (16 * (s)) * RSA + 64 * i); A1[i] = TRR(trA + (16 * (s) + 4) * RSA + 64 * i); } \
        } while (0)
#define UPD_MMA(B0, B1, A0, A1, W0, W1) do { bf16x8 bfr = __builtin_shufflevector(B0, B1, 0, 1, 2, 3, 4, 5, 6, 7); \
        _Pragma("unroll") for (int i = 0; i < 4; ++i) S[i] = __builtin_amdgcn_mfma_f32_32x32x16_bf16(__builtin_shufflevector(A0[i], A1[i], 0, 1, 2, 3, 4, 5, 6, 7), bfr, S[i], 0, 0, 0); } while (0)
        {
            s16x4 xb0, xb1, xa0[4], xa1[4], yb0, yb1, ya0[4], ya1[4]; f32x4 xw0, xw1, yw0, yw1;
            xw0 = xw1 = yw0 = yw1 = (f32x4){0.f, 0.f, 0.f, 0.f};
            UPD_LOAD(0, xb0, xb1, xa0, xa1, xw0, xw1);
            UPD_LOAD(1, yb0, yb1, ya0, ya1, yw0, yw1);
            __builtin_amdgcn_sched_barrier(0);
            UPD_MMA(xb0, xb1, xa0, xa1, xw0, xw1);
            __builtin_amdgcn_sched_barrier(0);
            UPD_LOAD(2, xb0, xb1, xa0, xa1, xw0, xw1);
            __builtin_amdgcn_sched_barrier(0);
            UPD_MMA(yb0, yb1, ya0, ya1, yw0, yw1);
            __builtin_amdgcn_sched_barrier(0);
            UPD_LOAD(3, yb0, yb1, ya0, ya1, yw0, yw1);
            __builtin_amdgcn_sched_barrier(0);
            UPD_MMA(xb0, xb1, xa0, xa1, xw0, xw1);
            __builtin_amdgcn_sched_barrier(0);
            UPD_MMA(yb0, yb1, ya0, ya1, yw0, yw1);
        }
#undef UPD_LOAD
#undef UPD_MMA
        f32x16 OT[2];
#pragma unroll
        for (int j2 = 0; j2 < 2; ++j2)
#pragma unroll
            for (int e = 0; e < 16; ++e) OT[j2][e] = 0.f;
        {
            u32x2 qf[3][2][2];
#define Q_LOAD(sp, buf) do { _Pragma("unroll") for (int j2 = 0; j2 < 2; ++j2) { qf[buf][j2][0] = *(const LAS u32x2*)(lds + qB + 32 * j2 * RSQ + (16 * (sp)) * 2); qf[buf][j2][1] = *(const LAS u32x2*)(lds + qB + 32 * j2 * RSQ + (16 * (sp) + 8) * 2); } } while (0)
            Q_LOAD(0, 0); Q_LOAD(1, 1);
#pragma unroll
            for (int sp = 0; sp < 8; ++sp) {
                const int i = sp >> 1, o8 = 8 * (sp & 1);
                if (sp + 2 < 8) Q_LOAD(sp + 2, (sp + 2) % 3);
                u32x4 pk;
                pk.x = cvt_pk_bf16(S[i][o8 + 0], S[i][o8 + 1]); pk.y = cvt_pk_bf16(S[i][o8 + 2], S[i][o8 + 3]);
                pk.z = cvt_pk_bf16(S[i][o8 + 4], S[i][o8 + 5]); pk.w = cvt_pk_bf16(S[i][o8 + 6], S[i][o8 + 7]);
                const bf16x8 sfr = __builtin_bit_cast(bf16x8, pk);
                __builtin_amdgcn_sched_barrier(0);
#pragma unroll
                for (int j2 = 0; j2 < 2; ++j2) {
                    const bf16x8 qfr = __builtin_bit_cast(bf16x8, (u32x4){qf[sp % 3][j2][0].x, qf[sp % 3][j2][0].y, qf[sp % 3][j2][1].x, qf[sp % 3][j2][1].y});
                    OT[j2] = __builtin_amdgcn_mfma_f32_32x32x16_bf16(sfr, qfr, OT[j2], 0, 0, 0);
                }
                __builtin_amdgcn_sched_barrier(0);
            }
#undef Q_LOAD
        }
#undef TRR
        u32x2 gv[2][4];
#pragma unroll
        for (int j2 = 0; j2 < 2; ++j2)
#pragma unroll
            for (int g = 0; g < 4; ++g) gv[j2][g] = *(const LAS u32x2*)(lds + gB + 32 * j2 * RSG + 16 * g);
        float part[2] = {0.f, 0.f};
#pragma unroll
        for (int j2 = 0; j2 < 2; ++j2)
#pragma unroll
            for (int g = 0; g < 4; ++g) {
                if (SSD) {
                    const u32x2 xs = *(const LAS u32x2*)(lds + OFF_XS2 + (32 * j2 + r) * RSX + (32 * w + 8 * g + 4 * h) * 2);
                    OT[j2][4 * g + 0] = (OT[j2][4 * g + 0] + dsk * bf_lo(xs.x)) * bf_lo(gv[j2][g].x);
                    OT[j2][4 * g + 1] = (OT[j2][4 * g + 1] + dsk * bf_hi(xs.x)) * bf_hi(gv[j2][g].x);
                    OT[j2][4 * g + 2] = (OT[j2][4 * g + 2] + dsk * bf_lo(xs.y)) * bf_lo(gv[j2][g].y);
                    OT[j2][4 * g + 3] = (OT[j2][4 * g + 3] + dsk * bf_hi(xs.y)) * bf_hi(gv[j2][g].y);
                }
#pragma unroll
                for (int k = 0; k < 4; ++k) part[j2] += OT[j2][4 * g + k] * OT[j2][4 * g + k];
            }
        part[0] += __shfl_xor(part[0], 32); part[1] += __shfl_xor(part[1], 32);
        if (h == 0) { *(LAS float*)(lds + OFF_RED + (w * 64 + r) * 4) = part[0]; *(LAS float*)(lds + OFF_RED + (w * 64 + 32 + r) * 4) = part[1]; }
        LBAR();
#pragma unroll
        for (int j2 = 0; j2 < 2; ++j2) {
            float tot = 0.f;
#pragma unroll
            for (int ww = 0; ww < 8; ++ww) tot += *(const LAS float*)(lds + OFF_RED + (ww * 64 + 32 * j2 + r) * 4);
            const float rstd = rsqrtf(tot * (1.f / 256.f) + EPS);
#pragma unroll
            for (int g = 0; g < 4; ++g) {
                const f32x4 n4 = *(const LAS f32x4*)(lds + OFF_NW + (32 * w + 8 * g + 4 * h) * 4);
                float v0 = OT[j2][4 * g + 0] * rstd * n4.x, v1 = OT[j2][4 * g + 1] * rstd * n4.y, v2 = OT[j2][4 * g + 2] * rstd * n4.z, v3 = OT[j2][4 * g + 3] * rstd * n4.w;
                if (!SSD) { v0 *= bf_lo(gv[j2][g].x); v1 *= bf_hi(gv[j2][g].x); v2 *= bf_lo(gv[j2][g].y); v3 *= bf_hi(gv[j2][g].y); }
                *(LAS u32x2*)(lds + gB + 32 * j2 * RSG + 16 * g) = (u32x2){cvt_pk_bf16(v0, v1), cvt_pk_bf16(v2, v3)};
            }
        }
        LBAR();
#pragma unroll
        for (int i = 0; i < 4; ++i) {
            const u32x2 o0 = *(const LAS u32x2*)(lds + OFF_GT + (brow0 + 16 * i) * RSG + bpc * 16), o1 = *(const LAS u32x2*)(lds + OFF_GT + (brow0 + 16 * i) * RSG + bpc * 16 + 8);
            *(u32x4*)(a.out + ((size_t)c * 64 + brow0 + 16 * i) * a.ld_o + bpc * 8) = (u32x4){o0.x, o0.y, o1.x, o1.y};
        }
        if (c + 1 < NCH) MIX_STORE();
        LBAR();
    }
#undef MIX_LOAD
#undef MIX_STORE
}

__device__ __forceinline__ void p5_mixer(KP Pp, LAS unsigned char* lds, int G) {
    const Params P = load_params(Pp);
    unsigned char* ws = P.ws; unsigned char* T = ws + WS_BIG;
    for (int it = blockIdx.x; it < HB * 12; it += G) {
        const int b = it / 12, k = it % 12;
        const size_t row0 = (size_t)b * SEQ;
        MixArgs a;
        if (k < 4) {
            const int hd = k;
            a.ak = (const bf16_t*)(T + T_K) + row0 * 512 + hd * 128; a.ld_ak = 512;
            a.qq = (const bf16_t*)(T + T_Q) + row0 * 512 + hd * 128; a.ld_q = 512;
            a.bv = (const bf16_t*)(T + T_V) + row0 * 1024 + hd * 256; a.ld_bv = 1024;
            a.gt = (const bf16_t*)(T + T_SG) + row0 * 1024 + hd * 256; a.ld_g = 1024;
            a.out = (bf16_t*)(T + T_V) + row0 * 1024 + hd * 256; a.ld_o = 1024;
            a.dec = (const float*)(ws + WS_DEC) + (size_t)b * NCH * 512 + hd * 128;
            a.wg = nullptr; a.nw = P.in[9]; a.dsk = nullptr;
            mixer_item<false>(lds, a);
        } else {
            const int g = k - 4;
            const bf16_t* X = (const bf16_t*)(T + T_XBC) + row0 * 4096;
            a.ak = X + 2048 + g * 128; a.ld_ak = 4096;
            a.qq = X + 3072 + g * 128; a.ld_q = 4096;
            a.bv = X + g * 256; a.ld_bv = 4096;
            a.gt = (const bf16_t*)(T + T_SZ) + row0 * 2048 + g * 256; a.ld_g = 2048;
            a.out = (bf16_t*)(T + T_XBC) + row0 * 4096 + g * 256; a.ld_o = 4096;
            a.dec = (const float*)(ws + WS_DECS) + (size_t)b * NCH * 32 + g * 4;
            a.wg = (const float*)(ws + WS_WG) + row0 * 32 + g * 4;
            a.nw = P.in[16] + g * 256; a.dsk = P.in[15] + g * 4;
            mixer_item<true>(lds, a);
        }
        __syncthreads();
    }
}

__device__ __forceinline__ KP get_params() {
    KP p = (KP)__builtin_amdgcn_kernarg_segment_ptr(); asm volatile("" : "+s"(p)); return p;
}

#define XB_TMO      128
#define XB_XCNT(j)  (256  + 64 * (j))
#define XB_XSUB(j)  (1280 + 64 * (j))
#define XB_XGEN(j)  (2304 + 64 * (j))
#define XB_TOP      3328
#define XB_TOPGEN   3392
#define XCD_BAR_WORDS 3456
#define XB_SPIN_CAP (1u << 18)
__device__ __forceinline__ unsigned xb_ld(unsigned* p)              { return __hip_atomic_load(p, __ATOMIC_RELAXED, __HIP_MEMORY_SCOPE_AGENT); }
__device__ __forceinline__ unsigned xb_add(unsigned* p, unsigned v) { return __hip_atomic_fetch_add(p, v, __ATOMIC_RELAXED, __HIP_MEMORY_SCOPE_AGENT); }
__device__ __forceinline__ unsigned xb_xcc_id() { return (unsigned)__builtin_amdgcn_s_getreg((3 << 11) | 20) & 0xFu; }
#define XB_SPIN(cond, bar) do { unsigned _sp = 0; while (cond) { __builtin_amdgcn_s_sleep(1); \
    if ((++_sp & 255u) == 0u) { if (xb_ld(&(bar)[XB_TMO])) break; if (_sp > XB_SPIN_CAP) { atomicAdd(&(bar)[XB_TMO], 1u); break; } } } } while (0)
struct XcdBarrier { unsigned* bar; unsigned x; volatile LAS unsigned* st; };
__device__ __forceinline__ XcdBarrier xcd_barrier_post(unsigned* bar, volatile LAS unsigned* st) {
    XcdBarrier b; b.bar = bar; b.x = xb_xcc_id(); b.st = st;
    if (threadIdx.x == 0) (void)xb_add(&bar[XB_XCNT(b.x)], 1u);
    return b;
}
__device__ __forceinline__ void xcd_barrier_complete(unsigned* bar, unsigned x, unsigned& nloc, unsigned& nx) {
    const unsigned G = gridDim.x * gridDim.y * gridDim.z;
    unsigned sum, cnt, mine, sp = 0u;
    for (;;) {
        sum = 0u; cnt = 0u; mine = 0u;
#pragma unroll
        for (unsigned j = 0; j < 16; ++j) { const unsigned c = xb_ld(&bar[XB_XCNT(j)]); sum += c; cnt += (c > 0u) ? 1u : 0u; mine = (j == x) ? c : mine; }
        if (sum == G) break;
        __builtin_amdgcn_s_sleep(1);
        if ((++sp & 255u) == 0u) { if (xb_ld(&bar[XB_TMO])) break; if (sp > XB_SPIN_CAP) { atomicAdd(&bar[XB_TMO], 1u); break; } }
    }
    nloc = mine > 0u ? mine : 1u; nx = cnt > 0u ? cnt : 1u;
}
__device__ __forceinline__ void xcd_barrier(const XcdBarrier& b) {
    asm volatile("s_waitcnt vmcnt(0)" ::: "memory");
    __syncthreads();
    if (threadIdx.x == 0) {
        unsigned* bar = b.bar;
        __builtin_amdgcn_s_waitcnt(0);
        unsigned nloc = b.st[0], nx = b.st[1];
        if (nloc == 0u) { xcd_barrier_complete(bar, b.x, nloc, nx); b.st[0] = nloc; b.st[1] = nx; }
        const unsigned old = xb_add(&bar[XB_XSUB(b.x)], 1u);
        const unsigned gen = old / nloc;
        if (old + 1u == (gen + 1u) * nloc) {
            __builtin_amdgcn_fence(__ATOMIC_RELEASE, "agent");
            asm volatile("s_waitcnt vmcnt(0)" ::: "memory");
            const unsigned og = xb_add(&bar[XB_TOP], 1u);
            const unsigned tg = og / nx;
            if (og + 1u == (tg + 1u) * nx) xb_add(&bar[XB_TOPGEN], 1u);
            else XB_SPIN(xb_ld(&bar[XB_TOPGEN]) == tg, bar);
            __builtin_amdgcn_fence(__ATOMIC_ACQUIRE, "agent");
            xb_add(&bar[XB_XGEN(b.x)], 1u);
            asm volatile("s_waitcnt vmcnt(0)" ::: "memory");
        } else {
            XB_SPIN(xb_ld(&bar[XB_XGEN(b.x)]) == gen, bar);
            __builtin_amdgcn_fence(__ATOMIC_ACQUIRE, "agent");
            asm volatile("s_waitcnt vmcnt(0)" ::: "memory");
        }
    }
    __syncthreads();
}

#define PROBE_MASK 0x0
#define PROBE_DSYNC 0
#if PROBE_MASK
#define PH_BEGIN(i) const unsigned long long _t##i = __builtin_amdgcn_s_memrealtime();
#define PH_END(i) if ((PROBE_MASK >> (i)) & 1) probe_acc += __builtin_amdgcn_s_memrealtime() - _t##i;
#else
#define PH_BEGIN(i)
#define PH_END(i)
#endif
#if PROBE_DSYNC
#define GSYNC() do { xcd_barrier(xbar); xcd_barrier(xbar); } while (0)
#else
#define GSYNC() xcd_barrier(xbar)
#endif
__global__ void __launch_bounds__(512, 2) fwd_megakernel(Params Parg) {
    extern __shared__ __attribute__((aligned(16))) unsigned char lds_raw[];
    LAS unsigned char* lds = (LAS unsigned char*)lds_raw;
    cg::grid_group grid = cg::this_grid();
    const int G = gridDim.x;
    pg8::StaticOrder S;
#if PROBE_MASK
    unsigned long long probe_acc = 0;
#endif

    { unsigned* bw = (unsigned*)(get_params()->ws + WS_BAR);
      if (blockIdx.x == 0) for (int i = threadIdx.x; i < XCD_BAR_WORDS; i += 512) bw[i] = 0u;
      if (threadIdx.x < 2) *(volatile LAS unsigned*)(lds + LDS_XB + threadIdx.x * 4) = 0u; }
    XcdBarrier xbar;
    { PH_BEGIN(0) p0_prologue(get_params(), lds, G);
    grid.sync();
    xbar = xcd_barrier_post((unsigned*)(get_params()->ws + WS_BAR), (volatile LAS unsigned*)(lds + LDS_XB));
    PH_END(0) }
    { PH_BEGIN(1) { KP P = get_params(); unsigned char* ws = P->ws;
      pg8::Gemm g{(const bf16_t*)(ws + WS_XB), (const bf16_t*)(ws + WS_WGU1), MTOK, NGU, D, D, D}; S.init(MTOK, NGU, G, blockIdx.x);
      EpiGU E{(const float*)(ws + WS_SSQ), (bf16_t*)(ws + WS_BIG)}; pg8::gemm_phase(lds, g, S, E); }
    GSYNC(); PH_END(1) }
    { PH_BEGIN(2) { KP P = get_params(); unsigned char* ws = P->ws;
      pg8::Gemm g{(const bf16_t*)(ws + WS_BIG), (const bf16_t*)(ws + WS_WD1), MTOK, D, DFF, DFF, DFF}; S.init(MTOK, D, G, blockIdx.x);
      EpiRes E{(bf16_t*)(ws + WS_XB), (float*)(ws + WS_SSQ) + MTOK, 0.5f}; pg8::gemm_phase(lds, g, S, E); }
    GSYNC(); PH_END(2) }
    for (int hf = 0; hf < 2; ++hf) {
        const size_t r0 = (size_t)hf * MH;
        { PH_BEGIN(3) { KP P = get_params(); unsigned char* ws = P->ws;
          pg8::Gemm g{(const bf16_t*)(ws + WS_XB) + r0 * D, (const bf16_t*)(ws + WS_WIN), MH, NIN, D, D, D}; S.init(MH, NIN, G, blockIdx.x);
          EpiIn E{(const float*)(ws + WS_SSQ) + MTOK + r0, ws + WS_BIG, (bf16_t*)(ws + WS_HALO), (float*)(ws + WS_SM)}; pg8::gemm_phase(lds, g, S, E); }
        GSYNC(); PH_END(3) }
        { PH_BEGIN(4) p4_prep(get_params(), lds, G);
        GSYNC(); PH_END(4) }
        { PH_BEGIN(5) p5_mixer(get_params(), lds, G);
        GSYNC(); PH_END(5) }
        { PH_BEGIN(6) { KP P = get_params(); unsigned char* ws = P->ws; unsigned char* T = ws + WS_BIG;
          pg8::Gemm g{(const bf16_t*)(T + T_V), (const bf16_t*)(ws + WS_WGO), MH, D, D, D, D}; S.init(MH, D, G, blockIdx.x);
          EpiGate E{(const bf16_t*)(T + T_GT), nullptr, (bf16_t*)(T + T_T1), 0}; pg8::gemm_phase(lds, g, S, E); }
        { KP P = get_params(); unsigned char* ws = P->ws; unsigned char* T = ws + WS_BIG;
          pg8::Gemm g{(const bf16_t*)(T + T_XBC), (const bf16_t*)(ws + WS_WSO), MH, D, 2048, 4096, 2048}; S.init(MH, D, G, blockIdx.x);
          EpiGate E{(const bf16_t*)(T + T_GT), (const bf16_t*)(T + T_T1), (bf16_t*)(T + T_MRG), 1}; pg8::gemm_phase(lds, g, S, E); }
        GSYNC(); PH_END(6) }
        { PH_BEGIN(7) { KP P = get_params(); unsigned char* ws = P->ws;
          pg8::Gemm g{(const bf16_t*)(ws + WS_BIG + T_MRG), (const bf16_t*)(ws + WS_WOUT), MH, D, D, D, D}; S.init(MH, D, G, blockIdx.x);
          EpiRes E{(bf16_t*)(ws + WS_XB) + r0 * D, (float*)(ws + WS_SSQ) + 2 * MTOK + r0, 1.0f}; pg8::gemm_phase(lds, g, S, E); }
        GSYNC(); PH_END(7) }
    }
    { PH_BEGIN(8) { KP P = get_params(); unsigned char* ws = P->ws;
      pg8::Gemm g{(const bf16_t*)(ws + WS_XB), (const bf16_t*)(ws + WS_WGU2), MTOK, NGU, D, D, D}; S.init(MTOK, NGU, G, blockIdx.x);
      EpiGU E{(const float*)(ws + WS_SSQ) + 2 * MTOK, (bf16_t*)(ws + WS_BIG)}; pg8::gemm_phase(lds, g, S, E); }
    GSYNC(); PH_END(8) }
    { PH_BEGIN(9) { KP P = get_params(); unsigned char* ws = P->ws;
      pg8::Gemm g{(const bf16_t*)(ws + WS_BIG), (const bf16_t*)(ws + WS_WD2), MTOK, D, DFF, DFF, DFF}; S.init(MTOK, D, G, blockIdx.x);
      EpiRes E{(bf16_t*)(ws + WS_XB), (float*)(ws + WS_SSQ) + 3 * MTOK, 0.5f}; pg8::gemm_phase(lds, g, S, E); }
    GSYNC(); PH_END(9) }
    { PH_BEGIN(10)
    {
        KP P = get_params(); const float* ssq = (const float*)(P->ws + WS_SSQ) + 3 * MTOK;
        const int tid = tid_fresh(), lane = tid & 63, gw = blockIdx.x * 8 + (tid >> 6), NGW = G * 8;
        const float* fw = P->in[23]; float* outp = P->out; const bf16_t* xb = (const bf16_t*)(P->ws + WS_XB);
        f32x4 wv[4];
#pragma unroll
        for (int jj = 0; jj < 4; ++jj) wv[jj] = ((const f32x4*)fw)[lane + 64 * jj];
        for (int m = gw; m < MTOK; m += NGW) {
            const float rstd = rsqrtf(ssq[m] * (1.f / D) + EPS);
            const u32x2* xr = (const u32x2*)(xb + (size_t)m * D) + lane;
            f32x4* orow = (f32x4*)(outp + (size_t)m * D) + lane;
#pragma unroll
            for (int jj = 0; jj < 4; ++jj) { const u32x2 q = xr[64 * jj]; f32x4 v;
                v.x = bf_lo(q.x) * rstd * wv[jj].x; v.y = bf_hi(q.x) * rstd * wv[jj].y; v.z = bf_lo(q.y) * rstd * wv[jj].z; v.w = bf_hi(q.y) * rstd * wv[jj].w; orow[64 * jj] = v; }
        }
    }
    PH_END(10) }
#if PROBE_MASK
    if (blockIdx.x == 0) {
        const unsigned long long t0 = __builtin_amdgcn_s_memrealtime();
        while (__builtin_amdgcn_s_memrealtime() - t0 < probe_acc) __builtin_amdgcn_s_sleep(8);
    }
#endif
}

extern "C" void kernel_launch(void* const* d_in, const int* in_sizes, int n_in, void* d_out, int out_size, void* d_ws, size_t ws_size, hipStream_t stream) {
    static int grid = 0;
    if (grid == 0) {
        if (n_in != 24 || ws_size < WS_NEED) { fprintf(stderr, "kernel_launch: unexpected n_in %d or ws_size %zu (need %zu)\n", n_in, ws_size, (size_t)WS_NEED); grid = -1; return; }
        int dev = 0, cus = 0, per_cu = 0;
        hipGetDevice(&dev);
        hipDeviceGetAttribute(&cus, hipDeviceAttributeMultiprocessorCount, dev);
        hipFuncSetAttribute((const void*)fwd_megakernel, hipFuncAttributeMaxDynamicSharedMemorySize, LDS_BYTES);
        hipOccupancyMaxActiveBlocksPerMultiprocessor(&per_cu, (const void*)fwd_megakernel, 512, LDS_BYTES);
        if (per_cu < 1) { fprintf(stderr, "kernel_launch: occupancy query gave %d\n", per_cu); per_cu = 1; }
        grid = cus * per_cu;
        (void)hipGetLastError();
    }
    if (grid < 0) return;
    Params p{};
    for (int i = 0; i < 24; ++i) p.in[i] = (const float*)d_in[i];
    p.out = (float*)d_out; p.ws = (unsigned char*)d_ws;
    void* args[] = {&p};
    hipError_t e = hipLaunchCooperativeKernel((const void*)fwd_megakernel, dim3(grid), dim3(512), args, LDS_BYTES, stream);
    if (e != hipSuccess) fprintf(stderr, "cooperative launch failed: %s (grid %d)\n", hipGetErrorString(e), grid);
}
```

```cpp
#include <hip/hip_runtime.h>
#include <hip/hip_cooperative_groups.h>
#include <cstdio>
#include <cstdint>
namespace cg = cooperative_groups;

#define LAS __attribute__((address_space(3)))
typedef unsigned short bf16_t;
typedef short bf16x8 __attribute__((ext_vector_type(8)));
typedef short s16x4 __attribute__((ext_vector_type(4)));
typedef float f32x4 __attribute__((ext_vector_type(4)));
typedef float f32x16 __attribute__((ext_vector_type(16)));
typedef unsigned u32x4 __attribute__((ext_vector_type(4)));
typedef unsigned u32x2 __attribute__((ext_vector_type(2)));

constexpr int D = 1024, BATCH = 32, SEQ = 2048, MTOK = BATCH * SEQ;
constexpr int NCH = SEQ / 64;
constexpr int DFF = 2816, NGU = 2 * DFF;
constexpr int IN_DIM = 11312, NIN = 45 * 256;
constexpr int HB = 16, MH = HB * SEQ;
constexpr float EPS = 1e-6f;

constexpr size_t MiB = 1u << 20;
constexpr size_t WS_SSQ = 0;
constexpr size_t WS_WGU1 = 1 * MiB, WS_WD1 = 12 * MiB, WS_WIN = 18 * MiB, WS_WGO = 41 * MiB, WS_WSO = 43 * MiB, WS_WOUT = 47 * MiB, WS_WGU2 = 49 * MiB, WS_WD2 = 60 * MiB;
constexpr size_t WS_DEC = 66 * MiB, WS_DECS = 67 * MiB, WS_WG = 68 * MiB, WS_HALO = 72 * MiB, WS_SM = 84 * MiB;
constexpr size_t WS_BAR = 92 * MiB;
constexpr size_t WS_XB = 96 * MiB;
constexpr size_t WS_BIG = 224 * MiB;
constexpr size_t T_Q = 0, T_K = 32 * MiB, T_V = 64 * MiB, T_SG = 128 * MiB, T_SZ = 192 * MiB, T_XBC = 320 * MiB, T_GT = 576 * MiB, T_END = 704 * MiB;
constexpr size_t T_T1 = T_Q, T_MRG = T_SG;
constexpr size_t WS_NEED = WS_BIG + T_END;

constexpr int LDS_MAIN = 131072, LDS_XB = 149504, LDS_BYTES = LDS_XB + 64;

__device__ __forceinline__ unsigned cvt_pk_bf16(float lo, float hi) { unsigned r; asm volatile("v_cvt_pk_bf16_f32 %0, %1, %2" : "=v"(r) : "v"(lo), "v"(hi)); return r; }
__device__ __forceinline__ float bf_lo(unsigned u) { return __uint_as_float(u << 16); }
__device__ __forceinline__ float bf_hi(unsigned u) { return __uint_as_float(u & 0xffff0000u); }
__device__ __forceinline__ float fast_rcp(float x) { return __builtin_amdgcn_rcpf(x); }
__device__ __forceinline__ float sigmoidf_(float x) { return fast_rcp(1.f + __expf(-x)); }
__device__ __forceinline__ float siluf_(float x) { return x * sigmoidf_(x); }
__device__ __forceinline__ float softplusf_(float x) { return fmaxf(x, 0.f) + __logf(1.f + __expf(-fabsf(x))); }
__device__ __forceinline__ float wave_sum(float v) {
#pragma unroll
    for (int o = 1; o < 64; o <<= 1) v += __shfl_xor(v, o);
    return v;
}

namespace pg8 {
constexpr int BM = 256, BK = 64, HALF = 128, HTB = HALF * BK * 2, STAGE_BYTES = 8 * HTB, NXCD = 8, WGM = 8;
__host__ __device__ __forceinline__ int lds_byte(int r, int c) { const int st = (r >> 4) * 2 + (c >> 5), rr = r & 15, cc = c & 31, ob = rr * 64 + cc * 2; return st * 1024 + (ob ^ (((ob >> 9) & 1) << 5)); }
__host__ __device__ __forceinline__ void stage_rc(int b, int& R, int& C) { const int st = b / 1024, sb = b % 1024, swz = sb ^ (((sb >> 9) & 1) << 5); R = (st >> 1) * 16 + swz / 64; C = (st & 1) * 32 + (swz % 64) / 2; }
__host__ __device__ __forceinline__ int perm32(int rho) { const int n = rho >> 4, i = rho & 15; return 8 * (i >> 2) + 4 * n + (i & 3); }

struct Unit { int pm, pn; };
struct Gemm { const bf16_t* A; const bf16_t* Bt; int M, N, K, lda, ldb; };

struct StaticOrder {
    int nM, nN, nwg, G, c;
    __device__ void init(int M, int N, int G_, int c_) { nM = M / BM; nN = N / BM; nwg = nM * nN; G = G_; c = c_; }
    __device__ bool next(int i, Unit& u) const {
        const long L = (long)i * G + c; if (L >= nwg) return false;
        int wgid = (int)L; { const int q = nwg / NXCD, r = nwg % NXCD, xcd = wgid % NXCD, off = wgid / NXCD; wgid = (xcd < r ? xcd * (q + 1) : r * (q + 1) + (xcd - r) * q) + off; }
        const int nig = WGM * nN, gid = wgid / nig, fm = gid * WGM, gsz = (nM - fm) < WGM ? (nM - fm) : WGM;
        u.pm = fm + ((wgid % nig) % gsz); u.pn = (wgid % nig) / gsz; return true;
    }
};

template <class Epi, bool ALIGN_EPI = true, bool SP2 = true>
__device__ __forceinline__ void gemm_phase(LAS unsigned char* lds, const Gemm g, const StaticOrder& S, const Epi& E) {
    int tid = threadIdx.x; asm volatile("" : "+v"(tid));
    const int wid = __builtin_amdgcn_readfirstlane(tid >> 6), lane = tid & 63, wr = wid >> 2, wc = wid & 3, fr = lane & 15, fq = lane >> 4;
    const int K = g.K, nt = K / BK;
    unsigned voffA[2], voffB[2];
#pragma unroll
    for (int i = 0; i < 2; ++i) { int R, C; stage_rc(tid * 16 + i * 8192, R, C); const int Rb = (R & ~31) + perm32(R & 31);
        voffA[i] = (unsigned)(R * g.lda + C) * 2u; voffB[i] = (unsigned)(Rb * g.ldb + C) * 2u; }
    const size_t kstep = (size_t)(BK * 2);
    const size_t hstA = (size_t)HALF * g.lda * 2, hstB = (size_t)HALF * g.ldb * 2;
    const size_t tstA = 2 * hstA, tstB = 2 * hstB;
    const unsigned ldsw = (unsigned)wid * 1024u;
    const int aoff = lds_byte(wr * 64 + fr, fq * 8), boff = lds_byte(wc * 32 + fr, fq * 8);
#define PG8_SA(b, h) (((b) * 2 + (h)) * HTB)
#define PG8_SB(b, h) ((4 + (b) * 2 + (h)) * HTB)
#define PG8_STAGE(bufoff, gbase, voff) do { _Pragma("unroll") for (int _i = 0; _i < 2; ++_i) \
        __builtin_amdgcn_global_load_lds((const unsigned*)((const char*)(gbase) + (voff)[_i]), (LAS unsigned*)(lds + (bufoff) + ldsw + _i * 8192), 16, 0, 0); } while (0)
#define PG8_LDA(dst, b, h) do { _Pragma("unroll") for (int m = 0; m < 4; ++m) _Pragma("unroll") for (int k = 0; k < 2; ++k) dst[m][k] = *(const LAS bf16x8*)(lds + PG8_SA(b, h) + aoff + m * 2048 + k * 1024); } while (0)
#define PG8_LDB(dst, b, h) do { _Pragma("unroll") for (int n = 0; n < 2; ++n) _Pragma("unroll") for (int k = 0; k < 2; ++k) dst[n][k] = *(const LAS bf16x8*)(lds + PG8_SB(b, h) + boff + n * 2048 + k * 1024); } while (0)
#define PG8_MMA(ai, bj, At, Bt) do { __builtin_amdgcn_s_setprio(1); _Pragma("unroll") for (int m = 0; m < 4; ++m) _Pragma("unroll") for (int n = 0; n < 2; ++n) _Pragma("unroll") for (int k = 0; k < 2; ++k) \
        acc[ai][bj][m][n] = __builtin_amdgcn_mfma_f32_16x16x32_bf16(Bt[n][k], At[m][k], acc[ai][bj][m][n], 0, 0, 0); __builtin_amdgcn_s_setprio(0); } while (0)
#define PG8_WAIT_V(n) asm volatile("s_waitcnt vmcnt(" #n ")" ::: "memory")
#define PG8_WAIT_L(n) asm volatile("s_waitcnt lgkmcnt(" #n ")" ::: "memory")
#define PG8_BAR __builtin_amdgcn_s_barrier()
#define PG8_SCHED __builtin_amdgcn_sched_barrier(0)
    Unit cur, nxt; int ui = 0;
    if (!S.next(0, cur)) return;
    f32x4 acc[2][2][4][2];
#pragma unroll
    for (int a = 0; a < 2; ++a)
#pragma unroll
        for (int b = 0; b < 2; ++b)
#pragma unroll
            for (int m = 0; m < 4; ++m)
#pragma unroll
                for (int n = 0; n < 2; ++n) acc[a][b][m][n] = (f32x4){0.f, 0.f, 0.f, 0.f};
    bf16x8 At[4][2], B0[2][2], B1[2][2];
    const char* cA = (const char*)g.A + (size_t)cur.pm * tstA; const char* cB = (const char*)g.Bt + (size_t)cur.pn * tstB;
    if constexpr (SP2) {
        PG8_STAGE(PG8_SB(0, 0), cB, voffB); PG8_STAGE(PG8_SB(0, 1), cB + hstB, voffB); PG8_STAGE(PG8_SA(0, 0), cA, voffA); PG8_STAGE(PG8_SA(0, 1), cA + hstA, voffA);
        if (wr == 1) PG8_BAR;
        PG8_WAIT_V(2); PG8_BAR;
        PG8_STAGE(PG8_SB(1, 0), cB + kstep, voffB); PG8_STAGE(PG8_SA(1, 0), cA + kstep, voffA); PG8_STAGE(PG8_SB(1, 1), cB + hstB + kstep, voffB);
        PG8_WAIT_V(6); PG8_BAR;
    } else {
    PG8_STAGE(PG8_SB(0, 0), cB, voffB); PG8_STAGE(PG8_SA(0, 0), cA, voffA); PG8_STAGE(PG8_SB(0, 1), cB + hstB, voffB); PG8_STAGE(PG8_SA(0, 1), cA + hstA, voffA);
    if (wr == 1) PG8_BAR;
    PG8_WAIT_V(4); PG8_BAR;
    PG8_STAGE(PG8_SB(1, 0), cB + kstep, voffB); PG8_STAGE(PG8_SA(1, 0), cA + kstep, voffA); PG8_STAGE(PG8_SB(1, 1), cB + hstB + kstep, voffB);
    PG8_WAIT_V(6); PG8_BAR;
    }
    for (;;) {
        const bool has_next = S.next(ui + 1, nxt);
        const char* nA = has_next ? (const char*)g.A + (size_t)nxt.pm * tstA : cA; const char* nB = has_next ? (const char*)g.Bt + (size_t)nxt.pn * tstB : cB;
        for (int t = 0; t < nt; t += 2) {
            const bool last = (t == nt - 2);
            const char* a1 = cA + (size_t)(t + 1) * kstep;
            const char* a2 = last ? nA : cA + (size_t)(t + 2) * kstep; const char* b2 = last ? nB : cB + (size_t)(t + 2) * kstep;
            const char* a3 = a2 + kstep; const char* b3 = b2 + kstep;
            if constexpr (SP2) {
            PG8_LDB(B0, 0, 0); PG8_LDB(B1, 0, 1); PG8_SCHED; PG8_LDA(At, 0, 0); PG8_STAGE(PG8_SA(1, 1), a1 + hstA, voffA);
            PG8_WAIT_V(8); PG8_WAIT_L(0); PG8_BAR; PG8_MMA(0, 0, At, B0); PG8_MMA(0, 1, At, B1); PG8_BAR; PG8_SCHED;
            PG8_LDA(At, 0, 1); PG8_STAGE(PG8_SB(0, 0), b2, voffB); PG8_STAGE(PG8_SB(0, 1), b2 + hstB, voffB); PG8_STAGE(PG8_SA(0, 0), a2, voffA);
            PG8_WAIT_V(8); PG8_WAIT_L(0); PG8_BAR; PG8_MMA(1, 0, At, B0); PG8_MMA(1, 1, At, B1); PG8_BAR; PG8_SCHED;
            PG8_LDB(B0, 1, 0); PG8_LDB(B1, 1, 1); PG8_SCHED; PG8_LDA(At, 1, 0); PG8_STAGE(PG8_SA(0, 1), a2 + hstA, voffA);
            PG8_WAIT_V(8); PG8_WAIT_L(0); PG8_BAR; PG8_MMA(0, 0, At, B0); PG8_MMA(0, 1, At, B1); PG8_BAR; PG8_SCHED;
            PG8_LDA(At, 1, 1); PG8_STAGE(PG8_SB(1, 0), b3, voffB); PG8_STAGE(PG8_SB(1, 1), b3 + hstB, voffB); PG8_STAGE(PG8_SA(1, 0), a3, voffA);
            PG8_WAIT_V(8); PG8_WAIT_L(0); PG8_BAR; PG8_MMA(1, 0, At, B0); PG8_MMA(1, 1, At, B1); PG8_BAR; PG8_SCHED;
            } else {
            PG8_LDB(B0, 0, 0); PG8_SCHED; PG8_LDA(At, 0, 0); PG8_STAGE(PG8_SA(1, 1), a1 + hstA, voffA);
            PG8_WAIT_L(8); PG8_BAR; PG8_WAIT_L(0); PG8_MMA(0, 0, At, B0); PG8_BAR; PG8_SCHED;
            PG8_LDB(B1, 0, 1); PG8_STAGE(PG8_SB(0, 0), b2, voffB);
            PG8_BAR; PG8_WAIT_L(0); PG8_MMA(0, 1, At, B1); PG8_BAR;
            PG8_LDA(At, 0, 1); PG8_STAGE(PG8_SA(0, 0), a2, voffA);
            PG8_BAR; PG8_WAIT_L(0); PG8_MMA(1, 0, At, B0); PG8_BAR; PG8_SCHED;
            PG8_STAGE(PG8_SB(0, 1), b2 + hstB, voffB);
            PG8_WAIT_V(6); PG8_BAR; PG8_MMA(1, 1, At, B1); PG8_BAR;
            PG8_LDB(B0, 1, 0); PG8_SCHED; PG8_LDA(At, 1, 0); PG8_STAGE(PG8_SA(0, 1), a2 + hstA, voffA);
            PG8_WAIT_L(8); PG8_BAR; PG8_WAIT_L(0); PG8_MMA(0, 0, At, B0); PG8_BAR; PG8_SCHED;
            PG8_LDB(B1, 1, 1); PG8_STAGE(PG8_SB(1, 0), b3, voffB);
            PG8_BAR; PG8_WAIT_L(0); PG8_MMA(0, 1, At, B1); PG8_BAR;
            PG8_LDA(At, 1, 1); PG8_STAGE(PG8_SA(1, 0), a3, voffA);
            PG8_BAR; PG8_WAIT_L(0); PG8_MMA(1, 0, At, B0); PG8_BAR; PG8_SCHED;
            PG8_STAGE(PG8_SB(1, 1), b3 + hstB, voffB);
            PG8_WAIT_V(6); PG8_BAR; PG8_MMA(1, 1, At, B1); PG8_BAR;
            }
        }
        if constexpr (ALIGN_EPI) { if (wr == 0) PG8_BAR; }
        E(acc, cur, wr, wc, fr, fq);
        if (!has_next) break;
#pragma unroll
        for (int a = 0; a < 2; ++a)
#pragma unroll
            for (int b = 0; b < 2; ++b)
#pragma unroll
                for (int m = 0; m < 4; ++m)
#pragma unroll
                    for (int n = 0; n < 2; ++n) acc[a][b][m][n] = (f32x4){0.f, 0.f, 0.f, 0.f};
        cur = nxt; cA = nA; cB = nB; ++ui;
        if constexpr (ALIGN_EPI) { if (wr == 1) PG8_BAR; }
    }
    PG8_WAIT_V(0);
    if constexpr (!ALIGN_EPI) { if (wr == 0) PG8_BAR; }
    PG8_BAR;
#undef PG8_SA
#undef PG8_SB
#undef PG8_STAGE
#undef PG8_LDA
#undef PG8_LDB
#undef PG8_MMA
#undef PG8_WAIT_V
#undef PG8_WAIT_L
#undef PG8_BAR
#undef PG8_SCHED
}
}

typedef f32x4 AccT[2][2][4][2];

struct EpiGU {
    const float* ssq; bf16_t* O;
    __device__ __forceinline__ void operator()(const AccT& acc, const pg8::Unit& u, int wr, int wc, int fr, int fq) const {
        const int row0 = u.pm * 256 + wr * 64 + fr, col0 = u.pn * 128 + wc * 32 + 8 * fq;
        float rs[2][4];
#pragma unroll
        for (int ai = 0; ai < 2; ++ai)
#pragma unroll
            for (int m = 0; m < 4; ++m) rs[ai][m] = ssq[row0 + ai * 128 + m * 16];
        __builtin_amdgcn_sched_barrier(0);
#pragma unroll
        for (int ai = 0; ai < 2; ++ai)
#pragma unroll
            for (int m = 0; m < 4; ++m) {
                const int row = row0 + ai * 128 + m * 16;
                const float rstd = rsqrtf(rs[ai][m] * (1.f / D) + EPS);
                float v[8];
#pragma unroll
                for (int n = 0; n < 2; ++n)
#pragma unroll
                    for (int j = 0; j < 4; ++j) { const float gg = acc[ai][0][m][n][j] * rstd, uu = acc[ai][1][m][n][j] * rstd; v[4 * n + j] = siluf_(gg) * uu; }
                u32x4 w; w.x = cvt_pk_bf16(v[0], v[1]); w.y = cvt_pk_bf16(v[2], v[3]); w.z = cvt_pk_bf16(v[4], v[5]); w.w = cvt_pk_bf16(v[6], v[7]);
                *(u32x4*)(O + (size_t)row * DFF + col0) = w;
            }
    }
};
struct EpiRes {
    bf16_t* xb; float* ssq; float alpha;
    __device__ __forceinline__ void operator()(const AccT& acc, const pg8::Unit& u, int wr, int wc, int fr, int fq) const {
        const int row0 = u.pm * 256 + wr * 64 + fr, col0 = u.pn * 256 + wc * 32 + 8 * fq;
        u32x4 xv[2][4][2];
#pragma unroll
        for (int ai = 0; ai < 2; ++ai)
#pragma unroll
            for (int m = 0; m < 4; ++m)
#pragma unroll
                for (int bj = 0; bj < 2; ++bj) xv[ai][m][bj] = *(const u32x4*)(xb + (size_t)(row0 + ai * 128 + m * 16) * D + col0 + bj * 128);
        __builtin_amdgcn_sched_barrier(0);
#pragma unroll
        for (int ai = 0; ai < 2; ++ai)
#pragma unroll
            for (int m = 0; m < 4; ++m) {
                const int row = row0 + ai * 128 + m * 16;
                float s = 0.f;
#pragma unroll
                for (int bj = 0; bj < 2; ++bj) {
                    const u32x4 q = xv[ai][m][bj];
                    float y[8];
                    y[0] = bf_lo(q.x) + acc[ai][bj][m][0].x * alpha; y[1] = bf_hi(q.x) + acc[ai][bj][m][0].y * alpha; y[2] = bf_lo(q.y) + acc[ai][bj][m][0].z * alpha; y[3] = bf_hi(q.y) + acc[ai][bj][m][0].w * alpha;
                    y[4] = bf_lo(q.z) + acc[ai][bj][m][1].x * alpha; y[5] = bf_hi(q.z) + acc[ai][bj][m][1].y * alpha; y[6] = bf_lo(q.w) + acc[ai][bj][m][1].z * alpha; y[7] = bf_hi(q.w) + acc[ai][bj][m][1].w * alpha;
#pragma unroll
                    for (int e = 0; e < 8; ++e) s += y[e] * y[e];
                    u32x4 w; w.x = cvt_pk_bf16(y[0], y[1]); w.y = cvt_pk_bf16(y[2], y[3]); w.z = cvt_pk_bf16(y[4], y[5]); w.w = cvt_pk_bf16(y[6], y[7]);
                    *(u32x4*)(xb + (size_t)row * D + col0 + bj * 128) = w;
                }
                s += __shfl_xor(s, 16); s += __shfl_xor(s, 32);
                if (fq == 0) atomicAdd(ssq + row, s);
            }
    }
};
struct EpiIn {
    const float* ssq; unsigned char* T; bf16_t* halo; float* sm;
    __device__ __forceinline__ void operator()(const AccT& acc, const pg8::Unit& u, int wr, int wc, int fr, int fq) const {
        const int pn = u.pn;
        const int row0 = u.pm * 256 + wr * 64 + fr;
        float rs[2][4];
#pragma unroll
        for (int ai = 0; ai < 2; ++ai)
#pragma unroll
            for (int m = 0; m < 4; ++m) rs[ai][m] = ssq[row0 + ai * 128 + m * 16];
        __builtin_amdgcn_sched_barrier(0);
        int act = 0, ld, ct; bf16_t* base;
        if (pn < 2) { base = (bf16_t*)(T + T_Q); ld = 512; ct = pn; }
        else if (pn < 4) { base = (bf16_t*)(T + T_K); ld = 512; ct = pn - 2; }
        else if (pn < 8) { base = (bf16_t*)(T + T_V); ld = 1024; ct = pn - 4; }
        else if (pn < 12) { base = (bf16_t*)(T + T_SG); ld = 1024; ct = pn - 8; act = 1; }
        else if (pn < 20) { base = (bf16_t*)(T + T_SZ); ld = 2048; ct = pn - 12; act = 1; }
        else if (pn < 36) { base = (bf16_t*)(T + T_XBC); ld = 4096; ct = pn - 20; act = 3; }
        else if (pn < 44) { base = (bf16_t*)(T + T_GT); ld = 2048; ct = pn - 36; act = 2; }
        else { base = nullptr; ld = 0; ct = 0; act = 4; }
        if (act == 4) {
            if (wc < 2) {
#pragma unroll
                for (int ai = 0; ai < 2; ++ai)
#pragma unroll
                    for (int m = 0; m < 4; ++m) {
                        const int row = row0 + ai * 128 + m * 16;
                        const float rstd = rsqrtf(rs[ai][m] * (1.f / D) + EPS);
                        float* p = sm + (size_t)row * 64 + wc * 32 + 8 * fq;
                        *(f32x4*)p = acc[ai][0][m][0] * rstd; *(f32x4*)(p + 4) = acc[ai][0][m][1] * rstd;
                    }
            }
            return;
        }
        const int col0 = ct * 256 + wc * 32 + 8 * fq;
        if (act == 1) tile<1>(acc, rs, base, ld, row0, col0);
        else if (act == 2) tile<2>(acc, rs, base, ld, row0, col0);
        else if (act == 3) tile<3>(acc, rs, base, ld, row0, col0);
        else tile<0>(acc, rs, base, ld, row0, col0);
    }
    template <int ACT> __device__ __forceinline__ void tile(const AccT& acc, const float (&rs)[2][4], bf16_t* base, int ld, int row0, int col0) const {
#pragma unroll
        for (int ai = 0; ai < 2; ++ai)
#pragma unroll
            for (int m = 0; m < 4; ++m) {
                const int row = row0 + ai * 128 + m * 16;
                const float rstd = rsqrtf(rs[ai][m] * (1.f / D) + EPS);
#pragma unroll
                for (int bj = 0; bj < 2; ++bj) {
                    float v[8];
#pragma unroll
                    for (int n = 0; n < 2; ++n)
#pragma unroll
                        for (int j = 0; j < 4; ++j) { float x = acc[ai][bj][m][n][j] * rstd; if (ACT == 1) x = siluf_(x); else if (ACT == 2) x = sigmoidf_(x); v[4 * n + j] = x; }
                    u32x4 w; w.x = cvt_pk_bf16(v[0], v[1]); w.y = cvt_pk_bf16(v[2], v[3]); w.z = cvt_pk_bf16(v[4], v[5]); w.w = cvt_pk_bf16(v[6], v[7]);
                    *(u32x4*)(base + (size_t)row * ld + col0 + bj * 128) = w;
                    if (ACT == 3 && (row & 63) >= 61) *(u32x4*)(halo + ((size_t)(row >> 6) * 3 + ((row & 63) - 61)) * 4096 + col0 + bj * 128) = w;
                }
            }
    }
};
struct EpiGate {
    const bf16_t* gt; const bf16_t* t1; bf16_t* out; int mode;
    __device__ __forceinline__ void operator()(const AccT& acc, const pg8::Unit& u, int wr, int wc, int fr, int fq) const {
        const int row0 = u.pm * 256 + wr * 64 + fr, col0 = u.pn * 256 + wc * 32 + 8 * fq;
#pragma unroll
        for (int ai = 0; ai < 2; ++ai) {
            u32x4 gq[4][2], tq[4][2];
#pragma unroll
            for (int m = 0; m < 4; ++m)
#pragma unroll
                for (int bj = 0; bj < 2; ++bj) { const int row = row0 + ai * 128 + m * 16, col = col0 + bj * 128;
                    gq[m][bj] = *(const u32x4*)(gt + (size_t)row * 2048 + mode * 1024 + col);
                    tq[m][bj] = mode ? *(const u32x4*)(t1 + (size_t)row * D + col) : (u32x4){0u, 0u, 0u, 0u}; }
            __builtin_amdgcn_sched_barrier(0);
#pragma unroll
            for (int m = 0; m < 4; ++m)
#pragma unroll
                for (int bj = 0; bj < 2; ++bj) {
                    const int row = row0 + ai * 128 + m * 16, col = col0 + bj * 128;
                    const u32x4 g4 = gq[m][bj], t4 = tq[m][bj];
                    float v[8];
                    v[0] = acc[ai][bj][m][0].x * bf_lo(g4.x); v[1] = acc[ai][bj][m][0].y * bf_hi(g4.x); v[2] = acc[ai][bj][m][0].z * bf_lo(g4.y); v[3] = acc[ai][bj][m][0].w * bf_hi(g4.y);
                    v[4] = acc[ai][bj][m][1].x * bf_lo(g4.z); v[5] = acc[ai][bj][m][1].y * bf_hi(g4.z); v[6] = acc[ai][bj][m][1].z * bf_lo(g4.w); v[7] = acc[ai][bj][m][1].w * bf_hi(g4.w);
                    if (mode) { v[0] += bf_lo(t4.x); v[1] += bf_hi(t4.x); v[2] += bf_lo(t4.y); v[3] += bf_hi(t4.y); v[4] += bf_lo(t4.z); v[5] += bf_hi(t4.z); v[6] += bf_lo(t4.w); v[7] += bf_hi(t4.w); }
                    u32x4 w; w.x = cvt_pk_bf16(v[0], v[1]); w.y = cvt_pk_bf16(v[2], v[3]); w.z = cvt_pk_bf16(v[4], v[5]); w.w = cvt_pk_bf16(v[6], v[7]);
                    *(u32x4*)(out + (size_t)row * D + col) = w;
                }
        }
    }
};

__device__ __forceinline__ void tr_item(const float* srcp, int ld, const float* sk, float mul, int k0, int K, bf16_t* dst, int n0, LAS float* scr, int lane) {
#pragma unroll
    for (int i = 0; i < 32; ++i) { const int kk = 2 * i + (lane >> 5);
        float v = 0.f; if (srcp) v = srcp[(size_t)(k0 + kk) * ld] * (sk ? sk[k0 + kk] : 1.f) * mul;
        scr[kk * 33 + (lane & 31)] = v; }
    asm volatile("s_waitcnt lgkmcnt(0)" ::: "memory");
    const int c = lane & 7;
#pragma unroll
    for (int j = 0; j < 4; ++j) { const int n = (lane >> 3) + 8 * j; const LAS float* s = scr + (8 * c) * 33 + n;
        u32x4 o; o.x = cvt_pk_bf16(s[0 * 33], s[1 * 33]); o.y = cvt_pk_bf16(s[2 * 33], s[3 * 33]); o.z = cvt_pk_bf16(s[4 * 33], s[5 * 33]); o.w = cvt_pk_bf16(s[6 * 33], s[7 * 33]);
        *(u32x4*)(dst + (size_t)(n0 + n) * K + k0 + 8 * c) = o; }
    asm volatile("s_waitcnt lgkmcnt(0)" ::: "memory");
}
__device__ __forceinline__ int win_src_col(int nd) {
    if (nd < 3072) return nd;
    if (nd < 5120) return 3088 + (nd - 3072);
    if (nd < 9216) return 5136 + (nd - 5120);
    if (nd < 11264) return 9264 + (nd - 9216);
    if (nd < 11280) return 3072 + (nd - 11264);
    if (nd < 11312) return 9232 + (nd - 11280);
    return -1;
}

struct Params {
    const float* in[24];
    float* out;
    unsigned char* ws;
};

typedef __attribute__((address_space(4))) const Params* KP;
__device__ __forceinline__ Params load_params(KP p) { Params r;
#pragma unroll
    for (int i = 0; i < 24; ++i) r.in[i] = p->in[i];
    r.out = p->out; r.ws = p->ws; return r; }
__device__ __forceinline__ int tid_fresh() { int t = threadIdx.x; asm volatile("" : "+v"(t)); return t; }
__device__ __forceinline__ void p0_prologue(KP Pp, LAS unsigned char* lds, int G) {
    const Params P = load_params(Pp);
    const int tid = tid_fresh(), lane = tid & 63, wave = tid >> 6;
    LAS float* scr = (LAS float*)(lds + wave * 16384);
    const int gw = blockIdx.x * 8 + wave, NGW = G * 8;
    unsigned char* ws = P.ws;
    constexpr int I_GU = (D / 64) * (NGU / 32), I_DN = (DFF / 64) * (D / 32), I_IN = (D / 64) * (NIN / 32), I_GO = (D / 64) * (D / 32), I_SO = (2048 / 64) * (D / 32);
    constexpr int NITEMS = 2 * I_GU + 2 * I_DN + I_IN + 2 * I_GO + I_SO;
    for (int it = gw; it < NITEMS; it += NGW) {
        int r = it; const int j = lane & 31;
        if (r < 2 * I_GU) { const int l2 = r >= I_GU; r -= l2 * I_GU; const int nb = r % (NGU / 32), kb = r / (NGU / 32); const int nd = nb * 32 + j, tile = nd >> 8, w = nd & 255;
            const float* Wg = P.in[l2 ? 20 : 2]; const float* Wu = P.in[l2 ? 21 : 3];
            const float* sp = (w < 128 ? Wg : Wu) + 128 * tile + (w & 127);
            tr_item(sp, DFF, P.in[l2 ? 19 : 1], 1.f, kb * 64, D, (bf16_t*)(ws + (l2 ? WS_WGU2 : WS_WGU1)), nb * 32, scr, lane); continue; }
        r -= 2 * I_GU;
        if (r < 2 * I_DN) { const int l2 = r >= I_DN; r -= l2 * I_DN; const int nb = r % (D / 32), kb = r / (D / 32);
            tr_item(P.in[l2 ? 22 : 4] + nb * 32 + j, D, nullptr, 1.f, kb * 64, DFF, (bf16_t*)(ws + (l2 ? WS_WD2 : WS_WD1)), nb * 32, scr, lane); continue; }
        r -= 2 * I_DN;
        if (r < I_IN) { const int nb = r % (NIN / 32), kb = r / (NIN / 32); const int nd = nb * 32 + j, sc = win_src_col(nd);
            tr_item(sc >= 0 ? P.in[6] + sc : nullptr, IN_DIM, P.in[5], nd < 512 ? 0.08838834764831845f : 1.f, kb * 64, D, (bf16_t*)(ws + WS_WIN), nb * 32, scr, lane); continue; }
        r -= I_IN;
        if (r < 2 * I_GO) { const int l2 = r >= I_GO; r -= l2 * I_GO; const int nb = r % (D / 32), kb = r / (D / 32);
            tr_item(P.in[l2 ? 18 : 10] + nb * 32 + j, D, nullptr, 1.f, kb * 64, D, (bf16_t*)(ws + (l2 ? WS_WOUT : WS_WGO)), nb * 32, scr, lane); continue; }
        r -= 2 * I_GO;
        { const int nb = r % (D / 32), kb = r / (D / 32);
            tr_item(P.in[17] + nb * 32 + j, D, nullptr, 1.f, kb * 64, 2048, (bf16_t*)(ws + WS_WSO), nb * 32, scr, lane); }
    }
    const float* x = P.in[0]; bf16_t* xb = (bf16_t*)(ws + WS_XB); float* ssq = (float*)(ws + WS_SSQ);
    for (int m0 = gw; m0 < MTOK; m0 += 4 * NGW) {
        f32x4 v[4][4];
#pragma unroll
        for (int u = 0; u < 4; ++u) { const int m = m0 + u * NGW; if (m < MTOK) { const f32x4* xr = (const f32x4*)(x + (size_t)m * D) + lane;
#pragma unroll
            for (int jj = 0; jj < 4; ++jj) v[u][jj] = xr[64 * jj]; } }
#pragma unroll
        for (int u = 0; u < 4; ++u) { const int m = m0 + u * NGW; if (m < MTOK) {
            unsigned long long* o8 = (unsigned long long*)(xb + (size_t)m * D) + lane;
            float s = 0.f;
#pragma unroll
            for (int jj = 0; jj < 4; ++jj) { const f32x4 q = v[u][jj]; s += q.x * q.x + q.y * q.y + q.z * q.z + q.w * q.w;
                o8[64 * jj] = (unsigned long long)cvt_pk_bf16(q.x, q.y) | ((unsigned long long)cvt_pk_bf16(q.z, q.w) << 32); }
            s = wave_sum(s);
            if (lane == 0) { ssq[m] = s; ssq[MTOK + m] = 0.f; ssq[2 * MTOK + m] = 0.f; ssq[3 * MTOK + m] = 0.f; } } }
    }
}

__device__ __forceinline__ void p4_prep(KP Pp, LAS unsigned char* lds, int G) {
    const Params P = load_params(Pp);
    const int tid = tid_fresh();
    unsigned char* ws = P.ws; unsigned char* T = ws + WS_BIG;
    const float* sm = (const float*)(ws + WS_SM);
    for (int it = blockIdx.x; it < HB * NCH; it += G) {
        const int row0 = it * 64;
#pragma unroll
        for (int i = 0; i < 2; ++i) { const int idx = tid + 512 * i; *(LAS f32x4*)(lds + idx * 16) = *(const f32x4*)(sm + (size_t)row0 * 64 + idx * 4); }
        __syncthreads();
        {
            const int hc = tid;
            const float* wf = P.in[7]; float w[16];
#pragma unroll
            for (int j = 0; j < 16; ++j) w[j] = wf[j * 512 + hc];
            const float bfv = P.in[8][hc];
            float la[64]; float cum = 0.f;
#pragma unroll
            for (int t = 0; t < 64; ++t) { float z = bfv;
#pragma unroll
                for (int j4 = 0; j4 < 4; ++j4) { const f32x4 f = *(const LAS f32x4*)(lds + t * 256 + j4 * 16); z += f.x * w[4 * j4] + f.y * w[4 * j4 + 1] + f.z * w[4 * j4 + 2] + f.w * w[4 * j4 + 3]; }
                la[t] = (fminf(z, 0.f) - __logf(1.f + __expf(-fabsf(z)))) * (1.f / 16.f); cum += la[t]; }
            const float end = cum; cum = 0.f;
            bf16_t* kp = (bf16_t*)(T + T_K) + (size_t)row0 * 512 + hc;
#pragma unroll
            for (int tb = 0; tb < 4; ++tb) {
                bf16_t kk[16];
#pragma unroll
                for (int u = 0; u < 16; ++u) kk[u] = kp[(size_t)(tb * 16 + u) * 512];
#pragma unroll
                for (int u = 0; u < 16; ++u) { const int t = tb * 16 + u;
                    cum += la[t];
                    const float kv = __uint_as_float((unsigned)kk[u] << 16) * __expf(end - cum);
                    kp[(size_t)t * 512] = (bf16_t)(cvt_pk_bf16(kv, 0.f) & 0xffffu); }
            }
            ((float*)(ws + WS_DEC))[(size_t)it * 512 + hc] = __expf(end);
        }
        if (tid < 32) {
            const float bias = P.in[13][tid], A = -__expf(P.in[14][tid]);
            float cum = 0.f;
#pragma unroll 4
            for (int t = 0; t < 64; ++t) cum += softplusf_(*(const LAS float*)(lds + t * 256 + (16 + tid) * 4) + bias) * A;
            const float end = cum; cum = 0.f;
            float* wg = (float*)(ws + WS_WG);
#pragma unroll 4
            for (int t = 0; t < 64; ++t) { const float dt = softplusf_(*(const LAS float*)(lds + t * 256 + (16 + tid) * 4) + bias); cum += dt * A; wg[(size_t)(row0 + t) * 32 + tid] = __expf(end - cum) * dt; }
            ((float*)(ws + WS_DECS))[it * 32 + tid] = __expf(end);
        }
        __syncthreads();
    }
    const int co = tid & 63, rg = tid >> 6;
    u32x4 raw[11];
#define CONV_LOAD(itx) do { const int _ci = (itx) >> 3, _col = ((itx) & 7) * 512 + co * 8; \
        const bf16_t* _xp = (const bf16_t*)(T + T_XBC) + (size_t)(_ci * 64 + rg * 8) * 4096 + _col; \
        _Pragma("unroll") for (int i = 0; i < 8; ++i) raw[3 + i] = *(const u32x4*)(_xp + (size_t)i * 4096); \
        if (rg > 0) { _Pragma("unroll") for (int i = 0; i < 3; ++i) raw[i] = *(const u32x4*)(_xp - (size_t)(3 - i) * 4096); } \
        else if ((_ci & (NCH - 1)) != 0) { const bf16_t* _hp = (const bf16_t*)(ws + WS_HALO) + (size_t)(_ci - 1) * 3 * 4096 + _col; \
            _Pragma("unroll") for (int i = 0; i < 3; ++i) raw[i] = *(const u32x4*)(_hp + (size_t)i * 4096); } \
        else { _Pragma("unroll") for (int i = 0; i < 3; ++i) raw[i] = (u32x4){0u, 0u, 0u, 0u}; } } while (0)
    float cw[4][8], cbv[8];
    { const int colw = ((G & 7) == 0 ? ((int)blockIdx.x & 7) : 0) * 512 + co * 8;
#pragma unroll
      for (int k = 0; k < 4; ++k) { const f32x4 a = *(const f32x4*)(P.in[11] + k * 4096 + colw), b = *(const f32x4*)(P.in[11] + k * 4096 + colw + 4);
          cw[k][0] = a.x; cw[k][1] = a.y; cw[k][2] = a.z; cw[k][3] = a.w; cw[k][4] = b.x; cw[k][5] = b.y; cw[k][6] = b.z; cw[k][7] = b.w; }
      { const f32x4 a = *(const f32x4*)(P.in[12] + colw), b = *(const f32x4*)(P.in[12] + colw + 4);
          cbv[0] = a.x; cbv[1] = a.y; cbv[2] = a.z; cbv[3] = a.w; cbv[4] = b.x; cbv[5] = b.y; cbv[6] = b.z; cbv[7] = b.w; } }
    if ((int)blockIdx.x < HB * NCH * 8) CONV_LOAD((int)blockIdx.x);
    for (int it = blockIdx.x; it < HB * NCH * 8; it += G) {
        const int ci = it >> 3, cb = it & 7, col = cb * 512 + co * 8, row0 = ci * 64 + rg * 8;
        bf16_t* xp = (bf16_t*)(T + T_XBC) + (size_t)row0 * 4096 + col;
        if ((G & 7) != 0) {
#pragma unroll
            for (int k = 0; k < 4; ++k) { const f32x4 a = *(const f32x4*)(P.in[11] + k * 4096 + col), b = *(const f32x4*)(P.in[11] + k * 4096 + col + 4);
                cw[k][0] = a.x; cw[k][1] = a.y; cw[k][2] = a.z; cw[k][3] = a.w; cw[k][4] = b.x; cw[k][5] = b.y; cw[k][6] = b.z; cw[k][7] = b.w; }
            { const f32x4 a = *(const f32x4*)(P.in[12] + col), b = *(const f32x4*)(P.in[12] + col + 4);
                cbv[0] = a.x; cbv[1] = a.y; cbv[2] = a.z; cbv[3] = a.w; cbv[4] = b.x; cbv[5] = b.y; cbv[6] = b.z; cbv[7] = b.w; }
        }
        asm volatile("s_waitcnt vmcnt(0)" ::: "memory");
        __syncthreads();
        u32x4 outv[8];
#pragma unroll
        for (int i = 0; i < 8; ++i) {
            float v[8];
#pragma unroll
            for (int e = 0; e < 8; ++e) v[e] = cbv[e];
#pragma unroll
            for (int k = 0; k < 4; ++k) { const u32x4 q = raw[i + k];
                v[0] += cw[k][0] * bf_lo(q.x); v[1] += cw[k][1] * bf_hi(q.x); v[2] += cw[k][2] * bf_lo(q.y); v[3] += cw[k][3] * bf_hi(q.y);
                v[4] += cw[k][4] * bf_lo(q.z); v[5] += cw[k][5] * bf_hi(q.z); v[6] += cw[k][6] * bf_lo(q.w); v[7] += cw[k][7] * bf_hi(q.w); }
#pragma unroll
            for (int e = 0; e < 8; ++e) v[e] = siluf_(v[e]);
            outv[i].x = cvt_pk_bf16(v[0], v[1]); outv[i].y = cvt_pk_bf16(v[2], v[3]); outv[i].z = cvt_pk_bf16(v[4], v[5]); outv[i].w = cvt_pk_bf16(v[6], v[7]);
        }
        if (it + G < HB * NCH * 8) CONV_LOAD(it + G);
#pragma unroll
        for (int i = 0; i < 8; ++i) *(u32x4*)(xp + (size_t)i * 4096) = outv[i];
    }
#undef CONV_LOAD
}

struct MixArgs {
    const bf16_t* ak; int ld_ak;
    const bf16_t* qq; int ld_q;
    const bf16_t* bv; int ld_bv;
    const bf16_t* gt; int ld_g;
    bf16_t* out; int ld_o;
    const float* dec;
    const float* wg;
    const float* nw;
    const float* dsk;
};
constexpr int RSA = 320, RSB = 576, RSQ = 264, RSG = 520, RSX = 520;
constexpr int OFF_AK = 0, OFF_BV = 64 * RSA, OFF_QQ = OFF_BV + 64 * RSB, OFF_WGT = OFF_QQ + 64 * RSQ, OFF_DEC = OFF_WGT + 1024, OFF_RED = OFF_DEC + 512, OFF_NW = OFF_RED + 2048, OFF_GT = OFF_NW + 1024, OFF_XS2 = OFF_GT + 64 * RSG;
static_assert(OFF_XS2 + 64 * RSX <= LDS_XB, "mixer LDS");

#define LBAR() do { asm volatile("s_waitcnt lgkmcnt(0)" ::: "memory"); __builtin_amdgcn_s_barrier(); asm volatile("" ::: "memory"); } while (0)
template <bool SSD>
__device__ __forceinline__ void mixer_item(LAS unsigned char* lds, const MixArgs& a) {
    const int tid = tid_fresh(), lane = tid & 63, w = __builtin_amdgcn_readfirstlane(tid >> 6);
    const int r = lane & 31, h = lane >> 5, gg = lane >> 4, q = (lane & 15) >> 2, p = lane & 3;
    const int arow0 = tid >> 4, apc = tid & 15;
    const int brow0 = tid >> 5, bpc = tid & 31;
    u32x4 stA[2], stQ[2], stB[4], stG[4], stD; float stWp[4];
    stD = (u32x4){0u, 0u, 0u, 0u}; stWp[0] = stWp[1] = stWp[2] = stWp[3] = 0.f;
#define MIX_LOAD(c) do { const size_t _r0 = (size_t)(c) * 64; \
        _Pragma("unroll") for (int i = 0; i < 2; ++i) { stA[i] = *(const u32x4*)(a.ak + (_r0 + arow0 + 32 * i) * a.ld_ak + apc * 8); stQ[i] = *(const u32x4*)(a.qq + (_r0 + arow0 + 32 * i) * a.ld_q + apc * 8); } \
        _Pragma("unroll") for (int i = 0; i < 4; ++i) { stB[i] = *(const u32x4*)(a.bv + (_r0 + brow0 + 16 * i) * a.ld_bv + bpc * 8); stG[i] = *(const u32x4*)(a.gt + (_r0 + brow0 + 16 * i) * a.ld_g + bpc * 8); } \
        if (SSD) { _Pragma("unroll") for (int i = 0; i < 4; ++i) stWp[i] = a.wg[(_r0 + brow0 + 16 * i) * 32 + (bpc >> 3)]; }     \
        else { if (tid < 32) stD = *(const u32x4*)(a.dec + (size_t)(c) * 512 + tid * 4); } } while (0)
#define MIX_STORE() do { \
        _Pragma("unroll") for (int i = 0; i < 2; ++i) { *(LAS u32x4*)(lds + OFF_AK + (arow0 + 32 * i) * RSA + apc * 16) = stA[i]; \
            *(LAS u32x2*)(lds + OFF_QQ + (arow0 + 32 * i) * RSQ + apc * 16) = (u32x2){stQ[i].x, stQ[i].y}; *(LAS u32x2*)(lds + OFF_QQ + (arow0 + 32 * i) * RSQ + apc * 16 + 8) = (u32x2){stQ[i].z, stQ[i].w}; } \
        _Pragma("unroll") for (int i = 0; i < 4; ++i) { \
            if (SSD) { *(LAS u32x2*)(lds + OFF_XS2 + (brow0 + 16 * i) * RSX + bpc * 16) = (u32x2){stB[i].x, stB[i].y}; *(LAS u32x2*)(lds + OFF_XS2 + (brow0 + 16 * i) * RSX + bpc * 16 + 8) = (u32x2){stB[i].z, stB[i].w}; \
                const float _w = stWp[i]; u32x4 _b; _b.x = cvt_pk_bf16(bf_lo(stB[i].x) * _w, bf_hi(stB[i].x) * _w); _b.y = cvt_pk_bf16(bf_lo(stB[i].y) * _w, bf_hi(stB[i].y) * _w); \
                _b.z = cvt_pk_bf16(bf_lo(stB[i].z) * _w, bf_hi(stB[i].z) * _w); _b.w = cvt_pk_bf16(bf_lo(stB[i].w) * _w, bf_hi(stB[i].w) * _w); \
                *(LAS u32x4*)(lds + OFF_BV + (brow0 + 16 * i) * RSB + bpc * 16) = _b; } \
            else *(LAS u32x4*)(lds + OFF_BV + (brow0 + 16 * i) * RSB + bpc * 16) = stB[i]; \
            *(LAS u32x2*)(lds + OFF_GT + (brow0 + 16 * i) * RSG + bpc * 16) = (u32x2){stG[i].x, stG[i].y}; *(LAS u32x2*)(lds + OFF_GT + (brow0 + 16 * i) * RSG + bpc * 16 + 8) = (u32x2){stG[i].z, stG[i].w}; } \
        if (!SSD) { if (tid < 32) *(LAS u32x4*)(lds + OFF_DEC + tid * 16) = stD; } } while (0)

    if (tid < 256) *(LAS float*)(lds + OFF_NW + tid * 4) = a.nw[tid];
    MIX_LOAD(0);
    MIX_STORE();
    __syncthreads();

    f32x16 S[4];
#pragma unroll
    for (int i = 0; i < 4; ++i)
#pragma unroll
        for (int e = 0; e < 16; ++e) S[i][e] = 0.f;

    const int trA = OFF_AK + (8 * h + q) * RSA + (16 * (gg & 1) + 4 * p) * 2;
    const int trB = OFF_BV + (8 * h + q) * RSB + (32 * w + 16 * (gg & 1) + 4 * p) * 2;
    const int qB = OFF_QQ + r * RSQ + 8 * h;
    const int gB = OFF_GT + r * RSG + (32 * w + 4 * h) * 2;
    const float dsk = SSD ? a.dsk[w >> 1] : 0.f;
    float dc_next = SSD ? a.dec[w >> 1] : 0.f;

    for (int c = 0; c < NCH; ++c) {
        if (c + 1 < NCH) MIX_LOAD(c + 1);
        if (SSD) {
            const float dc = dc_next;
            if (c + 1 < NCH) dc_next = a.dec[(size_t)(c + 1) * 32 + (w >> 1)];
#pragma unroll
            for (int i = 0; i < 4; ++i)
#pragma unroll
                for (int e = 0; e < 16; ++e) S[i][e] *= dc;
        } else {
#pragma unroll
            for (int i = 0; i < 4; ++i)
#pragma unroll
                for (int g = 0; g < 4; ++g) { const f32x4 d4 = *(const LAS f32x4*)(lds + OFF_DEC + (32 * i + 8 * g + 4 * h) * 4);
                    S[i][4 * g + 0] *= d4.x; S[i][4 * g + 1] *= d4.y; S[i][4 * g + 2] *= d4.z; S[i][4 * g + 3] *= d4.w; }
        }
#define TRR(addr) __builtin_bit_cast(s16x4, __builtin_amdgcn_ds_read_tr16_b64_v4i16((LAS s16x4*)(lds + (addr))))
#define UPD_LOAD(s, B0, B1, A0, A1, W0, W1) do { B0 = TRR(trB + (16 * (s)) * RSB); B1 = TRR(trB + (16 * (s) + 4) * RSB); \
        _Pragma("unroll") for (int i = 0; i < 4; ++i) { A0[i] = TRR(trA + (16 * (s)) * RSA + 64 * i); A1[i] = TRR(trA + (16 * (s) + 4) * RSA + 64 * i); } \
        } while (0)
#define UPD_MMA(B0, B1, A0, A1, W0, W1) do { bf16x8 bfr = __builtin_shufflevector(B0, B1, 0, 1, 2, 3, 4, 5, 6, 7); \
        _Pragma("unroll") for (int i = 0; i < 4; ++i) S[i] = __builtin_amdgcn_mfma_f32_32x32x16_bf16(__builtin_shufflevector(A0[i], A1[i], 0, 1, 2, 3, 4, 5, 6, 7), bfr, S[i], 0, 0, 0); } while (0)
        {
            s16x4 xb0, xb1, xa0[4], xa1[4], yb0, yb1, ya0[4], ya1[4]; f32x4 xw0, xw1, yw0, yw1;
            xw0 = xw1 = yw0 = yw1 = (f32x4){0.f, 0.f, 0.f, 0.f};
            UPD_LOAD(0, xb0, xb1, xa0, xa1, xw0, xw1);
            UPD_LOAD(1, yb0, yb1, ya0, ya1, yw0, yw1);
            __builtin_amdgcn_sched_barrier(0);
            UPD_MMA(xb0, xb1, xa0, xa1, xw0, xw1);
            __builtin_amdgcn_sched_barrier(0);
            UPD_LOAD(2, xb0, xb1, xa0, xa1, xw0, xw1);
            __builtin_amdgcn_sched_barrier(0);
            UPD_MMA(yb0, yb1, ya0, ya1, yw0, yw1);
            __builtin_amdgcn_sched_barrier(0);
            UPD_LOAD(3, yb0, yb1, ya0, ya1, yw0, yw1);
            __builtin_amdgcn_sched_barrier(0);
            UPD_MMA(xb0, xb1, xa0, xa1, xw0, xw1);
            __builtin_amdgcn_sched_barrier(0);
            UPD_MMA(yb0, yb1, ya0, ya1, yw0, yw1);
        }
#undef UPD_LOAD
#undef UPD_MMA
        f32x16 OT[2];
#pragma unroll
        for (int j2 = 0; j2 < 2; ++j2)
#pragma unroll
            for (int e = 0; e < 16; ++e) OT[j2][e] = 0.f;
        {
            u32x2 qf[3][2][2];
#define Q_LOAD(sp, buf) do { _Pragma("unroll") for (int j2 = 0; j2 < 2; ++j2) { qf[buf][j2][0] = *(const LAS u32x2*)(lds + qB + 32 * j2 * RSQ + (16 * (sp)) * 2); qf[buf][j2][1] = *(const LAS u32x2*)(lds + qB + 32 * j2 * RSQ + (16 * (sp) + 8) * 2); } } while (0)
            Q_LOAD(0, 0); Q_LOAD(1, 1);
#pragma unroll
            for (int sp = 0; sp < 8; ++sp) {
                const int i = sp >> 1, o8 = 8 * (sp & 1);
                if (sp + 2 < 8) Q_LOAD(sp + 2, (sp + 2) % 3);
                u32x4 pk;
                pk.x = cvt_pk_bf16(S[i][o8 + 0], S[i][o8 + 1]); pk.y = cvt_pk_bf16(S[i][o8 + 2], S[i][o8 + 3]);
                pk.z = cvt_pk_bf16(S[i][o8 + 4], S[i][o8 + 5]); pk.w = cvt_pk_bf16(S[i][o8 + 6], S[i][o8 + 7]);
                const bf16x8 sfr = __builtin_bit_cast(bf16x8, pk);
                __builtin_amdgcn_sched_barrier(0);
#pragma unroll
                for (int j2 = 0; j2 < 2; ++j2) {
                    const bf16x8 qfr = __builtin_bit_cast(bf16x8, (u32x4){qf[sp % 3][j2][0].x, qf[sp % 3][j2][0].y, qf[sp % 3][j2][1].x, qf[sp % 3][j2][1].y});
                    OT[j2] = __builtin_amdgcn_mfma_f32_32x32x16_bf16(sfr, qfr, OT[j2], 0, 0, 0);
                }
                __builtin_amdgcn_sched_barrier(0);
            }
#undef Q_LOAD
        }
#undef TRR
        u32x2 gv[2][4];
#pragma unroll
        for (int j2 = 0; j2 < 2; ++j2)
#pragma unroll
            for (int g = 0; g < 4; ++g) gv[j2][g] = *(const LAS u32x2*)(lds + gB + 32 * j2 * RSG + 16 * g);
        float part[2] = {0.f, 0.f};
#pragma unroll
        for (int j2 = 0; j2 < 2; ++j2)
#pragma unroll
            for (int g = 0; g < 4; ++g) {
                if (SSD) {
                    const u32x2 xs = *(const LAS u32x2*)(lds + OFF_XS2 + (32 * j2 + r) * RSX + (32 * w + 8 * g + 4 * h) * 2);
                    OT[j2][4 * g + 0] = (OT[j2][4 * g + 0] + dsk * bf_lo(xs.x)) * bf_lo(gv[j2][g].x);
                    OT[j2][4 * g + 1] = (OT[j2][4 * g + 1] + dsk * bf_hi(xs.x)) * bf_hi(gv[j2][g].x);
                    OT[j2][4 * g + 2] = (OT[j2][4 * g + 2] + dsk * bf_lo(xs.y)) * bf_lo(gv[j2][g].y);
                    OT[j2][4 * g + 3] = (OT[j2][4 * g + 3] + dsk * bf_hi(xs.y)) * bf_hi(gv[j2][g].y);
                }
#pragma unroll
                for (int k = 0; k < 4; ++k) part[j2] += OT[j2][4 * g + k] * OT[j2][4 * g + k];
            }
        part[0] += __shfl_xor(part[0], 32); part[1] += __shfl_xor(part[1], 32);
        if (h == 0) { *(LAS float*)(lds + OFF_RED + (w * 64 + r) * 4) = part[0]; *(LAS float*)(lds + OFF_RED + (w * 64 + 32 + r) * 4) = part[1]; }
        LBAR();
#pragma unroll
        for (int j2 = 0; j2 < 2; ++j2) {
            float tot = 0.f;
#pragma unroll
            for (int ww = 0; ww < 8; ++ww) tot += *(const LAS float*)(lds + OFF_RED + (ww * 64 + 32 * j2 + r) * 4);
            const float rstd = rsqrtf(tot * (1.f / 256.f) + EPS);
#pragma unroll
            for (int g = 0; g < 4; ++g) {
                const f32x4 n4 = *(const LAS f32x4*)(lds + OFF_NW + (32 * w + 8 * g + 4 * h) * 4);
                float v0 = OT[j2][4 * g + 0] * rstd * n4.x, v1 = OT[j2][4 * g + 1] * rstd * n4.y, v2 = OT[j2][4 * g + 2] * rstd * n4.z, v3 = OT[j2][4 * g + 3] * rstd * n4.w;
                if (!SSD) { v0 *= bf_lo(gv[j2][g].x); v1 *= bf_hi(gv[j2][g].x); v2 *= bf_lo(gv[j2][g].y); v3 *= bf_hi(gv[j2][g].y); }
                *(LAS u32x2*)(lds + gB + 32 * j2 * RSG + 16 * g) = (u32x2){cvt_pk_bf16(v0, v1), cvt_pk_bf16(v2, v3)};
            }
        }
        LBAR();
#pragma unroll
        for (int i = 0; i < 4; ++i) {
            const u32x2 o0 = *(const LAS u32x2*)(lds + OFF_GT + (brow0 + 16 * i) * RSG + bpc * 16), o1 = *(const LAS u32x2*)(lds + OFF_GT + (brow0 + 16 * i) * RSG + bpc * 16 + 8);
            *(u32x4*)(a.out + ((size_t)c * 64 + brow0 + 16 * i) * a.ld_o + bpc * 8) = (u32x4){o0.x, o0.y, o1.x, o1.y};
        }
        if (c + 1 < NCH) MIX_STORE();
        LBAR();
    }
#undef MIX_LOAD
#undef MIX_STORE
}

__device__ __forceinline__ void p5_mixer(KP Pp, LAS unsigned char* lds, int G) {
    const Params P = load_params(Pp);
    unsigned char* ws = P.ws; unsigned char* T = ws + WS_BIG;
    for (int it = blockIdx.x; it < HB * 12; it += G) {
        const int b = it / 12, k = it % 12;
        const size_t row0 = (size_t)b * SEQ;
        MixArgs a;
        if (k < 4) {
            const int hd = k;
            a.ak = (const bf16_t*)(T + T_K) + row0 * 512 + hd * 128; a.ld_ak = 512;
            a.qq = (const bf16_t*)(T + T_Q) + row0 * 512 + hd * 128; a.ld_q = 512;
            a.bv = (const bf16_t*)(T + T_V) + row0 * 1024 + hd * 256; a.ld_bv = 1024;
            a.gt = (const bf16_t*)(T + T_SG) + row0 * 1024 + hd * 256; a.ld_g = 1024;
            a.out = (bf16_t*)(T + T_V) + row0 * 1024 + hd * 256; a.ld_o = 1024;
            a.dec = (const float*)(ws + WS_DEC) + (size_t)b * NCH * 512 + hd * 128;
            a.wg = nullptr; a.nw = P.in[9]; a.dsk = nullptr;
            mixer_item<false>(lds, a);
        } else {
            const int g = k - 4;
            const bf16_t* X = (const bf16_t*)(T + T_XBC) + row0 * 4096;
            a.ak = X + 2048 + g * 128; a.ld_ak = 4096;
            a.qq = X + 3072 + g * 128; a.ld_q = 4096;
            a.bv = X + g * 256; a.ld_bv = 4096;
            a.gt = (const bf16_t*)(T + T_SZ) + row0 * 2048 + g * 256; a.ld_g = 2048;
            a.out = (bf16_t*)(T + T_XBC) + row0 * 4096 + g * 256; a.ld_o = 4096;
            a.dec = (const float*)(ws + WS_DECS) + (size_t)b * NCH * 32 + g * 4;
            a.wg = (const float*)(ws + WS_WG) + row0 * 32 + g * 4;
            a.nw = P.in[16] + g * 256; a.dsk = P.in[15] + g * 4;
            mixer_item<true>(lds, a);
        }
        __syncthreads();
    }
}

__device__ __forceinline__ KP get_params() {
    KP p = (KP)__builtin_amdgcn_kernarg_segment_ptr(); asm volatile("" : "+s"(p)); return p;
}

#define XB_TMO      128
#define XB_XCNT(j)  (256  + 64 * (j))
#define XB_XSUB(j)  (1280 + 64 * (j))
#define XB_XGEN(j)  (2304 + 64 * (j))
#define XB_TOP      3328
#define XB_TOPGEN   3392
#define XCD_BAR_WORDS 3456
#define XB_SPIN_CAP (1u << 18)
__device__ __forceinline__ unsigned xb_ld(unsigned* p)              { return __hip_atomic_load(p, __ATOMIC_RELAXED, __HIP_MEMORY_SCOPE_AGENT); }
__device__ __forceinline__ unsigned xb_add(unsigned* p, unsigned v) { return __hip_atomic_fetch_add(p, v, __ATOMIC_RELAXED, __HIP_MEMORY_SCOPE_AGENT); }
__device__ __forceinline__ unsigned xb_xcc_id() { return (unsigned)__builtin_amdgcn_s_getreg((3 << 11) | 20) & 0xFu; }
#define XB_SPIN(cond, bar) do { unsigned _sp = 0; while (cond) { __builtin_amdgcn_s_sleep(1); \
    if ((++_sp & 255u) == 0u) { if (xb_ld(&(bar)[XB_TMO])) break; if (_sp > XB_SPIN_CAP) { atomicAdd(&(bar)[XB_TMO], 1u); break; } } } } while (0)
struct XcdBarrier { unsigned* bar; unsigned x; volatile LAS unsigned* st; };
__device__ __forceinline__ XcdBarrier xcd_barrier_post(unsigned* bar, volatile LAS unsigned* st) {
    XcdBarrier b; b.bar = bar; b.x = xb_xcc_id(); b.st = st;
    if (threadIdx.x == 0) (void)xb_add(&bar[XB_XCNT(b.x)], 1u);
    return b;
}
__device__ __forceinline__ void xcd_barrier_complete(unsigned* bar, unsigned x, unsigned& nloc, unsigned& nx) {
    const unsigned G = gridDim.x * gridDim.y * gridDim.z;
    unsigned sum, cnt, mine, sp = 0u;
    for (;;) {
        sum = 0u; cnt = 0u; mine = 0u;
#pragma unroll
        for (unsigned j = 0; j < 16; ++j) { const unsigned c = xb_ld(&bar[XB_XCNT(j)]); sum += c; cnt += (c > 0u) ? 1u : 0u; mine = (j == x) ? c : mine; }
        if (sum == G) break;
        __builtin_amdgcn_s_sleep(1);
        if ((++sp & 255u) == 0u) { if (xb_ld(&bar[XB_TMO])) break; if (sp > XB_SPIN_CAP) { atomicAdd(&bar[XB_TMO], 1u); break; } }
    }
    nloc = mine > 0u ? mine : 1u; nx = cnt > 0u ? cnt : 1u;
}
__device__ __forceinline__ void xcd_barrier(const XcdBarrier& b) {
    asm volatile("s_waitcnt vmcnt(0)" ::: "memory");
    __syncthreads();
    if (threadIdx.x == 0) {
        unsigned* bar = b.bar;
        __builtin_amdgcn_s_waitcnt(0);
        unsigned nloc = b.st[0], nx = b.st[1];
        if (nloc == 0u) { xcd_barrier_complete(bar, b.x, nloc, nx); b.st[0] = nloc; b.st[1] = nx; }
        const unsigned old = xb_add(&bar[XB_XSUB(b.x)], 1u);
        const unsigned gen = old / nloc;
        if (old + 1u == (gen + 1u) * nloc) {
            __builtin_amdgcn_fence(__ATOMIC_RELEASE, "agent");
            asm volatile("s_waitcnt vmcnt(0)" ::: "memory");
            const unsigned og = xb_add(&bar[XB_TOP], 1u);
            const unsigned tg = og / nx;
            if (og + 1u == (tg + 1u) * nx) xb_add(&bar[XB_TOPGEN], 1u);
            else XB_SPIN(xb_ld(&bar[XB_TOPGEN]) == tg, bar);
            __builtin_amdgcn_fence(__ATOMIC_ACQUIRE, "agent");
            xb_add(&bar[XB_XGEN(b.x)], 1u);
            asm volatile("s_waitcnt vmcnt(0)" ::: "memory");
        } else {
            XB_SPIN(xb_ld(&bar[XB_XGEN(b.x)]) == gen, bar);
            __builtin_amdgcn_fence(__ATOMIC_ACQUIRE, "agent");
            asm volatile("s_waitcnt vmcnt(0)" ::: "memory");
        }
    }
    __syncthreads();
}

#define PROBE_MASK 0x0
#define PROBE_DSYNC 0
#if PROBE_MASK
#define PH_BEGIN(i) const unsigned long long _t##i = __builtin_amdgcn_s_memrealtime();
#define PH_END(i) if ((PROBE_MASK >> (i)) & 1) probe_acc += __builtin_amdgcn_s_memrealtime() - _t##i;
#else
#define PH_BEGIN(i)
#define PH_END(i)
#endif
#if PROBE_DSYNC
#define GSYNC() do { xcd_barrier(xbar); xcd_barrier(xbar); } while (0)
#else
#define GSYNC() xcd_barrier(xbar)
#endif
__global__ void __launch_bounds__(512, 2) fwd_megakernel(Params Parg) {
    extern __shared__ __attribute__((aligned(16))) unsigned char lds_raw[];
    LAS unsigned char* lds = (LAS unsigned char*)lds_raw;
    cg::grid_group grid = cg::this_grid();
    const int G = gridDim.x;
    pg8::StaticOrder S;
#if PROBE_MASK
    unsigned long long probe_acc = 0;
#endif

    { unsigned* bw = (unsigned*)(get_params()->ws + WS_BAR);
      if (blockIdx.x == 0) for (int i = threadIdx.x; i < XCD_BAR_WORDS; i += 512) bw[i] = 0u;
      if (threadIdx.x < 2) *(volatile LAS unsigned*)(lds + LDS_XB + threadIdx.x * 4) = 0u; }
    XcdBarrier xbar;
    { PH_BEGIN(0) p0_prologue(get_params(), lds, G);
    grid.sync();
    xbar = xcd_barrier_post((unsigned*)(get_params()->ws + WS_BAR), (volatile LAS unsigned*)(lds + LDS_XB));
    PH_END(0) }
    { PH_BEGIN(1) { KP P = get_params(); unsigned char* ws = P->ws;
      pg8::Gemm g{(const bf16_t*)(ws + WS_XB), (const bf16_t*)(ws + WS_WGU1), MTOK, NGU, D, D, D}; S.init(MTOK, NGU, G, blockIdx.x);
      EpiGU E{(const float*)(ws + WS_SSQ), (bf16_t*)(ws + WS_BIG)}; pg8::gemm_phase(lds, g, S, E); }
    GSYNC(); PH_END(1) }
    { PH_BEGIN(2) { KP P = get_params(); unsigned char* ws = P->ws;
      pg8::Gemm g{(const bf16_t*)(ws + WS_BIG), (const bf16_t*)(ws + WS_WD1), MTOK, D, DFF, DFF, DFF}; S.init(MTOK, D, G, blockIdx.x);
      EpiRes E{(bf16_t*)(ws + WS_XB), (float*)(ws + WS_SSQ) + MTOK, 0.5f}; pg8::gemm_phase(lds, g, S, E); }
    GSYNC(); PH_END(2) }
    for (int hf = 0; hf < 2; ++hf) {
        const size_t r0 = (size_t)hf * MH;
        { PH_BEGIN(3) { KP P = get_params(); unsigned char* ws = P->ws;
          pg8::Gemm g{(const bf16_t*)(ws + WS_XB) + r0 * D, (const bf16_t*)(ws + WS_WIN), MH, NIN, D, D, D}; S.init(MH, NIN, G, blockIdx.x);
          EpiIn E{(const float*)(ws + WS_SSQ) + MTOK + r0, ws + WS_BIG, (bf16_t*)(ws + WS_HALO), (float*)(ws + WS_SM)}; pg8::gemm_phase(lds, g, S, E); }
        GSYNC(); PH_END(3) }
        { PH_BEGIN(4) p4_prep(get_params(), lds, G);
        GSYNC(); PH_END(4) }
        { PH_BEGIN(5) p5_mixer(get_params(), lds, G);
        GSYNC(); PH_END(5) }
        { PH_BEGIN(6) { KP P = get_params(); unsigned char* ws = P->ws; unsigned char* T = ws + WS_BIG;
          pg8::Gemm g{(const bf16_t*)(T + T_V), (const bf16_t*)(ws + WS_WGO), MH, D, D, D, D}; S.init(MH, D, G, blockIdx.x);
          EpiGate E{(const bf16_t*)(T + T_GT), nullptr, (bf16_t*)(T + T_T1), 0}; pg8::gemm_phase(lds, g, S, E); }
        { KP P = get_params(); unsigned char* ws = P->ws; unsigned char* T = ws + WS_BIG;
          pg8::Gemm g{(const bf16_t*)(T + T_XBC), (const bf16_t*)(ws + WS_WSO), MH, D, 2048, 4096, 2048}; S.init(MH, D, G, blockIdx.x);
          EpiGate E{(const bf16_t*)(T + T_GT), (const bf16_t*)(T + T_T1), (bf16_t*)(T + T_MRG), 1}; pg8::gemm_phase(lds, g, S, E); }
        GSYNC(); PH_END(6) }
        { PH_BEGIN(7) { KP P = get_params(); unsigned char* ws = P->ws;
          pg8::Gemm g{(const bf16_t*)(ws + WS_BIG + T_MRG), (const bf16_t*)(ws + WS_WOUT), MH, D, D, D, D}; S.init(MH, D, G, blockIdx.x);
          EpiRes E{(bf16_t*)(ws + WS_XB) + r0 * D, (float*)(ws + WS_SSQ) + 2 * MTOK + r0, 1.0f}; pg8::gemm_phase(lds, g, S, E); }
        GSYNC(); PH_END(7) }
    }
    { PH_BEGIN(8) { KP P = get_params(); unsigned char* ws = P->ws;
      pg8::Gemm g{(const bf16_t*)(ws + WS_XB), (const bf16_t*)(ws + WS_WGU2), MTOK, NGU, D, D, D}; S.init(MTOK, NGU, G, blockIdx.x);
      EpiGU E{(const float*)(ws + WS_SSQ) + 2 * MTOK, (bf16_t*)(ws + WS_BIG)}; pg8::gemm_phase(lds, g, S, E); }
    GSYNC(); PH_END(8) }
    { PH_BEGIN(9) { KP P = get_params(); unsigned char* ws = P->ws;
      pg8::Gemm g{(const bf16_t*)(ws + WS_BIG), (const bf16_t*)(ws + WS_WD2), MTOK, D, DFF, DFF, DFF}; S.init(MTOK, D, G, blockIdx.x);
      EpiRes E{(bf16_t*)(ws + WS_XB), (float*)(ws + WS_SSQ) + 3 * MTOK, 0.5f}; pg8::gemm_phase(lds, g, S, E); }
    GSYNC(); PH_END(9) }
    { PH_BEGIN(10)
    {
        KP P = get_params(); const float* ssq = (const float*)(P->ws + WS_SSQ) + 3 * MTOK;
        const int tid = tid_fresh(), lane = tid & 63, gw = blockIdx.x * 8 + (tid >> 6), NGW = G * 8;
        const float* fw = P->in[23]; float* outp = P->out; const bf16_t* xb = (const bf16_t*)(P->ws + WS_XB);
        f32x4 wv[4];
#pragma unroll
        for (int jj = 0; jj < 4; ++jj) wv[jj] = ((const f32x4*)fw)[lane + 64 * jj];
        for (int m = gw; m < MTOK; m += NGW) {
            const float rstd = rsqrtf(ssq[m] * (1.f / D) + EPS);
            const u32x2* xr = (const u32x2*)(xb + (size_t)m * D) + lane;
            f32x4* orow = (f32x4*)(outp + (size_t)m * D) + lane;
#pragma unroll
            for (int jj = 0; jj < 4; ++jj) { const u32x2 q = xr[64 * jj]; f32x4 v;
                v.x = bf_lo(q.x) * rstd * wv[jj].x; v.y = bf_hi(q.x) * rstd * wv[jj].y; v.z = bf_lo(q.y) * rstd * wv[jj].z; v.w = bf_hi(q.y) * rstd * wv[jj].w; orow[64 * jj] = v; }
        }
    }
    PH_END(10) }
#if PROBE_MASK
    if (blockIdx.x == 0) {
        const unsigned long long t0 = __builtin_amdgcn_s_memrealtime();
        while (__builtin_amdgcn_s_memrealtime() - t0 < probe_acc) __builtin_amdgcn_s_sleep(8);
    }
#endif
}

extern "C" void kernel_launch(void* const* d_in, const int* in_sizes, int n_in, void* d_out, int out_size, void* d_ws, size_t ws_size, hipStream_t stream) {
    static int grid = 0;
    if (grid == 0) {
        if (n_in != 24 || ws_size < WS_NEED) { fprintf(stderr, "kernel_launch: unexpected n_in %d or ws_size %zu (need %zu)\n", n_in, ws_size, (size_t)WS_NEED); grid = -1; return; }
        int dev = 0, cus = 0, per_cu = 0;
        hipGetDevice(&dev);
        hipDeviceGetAttribute(&cus, hipDeviceAttributeMultiprocessorCount, dev);
        hipFuncSetAttribute((const void*)fwd_megakernel, hipFuncAttributeMaxDynamicSharedMemorySize, LDS_BYTES);
        hipOccupancyMaxActiveBlocksPerMultiprocessor(&per_cu, (const void*)fwd_megakernel, 512, LDS_BYTES);
        if (per_cu < 1) { fprintf(stderr, "kernel_launch: occupancy query gave %d\n", per_cu); per_cu = 1; }
        grid = cus * per_cu;
        (void)hipGetLastError();
    }
    if (grid < 0) return;
    Params p{};
    for (int i = 0; i < 24; ++i) p.in[i] = (const float*)d_in[i];
    p.out = (float*)d_out; p.ws = (unsigned char*)d_ws;
    void* args[] = {&p};
    hipError_t e = hipLaunchCooperativeKernel((const void*)fwd_megakernel, dim3(grid), dim3(512), args, LDS_BYTES, stream);
    if (e != hipSuccess) fprintf(stderr, "cooperative launch failed: %s (grid %d)\n", hipGetErrorString(e), grid);
}
```

```cpp
#include <hip/hip_runtime.h>
#include <hip/hip_cooperative_groups.h>
#include <cstdio>
#include <cstdint>
namespace cg = cooperative_groups;

#define LAS __attribute__((address_space(3)))
typedef unsigned short bf16_t;
typedef short bf16x8 __attribute__((ext_vector_type(8)));
typedef short s16x4 __attribute__((ext_vector_type(4)));
typedef float f32x4 __attribute__((ext_vector_type(4)));
typedef float f32x16 __attribute__((ext_vector_type(16)));
typedef unsigned u32x4 __attribute__((ext_vector_type(4)));
typedef unsigned u32x2 __attribute__((ext_vector_type(2)));

constexpr int D = 1024, BATCH = 32, SEQ = 2048, MTOK = BATCH * SEQ;
constexpr int NCH = SEQ / 64;
constexpr int DFF = 2816, NGU = 2 * DFF;
constexpr int IN_DIM = 11312, NIN = 45 * 256;
constexpr int HB = 16, MH = HB * SEQ;
constexpr float EPS = 1e-6f;

constexpr size_t MiB = 1u << 20;
constexpr size_t WS_SSQ = 0;
constexpr size_t WS_WGU1 = 1 * MiB, WS_WD1 = 12 * MiB, WS_WIN = 18 * MiB, WS_WGO = 41 * MiB, WS_WSO = 43 * MiB, WS_WOUT = 47 * MiB, WS_WGU2 = 49 * MiB, WS_WD2 = 60 * MiB;
constexpr size_t WS_DEC = 66 * MiB, WS_DECS = 67 * MiB, WS_WG = 68 * MiB, WS_HALO = 72 * MiB, WS_SM = 84 * MiB;
constexpr size_t WS_BAR = 92 * MiB;
constexpr size_t WS_XB = 96 * MiB;
constexpr size_t WS_BIG = 224 * MiB;
constexpr size_t T_Q = 0, T_K = 32 * MiB, T_V = 64 * MiB, T_SG = 128 * MiB, T_SZ = 192 * MiB, T_XBC = 320 * MiB, T_GT = 576 * MiB, T_END = 704 * MiB;
constexpr size_t T_T1 = T_Q, T_MRG = T_SG;
constexpr size_t WS_NEED = WS_BIG + T_END;

constexpr int LDS_MAIN = 131072, LDS_XB = 149504, LDS_BYTES = LDS_XB + 64;

__device__ __forceinline__ unsigned cvt_pk_bf16(float lo, float hi) { unsigned r; asm volatile("v_cvt_pk_bf16_f32 %0, %1, %2" : "=v"(r) : "v"(lo), "v"(hi)); return r; }
__device__ __forceinline__ float bf_lo(unsigned u) { return __uint_as_float(u << 16); }
__device__ __forceinline__ float bf_hi(unsigned u) { return __uint_as_float(u & 0xffff0000u); }
__device__ __forceinline__ float fast_rcp(float x) { return __builtin_amdgcn_rcpf(x); }
__device__ __forceinline__ float sigmoidf_(float x) { return fast_rcp(1.f + __expf(-x)); }
__device__ __forceinline__ float siluf_(float x) { return x * sigmoidf_(x); }
__device__ __forceinline__ float softplusf_(float x) { return fmaxf(x, 0.f) + __logf(1.f + __expf(-fabsf(x))); }
__device__ __forceinline__ float wave_sum(float v) {
#pragma unroll
    for (int o = 1; o < 64; o <<= 1) v += __shfl_xor(v, o);
    return v;
}

namespace pg8 {
constexpr int BM = 256, BK = 64, HALF = 128, HTB = HALF * BK * 2, STAGE_BYTES = 8 * HTB, NXCD = 8, WGM = 8, ROWV_OFF = STAGE_BYTES;
__host__ __device__ __forceinline__ int lds_byte(int r, int c) { const int st = (r >> 4) * 2 + (c >> 5), rr = r & 15, cc = c & 31, ob = rr * 64 + cc * 2; return st * 1024 + (ob ^ (((ob >> 9) & 1) << 5)); }
__host__ __device__ __forceinline__ void stage_rc(int b, int& R, int& C) { const int st = b / 1024, sb = b % 1024, swz = sb ^ (((sb >> 9) & 1) << 5); R = (st >> 1) * 16 + swz / 64; C = (st & 1) * 32 + (swz % 64) / 2; }
__host__ __device__ __forceinline__ int perm32(int rho) { const int n = rho >> 4, i = rho & 15; return 8 * (i >> 2) + 4 * n + (i & 3); }

struct Unit { int pm, pn; };
struct Gemm { const bf16_t* A; const bf16_t* Bt; int M, N, K, lda, ldb; const float* rowvec; };

struct StaticOrder {
    int nM, nN, nwg, G, c;
    __device__ void init(int M, int N, int G_, int c_) { nM = M / BM; nN = N / BM; nwg = nM * nN; G = G_; c = c_; }
    __device__ bool next(int i, Unit& u) const {
        const long L = (long)i * G + c; if (L >= nwg) return false;
        int wgid = (int)L; { const int q = nwg / NXCD, r = nwg % NXCD, xcd = wgid % NXCD, off = wgid / NXCD; wgid = (xcd < r ? xcd * (q + 1) : r * (q + 1) + (xcd - r) * q) + off; }
        const int nig = WGM * nN, gid = wgid / nig, fm = gid * WGM, gsz = (nM - fm) < WGM ? (nM - fm) : WGM;
        u.pm = fm + ((wgid % nig) % gsz); u.pn = (wgid % nig) / gsz; return true;
    }
};

template <class Epi, bool ALIGN_EPI = true, bool SP2 = true>
__device__ __forceinline__ void gemm_phase(LAS unsigned char* lds, const Gemm g, const StaticOrder& S, const Epi& E) {
    int tid = threadIdx.x; asm volatile("" : "+v"(tid));
    const int wid = __builtin_amdgcn_readfirstlane(tid >> 6), lane = tid & 63, wr = wid >> 2, wc = wid & 3, fr = lane & 15, fq = lane >> 4;
    const int K = g.K, nt = K / BK;
    unsigned voffA[2], voffB[2];
#pragma unroll
    for (int i = 0; i < 2; ++i) { int R, C; stage_rc(tid * 16 + i * 8192, R, C); const int Rb = (R & ~31) + perm32(R & 31);
        voffA[i] = (unsigned)(R * g.lda + C) * 2u; voffB[i] = (unsigned)(Rb * g.ldb + C) * 2u; }
    const size_t kstep = (size_t)(BK * 2);
    const size_t hstA = (size_t)HALF * g.lda * 2, hstB = (size_t)HALF * g.ldb * 2;
    const size_t tstA = 2 * hstA, tstB = 2 * hstB;
    const unsigned ldsw = (unsigned)wid * 1024u;
    const int aoff = lds_byte(wr * 64 + fr, fq * 8), boff = lds_byte(wc * 32 + fr, fq * 8);
#define PG8_SA(b, h) (((b) * 2 + (h)) * HTB)
#define PG8_SB(b, h) ((4 + (b) * 2 + (h)) * HTB)
#define PG8_STAGE(bufoff, gbase, voff) do { _Pragma("unroll") for (int _i = 0; _i < 2; ++_i) \
        __builtin_amdgcn_global_load_lds((const unsigned*)((const char*)(gbase) + (voff)[_i]), (LAS unsigned*)(lds + (bufoff) + ldsw + _i * 8192), 16, 0, 0); } while (0)
#define PG8_LDA(dst, b, h) do { _Pragma("unroll") for (int m = 0; m < 4; ++m) _Pragma("unroll") for (int k = 0; k < 2; ++k) dst[m][k] = *(const LAS bf16x8*)(lds + PG8_SA(b, h) + aoff + m * 2048 + k * 1024); } while (0)
#define PG8_LDB(dst, b, h) do { _Pragma("unroll") for (int n = 0; n < 2; ++n) _Pragma("unroll") for (int k = 0; k < 2; ++k) dst[n][k] = *(const LAS bf16x8*)(lds + PG8_SB(b, h) + boff + n * 2048 + k * 1024); } while (0)
#define PG8_MMA(ai, bj, At, Bt) do { __builtin_amdgcn_s_setprio(1); _Pragma("unroll") for (int m = 0; m < 4; ++m) _Pragma("unroll") for (int n = 0; n < 2; ++n) _Pragma("unroll") for (int k = 0; k < 2; ++k) \
        acc[ai][bj][m][n] = __builtin_amdgcn_mfma_f32_16x16x32_bf16(Bt[n][k], At[m][k], acc[ai][bj][m][n], 0, 0, 0); __builtin_amdgcn_s_setprio(0); } while (0)
#define PG8_WAIT_V(n) asm volatile("s_waitcnt vmcnt(" #n ")" ::: "memory")
#define PG8_WAIT_L(n) asm volatile("s_waitcnt lgkmcnt(" #n ")" ::: "memory")
#define PG8_BAR __builtin_amdgcn_s_barrier()
#define PG8_SCHED __builtin_amdgcn_sched_barrier(0)
    Unit cur, nxt; int ui = 0;
    if (!S.next(0, cur)) return;
    f32x4 acc[2][2][4][2];
#pragma unroll
    for (int a = 0; a < 2; ++a)
#pragma unroll
        for (int b = 0; b < 2; ++b)
#pragma unroll
            for (int m = 0; m < 4; ++m)
#pragma unroll
                for (int n = 0; n < 2; ++n) acc[a][b][m][n] = (f32x4){0.f, 0.f, 0.f, 0.f};
    bf16x8 At[4][2], B0[2][2], B1[2][2];
    const char* cA = (const char*)g.A + (size_t)cur.pm * tstA; const char* cB = (const char*)g.Bt + (size_t)cur.pn * tstB;
    if constexpr (SP2) {
        PG8_STAGE(PG8_SB(0, 0), cB, voffB); PG8_STAGE(PG8_SB(0, 1), cB + hstB, voffB); PG8_STAGE(PG8_SA(0, 0), cA, voffA); PG8_STAGE(PG8_SA(0, 1), cA + hstA, voffA);
        if (wr == 1) PG8_BAR;
        PG8_WAIT_V(2); PG8_BAR;
        PG8_STAGE(PG8_SB(1, 0), cB + kstep, voffB); PG8_STAGE(PG8_SA(1, 0), cA + kstep, voffA); PG8_STAGE(PG8_SB(1, 1), cB + hstB + kstep, voffB);
        PG8_WAIT_V(6); PG8_BAR;
    } else {
    PG8_STAGE(PG8_SB(0, 0), cB, voffB); PG8_STAGE(PG8_SA(0, 0), cA, voffA); PG8_STAGE(PG8_SB(0, 1), cB + hstB, voffB); PG8_STAGE(PG8_SA(0, 1), cA + hstA, voffA);
    if (wr == 1) PG8_BAR;
    PG8_WAIT_V(4); PG8_BAR;
    PG8_STAGE(PG8_SB(1, 0), cB + kstep, voffB); PG8_STAGE(PG8_SA(1, 0), cA + kstep, voffA); PG8_STAGE(PG8_SB(1, 1), cB + hstB + kstep, voffB);
    PG8_WAIT_V(6); PG8_BAR;
    }
    for (;;) {
        const bool has_next = S.next(ui + 1, nxt);
        const char* nA = has_next ? (const char*)g.A + (size_t)nxt.pm * tstA : cA; const char* nB = has_next ? (const char*)g.Bt + (size_t)nxt.pn * tstB : cB;
        if (g.rowvec && wid == 0)
            __builtin_amdgcn_global_load_lds((const unsigned*)(g.rowvec + cur.pm * BM + lane * 4), (LAS unsigned*)(lds + ROWV_OFF + (ui & 1) * 1024), 16, 0, 0);
        for (int t = 0; t < nt; t += 2) {
            const bool last = (t == nt - 2);
            const char* a1 = cA + (size_t)(t + 1) * kstep;
            const char* a2 = last ? nA : cA + (size_t)(t + 2) * kstep; const char* b2 = last ? nB : cB + (size_t)(t + 2) * kstep;
            const char* a3 = a2 + kstep; const char* b3 = b2 + kstep;
            if constexpr (SP2) {
            PG8_LDB(B0, 0, 0); PG8_LDB(B1, 0, 1); PG8_SCHED; PG8_LDA(At, 0, 0); PG8_STAGE(PG8_SA(1, 1), a1 + hstA, voffA);
            PG8_WAIT_V(8); PG8_WAIT_L(0); PG8_BAR; PG8_MMA(0, 0, At, B0); PG8_MMA(0, 1, At, B1); PG8_BAR; PG8_SCHED;
            PG8_LDA(At, 0, 1); PG8_STAGE(PG8_SB(0, 0), b2, voffB); PG8_STAGE(PG8_SB(0, 1), b2 + hstB, voffB); PG8_STAGE(PG8_SA(0, 0), a2, voffA);
            PG8_WAIT_V(8); PG8_WAIT_L(0); PG8_BAR; PG8_MMA(1, 0, At, B0); PG8_MMA(1, 1, At, B1); PG8_BAR; PG8_SCHED;
            PG8_LDB(B0, 1, 0); PG8_LDB(B1, 1, 1); PG8_SCHED; PG8_LDA(At, 1, 0); PG8_STAGE(PG8_SA(0, 1), a2 + hstA, voffA);
            PG8_WAIT_V(8); PG8_WAIT_L(0); PG8_BAR; PG8_MMA(0, 0, At, B0); PG8_MMA(0, 1, At, B1); PG8_BAR; PG8_SCHED;
            PG8_LDA(At, 1, 1); PG8_STAGE(PG8_SB(1, 0), b3, voffB); PG8_STAGE(PG8_SB(1, 1), b3 + hstB, voffB); PG8_STAGE(PG8_SA(1, 0), a3, voffA);
            PG8_WAIT_V(8); PG8_WAIT_L(0); PG8_BAR; PG8_MMA(1, 0, At, B0); PG8_MMA(1, 1, At, B1); PG8_BAR; PG8_SCHED;
            } else {
            PG8_LDB(B0, 0, 0); PG8_SCHED; PG8_LDA(At, 0, 0); PG8_STAGE(PG8_SA(1, 1), a1 + hstA, voffA);
            PG8_WAIT_L(8); PG8_BAR; PG8_WAIT_L(0); PG8_MMA(0, 0, At, B0); PG8_BAR; PG8_SCHED;
            PG8_LDB(B1, 0, 1); PG8_STAGE(PG8_SB(0, 0), b2, voffB);
            PG8_BAR; PG8_WAIT_L(0); PG8_MMA(0, 1, At, B1); PG8_BAR;
            PG8_LDA(At, 0, 1); PG8_STAGE(PG8_SA(0, 0), a2, voffA);
            PG8_BAR; PG8_WAIT_L(0); PG8_MMA(1, 0, At, B0); PG8_BAR; PG8_SCHED;
            PG8_STAGE(PG8_SB(0, 1), b2 + hstB, voffB);
            PG8_WAIT_V(6); PG8_BAR; PG8_MMA(1, 1, At, B1); PG8_BAR;
            PG8_LDB(B0, 1, 0); PG8_SCHED; PG8_LDA(At, 1, 0); PG8_STAGE(PG8_SA(0, 1), a2 + hstA, voffA);
            PG8_WAIT_L(8); PG8_BAR; PG8_WAIT_L(0); PG8_MMA(0, 0, At, B0); PG8_BAR; PG8_SCHED;
            PG8_LDB(B1, 1, 1); PG8_STAGE(PG8_SB(1, 0), b3, voffB);
            PG8_BAR; PG8_WAIT_L(0); PG8_MMA(0, 1, At, B1); PG8_BAR;
            PG8_LDA(At, 1, 1); PG8_STAGE(PG8_SA(1, 0), a3, voffA);
            PG8_BAR; PG8_WAIT_L(0); PG8_MMA(1, 0, At, B0); PG8_BAR; PG8_SCHED;
            PG8_STAGE(PG8_SB(1, 1), b3 + hstB, voffB);
            PG8_WAIT_V(6); PG8_BAR; PG8_MMA(1, 1, At, B1); PG8_BAR;
            }
        }
        if constexpr (ALIGN_EPI) { if (wr == 0) PG8_BAR; }
        E(acc, cur, wr, wc, fr, fq, (const LAS float*)(lds + ROWV_OFF + (ui & 1) * 1024));
        if (!has_next) break;
#pragma unroll
        for (int a = 0; a < 2; ++a)
#pragma unroll
            for (int b = 0; b < 2; ++b)
#pragma unroll
                for (int m = 0; m < 4; ++m)
#pragma unroll
                    for (int n = 0; n < 2; ++n) acc[a][b][m][n] = (f32x4){0.f, 0.f, 0.f, 0.f};
        cur = nxt; cA = nA; cB = nB; ++ui;
        if constexpr (ALIGN_EPI) { if (wr == 1) PG8_BAR; }
    }
    PG8_WAIT_V(0);
    if constexpr (!ALIGN_EPI) { if (wr == 0) PG8_BAR; }
    PG8_BAR;
#undef PG8_SA
#undef PG8_SB
#undef PG8_STAGE
#undef PG8_LDA
#undef PG8_LDB
#undef PG8_MMA
#undef PG8_WAIT_V
#undef PG8_WAIT_L
#undef PG8_BAR
#undef PG8_SCHED
}
}

typedef f32x4 AccT[2][2][4][2];

struct EpiGU {
    const float* ssq; bf16_t* O;
    __device__ __forceinline__ void operator()(const AccT& acc, const pg8::Unit& u, int wr, int wc, int fr, int fq, const LAS float* rowv) const {
        const int row0 = u.pm * 256 + wr * 64 + fr, col0 = u.pn * 128 + wc * 32 + 8 * fq;
        float rs[2][4];
#pragma unroll
        for (int ai = 0; ai < 2; ++ai)
#pragma unroll
            for (int m = 0; m < 4; ++m) rs[ai][m] = rowv[wr * 64 + fr + ai * 128 + m * 16];
#pragma unroll
        for (int ai = 0; ai < 2; ++ai)
#pragma unroll
            for (int m = 0; m < 4; ++m) {
                const int row = row0 + ai * 128 + m * 16;
                const float rstd = rsqrtf(rs[ai][m] * (1.f / D) + EPS);
                float v[8];
#pragma unroll
                for (int n = 0; n < 2; ++n)
#pragma unroll
                    for (int j = 0; j < 4; ++j) { const float gg = acc[ai][0][m][n][j] * rstd, uu = acc[ai][1][m][n][j] * rstd; v[4 * n + j] = siluf_(gg) * uu; }
                u32x4 w; w.x = cvt_pk_bf16(v[0], v[1]); w.y = cvt_pk_bf16(v[2], v[3]); w.z = cvt_pk_bf16(v[4], v[5]); w.w = cvt_pk_bf16(v[6], v[7]);
                *(u32x4*)(O + (size_t)row * DFF + col0) = w;
            }
    }
};
struct EpiRes {
    bf16_t* xb; float* ssq; float alpha;
    __device__ __forceinline__ void operator()(const AccT& acc, const pg8::Unit& u, int wr, int wc, int fr, int fq, const LAS float* rowv) const {
        const int row0 = u.pm * 256 + wr * 64 + fr, col0 = u.pn * 256 + wc * 32 + 8 * fq;
        u32x4 xv[2][4][2];
#pragma unroll
        for (int ai = 0; ai < 2; ++ai)
#pragma unroll
            for (int m = 0; m < 4; ++m)
#pragma unroll
                for (int bj = 0; bj < 2; ++bj) xv[ai][m][bj] = *(const u32x4*)(xb + (size_t)(row0 + ai * 128 + m * 16) * D + col0 + bj * 128);
        __builtin_amdgcn_sched_barrier(0);
#pragma unroll
        for (int ai = 0; ai < 2; ++ai)
#pragma unroll
            for (int m = 0; m < 4; ++m) {
                const int row = row0 + ai * 128 + m * 16;
                float s = 0.f;
#pragma unroll
                for (int bj = 0; bj < 2; ++bj) {
                    const u32x4 q = xv[ai][m][bj];
                    float y[8];
                    y[0] = bf_lo(q.x) + acc[ai][bj][m][0].x * alpha; y[1] = bf_hi(q.x) + acc[ai][bj][m][0].y * alpha; y[2] = bf_lo(q.y) + acc[ai][bj][m][0].z * alpha; y[3] = bf_hi(q.y) + acc[ai][bj][m][0].w * alpha;
                    y[4] = bf_lo(q.z) + acc[ai][bj][m][1].x * alpha; y[5] = bf_hi(q.z) + acc[ai][bj][m][1].y * alpha; y[6] = bf_lo(q.w) + acc[ai][bj][m][1].z * alpha; y[7] = bf_hi(q.w) + acc[ai][bj][m][1].w * alpha;
#pragma unroll
                    for (int e = 0; e < 8; ++e) s += y[e] * y[e];
                    u32x4 w; w.x = cvt_pk_bf16(y[0], y[1]); w.y = cvt_pk_bf16(y[2], y[3]); w.z = cvt_pk_bf16(y[4], y[5]); w.w = cvt_pk_bf16(y[6], y[7]);
                    *(u32x4*)(xb + (size_t)row * D + col0 + bj * 128) = w;
                }
                s += __shfl_xor(s, 16); s += __shfl_xor(s, 32);
                if (fq == 0) atomicAdd(ssq + row, s);
            }
    }
};
struct EpiIn {
    const float* ssq; unsigned char* T; bf16_t* halo; float* sm;
    __device__ __forceinline__ void operator()(const AccT& acc, const pg8::Unit& u, int wr, int wc, int fr, int fq, const LAS float* rowv) const {
        const int pn = u.pn;
        const int row0 = u.pm * 256 + wr * 64 + fr;
        float rs[2][4];
#pragma unroll
        for (int ai = 0; ai < 2; ++ai)
#pragma unroll
            for (int m = 0; m < 4; ++m) rs[ai][m] = rowv[wr * 64 + fr + ai * 128 + m * 16];
        int act = 0, ld, ct; bf16_t* base;
        if (pn < 2) { base = (bf16_t*)(T + T_Q); ld = 512; ct = pn; }
        else if (pn < 4) { base = (bf16_t*)(T + T_K); ld = 512; ct = pn - 2; }
        else if (pn < 8) { base = (bf16_t*)(T + T_V); ld = 1024; ct = pn - 4; }
        else if (pn < 12) { base = (bf16_t*)(T + T_SG); ld = 1024; ct = pn - 8; act = 1; }
        else if (pn < 20) { base = (bf16_t*)(T + T_SZ); ld = 2048; ct = pn - 12; act = 1; }
        else if (pn < 36) { base = (bf16_t*)(T + T_XBC); ld = 4096; ct = pn - 20; act = 3; }
        else if (pn < 44) { base = (bf16_t*)(T + T_GT); ld = 2048; ct = pn - 36; act = 2; }
        else { base = nullptr; ld = 0; ct = 0; act = 4; }
        if (act == 4) {
            if (wc < 2) {
#pragma unroll
                for (int ai = 0; ai < 2; ++ai)
#pragma unroll
                    for (int m = 0; m < 4; ++m) {
                        const int row = row0 + ai * 128 + m * 16;
                        const float rstd = rsqrtf(rs[ai][m] * (1.f / D) + EPS);
                        float* p = sm + (size_t)row * 64 + wc * 32 + 8 * fq;
                        *(f32x4*)p = acc[ai][0][m][0] * rstd; *(f32x4*)(p + 4) = acc[ai][0][m][1] * rstd;
                    }
            }
            return;
        }
        const int col0 = ct * 256 + wc * 32 + 8 * fq;
        if (act == 1) tile<1>(acc, rs, base, ld, row0, col0);
        else if (act == 2) tile<2>(acc, rs, base, ld, row0, col0);
        else if (act == 3) tile<3>(acc, rs, base, ld, row0, col0);
        else tile<0>(acc, rs, base, ld, row0, col0);
    }
    template <int ACT> __device__ __forceinline__ void tile(const AccT& acc, const float (&rs)[2][4], bf16_t* base, int ld, int row0, int col0) const {
#pragma unroll
        for (int ai = 0; ai < 2; ++ai)
#pragma unroll
            for (int m = 0; m < 4; ++m) {
                const int row = row0 + ai * 128 + m * 16;
                const float rstd = rsqrtf(rs[ai][m] * (1.f / D) + EPS);
#pragma unroll
                for (int bj = 0; bj < 2; ++bj) {
                    float v[8];
#pragma unroll
                    for (int n = 0; n < 2; ++n)
#pragma unroll
                        for (int j = 0; j < 4; ++j) { float x = acc[ai][bj][m][n][j] * rstd; if (ACT == 1) x = siluf_(x); else if (ACT == 2) x = sigmoidf_(x); v[4 * n + j] = x; }
                    u32x4 w; w.x = cvt_pk_bf16(v[0], v[1]); w.y = cvt_pk_bf16(v[2], v[3]); w.z = cvt_pk_bf16(v[4], v[5]); w.w = cvt_pk_bf16(v[6], v[7]);
                    *(u32x4*)(base + (size_t)row * ld + col0 + bj * 128) = w;
                    if (ACT == 3 && (row & 63) >= 61) *(u32x4*)(halo + ((size_t)(row >> 6) * 3 + ((row & 63) - 61)) * 4096 + col0 + bj * 128) = w;
                }
            }
    }
};
struct EpiGate {
    const bf16_t* gt; const bf16_t* t1; bf16_t* out; int mode;
    __device__ __forceinline__ void operator()(const AccT& acc, const pg8::Unit& u, int wr, int wc, int fr, int fq, const LAS float* rowv) const {
        const int row0 = u.pm * 256 + wr * 64 + fr, col0 = u.pn * 256 + wc * 32 + 8 * fq;
#pragma unroll
        for (int ai = 0; ai < 2; ++ai) {
            u32x4 gq[4][2], tq[4][2];
#pragma unroll
            for (int m = 0; m < 4; ++m)
#pragma unroll
                for (int bj = 0; bj < 2; ++bj) { const int row = row0 + ai * 128 + m * 16, col = col0 + bj * 128;
                    gq[m][bj] = *(const u32x4*)(gt + (size_t)row * 2048 + mode * 1024 + col);
                    tq[m][bj] = mode ? *(const u32x4*)(t1 + (size_t)row * D + col) : (u32x4){0u, 0u, 0u, 0u}; }
            __builtin_amdgcn_sched_barrier(0);
#pragma unroll
            for (int m = 0; m < 4; ++m)
#pragma unroll
                for (int bj = 0; bj < 2; ++bj) {
                    const int row = row0 + ai * 128 + m * 16, col = col0 + bj * 128;
                    const u32x4 g4 = gq[m][bj], t4 = tq[m][bj];
                    float v[8];
                    v[0] = acc[ai][bj][m][0].x * bf_lo(g4.x); v[1] = acc[ai][bj][m][0].y * bf_hi(g4.x); v[2] = acc[ai][bj][m][0].z * bf_lo(g4.y); v[3] = acc[ai][bj][m][0].w * bf_hi(g4.y);
                    v[4] = acc[ai][bj][m][1].x * bf_lo(g4.z); v[5] = acc[ai][bj][m][1].y * bf_hi(g4.z); v[6] = acc[ai][bj][m][1].z * bf_lo(g4.w); v[7] = acc[ai][bj][m][1].w * bf_hi(g4.w);
                    if (mode) { v[0] += bf_lo(t4.x); v[1] += bf_hi(t4.x); v[2] += bf_lo(t4.y); v[3] += bf_hi(t4.y); v[4] += bf_lo(t4.z); v[5] += bf_hi(t4.z); v[6] += bf_lo(t4.w); v[7] += bf_hi(t4.w); }
                    u32x4 w; w.x = cvt_pk_bf16(v[0], v[1]); w.y = cvt_pk_bf16(v[2], v[3]); w.z = cvt_pk_bf16(v[4], v[5]); w.w = cvt_pk_bf16(v[6], v[7]);
                    *(u32x4*)(out + (size_t)row * D + col) = w;
                }
        }
    }
};

__device__ __forceinline__ void tr_item(const float* srcp, int ld, const float* sk, float mul, int k0, int K, bf16_t* dst, int n0, LAS float* scr, int lane) {
#pragma unroll
    for (int i = 0; i < 32; ++i) { const int kk = 2 * i + (lane >> 5);
        float v = 0.f; if (srcp) v = srcp[(size_t)(k0 + kk) * ld] * (sk ? sk[k0 + kk] : 1.f) * mul;
        scr[kk * 33 + (lane & 31)] = v; }
    asm volatile("s_waitcnt lgkmcnt(0)" ::: "memory");
    const int c = lane & 7;
#pragma unroll
    for (int j = 0; j < 4; ++j) { const int n = (lane >> 3) + 8 * j; const LAS float* s = scr + (8 * c) * 33 + n;
        u32x4 o; o.x = cvt_pk_bf16(s[0 * 33], s[1 * 33]); o.y = cvt_pk_bf16(s[2 * 33], s[3 * 33]); o.z = cvt_pk_bf16(s[4 * 33], s[5 * 33]); o.w = cvt_pk_bf16(s[6 * 33], s[7 * 33]);
        *(u32x4*)(dst + (size_t)(n0 + n) * K + k0 + 8 * c) = o; }
    asm volatile("s_waitcnt lgkmcnt(0)" ::: "memory");
}
__device__ __forceinline__ int win_src_col(int nd) {
    if (nd < 3072) return nd;
    if (nd < 5120) return 3088 + (nd - 3072);
    if (nd < 9216) return 5136 + (nd - 5120);
    if (nd < 11264) return 9264 + (nd - 9216);
    if (nd < 11280) return 3072 + (nd - 11264);
    if (nd < 11312) return 9232 + (nd - 11280);
    return -1;
}

struct Params {
    const float* in[24];
    float* out;
    unsigned char* ws;
};

typedef __attribute__((address_space(4))) const Params* KP;
__device__ __forceinline__ Params load_params(KP p) { Params r;
#pragma unroll
    for (int i = 0; i < 24; ++i) r.in[i] = p->in[i];
    r.out = p->out; r.ws = p->ws; return r; }
__device__ __forceinline__ int tid_fresh() { int t = threadIdx.x; asm volatile("" : "+v"(t)); return t; }
__device__ __forceinline__ void p0_prologue(KP Pp, LAS unsigned char* lds, int G) {
    const Params P = load_params(Pp);
    const int tid = tid_fresh(), lane = tid & 63, wave = tid >> 6;
    LAS float* scr = (LAS float*)(lds + wave * 16384);
    const int gw = blockIdx.x * 8 + wave, NGW = G * 8;
    unsigned char* ws = P.ws;
    constexpr int I_GU = (D / 64) * (NGU / 32), I_DN = (DFF / 64) * (D / 32), I_IN = (D / 64) * (NIN / 32), I_GO = (D / 64) * (D / 32), I_SO = (2048 / 64) * (D / 32);
    constexpr int NITEMS = 2 * I_GU + 2 * I_DN + I_IN + 2 * I_GO + I_SO;
    for (int it = gw; it < NITEMS; it += NGW) {
        int r = it; const int j = lane & 31;
        if (r < 2 * I_GU) { const int l2 = r >= I_GU; r -= l2 * I_GU; const int nb = r % (NGU / 32), kb = r / (NGU / 32); const int nd = nb * 32 + j, tile = nd >> 8, w = nd & 255;
            const float* Wg = P.in[l2 ? 20 : 2]; const float* Wu = P.in[l2 ? 21 : 3];
            const float* sp = (w < 128 ? Wg : Wu) + 128 * tile + (w & 127);
            tr_item(sp, DFF, P.in[l2 ? 19 : 1], 1.f, kb * 64, D, (bf16_t*)(ws + (l2 ? WS_WGU2 : WS_WGU1)), nb * 32, scr, lane); continue; }
        r -= 2 * I_GU;
        if (r < 2 * I_DN) { const int l2 = r >= I_DN; r -= l2 * I_DN; const int nb = r % (D / 32), kb = r / (D / 32);
            tr_item(P.in[l2 ? 22 : 4] + nb * 32 + j, D, nullptr, 1.f, kb * 64, DFF, (bf16_t*)(ws + (l2 ? WS_WD2 : WS_WD1)), nb * 32, scr, lane); continue; }
        r -= 2 * I_DN;
        if (r < I_IN) { const int nb = r % (NIN / 32), kb = r / (NIN / 32); const int nd = nb * 32 + j, sc = win_src_col(nd);
            tr_item(sc >= 0 ? P.in[6] + sc : nullptr, IN_DIM, P.in[5], nd < 512 ? 0.08838834764831845f : 1.f, kb * 64, D, (bf16_t*)(ws + WS_WIN), nb * 32, scr, lane); continue; }
        r -= I_IN;
        if (r < 2 * I_GO) { const int l2 = r >= I_GO; r -= l2 * I_GO; const int nb = r % (D / 32), kb = r / (D / 32);
            tr_item(P.in[l2 ? 18 : 10] + nb * 32 + j, D, nullptr, 1.f, kb * 64, D, (bf16_t*)(ws + (l2 ? WS_WOUT : WS_WGO)), nb * 32, scr, lane); continue; }
        r -= 2 * I_GO;
        { const int nb = r % (D / 32), kb = r / (D / 32);
            tr_item(P.in[17] + nb * 32 + j, D, nullptr, 1.f, kb * 64, 2048, (bf16_t*)(ws + WS_WSO), nb * 32, scr, lane); }
    }
    const float* x = P.in[0]; bf16_t* xb = (bf16_t*)(ws + WS_XB); float* ssq = (float*)(ws + WS_SSQ);
    for (int m0 = gw; m0 < MTOK; m0 += 4 * NGW) {
        f32x4 v[4][4];
#pragma unroll
        for (int u = 0; u < 4; ++u) { const int m = m0 + u * NGW; if (m < MTOK) { const f32x4* xr = (const f32x4*)(x + (size_t)m * D) + lane;
#pragma unroll
            for (int jj = 0; jj < 4; ++jj) v[u][jj] = xr[64 * jj]; } }
#pragma unroll
        for (int u = 0; u < 4; ++u) { const int m = m0 + u * NGW; if (m < MTOK) {
            unsigned long long* o8 = (unsigned long long*)(xb + (size_t)m * D) + lane;
            float s = 0.f;
#pragma unroll
            for (int jj = 0; jj < 4; ++jj) { const f32x4 q = v[u][jj]; s += q.x * q.x + q.y * q.y + q.z * q.z + q.w * q.w;
                o8[64 * jj] = (unsigned long long)cvt_pk_bf16(q.x, q.y) | ((unsigned long long)cvt_pk_bf16(q.z, q.w) << 32); }
            s = wave_sum(s);
            if (lane == 0) { ssq[m] = s; ssq[MTOK + m] = 0.f; ssq[2 * MTOK + m] = 0.f; ssq[3 * MTOK + m] = 0.f; } } }
    }
}

__device__ __forceinline__ void p4_prep(KP Pp, LAS unsigned char* lds, int G) {
    const Params P = load_params(Pp);
    const int tid = tid_fresh();
    unsigned char* ws = P.ws; unsigned char* T = ws + WS_BIG;
    const float* sm = (const float*)(ws + WS_SM);
    for (int it = blockIdx.x; it < HB * NCH; it += G) {
        const int row0 = it * 64;
#pragma unroll
        for (int i = 0; i < 2; ++i) { const int idx = tid + 512 * i; *(LAS f32x4*)(lds + idx * 16) = *(const f32x4*)(sm + (size_t)row0 * 64 + idx * 4); }
        __syncthreads();
        {
            const int hc = tid;
            const float* wf = P.in[7]; float w[16];
#pragma unroll
            for (int j = 0; j < 16; ++j) w[j] = wf[j * 512 + hc];
            const float bfv = P.in[8][hc];
            float la[64]; float cum = 0.f;
#pragma unroll
            for (int t = 0; t < 64; ++t) { float z = bfv;
#pragma unroll
                for (int j4 = 0; j4 < 4; ++j4) { const f32x4 f = *(const LAS f32x4*)(lds + t * 256 + j4 * 16); z += f.x * w[4 * j4] + f.y * w[4 * j4 + 1] + f.z * w[4 * j4 + 2] + f.w * w[4 * j4 + 3]; }
                la[t] = (fminf(z, 0.f) - __logf(1.f + __expf(-fabsf(z)))) * (1.f / 16.f); cum += la[t]; }
            const float end = cum; cum = 0.f;
            bf16_t* kp = (bf16_t*)(T + T_K) + (size_t)row0 * 512 + hc;
#pragma unroll
            for (int tb = 0; tb < 4; ++tb) {
                bf16_t kk[16];
#pragma unroll
                for (int u = 0; u < 16; ++u) kk[u] = kp[(size_t)(tb * 16 + u) * 512];
#pragma unroll
                for (int u = 0; u < 16; ++u) { const int t = tb * 16 + u;
                    cum += la[t];
                    const float kv = __uint_as_float((unsigned)kk[u] << 16) * __expf(end - cum);
                    kp[(size_t)t * 512] = (bf16_t)(cvt_pk_bf16(kv, 0.f) & 0xffffu); }
            }
            ((float*)(ws + WS_DEC))[(size_t)it * 512 + hc] = __expf(end);
        }
        if (tid < 32) {
            const float bias = P.in[13][tid], A = -__expf(P.in[14][tid]);
            float cum = 0.f;
#pragma unroll 4
            for (int t = 0; t < 64; ++t) cum += softplusf_(*(const LAS float*)(lds + t * 256 + (16 + tid) * 4) + bias) * A;
            const float end = cum; cum = 0.f;
            float* wg = (float*)(ws + WS_WG);
#pragma unroll 4
            for (int t = 0; t < 64; ++t) { const float dt = softplusf_(*(const LAS float*)(lds + t * 256 + (16 + tid) * 4) + bias); cum += dt * A; wg[(size_t)(row0 + t) * 32 + tid] = __expf(end - cum) * dt; }
            ((float*)(ws + WS_DECS))[it * 32 + tid] = __expf(end);
        }
        __syncthreads();
    }
    const int co = tid & 63, rg = tid >> 6;
    u32x4 raw[11];
#define CONV_LOAD(itx) do { const int _ci = (itx) >> 3, _col = ((itx) & 7) * 512 + co * 8; \
        const bf16_t* _xp = (const bf16_t*)(T + T_XBC) + (size_t)(_ci * 64 + rg * 8) * 4096 + _col; \
        _Pragma("unroll") for (int i = 0; i < 8; ++i) raw[3 + i] = *(const u32x4*)(_xp + (size_t)i * 4096); \
        if (rg > 0) { _Pragma("unroll") for (int i = 0; i < 3; ++i) raw[i] = *(const u32x4*)(_xp - (size_t)(3 - i) * 4096); } \
        else if ((_ci & (NCH - 1)) != 0) { const bf16_t* _hp = (const bf16_t*)(ws + WS_HALO) + (size_t)(_ci - 1) * 3 * 4096 + _col; \
            _Pragma("unroll") for (int i = 0; i < 3; ++i) raw[i] = *(const u32x4*)(_hp + (size_t)i * 4096); } \
        else { _Pragma("unroll") for (int i = 0; i < 3; ++i) raw[i] = (u32x4){0u, 0u, 0u, 0u}; } } while (0)
    float cw[4][8], cbv[8];
    { const int colw = ((G & 7) == 0 ? ((int)blockIdx.x & 7) : 0) * 512 + co * 8;
#pragma unroll
      for (int k = 0; k < 4; ++k) { const f32x4 a = *(const f32x4*)(P.in[11] + k * 4096 + colw), b = *(const f32x4*)(P.in[11] + k * 4096 + colw + 4);
          cw[k][0] = a.x; cw[k][1] = a.y; cw[k][2] = a.z; cw[k][3] = a.w; cw[k][4] = b.x; cw[k][5] = b.y; cw[k][6] = b.z; cw[k][7] = b.w; }
      { const f32x4 a = *(const f32x4*)(P.in[12] + colw), b = *(const f32x4*)(P.in[12] + colw + 4);
          cbv[0] = a.x; cbv[1] = a.y; cbv[2] = a.z; cbv[3] = a.w; cbv[4] = b.x; cbv[5] = b.y; cbv[6] = b.z; cbv[7] = b.w; } }
    if ((int)blockIdx.x < HB * NCH * 8) CONV_LOAD((int)blockIdx.x);
    for (int it = blockIdx.x; it < HB * NCH * 8; it += G) {
        const int ci = it >> 3, cb = it & 7, col = cb * 512 + co * 8, row0 = ci * 64 + rg * 8;
        bf16_t* xp = (bf16_t*)(T + T_XBC) + (size_t)row0 * 4096 + col;
        if ((G & 7) != 0) {
#pragma unroll
            for (int k = 0; k < 4; ++k) { const f32x4 a = *(const f32x4*)(P.in[11] + k * 4096 + col), b = *(const f32x4*)(P.in[11] + k * 4096 + col + 4);
                cw[k][0] = a.x; cw[k][1] = a.y; cw[k][2] = a.z; cw[k][3] = a.w; cw[k][4] = b.x; cw[k][5] = b.y; cw[k][6] = b.z; cw[k][7] = b.w; }
            { const f32x4 a = *(const f32x4*)(P.in[12] + col), b = *(const f32x4*)(P.in[12] + col + 4);
                cbv[0] = a.x; cbv[1] = a.y; cbv[2] = a.z; cbv[3] = a.w; cbv[4] = b.x; cbv[5] = b.y; cbv[6] = b.z; cbv[7] = b.w; }
        }
        asm volatile("s_waitcnt vmcnt(0)" ::: "memory");
        __syncthreads();
        u32x4 outv[8];
#pragma unroll
        for (int i = 0; i < 8; ++i) {
            float v[8];
#pragma unroll
            for (int e = 0; e < 8; ++e) v[e] = cbv[e];
#pragma unroll
            for (int k = 0; k < 4; ++k) { const u32x4 q = raw[i + k];
                v[0] += cw[k][0] * bf_lo(q.x); v[1] += cw[k][1] * bf_hi(q.x); v[2] += cw[k][2] * bf_lo(q.y); v[3] += cw[k][3] * bf_hi(q.y);
                v[4] += cw[k][4] * bf_lo(q.z); v[5] += cw[k][5] * bf_hi(q.z); v[6] += cw[k][6] * bf_lo(q.w); v[7] += cw[k][7] * bf_hi(q.w); }
#pragma unroll
            for (int e = 0; e < 8; ++e) v[e] = siluf_(v[e]);
            outv[i].x = cvt_pk_bf16(v[0], v[1]); outv[i].y = cvt_pk_bf16(v[2], v[3]); outv[i].z = cvt_pk_bf16(v[4], v[5]); outv[i].w = cvt_pk_bf16(v[6], v[7]);
        }
        if (it + G < HB * NCH * 8) CONV_LOAD(it + G);
#pragma unroll
        for (int i = 0; i < 8; ++i) *(u32x4*)(xp + (size_t)i * 4096) = outv[i];
    }
#undef CONV_LOAD
}

struct MixArgs {
    const bf16_t* ak; int ld_ak;
    const bf16_t* qq; int ld_q;
    const bf16_t* bv; int ld_bv;
    const bf16_t* gt; int ld_g;
    bf16_t* out; int ld_o;
    const float* dec;
    const float* wg;
    const float* nw;
    const float* dsk;
};
constexpr int RSA = 320, RSB = 576, RSQ = 264, RSG = 520, RSX = 520;
constexpr int OFF_AK = 0, OFF_BV = 64 * RSA, OFF_QQ = OFF_BV + 64 * RSB, OFF_WGT = OFF_QQ + 64 * RSQ, OFF_DEC = OFF_WGT + 1024, OFF_RED = OFF_DEC + 512, OFF_NW = OFF_RED + 2048, OFF_GT = OFF_NW + 1024, OFF_XS2 = OFF_GT + 64 * RSG;
static_assert(OFF_XS2 + 64 * RSX <= LDS_XB, "mixer LDS");

#define LBAR() do { asm volatile("s_waitcnt lgkmcnt(0)" ::: "memory"); __builtin_amdgcn_s_barrier(); asm volatile("" ::: "memory"); } while (0)
template <bool SSD>
__device__ __forceinline__ void mixer_item(LAS unsigned char* lds, const MixArgs& a) {
    const int tid = tid_fresh(), lane = tid & 63, w = __builtin_amdgcn_readfirstlane(tid >> 6);
    const int r = lane & 31, h = lane >> 5, gg = lane >> 4, q = (lane & 15) >> 2, p = lane & 3;
    const int arow0 = tid >> 4, apc = tid & 15;
    const int brow0 = tid >> 5, bpc = tid & 31;
    u32x4 stA[2], stQ[2], stB[4], stG[4], stD; float stWp[4];
    stD = (u32x4){0u, 0u, 0u, 0u}; stWp[0] = stWp[1] = stWp[2] = stWp[3] = 0.f;
#define MIX_LOAD(c) do { const size_t _r0 = (size_t)(c) * 64; \
        _Pragma("unroll") for (int i = 0; i < 2; ++i) { stA[i] = *(const u32x4*)(a.ak + (_r0 + arow0 + 32 * i) * a.ld_ak + apc * 8); stQ[i] = *(const u32x4*)(a.qq + (_r0 + arow0 + 32 * i) * a.ld_q + apc * 8); } \
        _Pragma("unroll") for (int i = 0; i < 4; ++i) { stB[i] = *(const u32x4*)(a.bv + (_r0 + brow0 + 16 * i) * a.ld_bv + bpc * 8); stG[i] = *(const u32x4*)(a.gt + (_r0 + brow0 + 16 * i) * a.ld_g + bpc * 8); } \
        if (SSD) { _Pragma("unroll") for (int i = 0; i < 4; ++i) stWp[i] = a.wg[(_r0 + brow0 + 16 * i) * 32 + (bpc >> 3)]; }     \
        else { if (tid < 32) stD = *(const u32x4*)(a.dec + (size_t)(c) * 512 + tid * 4); } } while (0)
#define MIX_STORE() do { \
        _Pragma("unroll") for (int i = 0; i < 2; ++i) { *(LAS u32x4*)(lds + OFF_AK + (arow0 + 32 * i) * RSA + apc * 16) = stA[i]; \
            *(LAS u32x2*)(lds + OFF_QQ + (arow0 + 32 * i) * RSQ + apc * 16) = (u32x2){stQ[i].x, stQ[i].y}; *(LAS u32x2*)(lds + OFF_QQ + (arow0 + 32 * i) * RSQ + apc * 16 + 8) = (u32x2){stQ[i].z, stQ[i].w}; } \
        _Pragma("unroll") for (int i = 0; i < 4; ++i) { \
            if (SSD) { *(LAS u32x2*)(lds + OFF_XS2 + (brow0 + 16 * i) * RSX + bpc * 16) = (u32x2){stB[i].x, stB[i].y}; *(LAS u32x2*)(lds + OFF_XS2 + (brow0 + 16 * i) * RSX + bpc * 16 + 8) = (u32x2){stB[i].z, stB[i].w}; \
                const float _w = stWp[i]; u32x4 _b; _b.x = cvt_pk_bf16(bf_lo(stB[i].x) * _w, bf_hi(stB[i].x) * _w); _b.y = cvt_pk_bf16(bf_lo(stB[i].y) * _w, bf_hi(stB[i].y) * _w); \
                _b.z = cvt_pk_bf16(bf_lo(stB[i].z) * _w, bf_hi(stB[i].z) * _w); _b.w = cvt_pk_bf16(bf_lo(stB[i].w) * _w, bf_hi(stB[i].w) * _w); \
                *(LAS u32x4*)(lds + OFF_BV + (brow0 + 16 * i) * RSB + bpc * 16) = _b; } \
            else *(LAS u32x4*)(lds + OFF_BV + (brow0 + 16 * i) * RSB + bpc * 16) = stB[i]; \
            *(LAS u32x2*)(lds + OFF_GT + (brow0 + 16 * i) * RSG + bpc * 16) = (u32x2){stG[i].x, stG[i].y}; *(LAS u32x2*)(lds + OFF_GT + (brow0 + 16 * i) * RSG + bpc * 16 + 8) = (u32x2){stG[i].z, stG[i].w}; } \
        if (!SSD) { if (tid < 32) *(LAS u32x4*)(lds + OFF_DEC + tid * 16) = stD; } } while (0)

    if (tid < 256) *(LAS float*)(lds + OFF_NW + tid * 4) = a.nw[tid];
    MIX_LOAD(0);
    MIX_STORE();
    __syncthreads();

    f32x16 S[4];
#pragma unroll
    for (int i = 0; i < 4; ++i)
#pragma unroll
        for (int e = 0; e < 16; ++e) S[i][e] = 0.f;

    const int trA = OFF_AK + (8 * h + q) * RSA + (16 * (gg & 1) + 4 * p) * 2;
    const int trB = OFF_BV + (8 * h + q) * RSB + (32 * w + 16 * (gg & 1) + 4 * p) * 2;
    const int qB = OFF_QQ + r * RSQ + 8 * h;
    const int gB = OFF_GT + r * RSG + (32 * w + 4 * h) * 2;
    const float dsk = SSD ? a.dsk[w >> 1] : 0.f;
    float dc_next = SSD ? a.dec[w >> 1] : 0.f;

    for (int c = 0; c < NCH; ++c) {
        if (c + 1 < NCH) MIX_LOAD(c + 1);
        if (SSD) {
            const float dc = dc_next;
            if (c + 1 < NCH) dc_next = a.dec[(size_t)(c + 1) * 32 + (w >> 1)];
#pragma unroll
            for (int i = 0; i < 4; ++i)
#pragma unroll
                for (int e = 0; e < 16; ++e) S[i][e] *= dc;
        } else {
#pragma unroll
            for (int i = 0; i < 4; ++i)
#pragma unroll
                for (int g = 0; g < 4; ++g) { const f32x4 d4 = *(const LAS f32x4*)(lds + OFF_DEC + (32 * i + 8 * g + 4 * h) * 4);
                    S[i][4 * g + 0] *= d4.x; S[i][4 * g + 1] *= d4.y; S[i][4 * g + 2] *= d4.z; S[i][4 * g + 3] *= d4.w; }
        }
#define TRR(addr) __builtin_bit_cast(s16x4, __builtin_amdgcn_ds_read_tr16_b64_v4i16((LAS s16x4*)(lds + (addr))))
#define UPD_LOAD(s, B0, B1, A0, A1, W0, W1) do { B0 = TRR(trB + (16 * (s)) * RSB); B1 = TRR(trB + (16 * (s) + 4) * RSB); \
        _Pragma("unroll") for (int i = 0; i < 4; ++i) { A0[i] = TRR(trA + (16 * (s)) * RSA + 64 * i); A1[i] = TRR(trA + (16 * (s) + 4) * RSA + 64 * i); } \
        } while (0)
#define UPD_MMA(B0, B1, A0, A1, W0, W1) do { bf16x8 bfr = __builtin_shufflevector(B0, B1, 0, 1, 2, 3, 4, 5, 6, 7); \
        _Pragma("unroll") for (int i = 0; i < 4; ++i) S[i] = __builtin_amdgcn_mfma_f32_32x32x16_bf16(__builtin_shufflevector(A0[i], A1[i], 0, 1, 2, 3, 4, 5, 6, 7), bfr, S[i], 0, 0, 0); } while (0)
        {
            s16x4 xb0, xb1, xa0[4], xa1[4], yb0, yb1, ya0[4], ya1[4]; f32x4 xw0, xw1, yw0, yw1;
            xw0 = xw1 = yw0 = yw1 = (f32x4){0.f, 0.f, 0.f, 0.f};
            UPD_LOAD(0, xb0, xb1, xa0, xa1, xw0, xw1);
            UPD_LOAD(1, yb0, yb1, ya0, ya1, yw0, yw1);
            __builtin_amdgcn_sched_barrier(0);
            UPD_MMA(xb0, xb1, xa0, xa1, xw0, xw1);
            __builtin_amdgcn_sched_barrier(0);
            UPD_LOAD(2, xb0, xb1, xa0, xa1, xw0, xw1);
            __builtin_amdgcn_sched_barrier(0);
            UPD_MMA(yb0, yb1, ya0, ya1, yw0, yw1);
            __builtin_amdgcn_sched_barrier(0);
            UPD_LOAD(3, yb0, yb1, ya0, ya1, yw0, yw1);
            __builtin_amdgcn_sched_barrier(0);
            UPD_MMA(xb0, xb1, xa0, xa1, xw0, xw1);
            __builtin_amdgcn_sched_barrier(0);
            UPD_MMA(yb0, yb1, ya0, ya1, yw0, yw1);
        }
#undef UPD_LOAD
#undef UPD_MMA
        f32x16 OT[2];
#pragma unroll
        for (int j2 = 0; j2 < 2; ++j2)
#pragma unroll
            for (int e = 0; e < 16; ++e) OT[j2][e] = 0.f;
        {
            u32x2 qf[3][2][2];
#define Q_LOAD(sp, buf) do { _Pragma("unroll") for (int j2 = 0; j2 < 2; ++j2) { qf[buf][j2][0] = *(const LAS u32x2*)(lds + qB + 32 * j2 * RSQ + (16 * (sp)) * 2); qf[buf][j2][1] = *(const LAS u32x2*)(lds + qB + 32 * j2 * RSQ + (16 * (sp) + 8) * 2); } } while (0)
            Q_LOAD(0, 0); Q_LOAD(1, 1);
#pragma unroll
            for (int sp = 0; sp < 8; ++sp) {
                const int i = sp >> 1, o8 = 8 * (sp & 1);
                if (sp + 2 < 8) Q_LOAD(sp + 2, (sp + 2) % 3);
                u32x4 pk;
                pk.x = cvt_pk_bf16(S[i][o8 + 0], S[i][o8 + 1]); pk.y = cvt_pk_bf16(S[i][o8 + 2], S[i][o8 + 3]);
                pk.z = cvt_pk_bf16(S[i][o8 + 4], S[i][o8 + 5]); pk.w = cvt_pk_bf16(S[i][o8 + 6], S[i][o8 + 7]);
                const bf16x8 sfr = __builtin_bit_cast(bf16x8, pk);
                __builtin_amdgcn_sched_barrier(0);
#pragma unroll
                for (int j2 = 0; j2 < 2; ++j2) {
                    const bf16x8 qfr = __builtin_bit_cast(bf16x8, (u32x4){qf[sp % 3][j2][0].x, qf[sp % 3][j2][0].y, qf[sp % 3][j2][1].x, qf[sp % 3][j2][1].y});
                    OT[j2] = __builtin_amdgcn_mfma_f32_32x32x16_bf16(sfr, qfr, OT[j2], 0, 0, 0);
                }
                __builtin_amdgcn_sched_barrier(0);
            }
#undef Q_LOAD
        }
#undef TRR
        u32x2 gv[2][4];
#pragma unroll
        for (int j2 = 0; j2 < 2; ++j2)
#pragma unroll
            for (int g = 0; g < 4; ++g) gv[j2][g] = *(const LAS u32x2*)(lds + gB + 32 * j2 * RSG + 16 * g);
        float part[2] = {0.f, 0.f};
#pragma unroll
        for (int j2 = 0; j2 < 2; ++j2)
#pragma unroll
            for (int g = 0; g < 4; ++g) {
                if (SSD) {
                    const u32x2 xs = *(const LAS u32x2*)(lds + OFF_XS2 + (32 * j2 + r) * RSX + (32 * w + 8 * g + 4 * h) * 2);
                    OT[j2][4 * g + 0] = (OT[j2][4 * g + 0] + dsk * bf_lo(xs.x)) * bf_lo(gv[j2][g].x);
                    OT[j2][4 * g + 1] = (OT[j2][4 * g + 1] + dsk * bf_hi(xs.x)) * bf_hi(gv[j2][g].x);
                    OT[j2][4 * g + 2] = (OT[j2][4 * g + 2] + dsk * bf_lo(xs.y)) * bf_lo(gv[j2][g].y);
                    OT[j2][4 * g + 3] = (OT[j2][4 * g + 3] + dsk * bf_hi(xs.y)) * bf_hi(gv[j2][g].y);
                }
#pragma unroll
                for (int k = 0; k < 4; ++k) part[j2] += OT[j2][4 * g + k] * OT[j2][4 * g + k];
            }
        part[0] += __shfl_xor(part[0], 32); part[1] += __shfl_xor(part[1], 32);
        if (h == 0) { *(LAS float*)(lds + OFF_RED + (w * 64 + r) * 4) = part[0]; *(LAS float*)(lds + OFF_RED + (w * 64 + 32 + r) * 4) = part[1]; }
        LBAR();
#pragma unroll
        for (int j2 = 0; j2 < 2; ++j2) {
            float tot = 0.f;
#pragma unroll
            for (int ww = 0; ww < 8; ++ww) tot += *(const LAS float*)(lds + OFF_RED + (ww * 64 + 32 * j2 + r) * 4);
            const float rstd = rsqrtf(tot * (1.f / 256.f) + EPS);
#pragma unroll
            for (int g = 0; g < 4; ++g) {
                const f32x4 n4 = *(const LAS f32x4*)(lds + OFF_NW + (32 * w + 8 * g + 4 * h) * 4);
                float v0 = OT[j2][4 * g + 0] * rstd * n4.x, v1 = OT[j2][4 * g + 1] * rstd * n4.y, v2 = OT[j2][4 * g + 2] * rstd * n4.z, v3 = OT[j2][4 * g + 3] * rstd * n4.w;
                if (!SSD) { v0 *= bf_lo(gv[j2][g].x); v1 *= bf_hi(gv[j2][g].x); v2 *= bf_lo(gv[j2][g].y); v3 *= bf_hi(gv[j2][g].y); }
                *(LAS u32x2*)(lds + gB + 32 * j2 * RSG + 16 * g) = (u32x2){cvt_pk_bf16(v0, v1), cvt_pk_bf16(v2, v3)};
            }
        }
        LBAR();
#pragma unroll
        for (int i = 0; i < 4; ++i) {
            const u32x2 o0 = *(const LAS u32x2*)(lds + OFF_GT + (brow0 + 16 * i) * RSG + bpc * 16), o1 = *(const LAS u32x2*)(lds + OFF_GT + (brow0 + 16 * i) * RSG + bpc * 16 + 8);
            *(u32x4*)(a.out + ((size_t)c * 64 + brow0 + 16 * i) * a.ld_o + bpc * 8) = (u32x4){o0.x, o0.y, o1.x, o1.y};
        }
        if (c + 1 < NCH) MIX_STORE();
        LBAR();
    }
#undef MIX_LOAD
#undef MIX_STORE
}

__device__ __forceinline__ void p5_mixer(KP Pp, LAS unsigned char* lds, int G) {
    const Params P = load_params(Pp);
    unsigned char* ws = P.ws; unsigned char* T = ws + WS_BIG;
    for (int it = blockIdx.x; it < HB * 12; it += G) {
        const int b = it / 12, k = it % 12;
        const size_t row0 = (size_t)b * SEQ;
        MixArgs a;
        if (k < 4) {
            const int hd = k;
            a.ak = (const bf16_t*)(T + T_K) + row0 * 512 + hd * 128; a.ld_ak = 512;
            a.qq = (const bf16_t*)(T + T_Q) + row0 * 512 + hd * 128; a.ld_q = 512;
            a.bv = (const bf16_t*)(T + T_V) + row0 * 1024 + hd * 256; a.ld_bv = 1024;
            a.gt = (const bf16_t*)(T + T_SG) + row0 * 1024 + hd * 256; a.ld_g = 1024;
            a.out = (bf16_t*)(T + T_V) + row0 * 1024 + hd * 256; a.ld_o = 1024;
            a.dec = (const float*)(ws + WS_DEC) + (size_t)b * NCH * 512 + hd * 128;
            a.wg = nullptr; a.nw = P.in[9]; a.dsk = nullptr;
            mixer_item<false>(lds, a);
        } else {
            const int g = k - 4;
            const bf16_t* X = (const bf16_t*)(T + T_XBC) + row0 * 4096;
            a.ak = X + 2048 + g * 128; a.ld_ak = 4096;
            a.qq = X + 3072 + g * 128; a.ld_q = 4096;
            a.bv = X + g * 256; a.ld_bv = 4096;
            a.gt = (const bf16_t*)(T + T_SZ) + row0 * 2048 + g * 256; a.ld_g = 2048;
            a.out = (bf16_t*)(T + T_XBC) + row0 * 4096 + g * 256; a.ld_o = 4096;
            a.dec = (const float*)(ws + WS_DECS) + (size_t)b * NCH * 32 + g * 4;
            a.wg = (const float*)(ws + WS_WG) + row0 * 32 + g * 4;
            a.nw = P.in[16] + g * 256; a.dsk = P.in[15] + g * 4;
            mixer_item<true>(lds, a);
        }
        __syncthreads();
    }
}

__device__ __forceinline__ KP get_params() {
    KP p = (KP)__builtin_amdgcn_kernarg_segment_ptr(); asm volatile("" : "+s"(p)); return p;
}

#define XB_TMO      128
#define XB_XCNT(j)  (256  + 64 * (j))
#define XB_XSUB(j)  (1280 + 64 * (j))
#define XB_XGEN(j)  (2304 + 64 * (j))
#define XB_TOP      3328
#define XB_TOPGEN   3392
#define XCD_BAR_WORDS 3456
#define XB_SPIN_CAP (1u << 18)
__device__ __forceinline__ unsigned xb_ld(unsigned* p)              { return __hip_atomic_load(p, __ATOMIC_RELAXED, __HIP_MEMORY_SCOPE_AGENT); }
__device__ __forceinline__ unsigned xb_add(unsigned* p, unsigned v) { return __hip_atomic_fetch_add(p, v, __ATOMIC_RELAXED, __HIP_MEMORY_SCOPE_AGENT); }
__device__ __forceinline__ unsigned xb_xcc_id() { return (unsigned)__builtin_amdgcn_s_getreg((3 << 11) | 20) & 0xFu; }
#define XB_SPIN(cond, bar) do { unsigned _sp = 0; while (cond) { __builtin_amdgcn_s_sleep(1); \
    if ((++_sp & 255u) == 0u) { if (xb_ld(&(bar)[XB_TMO])) break; if (_sp > XB_SPIN_CAP) { atomicAdd(&(bar)[XB_TMO], 1u); break; } } } } while (0)
struct XcdBarrier { unsigned* bar; unsigned x; volatile LAS unsigned* st; };
__device__ __forceinline__ XcdBarrier xcd_barrier_post(unsigned* bar, volatile LAS unsigned* st) {
    XcdBarrier b; b.bar = bar; b.x = xb_xcc_id(); b.st = st;
    if (threadIdx.x == 0) (void)xb_add(&bar[XB_XCNT(b.x)], 1u);
    return b;
}
__device__ __forceinline__ void xcd_barrier_complete(unsigned* bar, unsigned x, unsigned& nloc, unsigned& nx) {
    const unsigned G = gridDim.x * gridDim.y * gridDim.z;
    unsigned sum, cnt, mine, sp = 0u;
    for (;;) {
        sum = 0u; cnt = 0u; mine = 0u;
#pragma unroll
        for (unsigned j = 0; j < 16; ++j) { const unsigned c = xb_ld(&bar[XB_XCNT(j)]); sum += c; cnt += (c > 0u) ? 1u : 0u; mine = (j == x) ? c : mine; }
        if (sum == G) break;
        __builtin_amdgcn_s_sleep(1);
        if ((++sp & 255u) == 0u) { if (xb_ld(&bar[XB_TMO])) break; if (sp > XB_SPIN_CAP) { atomicAdd(&bar[XB_TMO], 1u); break; } }
    }
    nloc = mine > 0u ? mine : 1u; nx = cnt > 0u ? cnt : 1u;
}
__device__ __forceinline__ void xcd_barrier(const XcdBarrier& b) {
    asm volatile("s_waitcnt vmcnt(0)" ::: "memory");
    __syncthreads();
    if (threadIdx.x == 0) {
        unsigned* bar = b.bar;
        __builtin_amdgcn_s_waitcnt(0);
        unsigned nloc = b.st[0], nx = b.st[1];
        if (nloc == 0u) { xcd_barrier_complete(bar, b.x, nloc, nx); b.st[0] = nloc; b.st[1] = nx; }
        const unsigned old = xb_add(&bar[XB_XSUB(b.x)], 1u);
        const unsigned gen = old / nloc;
        if (old + 1u == (gen + 1u) * nloc) {
            __builtin_amdgcn_fence(__ATOMIC_RELEASE, "agent");
            asm volatile("s_waitcnt vmcnt(0)" ::: "memory");
            const unsigned og = xb_add(&bar[XB_TOP], 1u);
            const unsigned tg = og / nx;
            if (og + 1u == (tg + 1u) * nx) xb_add(&bar[XB_TOPGEN], 1u);
            else XB_SPIN(xb_ld(&bar[XB_TOPGEN]) == tg, bar);
            __builtin_amdgcn_fence(__ATOMIC_ACQUIRE, "agent");
            xb_add(&bar[XB_XGEN(b.x)], 1u);
            asm volatile("s_waitcnt vmcnt(0)" ::: "memory");
        } else {
            XB_SPIN(xb_ld(&bar[XB_XGEN(b.x)]) == gen, bar);
            __builtin_amdgcn_fence(__ATOMIC_ACQUIRE, "agent");
            asm volatile("s_waitcnt vmcnt(0)" ::: "memory");
        }
    }
    __syncthreads();
}

#define PROBE_MASK 0x0
#define PROBE_DSYNC 0
#if PROBE_MASK
#define PH_BEGIN(i) const unsigned long long _t##i = __builtin_amdgcn_s_memrealtime();
#define PH_END(i) if ((PROBE_MASK >> (i)) & 1) probe_acc += __builtin_amdgcn_s_memrealtime() - _t##i;
#else
#define PH_BEGIN(i)
#define PH_END(i)
#endif
#if PROBE_DSYNC
#define GSYNC() do { xcd_barrier(xbar); xcd_barrier(xbar); } while (0)
#else
#define GSYNC() xcd_barrier(xbar)
#endif
__global__ void __launch_bounds__(512, 2) fwd_megakernel(Params Parg) {
    extern __shared__ __attribute__((aligned(16))) unsigned char lds_raw[];
    LAS unsigned char* lds = (LAS unsigned char*)lds_raw;
    cg::grid_group grid = cg::this_grid();
    const int G = gridDim.x;
    pg8::StaticOrder S;
#if PROBE_MASK
    unsigned long long probe_acc = 0;
#endif

    { unsigned* bw = (unsigned*)(get_params()->ws + WS_BAR);
      if (blockIdx.x == 0) for (int i = threadIdx.x; i < XCD_BAR_WORDS; i += 512) bw[i] = 0u;
      if (threadIdx.x < 2) *(volatile LAS unsigned*)(lds + LDS_XB + threadIdx.x * 4) = 0u; }
    XcdBarrier xbar;
    { PH_BEGIN(0) p0_prologue(get_params(), lds, G);
    grid.sync();
    xbar = xcd_barrier_post((unsigned*)(get_params()->ws + WS_BAR), (volatile LAS unsigned*)(lds + LDS_XB));
    PH_END(0) }
    { PH_BEGIN(1) { KP P = get_params(); unsigned char* ws = P->ws;
      pg8::Gemm g{(const bf16_t*)(ws + WS_XB), (const bf16_t*)(ws + WS_WGU1), MTOK, NGU, D, D, D, (const float*)(ws + WS_SSQ)}; S.init(MTOK, NGU, G, blockIdx.x);
      EpiGU E{(const float*)(ws + WS_SSQ), (bf16_t*)(ws + WS_BIG)}; pg8::gemm_phase(lds, g, S, E); }
    GSYNC(); PH_END(1) }
    { PH_BEGIN(2) { KP P = get_params(); unsigned char* ws = P->ws;
      pg8::Gemm g{(const bf16_t*)(ws + WS_BIG), (const bf16_t*)(ws + WS_WD1), MTOK, D, DFF, DFF, DFF, nullptr}; S.init(MTOK, D, G, blockIdx.x);
      EpiRes E{(bf16_t*)(ws + WS_XB), (float*)(ws + WS_SSQ) + MTOK, 0.5f}; pg8::gemm_phase(lds, g, S, E); }
    GSYNC(); PH_END(2) }
    for (int hf = 0; hf < 2; ++hf) {
        const size_t r0 = (size_t)hf * MH;
        { PH_BEGIN(3) { KP P = get_params(); unsigned char* ws = P->ws;
          pg8::Gemm g{(const bf16_t*)(ws + WS_XB) + r0 * D, (const bf16_t*)(ws + WS_WIN), MH, NIN, D, D, D, (const float*)(ws + WS_SSQ) + MTOK + r0}; S.init(MH, NIN, G, blockIdx.x);
          EpiIn E{(const float*)(ws + WS_SSQ) + MTOK + r0, ws + WS_BIG, (bf16_t*)(ws + WS_HALO), (float*)(ws + WS_SM)}; pg8::gemm_phase(lds, g, S, E); }
        GSYNC(); PH_END(3) }
        { PH_BEGIN(4) p4_prep(get_params(), lds, G);
        GSYNC(); PH_END(4) }
        { PH_BEGIN(5) p5_mixer(get_params(), lds, G);
        GSYNC(); PH_END(5) }
        { PH_BEGIN(6) { KP P = get_params(); unsigned char* ws = P->ws; unsigned char* T = ws + WS_BIG;
          pg8::Gemm g{(const bf16_t*)(T + T_V), (const bf16_t*)(ws + WS_WGO), MH, D, D, D, D, nullptr}; S.init(MH, D, G, blockIdx.x);
          EpiGate E{(const bf16_t*)(T + T_GT), nullptr, (bf16_t*)(T + T_T1), 0}; pg8::gemm_phase(lds, g, S, E); }
        { KP P = get_params(); unsigned char* ws = P->ws; unsigned char* T = ws + WS_BIG;
          pg8::Gemm g{(const bf16_t*)(T + T_XBC), (const bf16_t*)(ws + WS_WSO), MH, D, 2048, 4096, 2048, nullptr}; S.init(MH, D, G, blockIdx.x);
          EpiGate E{(const bf16_t*)(T + T_GT), (const bf16_t*)(T + T_T1), (bf16_t*)(T + T_MRG), 1}; pg8::gemm_phase(lds, g, S, E); }
        GSYNC(); PH_END(6) }
        { PH_BEGIN(7) { KP P = get_params(); unsigned char* ws = P->ws;
          pg8::Gemm g{(const bf16_t*)(ws + WS_BIG + T_MRG), (const bf16_t*)(ws + WS_WOUT), MH, D, D, D, D, nullptr}; S.init(MH, D, G, blockIdx.x);
          EpiRes E{(bf16_t*)(ws + WS_XB) + r0 * D, (float*)(ws + WS_SSQ) + 2 * MTOK + r0, 1.0f}; pg8::gemm_phase(lds, g, S, E); }
        GSYNC(); PH_END(7) }
    }
    { PH_BEGIN(8) { KP P = get_params(); unsigned char* ws = P->ws;
      pg8::Gemm g{(const bf16_t*)(ws + WS_XB), (const bf16_t*)(ws + WS_WGU2), MTOK, NGU, D, D, D, (const float*)(ws + WS_SSQ) + 2 * MTOK}; S.init(MTOK, NGU, G, blockIdx.x);
      EpiGU E{(const float*)(ws + WS_SSQ) + 2 * MTOK, (bf16_t*)(ws + WS_BIG)}; pg8::gemm_phase(lds, g, S, E); }
    GSYNC(); PH_END(8) }
    { PH_BEGIN(9) { KP P = get_params(); unsigned char* ws = P->ws;
      pg8::Gemm g{(const bf16_t*)(ws + WS_BIG), (const bf16_t*)(ws + WS_WD2), MTOK, D, DFF, DFF, DFF, nullptr}; S.init(MTOK, D, G, blockIdx.x);
      EpiRes E{(bf16_t*)(ws + WS_XB), (float*)(ws + WS_SSQ) + 3 * MTOK, 0.5f}; pg8::gemm_phase(lds, g, S, E); }
    GSYNC(); PH_END(9) }
    { PH_BEGIN(10)
    {
        KP P = get_params(); const float* ssq = (const float*)(P->ws + WS_SSQ) + 3 * MTOK;
        const int tid = tid_fresh(), lane = tid & 63, gw = blockIdx.x * 8 + (tid >> 6), NGW = G * 8;
        const float* fw = P->in[23]; float* outp = P->out; const bf16_t* xb = (const bf16_t*)(P->ws + WS_XB);
        f32x4 wv[4];
#pragma unroll
        for (int jj = 0; jj < 4; ++jj) wv[jj] = ((const f32x4*)fw)[lane + 64 * jj];
        for (int m = gw; m < MTOK; m += NGW) {
            const float rstd = rsqrtf(ssq[m] * (1.f / D) + EPS);
            const u32x2* xr = (const u32x2*)(xb + (size_t)m * D) + lane;
            f32x4* orow = (f32x4*)(outp + (size_t)m * D) + lane;
#pragma unroll
            for (int jj = 0; jj < 4; ++jj) { const u32x2 q = xr[64 * jj]; f32x4 v;
                v.x = bf_lo(q.x) * rstd * wv[jj].x; v.y = bf_hi(q.x) * rstd * wv[jj].y; v.z = bf_lo(q.y) * rstd * wv[jj].z; v.w = bf_hi(q.y) * rstd * wv[jj].w; orow[64 * jj] = v; }
        }
    }
    PH_END(10) }
#if PROBE_MASK
    if (blockIdx.x == 0) {
        const unsigned long long t0 = __builtin_amdgcn_s_memrealtime();
        while (__builtin_amdgcn_s_memrealtime() - t0 < probe_acc) __builtin_amdgcn_s_sleep(8);
    }
#endif
}

extern "C" void kernel_launch(void* const* d_in, const int* in_sizes, int n_in, void* d_out, int out_size, void* d_ws, size_t ws_size, hipStream_t stream) {
    static int grid = 0;
    if (grid == 0) {
        if (n_in != 24 || ws_size < WS_NEED) { fprintf(stderr, "kernel_launch: unexpected n_in %d or ws_size %zu (need %zu)\n", n_in, ws_size, (size_t)WS_NEED); grid = -1; return; }
        int dev = 0, cus = 0, per_cu = 0;
        hipGetDevice(&dev);
        hipDeviceGetAttribute(&cus, hipDeviceAttributeMultiprocessorCount, dev);
        hipFuncSetAttribute((const void*)fwd_megakernel, hipFuncAttributeMaxDynamicSharedMemorySize, LDS_BYTES);
        hipOccupancyMaxActiveBlocksPerMultiprocessor(&per_cu, (const void*)fwd_megakernel, 512, LDS_BYTES);
        if (per_cu < 1) { fprintf(stderr, "kernel_launch: occupancy query gave %d\n", per_cu); per_cu = 1; }
        grid = cus * per_cu;
        (void)hipGetLastError();
    }
    if (grid < 0) return;
    Params p{};
    for (int i = 0; i < 24; ++i) p.in[i] = (const float*)d_in[i];
    p.out = (float*)d_out; p.ws = (unsigned char*)d_ws;
    void* args[] = {&p};
    hipError_t e = hipLaunchCooperativeKernel((const void*)fwd_megakernel, dim3(grid), dim3(512), args, LDS_BYTES, stream);
    if (e != hipSuccess) fprintf(stderr, "cooperative launch failed: %s (grid %d)\n", hipGetErrorString(e), grid);
}
```

```cpp
#include <hip/hip_runtime.h>
#include <hip/hip_cooperative_groups.h>
#include <cstdio>
#include <cstdint>
namespace cg = cooperative_groups;

#define LAS __attribute__((address_space(3)))
typedef unsigned short bf16_t;
typedef short bf16x8 __attribute__((ext_vector_type(8)));
typedef short s16x4 __attribute__((ext_vector_type(4)));
typedef float f32x4 __attribute__((ext_vector_type(4)));
typedef float f32x16 __attribute__((ext_vector_type(16)));
typedef unsigned u32x4 __attribute__((ext_vector_type(4)));
typedef unsigned u32x2 __attribute__((ext_vector_type(2)));

constexpr int D = 1024, BATCH = 32, SEQ = 2048, MTOK = BATCH * SEQ;
constexpr int NCH = SEQ / 64;
constexpr int DFF = 2816, NGU = 2 * DFF;
constexpr int IN_DIM = 11312, NIN = 45 * 256;
constexpr int HB = 16, MH = HB * SEQ;
constexpr float EPS = 1e-6f;

constexpr size_t MiB = 1u << 20;
constexpr size_t WS_SSQ = 0;
constexpr size_t WS_WGU1 = 1 * MiB, WS_WD1 = 12 * MiB, WS_WIN = 18 * MiB, WS_WGO = 41 * MiB, WS_WSO = 43 * MiB, WS_WOUT = 47 * MiB, WS_WGU2 = 49 * MiB, WS_WD2 = 60 * MiB;
constexpr size_t WS_DEC = 66 * MiB, WS_DECS = 67 * MiB, WS_WG = 68 * MiB, WS_HALO = 72 * MiB, WS_SM = 84 * MiB;
constexpr size_t WS_BAR = 92 * MiB;
constexpr size_t WS_XB = 96 * MiB;
constexpr size_t WS_BIG = 224 * MiB;
constexpr size_t T_Q = 0, T_K = 32 * MiB, T_V = 64 * MiB, T_SG = 128 * MiB, T_SZ = 192 * MiB, T_XBC = 320 * MiB, T_GT = 576 * MiB, T_END = 704 * MiB;
constexpr size_t T_T1 = T_Q, T_MRG = T_SG;
constexpr size_t WS_NEED = WS_BIG + T_END;

constexpr int LDS_MAIN = 131072, LDS_XB = 149504, LDS_BYTES = LDS_XB + 64;

__device__ __forceinline__ unsigned cvt_pk_bf16(float lo, float hi) { unsigned r; asm volatile("v_cvt_pk_bf16_f32 %0, %1, %2" : "=v"(r) : "v"(lo), "v"(hi)); return r; }
__device__ __forceinline__ float bf_lo(unsigned u) { return __uint_as_float(u << 16); }
__device__ __forceinline__ float bf_hi(unsigned u) { return __uint_as_float(u & 0xffff0000u); }
__device__ __forceinline__ float fast_rcp(float x) { return __builtin_amdgcn_rcpf(x); }
__device__ __forceinline__ float sigmoidf_(float x) { return fast_rcp(1.f + __expf(-x)); }
__device__ __forceinline__ float siluf_(float x) { return x * sigmoidf_(x); }
__device__ __forceinline__ float softplusf_(float x) { return fmaxf(x, 0.f) + __logf(1.f + __expf(-fabsf(x))); }
__device__ __forceinline__ float wave_sum(float v) {
#pragma unroll
    for (int o = 1; o < 64; o <<= 1) v += __shfl_xor(v, o);
    return v;
}

namespace pg8 {
constexpr int BM = 256, BK = 64, HALF = 128, HTB = HALF * BK * 2, STAGE_BYTES = 8 * HTB, NXCD = 8, WGM = 8, ROWV_OFF = STAGE_BYTES;
__host__ __device__ __forceinline__ int lds_byte(int r, int c) { const int st = (r >> 4) * 2 + (c >> 5), rr = r & 15, cc = c & 31, ob = rr * 64 + cc * 2; return st * 1024 + (ob ^ (((ob >> 9) & 1) << 5)); }
__host__ __device__ __forceinline__ void stage_rc(int b, int& R, int& C) { const int st = b / 1024, sb = b % 1024, swz = sb ^ (((sb >> 9) & 1) << 5); R = (st >> 1) * 16 + swz / 64; C = (st & 1) * 32 + (swz % 64) / 2; }
__host__ __device__ __forceinline__ int perm32(int rho) { const int n = rho >> 4, i = rho & 15; return 8 * (i >> 2) + 4 * n + (i & 3); }

struct Unit { int pm, pn; };
struct Gemm { const bf16_t* A; const bf16_t* Bt; int M, N, K, lda, ldb; const float* rowvec; };

struct StaticOrder {
    int nM, nN, nwg, G, c;
    __device__ void init(int M, int N, int G_, int c_) { nM = M / BM; nN = N / BM; nwg = nM * nN; G = G_; c = c_; }
    __device__ bool next(int i, Unit& u) const {
        const long L = (long)i * G + c; if (L >= nwg) return false;
        int wgid = (int)L; { const int q = nwg / NXCD, r = nwg % NXCD, xcd = wgid % NXCD, off = wgid / NXCD; wgid = (xcd < r ? xcd * (q + 1) : r * (q + 1) + (xcd - r) * q) + off; }
        const int nig = WGM * nN, gid = wgid / nig, fm = gid * WGM, gsz = (nM - fm) < WGM ? (nM - fm) : WGM;
        u.pm = fm + ((wgid % nig) % gsz); u.pn = (wgid % nig) / gsz; return true;
    }
};

template <class Epi, bool ALIGN_EPI = true, bool SP2 = true>
__device__ __forceinline__ void gemm_phase(LAS unsigned char* lds, const Gemm g, const StaticOrder& S, const Epi& E) {
    int tid = threadIdx.x; asm volatile("" : "+v"(tid));
    const int wid = __builtin_amdgcn_readfirstlane(tid >> 6), lane = tid & 63, wr = wid >> 2, wc = wid & 3, fr = lane & 15, fq = lane >> 4;
    const int K = g.K, nt = K / BK;
    unsigned voffA[2], voffB[2];
#pragma unroll
    for (int i = 0; i < 2; ++i) { int R, C; stage_rc(tid * 16 + i * 8192, R, C); const int Rb = (R & ~31) + perm32(R & 31);
        voffA[i] = (unsigned)(R * g.lda + C) * 2u; voffB[i] = (unsigned)(Rb * g.ldb + C) * 2u; }
    const size_t kstep = (size_t)(BK * 2);
    const size_t hstA = (size_t)HALF * g.lda * 2, hstB = (size_t)HALF * g.ldb * 2;
    const size_t tstA = 2 * hstA, tstB = 2 * hstB;
    const unsigned ldsw = (unsigned)wid * 1024u;
    const int aoff = lds_byte(wr * 64 + fr, fq * 8), boff = lds_byte(wc * 32 + fr, fq * 8);
#define PG8_SA(b, h) (((b) * 2 + (h)) * HTB)
#define PG8_SB(b, h) ((4 + (b) * 2 + (h)) * HTB)
#define PG8_STAGE(bufoff, gbase, voff) do { _Pragma("unroll") for (int _i = 0; _i < 2; ++_i) \
        __builtin_amdgcn_global_load_lds((const unsigned*)((const char*)(gbase) + (voff)[_i]), (LAS unsigned*)(lds + (bufoff) + ldsw + _i * 8192), 16, 0, 0); } while (0)
#define PG8_LDA(dst, b, h) do { _Pragma("unroll") for (int m = 0; m < 4; ++m) _Pragma("unroll") for (int k = 0; k < 2; ++k) dst[m][k] = *(const LAS bf16x8*)(lds + PG8_SA(b, h) + aoff + m * 2048 + k * 1024); } while (0)
#define PG8_LDB(dst, b, h) do { _Pragma("unroll") for (int n = 0; n < 2; ++n) _Pragma("unroll") for (int k = 0; k < 2; ++k) dst[n][k] = *(const LAS bf16x8*)(lds + PG8_SB(b, h) + boff + n * 2048 + k * 1024); } while (0)
#define PG8_MMA(ai, bj, At, Bt) do { __builtin_amdgcn_s_setprio(1); _Pragma("unroll") for (int m = 0; m < 4; ++m) _Pragma("unroll") for (int n = 0; n < 2; ++n) _Pragma("unroll") for (int k = 0; k < 2; ++k) \
        acc[ai][bj][m][n] = __builtin_amdgcn_mfma_f32_16x16x32_bf16(Bt[n][k], At[m][k], acc[ai][bj][m][n], 0, 0, 0); __builtin_amdgcn_s_setprio(0); } while (0)
#define PG8_WAIT_V(n) asm volatile("s_waitcnt vmcnt(" #n ")" ::: "memory")
#define PG8_WAIT_L(n) asm volatile("s_waitcnt lgkmcnt(" #n ")" ::: "memory")
#define PG8_BAR __builtin_amdgcn_s_barrier()
#define PG8_SCHED __builtin_amdgcn_sched_barrier(0)
    Unit cur, nxt; int ui = 0;
    if (!S.next(0, cur)) return;
    f32x4 acc[2][2][4][2];
#pragma unroll
    for (int a = 0; a < 2; ++a)
#pragma unroll
        for (int b = 0; b < 2; ++b)
#pragma unroll
            for (int m = 0; m < 4; ++m)
#pragma unroll
                for (int n = 0; n < 2; ++n) acc[a][b][m][n] = (f32x4){0.f, 0.f, 0.f, 0.f};
    bf16x8 At[4][2], B0[2][2], B1[2][2];
    const char* cA = (const char*)g.A + (size_t)cur.pm * tstA; const char* cB = (const char*)g.Bt + (size_t)cur.pn * tstB;
    if constexpr (SP2) {
        PG8_STAGE(PG8_SB(0, 0), cB, voffB); PG8_STAGE(PG8_SB(0, 1), cB + hstB, voffB); PG8_STAGE(PG8_SA(0, 0), cA, voffA); PG8_STAGE(PG8_SA(0, 1), cA + hstA, voffA);
        if (wr == 1) PG8_BAR;
        PG8_WAIT_V(2); PG8_BAR;
        PG8_STAGE(PG8_SB(1, 0), cB + kstep, voffB); PG8_STAGE(PG8_SA(1, 0), cA + kstep, voffA); PG8_STAGE(PG8_SB(1, 1), cB + hstB + kstep, voffB);
        PG8_WAIT_V(6); PG8_BAR;
    } else {
    PG8_STAGE(PG8_SB(0, 0), cB, voffB); PG8_STAGE(PG8_SA(0, 0), cA, voffA); PG8_STAGE(PG8_SB(0, 1), cB + hstB, voffB); PG8_STAGE(PG8_SA(0, 1), cA + hstA, voffA);
    if (wr == 1) PG8_BAR;
    PG8_WAIT_V(4); PG8_BAR;
    PG8_STAGE(PG8_SB(1, 0), cB + kstep, voffB); PG8_STAGE(PG8_SA(1, 0), cA + kstep, voffA); PG8_STAGE(PG8_SB(1, 1), cB + hstB + kstep, voffB);
    PG8_WAIT_V(6); PG8_BAR;
    }
    for (;;) {
        const bool has_next = S.next(ui + 1, nxt);
        const char* nA = has_next ? (const char*)g.A + (size_t)nxt.pm * tstA : cA; const char* nB = has_next ? (const char*)g.Bt + (size_t)nxt.pn * tstB : cB;
        if (g.rowvec && wid == 0)
            __builtin_amdgcn_global_load_lds((const unsigned*)(g.rowvec + cur.pm * BM + lane * 4), (LAS unsigned*)(lds + ROWV_OFF + (ui & 1) * 1024), 16, 0, 0);
        for (int t = 0; t < nt; t += 2) {
            const bool last = (t == nt - 2);
            const char* a1 = cA + (size_t)(t + 1) * kstep;
            const char* a2 = last ? nA : cA + (size_t)(t + 2) * kstep; const char* b2 = last ? nB : cB + (size_t)(t + 2) * kstep;
            const char* a3 = a2 + kstep; const char* b3 = b2 + kstep;
            if constexpr (SP2) {
            PG8_LDB(B0, 0, 0); PG8_LDB(B1, 0, 1); PG8_SCHED; PG8_LDA(At, 0, 0); PG8_STAGE(PG8_SA(1, 1), a1 + hstA, voffA);
            PG8_WAIT_V(8); PG8_WAIT_L(0); PG8_BAR; PG8_MMA(0, 0, At, B0); PG8_MMA(0, 1, At, B1); PG8_BAR; PG8_SCHED;
            PG8_LDA(At, 0, 1); PG8_STAGE(PG8_SB(0, 0), b2, voffB); PG8_STAGE(PG8_SB(0, 1), b2 + hstB, voffB); PG8_STAGE(PG8_SA(0, 0), a2, voffA);
            PG8_WAIT_V(8); PG8_WAIT_L(0); PG8_BAR; PG8_MMA(1, 0, At, B0); PG8_MMA(1, 1, At, B1); PG8_BAR; PG8_SCHED;
            PG8_LDB(B0, 1, 0); PG8_LDB(B1, 1, 1); PG8_SCHED; PG8_LDA(At, 1, 0); PG8_STAGE(PG8_SA(0, 1), a2 + hstA, voffA);
            PG8_WAIT_V(8); PG8_WAIT_L(0); PG8_BAR; PG8_MMA(0, 0, At, B0); PG8_MMA(0, 1, At, B1); PG8_BAR; PG8_SCHED;
            PG8_LDA(At, 1, 1); PG8_STAGE(PG8_SB(1, 0), b3, voffB); PG8_STAGE(PG8_SB(1, 1), b3 + hstB, voffB); PG8_STAGE(PG8_SA(1, 0), a3, voffA);
            PG8_WAIT_V(8); PG8_WAIT_L(0); PG8_BAR; PG8_MMA(1, 0, At, B0); PG8_MMA(1, 1, At, B1); PG8_BAR; PG8_SCHED;
            } else {
            PG8_LDB(B0, 0, 0); PG8_SCHED; PG8_LDA(At, 0, 0); PG8_STAGE(PG8_SA(1, 1), a1 + hstA, voffA);
            PG8_WAIT_L(8); PG8_BAR; PG8_WAIT_L(0); PG8_MMA(0, 0, At, B0); PG8_BAR; PG8_SCHED;
            PG8_LDB(B1, 0, 1); PG8_STAGE(PG8_SB(0, 0), b2, voffB);
            PG8_BAR; PG8_WAIT_L(0); PG8_MMA(0, 1, At, B1); PG8_BAR;
            PG8_LDA(At, 0, 1); PG8_STAGE(PG8_SA(0, 0), a2, voffA);
            PG8_BAR; PG8_WAIT_L(0); PG8_MMA(1, 0, At, B0); PG8_BAR; PG8_SCHED;
            PG8_STAGE(PG8_SB(0, 1), b2 + hstB, voffB);
            PG8_WAIT_V(6); PG8_BAR; PG8_MMA(1, 1, At, B1); PG8_BAR;
            PG8_LDB(B0, 1, 0); PG8_SCHED; PG8_LDA(At, 1, 0); PG8_STAGE(PG8_SA(0, 1), a2 + hstA, voffA);
            PG8_WAIT_L(8); PG8_BAR; PG8_WAIT_L(0); PG8_MMA(0, 0, At, B0); PG8_BAR; PG8_SCHED;
            PG8_LDB(B1, 1, 1); PG8_STAGE(PG8_SB(1, 0), b3, voffB);
            PG8_BAR; PG8_WAIT_L(0); PG8_MMA(0, 1, At, B1); PG8_BAR;
            PG8_LDA(At, 1, 1); PG8_STAGE(PG8_SA(1, 0), a3, voffA);
            PG8_BAR; PG8_WAIT_L(0); PG8_MMA(1, 0, At, B0); PG8_BAR; PG8_SCHED;
            PG8_STAGE(PG8_SB(1, 1), b3 + hstB, voffB);
            PG8_WAIT_V(6); PG8_BAR; PG8_MMA(1, 1, At, B1); PG8_BAR;
            }
        }
        if constexpr (ALIGN_EPI) { if (wr == 0) PG8_BAR; }
        E(acc, cur, wr, wc, fr, fq, (const LAS float*)(lds + ROWV_OFF + (ui & 1) * 1024));
        if (!has_next) break;
#pragma unroll
        for (int a = 0; a < 2; ++a)
#pragma unroll
            for (int b = 0; b < 2; ++b)
#pragma unroll
                for (int m = 0; m < 4; ++m)
#pragma unroll
                    for (int n = 0; n < 2; ++n) acc[a][b][m][n] = (f32x4){0.f, 0.f, 0.f, 0.f};
        cur = nxt; cA = nA; cB = nB; ++ui;
        if constexpr (ALIGN_EPI) { if (wr == 1) PG8_BAR; }
    }
    PG8_WAIT_V(0);
    if constexpr (!ALIGN_EPI) { if (wr == 0) PG8_BAR; }
    PG8_BAR;
#undef PG8_SA
#undef PG8_SB
#undef PG8_STAGE
#undef PG8_LDA
#undef PG8_LDB
#undef PG8_MMA
#undef PG8_WAIT_V
#undef PG8_WAIT_L
#undef PG8_BAR
#undef PG8_SCHED
}
}

typedef f32x4 AccT[2][2][4][2];

struct EpiGU {
    const float* ssq; bf16_t* O;
    __device__ __forceinline__ void operator()(const AccT& acc, const pg8::Unit& u, int wr, int wc, int fr, int fq, const LAS float* rowv) const {
        const int row0 = u.pm * 256 + wr * 64 + fr, col0 = u.pn * 128 + wc * 32 + 8 * fq;
        float rs[2][4];
#pragma unroll
        for (int ai = 0; ai < 2; ++ai)
#pragma unroll
            for (int m = 0; m < 4; ++m) rs[ai][m] = rowv[wr * 64 + fr + ai * 128 + m * 16];
#pragma unroll
        for (int ai = 0; ai < 2; ++ai)
#pragma unroll
            for (int m = 0; m < 4; ++m) {
                const int row = row0 + ai * 128 + m * 16;
                const float rstd = rsqrtf(rs[ai][m] * (1.f / D) + EPS);
                float v[8];
#pragma unroll
                for (int n = 0; n < 2; ++n)
#pragma unroll
                    for (int j = 0; j < 4; ++j) { const float gg = acc[ai][0][m][n][j] * rstd, uu = acc[ai][1][m][n][j] * rstd; v[4 * n + j] = siluf_(gg) * uu; }
                u32x4 w; w.x = cvt_pk_bf16(v[0], v[1]); w.y = cvt_pk_bf16(v[2], v[3]); w.z = cvt_pk_bf16(v[4], v[5]); w.w = cvt_pk_bf16(v[6], v[7]);
                *(u32x4*)(O + (size_t)row * DFF + col0) = w;
            }
    }
};
struct EpiRes {
    bf16_t* xb; float* ssq; float alpha;
    __device__ __forceinline__ void operator()(const AccT& acc, const pg8::Unit& u, int wr, int wc, int fr, int fq, const LAS float* rowv) const {
        const int row0 = u.pm * 256 + wr * 64 + fr, col0 = u.pn * 256 + wc * 32 + 8 * fq;
        u32x4 xv[2][4][2];
#pragma unroll
        for (int ai = 0; ai < 2; ++ai)
#pragma unroll
            for (int m = 0; m < 4; ++m)
#pragma unroll
                for (int bj = 0; bj < 2; ++bj) xv[ai][m][bj] = *(const u32x4*)(xb + (size_t)(row0 + ai * 128 + m * 16) * D + col0 + bj * 128);
        __builtin_amdgcn_sched_barrier(0);
#pragma unroll
        for (int ai = 0; ai < 2; ++ai)
#pragma unroll
            for (int m = 0; m < 4; ++m) {
                const int row = row0 + ai * 128 + m * 16;
                float s = 0.f;
#pragma unroll
                for (int bj = 0; bj < 2; ++bj) {
                    const u32x4 q = xv[ai][m][bj];
                    float y[8];
                    y[0] = bf_lo(q.x) + acc[ai][bj][m][0].x * alpha; y[1] = bf_hi(q.x) + acc[ai][bj][m][0].y * alpha; y[2] = bf_lo(q.y) + acc[ai][bj][m][0].z * alpha; y[3] = bf_hi(q.y) + acc[ai][bj][m][0].w * alpha;
                    y[4] = bf_lo(q.z) + acc[ai][bj][m][1].x * alpha; y[5] = bf_hi(q.z) + acc[ai][bj][m][1].y * alpha; y[6] = bf_lo(q.w) + acc[ai][bj][m][1].z * alpha; y[7] = bf_hi(q.w) + acc[ai][bj][m][1].w * alpha;
#pragma unroll
                    for (int e = 0; e < 8; ++e) s += y[e] * y[e];
                    u32x4 w; w.x = cvt_pk_bf16(y[0], y[1]); w.y = cvt_pk_bf16(y[2], y[3]); w.z = cvt_pk_bf16(y[4], y[5]); w.w = cvt_pk_bf16(y[6], y[7]);
                    *(u32x4*)(xb + (size_t)row * D + col0 + bj * 128) = w;
                }
                s += __shfl_xor(s, 16); s += __shfl_xor(s, 32);
                if (fq == 0) atomicAdd(ssq + row, s);
            }
    }
};
struct EpiIn {
    const float* ssq; unsigned char* T; bf16_t* halo; float* sm;
    __device__ __forceinline__ void operator()(const AccT& acc, const pg8::Unit& u, int wr, int wc, int fr, int fq, const LAS float* rowv) const {
        const int pn = u.pn;
        const int row0 = u.pm * 256 + wr * 64 + fr;
        float rs[2][4];
#pragma unroll
        for (int ai = 0; ai < 2; ++ai)
#pragma unroll
            for (int m = 0; m < 4; ++m) rs[ai][m] = rowv[wr * 64 + fr + ai * 128 + m * 16];
        int act = 0, ld, ct; bf16_t* base;
        if (pn < 2) { base = (bf16_t*)(T + T_Q); ld = 512; ct = pn; }
        else if (pn < 4) { base = (bf16_t*)(T + T_K); ld = 512; ct = pn - 2; }
        else if (pn < 8) { base = (bf16_t*)(T + T_V); ld = 1024; ct = pn - 4; }
        else if (pn < 12) { base = (bf16_t*)(T + T_SG); ld = 1024; ct = pn - 8; act = 1; }
        else if (pn < 20) { base = (bf16_t*)(T + T_SZ); ld = 2048; ct = pn - 12; act = 1; }
        else if (pn < 36) { base = (bf16_t*)(T + T_XBC); ld = 4096; ct = pn - 20; act = 3; }
        else if (pn < 44) { base = (bf16_t*)(T + T_GT); ld = 2048; ct = pn - 36; act = 2; }
        else { base = nullptr; ld = 0; ct = 0; act = 4; }
        if (act == 4) {
            if (wc < 2) {
#pragma unroll
                for (int ai = 0; ai < 2; ++ai)
#pragma unroll
                    for (int m = 0; m < 4; ++m) {
                        const int row = row0 + ai * 128 + m * 16;
                        const float rstd = rsqrtf(rs[ai][m] * (1.f / D) + EPS);
                        float* p = sm + (size_t)row * 64 + wc * 32 + 8 * fq;
                        *(f32x4*)p = acc[ai][0][m][0] * rstd; *(f32x4*)(p + 4) = acc[ai][0][m][1] * rstd;
                    }
            }
            return;
        }
        const int col0 = ct * 256 + wc * 32 + 8 * fq;
        if (act == 1) tile<1>(acc, rs, base, ld, row0, col0);
        else if (act == 2) tile<2>(acc, rs, base, ld, row0, col0);
        else if (act == 3) tile<3>(acc, rs, base, ld, row0, col0);
        else tile<0>(acc, rs, base, ld, row0, col0);
    }
    template <int ACT> __device__ __forceinline__ void tile(const AccT& acc, const float (&rs)[2][4], bf16_t* base, int ld, int row0, int col0) const {
#pragma unroll
        for (int ai = 0; ai < 2; ++ai)
#pragma unroll
            for (int m = 0; m < 4; ++m) {
                const int row = row0 + ai * 128 + m * 16;
                const float rstd = rsqrtf(rs[ai][m] * (1.f / D) + EPS);
#pragma unroll
                for (int bj = 0; bj < 2; ++bj) {
                    float v[8];
#pragma unroll
                    for (int n = 0; n < 2; ++n)
#pragma unroll
                        for (int j = 0; j < 4; ++j) { float x = acc[ai][bj][m][n][j] * rstd; if (ACT == 1) x = siluf_(x); else if (ACT == 2) x = sigmoidf_(x); v[4 * n + j] = x; }
                    u32x4 w; w.x = cvt_pk_bf16(v[0], v[1]); w.y = cvt_pk_bf16(v[2], v[3]); w.z = cvt_pk_bf16(v[4], v[5]); w.w = cvt_pk_bf16(v[6], v[7]);
                    *(u32x4*)(base + (size_t)row * ld + col0 + bj * 128) = w;
                    if (ACT == 3 && (row & 63) >= 61) *(u32x4*)(halo + ((size_t)(row >> 6) * 3 + ((row & 63) - 61)) * 4096 + col0 + bj * 128) = w;
                }
            }
    }
};
struct EpiGate {
    const bf16_t* gt; const bf16_t* t1; bf16_t* out; int mode;
    __device__ __forceinline__ void operator()(const AccT& acc, const pg8::Unit& u, int wr, int wc, int fr, int fq, const LAS float* rowv) const {
        const int row0 = u.pm * 256 + wr * 64 + fr, col0 = u.pn * 256 + wc * 32 + 8 * fq;
#pragma unroll
        for (int ai = 0; ai < 2; ++ai) {
            u32x4 gq[4][2], tq[4][2];
#pragma unroll
            for (int m = 0; m < 4; ++m)
#pragma unroll
                for (int bj = 0; bj < 2; ++bj) { const int row = row0 + ai * 128 + m * 16, col = col0 + bj * 128;
                    gq[m][bj] = *(const u32x4*)(gt + (size_t)row * 2048 + mode * 1024 + col);
                    tq[m][bj] = mode ? *(const u32x4*)(t1 + (size_t)row * D + col) : (u32x4){0u, 0u, 0u, 0u}; }
            __builtin_amdgcn_sched_barrier(0);
#pragma unroll
            for (int m = 0; m < 4; ++m)
#pragma unroll
                for (int bj = 0; bj < 2; ++bj) {
                    const int row = row0 + ai * 128 + m * 16, col = col0 + bj * 128;
                    const u32x4 g4 = gq[m][bj], t4 = tq[m][bj];
                    float v[8];
                    v[0] = acc[ai][bj][m][0].x * bf_lo(g4.x); v[1] = acc[ai][bj][m][0].y * bf_hi(g4.x); v[2] = acc[ai][bj][m][0].z * bf_lo(g4.y); v[3] = acc[ai][bj][m][0].w * bf_hi(g4.y);
                    v[4] = acc[ai][bj][m][1].x * bf_lo(g4.z); v[5] = acc[ai][bj][m][1].y * bf_hi(g4.z); v[6] = acc[ai][bj][m][1].z * bf_lo(g4.w); v[7] = acc[ai][bj][m][1].w * bf_hi(g4.w);
                    if (mode) { v[0] += bf_lo(t4.x); v[1] += bf_hi(t4.x); v[2] += bf_lo(t4.y); v[3] += bf_hi(t4.y); v[4] += bf_lo(t4.z); v[5] += bf_hi(t4.z); v[6] += bf_lo(t4.w); v[7] += bf_hi(t4.w); }
                    u32x4 w; w.x = cvt_pk_bf16(v[0], v[1]); w.y = cvt_pk_bf16(v[2], v[3]); w.z = cvt_pk_bf16(v[4], v[5]); w.w = cvt_pk_bf16(v[6], v[7]);
                    *(u32x4*)(out + (size_t)row * D + col) = w;
                }
        }
    }
};

__device__ __forceinline__ void tr_item(const float* srcp, int ld, const float* sk, float mul, int k0, int K, bf16_t* dst, int n0, LAS float* scr, int lane) {
#pragma unroll
    for (int i = 0; i < 32; ++i) { const int kk = 2 * i + (lane >> 5);
        float v = 0.f; if (srcp) v = srcp[(size_t)(k0 + kk) * ld] * (sk ? sk[k0 + kk] : 1.f) * mul;
        scr[kk * 33 + (lane & 31)] = v; }
    asm volatile("s_waitcnt lgkmcnt(0)" ::: "memory");
    const int c = lane & 7;
#pragma unroll
    for (int j = 0; j < 4; ++j) { const int n = (lane >> 3) + 8 * j; const LAS float* s = scr + (8 * c) * 33 + n;
        u32x4 o; o.x = cvt_pk_bf16(s[0 * 33], s[1 * 33]); o.y = cvt_pk_bf16(s[2 * 33], s[3 * 33]); o.z = cvt_pk_bf16(s[4 * 33], s[5 * 33]); o.w = cvt_pk_bf16(s[6 * 33], s[7 * 33]);
        *(u32x4*)(dst + (size_t)(n0 + n) * K + k0 + 8 * c) = o; }
    asm volatile("s_waitcnt lgkmcnt(0)" ::: "memory");
}
__device__ __forceinline__ int win_src_col(int nd) {
    if (nd < 3072) return nd;
    if (nd < 5120) return 3088 + (nd - 3072);
    if (nd < 9216) return 5136 + (nd - 5120);
    if (nd < 11264) return 9264 + (nd - 9216);
    if (nd < 11280) return 3072 + (nd - 11264);
    if (nd < 11312) return 9232 + (nd - 11280);
    return -1;
}

struct Params {
    const float* in[24];
    float* out;
    unsigned char* ws;
};

typedef __attribute__((address_space(4))) const Params* KP;
__device__ __forceinline__ Params load_params(KP p) { Params r;
#pragma unroll
    for (int i = 0; i < 24; ++i) r.in[i] = p->in[i];
    r.out = p->out; r.ws = p->ws; return r; }
__device__ __forceinline__ int tid_fresh() { int t = threadIdx.x; asm volatile("" : "+v"(t)); return t; }
__device__ __forceinline__ void p0_prologue(KP Pp, LAS unsigned char* lds, int G) {
    const Params P = load_params(Pp);
    const int tid = tid_fresh(), lane = tid & 63, wave = tid >> 6;
    LAS float* scr = (LAS float*)(lds + wave * 16384);
    const int gw = blockIdx.x * 8 + wave, NGW = G * 8;
    unsigned char* ws = P.ws;
    constexpr int I_GU = (D / 64) * (NGU / 32), I_DN = (DFF / 64) * (D / 32), I_IN = (D / 64) * (NIN / 32), I_GO = (D / 64) * (D / 32), I_SO = (2048 / 64) * (D / 32);
    constexpr int NITEMS = 2 * I_GU + 2 * I_DN + I_IN + 2 * I_GO + I_SO;
    for (int it = gw; it < NITEMS; it += NGW) {
        int r = it; const int j = lane & 31;
        if (r < 2 * I_GU) { const int l2 = r >= I_GU; r -= l2 * I_GU; const int nb = r % (NGU / 32), kb = r / (NGU / 32); const int nd = nb * 32 + j, tile = nd >> 8, w = nd & 255;
            const float* Wg = P.in[l2 ? 20 : 2]; const float* Wu = P.in[l2 ? 21 : 3];
            const float* sp = (w < 128 ? Wg : Wu) + 128 * tile + (w & 127);
            tr_item(sp, DFF, P.in[l2 ? 19 : 1], 1.f, kb * 64, D, (bf16_t*)(ws + (l2 ? WS_WGU2 : WS_WGU1)), nb * 32, scr, lane); continue; }
        r -= 2 * I_GU;
        if (r < 2 * I_DN) { const int l2 = r >= I_DN; r -= l2 * I_DN; const int nb = r % (D / 32), kb = r / (D / 32);
            tr_item(P.in[l2 ? 22 : 4] + nb * 32 + j, D, nullptr, 1.f, kb * 64, DFF, (bf16_t*)(ws + (l2 ? WS_WD2 : WS_WD1)), nb * 32, scr, lane); continue; }
        r -= 2 * I_DN;
        if (r < I_IN) { const int nb = r % (NIN / 32), kb = r / (NIN / 32); const int nd = nb * 32 + j, sc = win_src_col(nd);
            tr_item(sc >= 0 ? P.in[6] + sc : nullptr, IN_DIM, P.in[5], nd < 512 ? 0.08838834764831845f : 1.f, kb * 64, D, (bf16_t*)(ws + WS_WIN), nb * 32, scr, lane); continue; }
        r -= I_IN;
        if (r < 2 * I_GO) { const int l2 = r >= I_GO; r -= l2 * I_GO; const int nb = r % (D / 32), kb = r / (D / 32);
            tr_item(P.in[l2 ? 18 : 10] + nb * 32 + j, D, nullptr, 1.f, kb * 64, D, (bf16_t*)(ws + (l2 ? WS_WOUT : WS_WGO)), nb * 32, scr, lane); continue; }
        r -= 2 * I_GO;
        { const int nb = r % (D / 32), kb = r / (D / 32);
            tr_item(P.in[17] + nb * 32 + j, D, nullptr, 1.f, kb * 64, 2048, (bf16_t*)(ws + WS_WSO), nb * 32, scr, lane); }
    }
    const float* x = P.in[0]; bf16_t* xb = (bf16_t*)(ws + WS_XB); float* ssq = (float*)(ws + WS_SSQ);
    for (int m0 = gw; m0 < MTOK; m0 += 4 * NGW) {
        f32x4 v[4][4];
#pragma unroll
        for (int u = 0; u < 4; ++u) { const int m = m0 + u * NGW; if (m < MTOK) { const f32x4* xr = (const f32x4*)(x + (size_t)m * D) + lane;
#pragma unroll
            for (int jj = 0; jj < 4; ++jj) v[u][jj] = xr[64 * jj]; } }
#pragma unroll
        for (int u = 0; u < 4; ++u) { const int m = m0 + u * NGW; if (m < MTOK) {
            unsigned long long* o8 = (unsigned long long*)(xb + (size_t)m * D) + lane;
            float s = 0.f;
#pragma unroll
            for (int jj = 0; jj < 4; ++jj) { const f32x4 q = v[u][jj]; s += q.x * q.x + q.y * q.y + q.z * q.z + q.w * q.w;
                o8[64 * jj] = (unsigned long long)cvt_pk_bf16(q.x, q.y) | ((unsigned long long)cvt_pk_bf16(q.z, q.w) << 32); }
            s = wave_sum(s);
            if (lane == 0) { ssq[m] = s; ssq[MTOK + m] = 0.f; ssq[2 * MTOK + m] = 0.f; ssq[3 * MTOK + m] = 0.f; } } }
    }
}

__device__ __forceinline__ void p4_prep(KP Pp, LAS unsigned char* lds, int G) {
    const Params P = load_params(Pp);
    const int tid = tid_fresh();
    unsigned char* ws = P.ws; unsigned char* T = ws + WS_BIG;
    const float* sm = (const float*)(ws + WS_SM);
    for (int it = blockIdx.x; it < HB * NCH; it += G) {
        const int row0 = it * 64;
#pragma unroll
        for (int i = 0; i < 2; ++i) { const int idx = tid + 512 * i; *(LAS f32x4*)(lds + idx * 16) = *(const f32x4*)(sm + (size_t)row0 * 64 + idx * 4); }
        __syncthreads();
        {
            const int hc = tid;
            const float* wf = P.in[7]; float w[16];
#pragma unroll
            for (int j = 0; j < 16; ++j) w[j] = wf[j * 512 + hc];
            const float bfv = P.in[8][hc];
            float la[64]; float cum = 0.f;
#pragma unroll
            for (int t = 0; t < 64; ++t) { float z = bfv;
#pragma unroll
                for (int j4 = 0; j4 < 4; ++j4) { const f32x4 f = *(const LAS f32x4*)(lds + t * 256 + j4 * 16); z += f.x * w[4 * j4] + f.y * w[4 * j4 + 1] + f.z * w[4 * j4 + 2] + f.w * w[4 * j4 + 3]; }
                la[t] = (fminf(z, 0.f) - __logf(1.f + __expf(-fabsf(z)))) * (1.f / 16.f); cum += la[t]; }
            const float end = cum; cum = 0.f;
            bf16_t* kp = (bf16_t*)(T + T_K) + (size_t)row0 * 512 + hc;
#pragma unroll
            for (int tb = 0; tb < 4; ++tb) {
                bf16_t kk[16];
#pragma unroll
                for (int u = 0; u < 16; ++u) kk[u] = kp[(size_t)(tb * 16 + u) * 512];
#pragma unroll
                for (int u = 0; u < 16; ++u) { const int t = tb * 16 + u;
                    cum += la[t];
                    const float kv = __uint_as_float((unsigned)kk[u] << 16) * __expf(end - cum);
                    kp[(size_t)t * 512] = (bf16_t)(cvt_pk_bf16(kv, 0.f) & 0xffffu); }
            }
            ((float*)(ws + WS_DEC))[(size_t)it * 512 + hc] = __expf(end);
        }
        if (tid < 32) {
            const float bias = P.in[13][tid], A = -__expf(P.in[14][tid]);
            float cum = 0.f;
#pragma unroll 4
            for (int t = 0; t < 64; ++t) cum += softplusf_(*(const LAS float*)(lds + t * 256 + (16 + tid) * 4) + bias) * A;
            const float end = cum; cum = 0.f;
            float* wg = (float*)(ws + WS_WG);
#pragma unroll 4
            for (int t = 0; t < 64; ++t) { const float dt = softplusf_(*(const LAS float*)(lds + t * 256 + (16 + tid) * 4) + bias); cum += dt * A; wg[(size_t)(row0 + t) * 32 + tid] = __expf(end - cum) * dt; }
            ((float*)(ws + WS_DECS))[it * 32 + tid] = __expf(end);
        }
        __syncthreads();
    }
    const int co = tid & 63, rg = tid >> 6;
    u32x4 raw[11];
#define CONV_LOAD(itx) do { const int _ci = (itx) >> 3, _col = ((itx) & 7) * 512 + co * 8; \
        const bf16_t* _xp = (const bf16_t*)(T + T_XBC) + (size_t)(_ci * 64 + rg * 8) * 4096 + _col; \
        _Pragma("unroll") for (int i = 0; i < 8; ++i) raw[3 + i] = *(const u32x4*)(_xp + (size_t)i * 4096); \
        if (rg > 0) { _Pragma("unroll") for (int i = 0; i < 3; ++i) raw[i] = *(const u32x4*)(_xp - (size_t)(3 - i) * 4096); } \
        else if ((_ci & (NCH - 1)) != 0) { const bf16_t* _hp = (const bf16_t*)(ws + WS_HALO) + (size_t)(_ci - 1) * 3 * 4096 + _col; \
            _Pragma("unroll") for (int i = 0; i < 3; ++i) raw[i] = *(const u32x4*)(_hp + (size_t)i * 4096); } \
        else { _Pragma("unroll") for (int i = 0; i < 3; ++i) raw[i] = (u32x4){0u, 0u, 0u, 0u}; } } while (0)
    float cw[4][8], cbv[8];
    { const int colw = ((G & 7) == 0 ? ((int)blockIdx.x & 7) : 0) * 512 + co * 8;
#pragma unroll
      for (int k = 0; k < 4; ++k) { const f32x4 a = *(const f32x4*)(P.in[11] + k * 4096 + colw), b = *(const f32x4*)(P.in[11] + k * 4096 + colw + 4);
          cw[k][0] = a.x; cw[k][1] = a.y; cw[k][2] = a.z; cw[k][3] = a.w; cw[k][4] = b.x; cw[k][5] = b.y; cw[k][6] = b.z; cw[k][7] = b.w; }
      { const f32x4 a = *(const f32x4*)(P.in[12] + colw), b = *(const f32x4*)(P.in[12] + colw + 4);
          cbv[0] = a.x; cbv[1] = a.y; cbv[2] = a.z; cbv[3] = a.w; cbv[4] = b.x; cbv[5] = b.y; cbv[6] = b.z; cbv[7] = b.w; } }
    if ((int)blockIdx.x < HB * NCH * 8) CONV_LOAD((int)blockIdx.x);
    for (int it = blockIdx.x; it < HB * NCH * 8; it += G) {
        const int ci = it >> 3, cb = it & 7, col = cb * 512 + co * 8, row0 = ci * 64 + rg * 8;
        bf16_t* xp = (bf16_t*)(T + T_XBC) + (size_t)row0 * 4096 + col;
        if ((G & 7) != 0) {
#pragma unroll
            for (int k = 0; k < 4; ++k) { const f32x4 a = *(const f32x4*)(P.in[11] + k * 4096 + col), b = *(const f32x4*)(P.in[11] + k * 4096 + col + 4);
                cw[k][0] = a.x; cw[k][1] = a.y; cw[k][2] = a.z; cw[k][3] = a.w; cw[k][4] = b.x; cw[k][5] = b.y; cw[k][6] = b.z; cw[k][7] = b.w; }
            { const f32x4 a = *(const f32x4*)(P.in[12] + col), b = *(const f32x4*)(P.in[12] + col + 4);
                cbv[0] = a.x; cbv[1] = a.y; cbv[2] = a.z; cbv[3] = a.w; cbv[4] = b.x; cbv[5] = b.y; cbv[6] = b.z; cbv[7] = b.w; }
        }
        asm volatile("s_waitcnt vmcnt(0)" ::: "memory");
        __syncthreads();
        u32x4 outv[8];
#pragma unroll
        for (int i = 0; i < 8; ++i) {
            float v[8];
#pragma unroll
            for (int e = 0; e < 8; ++e) v[e] = cbv[e];
#pragma unroll
            for (int k = 0; k < 4; ++k) { const u32x4 q = raw[i + k];
                v[0] += cw[k][0] * bf_lo(q.x); v[1] += cw[k][1] * bf_hi(q.x); v[2] += cw[k][2] * bf_lo(q.y); v[3] += cw[k][3] * bf_hi(q.y);
                v[4] += cw[k][4] * bf_lo(q.z); v[5] += cw[k][5] * bf_hi(q.z); v[6] += cw[k][6] * bf_lo(q.w); v[7] += cw[k][7] * bf_hi(q.w); }
#pragma unroll
            for (int e = 0; e < 8; ++e) v[e] = siluf_(v[e]);
            outv[i].x = cvt_pk_bf16(v[0], v[1]); outv[i].y = cvt_pk_bf16(v[2], v[3]); outv[i].z = cvt_pk_bf16(v[4], v[5]); outv[i].w = cvt_pk_bf16(v[6], v[7]);
        }
        if (it + G < HB * NCH * 8) CONV_LOAD(it + G);
#pragma unroll
        for (int i = 0; i < 8; ++i) *(u32x4*)(xp + (size_t)i * 4096) = outv[i];
    }
#undef CONV_LOAD
}

struct MixArgs {
    const bf16_t* ak; int ld_ak;
    const bf16_t* qq; int ld_q;
    const bf16_t* bv; int ld_bv;
    const bf16_t* gt; int ld_g;
    bf16_t* out; int ld_o;
    const float* dec;
    const float* wg;
    const float* nw;
    const float* dsk;
};
constexpr int RSA = 320, RSB = 576, RSQ = 264, RSG = 520, RSX = 520;
constexpr int OFF_AK = 0, OFF_BV = 64 * RSA, OFF_QQ = OFF_BV + 64 * RSB, OFF_WGT = OFF_QQ + 64 * RSQ, OFF_DEC = OFF_WGT + 1024, OFF_RED = OFF_DEC + 512, OFF_NW = OFF_RED + 2048, OFF_GT = OFF_NW + 1024, OFF_XS2 = OFF_GT + 64 * RSG;
static_assert(OFF_XS2 + 64 * RSX <= LDS_XB, "mixer LDS");

#define LBAR() do { asm volatile("s_waitcnt lgkmcnt(0)" ::: "memory"); __builtin_amdgcn_s_barrier(); asm volatile("" ::: "memory"); } while (0)
template <bool SSD>
__device__ __forceinline__ void mixer_item(LAS unsigned char* lds, const MixArgs& a) {
    const int tid = tid_fresh(), lane = tid & 63, w = __builtin_amdgcn_readfirstlane(tid >> 6);
    const int r = lane & 31, h = lane >> 5, gg = lane >> 4, q = (lane & 15) >> 2, p = lane & 3;
    const int arow0 = tid >> 4, apc = tid & 15;
    const int brow0 = tid >> 5, bpc = tid & 31;
    u32x4 stA[2], stQ[2], stB[4], stG[4], stD; float stWp[4];
    stD = (u32x4){0u, 0u, 0u, 0u}; stWp[0] = stWp[1] = stWp[2] = stWp[3] = 0.f;
#define MIX_LOAD(c) do { const size_t _r0 = (size_t)(c) * 64; \
        _Pragma("unroll") for (int i = 0; i < 2; ++i) { stA[i] = *(const u32x4*)(a.ak + (_r0 + arow0 + 32 * i) * a.ld_ak + apc * 8); stQ[i] = *(const u32x4*)(a.qq + (_r0 + arow0 + 32 * i) * a.ld_q + apc * 8); } \
        _Pragma("unroll") for (int i = 0; i < 4; ++i) { stB[i] = *(const u32x4*)(a.bv + (_r0 + brow0 + 16 * i) * a.ld_bv + bpc * 8); stG[i] = *(const u32x4*)(a.gt + (_r0 + brow0 + 16 * i) * a.ld_g + bpc * 8); } \
        if (SSD) { _Pragma("unroll") for (int i = 0; i < 4; ++i) stWp[i] = a.wg[(_r0 + brow0 + 16 * i) * 32 + (bpc >> 3)]; }     \
        else { if (tid < 32) stD = *(const u32x4*)(a.dec + (size_t)(c) * 512 + tid * 4); } } while (0)
#define MIX_STORE() do { \
        _Pragma("unroll") for (int i = 0; i < 2; ++i) { *(LAS u32x4*)(lds + OFF_AK + (arow0 + 32 * i) * RSA + apc * 16) = stA[i]; \
            *(LAS u32x2*)(lds + OFF_QQ + (arow0 + 32 * i) * RSQ + apc * 16) = (u32x2){stQ[i].x, stQ[i].y}; *(LAS u32x2*)(lds + OFF_QQ + (arow0 + 32 * i) * RSQ + apc * 16 + 8) = (u32x2){stQ[i].z, stQ[i].w}; } \
        _Pragma("unroll") for (int i = 0; i < 4; ++i) { \
            if (SSD) { *(LAS u32x2*)(lds + OFF_XS2 + (brow0 + 16 * i) * RSX + bpc * 16) = (u32x2){stB[i].x, stB[i].y}; *(LAS u32x2*)(lds + OFF_XS2 + (brow0 + 16 * i) * RSX + bpc * 16 + 8) = (u32x2){stB[i].z, stB[i].w}; \
                const float _w = stWp[i]; u32x4 _b; _b.x = cvt_pk_bf16(bf_lo(stB[i].x) * _w, bf_hi(stB[i].x) * _w); _b.y = cvt_pk_bf16(bf_lo(stB[i].y) * _w, bf_hi(stB[i].y) * _w); \
                _b.z = cvt_pk_bf16(bf_lo(stB[i].z) * _w, bf_hi(stB[i].z) * _w); _b.w = cvt_pk_bf16(bf_lo(stB[i].w) * _w, bf_hi(stB[i].w) * _w); \
                *(LAS u32x4*)(lds + OFF_BV + (brow0 + 16 * i) * RSB + bpc * 16) = _b; } \
            else *(LAS u32x4*)(lds + OFF_BV + (brow0 + 16 * i) * RSB + bpc * 16) = stB[i]; \
            *(LAS u32x2*)(lds + OFF_GT + (brow0 + 16 * i) * RSG + bpc * 16) = (u32x2){stG[i].x, stG[i].y}; *(LAS u32x2*)(lds + OFF_GT + (brow0 + 16 * i) * RSG + bpc * 16 + 8) = (u32x2){stG[i].z, stG[i].w}; } \
        if (!SSD) { if (tid < 32) *(LAS u32x4*)(lds + OFF_DEC + tid * 16) = stD; } } while (0)

    if (tid < 256) *(LAS float*)(lds + OFF_NW + tid * 4) = a.nw[tid];
    MIX_LOAD(0);
    MIX_STORE();
    __syncthreads();

    f32x16 S[4];
#pragma unroll
    for (int i = 0; i < 4; ++i)
#pragma unroll
        for (int e = 0; e < 16; ++e) S[i][e] = 0.f;

    const int trA = OFF_AK + (8 * h + q) * RSA + (16 * (gg & 1) + 4 * p) * 2;
    const int trB = OFF_BV + (8 * h + q) * RSB + (32 * w + 16 * (gg & 1) + 4 * p) * 2;
    const int qB = OFF_QQ + r * RSQ + 8 * h;
    const int gB = OFF_GT + r * RSG + (32 * w + 4 * h) * 2;
    const float dsk = SSD ? a.dsk[w >> 1] : 0.f;
    float dc_next = SSD ? a.dec[w >> 1] : 0.f;

    for (int c = 0; c < NCH; ++c) {
        if (c + 1 < NCH) MIX_LOAD(c + 1);
        if (SSD) {
            const float dc = dc_next;
            if (c + 1 < NCH) dc_next = a.dec[(size_t)(c + 1) * 32 + (w >> 1)];
#pragma unroll
            for (int i = 0; i < 4; ++i)
#pragma unroll
                for (int e = 0; e < 16; ++e) S[i][e] *= dc;
        } else {
#pragma unroll
            for (int i = 0; i < 4; ++i)
#pragma unroll
                for (int g = 0; g < 4; ++g) { const f32x4 d4 = *(const LAS f32x4*)(lds + OFF_DEC + (32 * i + 8 * g + 4 * h) * 4);
                    S[i][4 * g + 0] *= d4.x; S[i][4 * g + 1] *= d4.y; S[i][4 * g + 2] *= d4.z; S[i][4 * g + 3] *= d4.w; }
        }
#define TRR(addr) __builtin_bit_cast(s16x4, __builtin_amdgcn_ds_read_tr16_b64_v4i16((LAS s16x4*)(lds + (addr))))
#define UPD_LOAD(s, B0, B1, A0, A1, W0, W1) do { B0 = TRR(trB + (16 * (s)) * RSB); B1 = TRR(trB + (16 * (s) + 4) * RSB); \
        _Pragma("unroll") for (int i = 0; i < 4; ++i) { A0[i] = TRR(trA + (16 * (s)) * RSA + 64 * i); A1[i] = TRR(trA + (16 * (s) + 4) * RSA + 64 * i); } \
        } while (0)
#define UPD_MMA(B0, B1, A0, A1, W0, W1) do { bf16x8 bfr = __builtin_shufflevector(B0, B1, 0, 1, 2, 3, 4, 5, 6, 7); \
        _Pragma("unroll") for (int i = 0; i < 4; ++i) S[i] = __builtin_amdgcn_mfma_f32_32x32x16_bf16(__builtin_shufflevector(A0[i], A1[i], 0, 1, 2, 3, 4, 5, 6, 7), bfr, S[i], 0, 0, 0); } while (0)
        {
            s16x4 xb0, xb1, xa0[4], xa1[4], yb0, yb1, ya0[4], ya1[4]; f32x4 xw0, xw1, yw0, yw1;
            xw0 = xw1 = yw0 = yw1 = (f32x4){0.f, 0.f, 0.f, 0.f};
            UPD_LOAD(0, xb0, xb1, xa0, xa1, xw0, xw1);
            UPD_LOAD(1, yb0, yb1, ya0, ya1, yw0, yw1);
            __builtin_amdgcn_sched_barrier(0);
            UPD_MMA(xb0, xb1, xa0, xa1, xw0, xw1);
            __builtin_amdgcn_sched_barrier(0);
            UPD_LOAD(2, xb0, xb1, xa0, xa1, xw0, xw1);
            __builtin_amdgcn_sched_barrier(0);
            UPD_MMA(yb0, yb1, ya0, ya1, yw0, yw1);
            __builtin_amdgcn_sched_barrier(0);
            UPD_LOAD(3, yb0, yb1, ya0, ya1, yw0, yw1);
            __builtin_amdgcn_sched_barrier(0);
            UPD_MMA(xb0, xb1, xa0, xa1, xw0, xw1);
            __builtin_amdgcn_sched_barrier(0);
            UPD_MMA(yb0, yb1, ya0, ya1, yw0, yw1);
        }
#undef UPD_LOAD
#undef UPD_MMA
        f32x16 OT[2];
#pragma unroll
        for (int j2 = 0; j2 < 2; ++j2)
#pragma unroll
            for (int e = 0; e < 16; ++e) OT[j2][e] = 0.f;
        {
            u32x2 qf[3][2][2];
#define Q_LOAD(sp, buf) do { _Pragma("unroll") for (int j2 = 0; j2 < 2; ++j2) { qf[buf][j2][0] = *(const LAS u32x2*)(lds + qB + 32 * j2 * RSQ + (16 * (sp)) * 2); qf[buf][j2][1] = *(const LAS u32x2*)(lds + qB + 32 * j2 * RSQ + (16 * (sp) + 8) * 2); } } while (0)
            Q_LOAD(0, 0); Q_LOAD(1, 1);
#pragma unroll
            for (int sp = 0; sp < 8; ++sp) {
                const int i = sp >> 1, o8 = 8 * (sp & 1);
                if (sp + 2 < 8) Q_LOAD(sp + 2, (sp + 2) % 3);
                u32x4 pk;
                pk.x = cvt_pk_bf16(S[i][o8 + 0], S[i][o8 + 1]); pk.y = cvt_pk_bf16(S[i][o8 + 2], S[i][o8 + 3]);
                pk.z = cvt_pk_bf16(S[i][o8 + 4], S[i][o8 + 5]); pk.w = cvt_pk_bf16(S[i][o8 + 6], S[i][o8 + 7]);
                const bf16x8 sfr = __builtin_bit_cast(bf16x8, pk);
                __builtin_amdgcn_sched_barrier(0);
#pragma unroll
                for (int j2 = 0; j2 < 2; ++j2) {
                    const bf16x8 qfr = __builtin_bit_cast(bf16x8, (u32x4){qf[sp % 3][j2][0].x, qf[sp % 3][j2][0].y, qf[sp % 3][j2][1].x, qf[sp % 3][j2][1].y});
                    OT[j2] = __builtin_amdgcn_mfma_f32_32x32x16_bf16(sfr, qfr, OT[j2], 0, 0, 0);
                }
                __builtin_amdgcn_sched_barrier(0);
            }
#undef Q_LOAD
        }
#undef TRR
        u32x2 gv[2][4];
#pragma unroll
        for (int j2 = 0; j2 < 2; ++j2)
#pragma unroll
            for (int g = 0; g < 4; ++g) gv[j2][g] = *(const LAS u32x2*)(lds + gB + 32 * j2 * RSG + 16 * g);
        float part[2] = {0.f, 0.f};
#pragma unroll
        for (int j2 = 0; j2 < 2; ++j2)
#pragma unroll
            for (int g = 0; g < 4; ++g) {
                if (SSD) {
                    const u32x2 xs = *(const LAS u32x2*)(lds + OFF_XS2 + (32 * j2 + r) * RSX + (32 * w + 8 * g + 4 * h) * 2);
                    OT[j2][4 * g + 0] = (OT[j2][4 * g + 0] + dsk * bf_lo(xs.x)) * bf_lo(gv[j2][g].x);
                    OT[j2][4 * g + 1] = (OT[j2][4 * g + 1] + dsk * bf_hi(xs.x)) * bf_hi(gv[j2][g].x);
                    OT[j2][4 * g + 2] = (OT[j2][4 * g + 2] + dsk * bf_lo(xs.y)) * bf_lo(gv[j2][g].y);
                    OT[j2][4 * g + 3] = (OT[j2][4 * g + 3] + dsk * bf_hi(xs.y)) * bf_hi(gv[j2][g].y);
                }
#pragma unroll
                for (int k = 0; k < 4; ++k) part[j2] += OT[j2][4 * g + k] * OT[j2][4 * g + k];
            }
        part[0] += __shfl_xor(part[0], 32); part[1] += __shfl_xor(part[1], 32);
        if (h == 0) { *(LAS float*)(lds + OFF_RED + (w * 64 + r) * 4) = part[0]; *(LAS float*)(lds + OFF_RED + (w * 64 + 32 + r) * 4) = part[1]; }
        LBAR();
#pragma unroll
        for (int j2 = 0; j2 < 2; ++j2) {
            float tot = 0.f;
#pragma unroll
            for (int ww = 0; ww < 8; ++ww) tot += *(const LAS float*)(lds + OFF_RED + (ww * 64 + 32 * j2 + r) * 4);
            const float rstd = rsqrtf(tot * (1.f / 256.f) + EPS);
#pragma unroll
            for (int g = 0; g < 4; ++g) {
                const f32x4 n4 = *(const LAS f32x4*)(lds + OFF_NW + (32 * w + 8 * g + 4 * h) * 4);
                float v0 = OT[j2][4 * g + 0] * rstd * n4.x, v1 = OT[j2][4 * g + 1] * rstd * n4.y, v2 = OT[j2][4 * g + 2] * rstd * n4.z, v3 = OT[j2][4 * g + 3] * rstd * n4.w;
                if (!SSD) { v0 *= bf_lo(gv[j2][g].x); v1 *= bf_hi(gv[j2][g].x); v2 *= bf_lo(gv[j2][g].y); v3 *= bf_hi(gv[j2][g].y); }
                *(LAS u32x2*)(lds + gB + 32 * j2 * RSG + 16 * g) = (u32x2){cvt_pk_bf16(v0, v1), cvt_pk_bf16(v2, v3)};
            }
        }
        LBAR();
#pragma unroll
        for (int i = 0; i < 4; ++i) {
            const u32x2 o0 = *(const LAS u32x2*)(lds + OFF_GT + (brow0 + 16 * i) * RSG + bpc * 16), o1 = *(const LAS u32x2*)(lds + OFF_GT + (brow0 + 16 * i) * RSG + bpc * 16 + 8);
            *(u32x4*)(a.out + ((size_t)c * 64 + brow0 + 16 * i) * a.ld_o + bpc * 8) = (u32x4){o0.x, o0.y, o1.x, o1.y};
        }
        if (c + 1 < NCH) MIX_STORE();
        LBAR();
    }
#undef MIX_LOAD
#undef MIX_STORE
}

__device__ __forceinline__ void p5_mixer(KP Pp, LAS unsigned char* lds, int G) {
    const Params P = load_params(Pp);
    unsigned char* ws = P.ws; unsigned char* T = ws + WS_BIG;
    for (int it = blockIdx.x; it < HB * 12; it += G) {
        const int b = it / 12, k = it % 12;
        const size_t row0 = (size_t)b * SEQ;
        MixArgs a;
        if (k < 4) {
            const int hd = k;
            a.ak = (const bf16_t*)(T + T_K) + row0 * 512 + hd * 128; a.ld_ak = 512;
            a.qq = (const bf16_t*)(T + T_Q) + row0 * 512 + hd * 128; a.ld_q = 512;
            a.bv = (const bf16_t*)(T + T_V) + row0 * 1024 + hd * 256; a.ld_bv = 1024;
            a.gt = (const bf16_t*)(T + T_SG) + row0 * 1024 + hd * 256; a.ld_g = 1024;
            a.out = (bf16_t*)(T + T_V) + row0 * 1024 + hd * 256; a.ld_o = 1024;
            a.dec = (const float*)(ws + WS_DEC) + (size_t)b * NCH * 512 + hd * 128;
            a.wg = nullptr; a.nw = P.in[9]; a.dsk = nullptr;
            mixer_item<false>(lds, a);
        } else {
            const int g = k - 4;
            const bf16_t* X = (const bf16_t*)(T + T_XBC) + row0 * 4096;
            a.ak = X + 2048 + g * 128; a.ld_ak = 4096;
            a.qq = X + 3072 + g * 128; a.ld_q = 4096;
            a.bv = X + g * 256; a.ld_bv = 4096;
            a.gt = (const bf16_t*)(T + T_SZ) + row0 * 2048 + g * 256; a.ld_g = 2048;
            a.out = (bf16_t*)(T + T_XBC) + row0 * 4096 + g * 256; a.ld_o = 4096;
            a.dec = (const float*)(ws + WS_DECS) + (size_t)b * NCH * 32 + g * 4;
            a.wg = (const float*)(ws + WS_WG) + row0 * 32 + g * 4;
            a.nw = P.in[16] + g * 256; a.dsk = P.in[15] + g * 4;
            mixer_item<true>(lds, a);
        }
        __syncthreads();
    }
}

__device__ __forceinline__ KP get_params() {
    KP p = (KP)__builtin_amdgcn_kernarg_segment_ptr(); asm volatile("" : "+s"(p)); return p;
}

#define XB_TMO      128
#define XB_XCNT(j)  (256  + 64 * (j))
#define XB_XSUB(j)  (1280 + 64 * (j))
#define XB_XGEN(j)  (2304 + 64 * (j))
#define XB_TOP      3328
#define XB_TOPGEN   3392
#define XCD_BAR_WORDS 3456
#define XB_SPIN_CAP (1u << 18)
__device__ __forceinline__ unsigned xb_ld(unsigned* p)              { return __hip_atomic_load(p, __ATOMIC_RELAXED, __HIP_MEMORY_SCOPE_AGENT); }
__device__ __forceinline__ unsigned xb_add(unsigned* p, unsigned v) { return __hip_atomic_fetch_add(p, v, __ATOMIC_RELAXED, __HIP_MEMORY_SCOPE_AGENT); }
__device__ __forceinline__ unsigned xb_xcc_id() { return (unsigned)__builtin_amdgcn_s_getreg((3 << 11) | 20) & 0xFu; }
#define XB_SPIN(cond, bar) do { unsigned _sp = 0; while (cond) { __builtin_amdgcn_s_sleep(1); \
    if ((++_sp & 255u) == 0u) { if (xb_ld(&(bar)[XB_TMO])) break; if (_sp > XB_SPIN_CAP) { atomicAdd(&(bar)[XB_TMO], 1u); break; } } } } while (0)
struct XcdBarrier { unsigned* bar; unsigned x; volatile LAS unsigned* st; };
__device__ __forceinline__ XcdBarrier xcd_barrier_post(unsigned* bar, volatile LAS unsigned* st) {
    XcdBarrier b; b.bar = bar; b.x = xb_xcc_id(); b.st = st;
    if (threadIdx.x == 0) (void)xb_add(&bar[XB_XCNT(b.x)], 1u);
    return b;
}
__device__ __forceinline__ void xcd_barrier_complete(unsigned* bar, unsigned x, unsigned& nloc, unsigned& nx) {
    const unsigned G = gridDim.x * gridDim.y * gridDim.z;
    unsigned sum, cnt, mine, sp = 0u;
    for (;;) {
        sum = 0u; cnt = 0u; mine = 0u;
#pragma unroll
        for (unsigned j = 0; j < 16; ++j) { const unsigned c = xb_ld(&bar[XB_XCNT(j)]); sum += c; cnt += (c > 0u) ? 1u : 0u; mine = (j == x) ? c : mine; }
        if (sum == G) break;
        __builtin_amdgcn_s_sleep(1);
        if ((++sp & 255u) == 0u) { if (xb_ld(&bar[XB_TMO])) break; if (sp > XB_SPIN_CAP) { atomicAdd(&bar[XB_TMO], 1u); break; } }
    }
    nloc = mine > 0u ? mine : 1u; nx = cnt > 0u ? cnt : 1u;
}
__device__ __forceinline__ void xcd_barrier(const XcdBarrier& b) {
    asm volatile("s_waitcnt vmcnt(0)" ::: "memory");
    __syncthreads();
    if (threadIdx.x == 0) {
        unsigned* bar = b.bar;
        __builtin_amdgcn_s_waitcnt(0);
        unsigned nloc = b.st[0], nx = b.st[1];
        if (nloc == 0u) { xcd_barrier_complete(bar, b.x, nloc, nx); b.st[0] = nloc; b.st[1] = nx; }
        const unsigned old = xb_add(&bar[XB_XSUB(b.x)], 1u);
        const unsigned gen = old / nloc;
        if (old + 1u == (gen + 1u) * nloc) {
            __builtin_amdgcn_fence(__ATOMIC_RELEASE, "agent");
            asm volatile("s_waitcnt vmcnt(0)" ::: "memory");
            const unsigned og = xb_add(&bar[XB_TOP], 1u);
            const unsigned tg = og / nx;
            if (og + 1u == (tg + 1u) * nx) xb_add(&bar[XB_TOPGEN], 1u);
            else XB_SPIN(xb_ld(&bar[XB_TOPGEN]) == tg, bar);
            __builtin_amdgcn_fence(__ATOMIC_ACQUIRE, "agent");
            xb_add(&bar[XB_XGEN(b.x)], 1u);
            asm volatile("s_waitcnt vmcnt(0)" ::: "memory");
        } else {
            XB_SPIN(xb_ld(&bar[XB_XGEN(b.x)]) == gen, bar);
            __builtin_amdgcn_fence(__ATOMIC_ACQUIRE, "agent");
            asm volatile("s_waitcnt vmcnt(0)" ::: "memory");
        }
    }
    __syncthreads();
}

#define PROBE_MASK 0x0
#define PROBE_DSYNC 0
#if PROBE_MASK
#define PH_BEGIN(i) const unsigned long long _t##i = __builtin_amdgcn_s_memrealtime();
#define PH_END(i) if ((PROBE_MASK >> (i)) & 1) probe_acc += __builtin_amdgcn_s_memrealtime() - _t##i;
#else
#define PH_BEGIN(i)
#define PH_END(i)
#endif
#define XBAR_NOW() XcdBarrier{(unsigned*)(get_params()->ws + WS_BAR), xb_xcc_id(), (volatile LAS unsigned*)(lds + LDS_XB)}
#if PROBE_DSYNC
#define GSYNC() do { xcd_barrier(XBAR_NOW()); xcd_barrier(XBAR_NOW()); } while (0)
#else
#define GSYNC() xcd_barrier(XBAR_NOW())
#endif
__global__ void __launch_bounds__(512, 2) fwd_megakernel(Params Parg) {
    extern __shared__ __attribute__((aligned(16))) unsigned char lds_raw[];
    LAS unsigned char* lds = (LAS unsigned char*)lds_raw;
    cg::grid_group grid = cg::this_grid();
    const int G = gridDim.x;
    pg8::StaticOrder S;
#if PROBE_MASK
    unsigned long long probe_acc = 0;
#endif

    { unsigned* bw = (unsigned*)(get_params()->ws + WS_BAR);
      if (blockIdx.x == 0) for (int i = threadIdx.x; i < XCD_BAR_WORDS; i += 512) bw[i] = 0u;
      if (threadIdx.x < 2) *(volatile LAS unsigned*)(lds + LDS_XB + threadIdx.x * 4) = 0u; }
    { PH_BEGIN(0) p0_prologue(get_params(), lds, G);
    grid.sync();
    (void)xcd_barrier_post((unsigned*)(get_params()->ws + WS_BAR), (volatile LAS unsigned*)(lds + LDS_XB));
    PH_END(0) }
    { PH_BEGIN(1) { KP P = get_params(); unsigned char* ws = P->ws;
      pg8::Gemm g{(const bf16_t*)(ws + WS_XB), (const bf16_t*)(ws + WS_WGU1), MTOK, NGU, D, D, D, (const float*)(ws + WS_SSQ)}; S.init(MTOK, NGU, G, blockIdx.x);
      EpiGU E{(const float*)(ws + WS_SSQ), (bf16_t*)(ws + WS_BIG)}; pg8::gemm_phase(lds, g, S, E); }
    GSYNC(); PH_END(1) }
    { PH_BEGIN(2) { KP P = get_params(); unsigned char* ws = P->ws;
      pg8::Gemm g{(const bf16_t*)(ws + WS_BIG), (const bf16_t*)(ws + WS_WD1), MTOK, D, DFF, DFF, DFF, nullptr}; S.init(MTOK, D, G, blockIdx.x);
      EpiRes E{(bf16_t*)(ws + WS_XB), (float*)(ws + WS_SSQ) + MTOK, 0.5f}; pg8::gemm_phase(lds, g, S, E); }
    GSYNC(); PH_END(2) }
    for (int hf = 0; hf < 2; ++hf) {
        const size_t r0 = (size_t)hf * MH;
        { PH_BEGIN(3) { KP P = get_params(); unsigned char* ws = P->ws;
          pg8::Gemm g{(const bf16_t*)(ws + WS_XB) + r0 * D, (const bf16_t*)(ws + WS_WIN), MH, NIN, D, D, D, (const float*)(ws + WS_SSQ) + MTOK + r0}; S.init(MH, NIN, G, blockIdx.x);
          EpiIn E{(const float*)(ws + WS_SSQ) + MTOK + r0, ws + WS_BIG, (bf16_t*)(ws + WS_HALO), (float*)(ws + WS_SM)}; pg8::gemm_phase(lds, g, S, E); }
        GSYNC(); PH_END(3) }
        { PH_BEGIN(4) p4_prep(get_params(), lds, G);
        GSYNC(); PH_END(4) }
        { PH_BEGIN(5) p5_mixer(get_params(), lds, G);
        GSYNC(); PH_END(5) }
        { PH_BEGIN(6) { KP P = get_params(); unsigned char* ws = P->ws; unsigned char* T = ws + WS_BIG;
          pg8::Gemm g{(const bf16_t*)(T + T_V), (const bf16_t*)(ws + WS_WGO), MH, D, D, D, D, nullptr}; S.init(MH, D, G, blockIdx.x);
          EpiGate E{(const bf16_t*)(T + T_GT), nullptr, (bf16_t*)(T + T_T1), 0}; pg8::gemm_phase(lds, g, S, E); }
        { KP P = get_params(); unsigned char* ws = P->ws; unsigned char* T = ws + WS_BIG;
          pg8::Gemm g{(const bf16_t*)(T + T_XBC), (const bf16_t*)(ws + WS_WSO), MH, D, 2048, 4096, 2048, nullptr}; S.init(MH, D, G, blockIdx.x);
          EpiGate E{(const bf16_t*)(T + T_GT), (const bf16_t*)(T + T_T1), (bf16_t*)(T + T_MRG), 1}; pg8::gemm_phase(lds, g, S, E); }
        GSYNC(); PH_END(6) }
        { PH_BEGIN(7) { KP P = get_params(); unsigned char* ws = P->ws;
          pg8::Gemm g{(const bf16_t*)(ws + WS_BIG + T_MRG), (const bf16_t*)(ws + WS_WOUT), MH, D, D, D, D, nullptr}; S.init(MH, D, G, blockIdx.x);
          EpiRes E{(bf16_t*)(ws + WS_XB) + r0 * D, (float*)(ws + WS_SSQ) + 2 * MTOK + r0, 1.0f}; pg8::gemm_phase(lds, g, S, E); }
        GSYNC(); PH_END(7) }
    }
    { PH_BEGIN(8) { KP P = get_params(); unsigned char* ws = P->ws;
      pg8::Gemm g{(const bf16_t*)(ws + WS_XB), (const bf16_t*)(ws + WS_WGU2), MTOK, NGU, D, D, D, (const float*)(ws + WS_SSQ) + 2 * MTOK}; S.init(MTOK, NGU, G, blockIdx.x);
      EpiGU E{(const float*)(ws + WS_SSQ) + 2 * MTOK, (bf16_t*)(ws + WS_BIG)}; pg8::gemm_phase(lds, g, S, E); }
    GSYNC(); PH_END(8) }
    { PH_BEGIN(9) { KP P = get_params(); unsigned char* ws = P->ws;
      pg8::Gemm g{(const bf16_t*)(ws + WS_BIG), (const bf16_t*)(ws + WS_WD2), MTOK, D, DFF, DFF, DFF, nullptr}; S.init(MTOK, D, G, blockIdx.x);
      EpiRes E{(bf16_t*)(ws + WS_XB), (float*)(ws + WS_SSQ) + 3 * MTOK, 0.5f}; pg8::gemm_phase(lds, g, S, E); }
    GSYNC(); PH_END(9) }
    { PH_BEGIN(10)
    {
        KP P = get_params(); const float* ssq = (const float*)(P->ws + WS_SSQ) + 3 * MTOK;
        const int tid = tid_fresh(), lane = tid & 63, gw = blockIdx.x * 8 + (tid >> 6), NGW = G * 8;
        const float* fw = P->in[23]; float* outp = P->out; const bf16_t* xb = (const bf16_t*)(P->ws + WS_XB);
        f32x4 wv[4];
#pragma unroll
        for (int jj = 0; jj < 4; ++jj) wv[jj] = ((const f32x4*)fw)[lane + 64 * jj];
        for (int m = gw; m < MTOK; m += NGW) {
            const float rstd = rsqrtf(ssq[m] * (1.f / D) + EPS);
            const u32x2* xr = (const u32x2*)(xb + (size_t)m * D) + lane;
            f32x4* orow = (f32x4*)(outp + (size_t)m * D) + lane;
#pragma unroll
            for (int jj = 0; jj < 4; ++jj) { const u32x2 q = xr[64 * jj]; f32x4 v;
                v.x = bf_lo(q.x) * rstd * wv[jj].x; v.y = bf_hi(q.x) * rstd * wv[jj].y; v.z = bf_lo(q.y) * rstd * wv[jj].z; v.w = bf_hi(q.y) * rstd * wv[jj].w; orow[64 * jj] = v; }
        }
    }
    PH_END(10) }
#if PROBE_MASK
    if (blockIdx.x == 0) {
        const unsigned long long t0 = __builtin_amdgcn_s_memrealtime();
        while (__builtin_amdgcn_s_memrealtime() - t0 < probe_acc) __builtin_amdgcn_s_sleep(8);
    }
#endif
}

extern "C" void kernel_launch(void* const* d_in, const int* in_sizes, int n_in, void* d_out, int out_size, void* d_ws, size_t ws_size, hipStream_t stream) {
    static int grid = 0;
    if (grid == 0) {
        if (n_in != 24 || ws_size < WS_NEED) { fprintf(stderr, "kernel_launch: unexpected n_in %d or ws_size %zu (need %zu)\n", n_in, ws_size, (size_t)WS_NEED); grid = -1; return; }
        int dev = 0, cus = 0, per_cu = 0;
        hipGetDevice(&dev);
        hipDeviceGetAttribute(&cus, hipDeviceAttributeMultiprocessorCount, dev);
        hipFuncSetAttribute((const void*)fwd_megakernel, hipFuncAttributeMaxDynamicSharedMemorySize, LDS_BYTES);
        hipOccupancyMaxActiveBlocksPerMultiprocessor(&per_cu, (const void*)fwd_megakernel, 512, LDS_BYTES);
        if (per_cu < 1) { fprintf(stderr, "kernel_launch: occupancy query gave %d\n", per_cu); per_cu = 1; }
        grid = cus * per_cu;
        (void)hipGetLastError();
    }
    if (grid < 0) return;
    Params p{};
    for (int i = 0; i < 24; ++i) p.in[i] = (const float*)d_in[i];
    p.out = (float*)d_out; p.ws = (unsigned char*)d_ws;
    void* args[] = {&p};
    hipError_t e = hipLaunchCooperativeKernel((const void*)fwd_megakernel, dim3(grid), dim3(512), args, LDS_BYTES, stream);
    if (e != hipSuccess) fprintf(stderr, "cooperative launch failed: %s (grid %d)\n", hipGetErrorString(e), grid);
}
```

```cpp
#include <hip/hip_runtime.h>
#include <hip/hip_cooperative_groups.h>
#include <cstdio>
#include <cstdint>
namespace cg = cooperative_groups;

#define LAS __attribute__((address_space(3)))
typedef unsigned short bf16_t;
typedef short bf16x8 __attribute__((ext_vector_type(8)));
typedef short s16x4 __attribute__((ext_vector_type(4)));
typedef float f32x4 __attribute__((ext_vector_type(4)));
typedef float f32x16 __attribute__((ext_vector_type(16)));
typedef unsigned u32x4 __attribute__((ext_vector_type(4)));
typedef unsigned u32x2 __attribute__((ext_vector_type(2)));

constexpr int D = 1024, BATCH = 32, SEQ = 2048, MTOK = BATCH * SEQ;
constexpr int NCH = SEQ / 64;
constexpr int DFF = 2816, NGU = 2 * DFF;
constexpr int IN_DIM = 11312, NIN = 45 * 256;
constexpr int HB = 16, MH = HB * SEQ;
constexpr float EPS = 1e-6f;

constexpr size_t MiB = 1u << 20;
constexpr size_t WS_SSQ = 0;
constexpr size_t WS_WGU1 = 1 * MiB, WS_WD1 = 12 * MiB, WS_WIN = 18 * MiB, WS_WGO = 41 * MiB, WS_WSO = 43 * MiB, WS_WOUT = 47 * MiB, WS_WGU2 = 49 * MiB, WS_WD2 = 60 * MiB;
constexpr size_t WS_DEC = 66 * MiB, WS_DECS = 67 * MiB, WS_WG = 68 * MiB, WS_HALO = 72 * MiB, WS_SM = 84 * MiB;
constexpr size_t WS_BAR = 92 * MiB;
constexpr size_t WS_XB = 96 * MiB;
constexpr size_t WS_BIG = 224 * MiB;
constexpr size_t T_Q = 0, T_K = 32 * MiB, T_V = 64 * MiB, T_SG = 128 * MiB, T_SZ = 192 * MiB, T_XBC = 320 * MiB, T_GT = 576 * MiB, T_END = 704 * MiB;
constexpr size_t T_T1 = T_Q, T_MRG = T_SG;
constexpr size_t WS_NEED = WS_BIG + T_END;

constexpr int LDS_MAIN = 131072, LDS_XB = 149504, LDS_BYTES = LDS_XB + 64;

__device__ __forceinline__ unsigned cvt_pk_bf16(float lo, float hi) { unsigned r; asm volatile("v_cvt_pk_bf16_f32 %0, %1, %2" : "=v"(r) : "v"(lo), "v"(hi)); return r; }
__device__ __forceinline__ float bf_lo(unsigned u) { return __uint_as_float(u << 16); }
__device__ __forceinline__ float bf_hi(unsigned u) { return __uint_as_float(u & 0xffff0000u); }
__device__ __forceinline__ float fast_rcp(float x) { return __builtin_amdgcn_rcpf(x); }
__device__ __forceinline__ float sigmoidf_(float x) { return fast_rcp(1.f + __expf(-x)); }
__device__ __forceinline__ float siluf_(float x) { return x * sigmoidf_(x); }
__device__ __forceinline__ float softplusf_(float x) { return fmaxf(x, 0.f) + __logf(1.f + __expf(-fabsf(x))); }
__device__ __forceinline__ float wave_sum(float v) {
#pragma unroll
    for (int o = 1; o < 64; o <<= 1) v += __shfl_xor(v, o);
    return v;
}

namespace pg8 {
constexpr int BM = 256, BK = 64, HALF = 128, HTB = HALF * BK * 2, STAGE_BYTES = 8 * HTB, NXCD = 8, WGM = 8, ROWV_OFF = STAGE_BYTES;
__host__ __device__ __forceinline__ int lds_byte(int r, int c) { const int st = (r >> 4) * 2 + (c >> 5), rr = r & 15, cc = c & 31, ob = rr * 64 + cc * 2; return st * 1024 + (ob ^ (((ob >> 9) & 1) << 5)); }
__host__ __device__ __forceinline__ void stage_rc(int b, int& R, int& C) { const int st = b / 1024, sb = b % 1024, swz = sb ^ (((sb >> 9) & 1) << 5); R = (st >> 1) * 16 + swz / 64; C = (st & 1) * 32 + (swz % 64) / 2; }
__host__ __device__ __forceinline__ int perm32(int rho) { const int n = rho >> 4, i = rho & 15; return 8 * (i >> 2) + 4 * n + (i & 3); }

struct Unit { int pm, pn; };
struct Gemm { const bf16_t* A; const bf16_t* Bt; int M, N, K, lda, ldb; const float* rowvec; };

struct StaticOrder {
    int nM, nN, nwg, G, c;
    __device__ void init(int M, int N, int G_, int c_) { nM = M / BM; nN = N / BM; nwg = nM * nN; G = G_; c = c_; }
    __device__ bool next(int i, Unit& u) const {
        const long L = (long)i * G + c; if (L >= nwg) return false;
        int wgid = (int)L; { const int q = nwg / NXCD, r = nwg % NXCD, xcd = wgid % NXCD, off = wgid / NXCD; wgid = (xcd < r ? xcd * (q + 1) : r * (q + 1) + (xcd - r) * q) + off; }
        const int nig = WGM * nN, gid = wgid / nig, fm = gid * WGM, gsz = (nM - fm) < WGM ? (nM - fm) : WGM;
        u.pm = fm + ((wgid % nig) % gsz); u.pn = (wgid % nig) / gsz; return true;
    }
};

template <class Epi, bool ALIGN_EPI = true, bool SP2 = true>
__device__ __forceinline__ void gemm_phase(LAS unsigned char* lds, const Gemm g, const StaticOrder& S, const Epi& E) {
    int tid = threadIdx.x; asm volatile("" : "+v"(tid));
    const int wid = __builtin_amdgcn_readfirstlane(tid >> 6), lane = tid & 63, wr = wid >> 2, wc = wid & 3, fr = lane & 15, fq = lane >> 4;
    const int K = g.K, nt = K / BK;
    unsigned voffA[2], voffB[2];
#pragma unroll
    for (int i = 0; i < 2; ++i) { int R, C; stage_rc(tid * 16 + i * 8192, R, C); const int Rb = (R & ~31) + perm32(R & 31);
        voffA[i] = (unsigned)(R * g.lda + C) * 2u; voffB[i] = (unsigned)(Rb * g.ldb + C) * 2u; }
    const size_t kstep = (size_t)(BK * 2);
    const size_t hstA = (size_t)HALF * g.lda * 2, hstB = (size_t)HALF * g.ldb * 2;
    const size_t tstA = 2 * hstA, tstB = 2 * hstB;
    const unsigned ldsw = (unsigned)wid * 1024u;
    const int aoff = lds_byte(wr * 64 + fr, fq * 8), boff = lds_byte(wc * 32 + fr, fq * 8);
#define PG8_SA(b, h) (((b) * 2 + (h)) * HTB)
#define PG8_SB(b, h) ((4 + (b) * 2 + (h)) * HTB)
#define PG8_STAGE(bufoff, gbase, voff) do { _Pragma("unroll") for (int _i = 0; _i < 2; ++_i) \
        __builtin_amdgcn_global_load_lds((const unsigned*)((const char*)(gbase) + (voff)[_i]), (LAS unsigned*)(lds + (bufoff) + ldsw + _i * 8192), 16, 0, 0); } while (0)
#define PG8_LDA(dst, b, h) do { _Pragma("unroll") for (int m = 0; m < 4; ++m) _Pragma("unroll") for (int k = 0; k < 2; ++k) dst[m][k] = *(const LAS bf16x8*)(lds + PG8_SA(b, h) + aoff + m * 2048 + k * 1024); } while (0)
#define PG8_LDB(dst, b, h) do { _Pragma("unroll") for (int n = 0; n < 2; ++n) _Pragma("unroll") for (int k = 0; k < 2; ++k) dst[n][k] = *(const LAS bf16x8*)(lds + PG8_SB(b, h) + boff + n * 2048 + k * 1024); } while (0)
#define PG8_MMA(ai, bj, At, Bt) do { __builtin_amdgcn_s_setprio(1); _Pragma("unroll") for (int m = 0; m < 4; ++m) _Pragma("unroll") for (int n = 0; n < 2; ++n) _Pragma("unroll") for (int k = 0; k < 2; ++k) \
        acc[ai][bj][m][n] = __builtin_amdgcn_mfma_f32_16x16x32_bf16(Bt[n][k], At[m][k], acc[ai][bj][m][n], 0, 0, 0); __builtin_amdgcn_s_setprio(0); } while (0)
#define PG8_WAIT_V(n) asm volatile("s_waitcnt vmcnt(" #n ")" ::: "memory")
#define PG8_WAIT_L(n) asm volatile("s_waitcnt lgkmcnt(" #n ")" ::: "memory")
#define PG8_BAR __builtin_amdgcn_s_barrier()
#define PG8_SCHED __builtin_amdgcn_sched_barrier(0)
    Unit cur, nxt; int ui = 0;
    if (!S.next(0, cur)) return;
    f32x4 acc[2][2][4][2];
#pragma unroll
    for (int a = 0; a < 2; ++a)
#pragma unroll
        for (int b = 0; b < 2; ++b)
#pragma unroll
            for (int m = 0; m < 4; ++m)
#pragma unroll
                for (int n = 0; n < 2; ++n) acc[a][b][m][n] = (f32x4){0.f, 0.f, 0.f, 0.f};
    bf16x8 At[4][2], B0[2][2], B1[2][2];
    const char* cA = (const char*)g.A + (size_t)cur.pm * tstA; const char* cB = (const char*)g.Bt + (size_t)cur.pn * tstB;
    if constexpr (SP2) {
        PG8_STAGE(PG8_SB(0, 0), cB, voffB); PG8_STAGE(PG8_SB(0, 1), cB + hstB, voffB); PG8_STAGE(PG8_SA(0, 0), cA, voffA); PG8_STAGE(PG8_SA(0, 1), cA + hstA, voffA);
        if (wr == 1) PG8_BAR;
        PG8_WAIT_V(2); PG8_BAR;
        PG8_STAGE(PG8_SB(1, 0), cB + kstep, voffB); PG8_STAGE(PG8_SA(1, 0), cA + kstep, voffA); PG8_STAGE(PG8_SB(1, 1), cB + hstB + kstep, voffB);
        PG8_WAIT_V(6); PG8_BAR;
    } else {
    PG8_STAGE(PG8_SB(0, 0), cB, voffB); PG8_STAGE(PG8_SA(0, 0), cA, voffA); PG8_STAGE(PG8_SB(0, 1), cB + hstB, voffB); PG8_STAGE(PG8_SA(0, 1), cA + hstA, voffA);
    if (wr == 1) PG8_BAR;
    PG8_WAIT_V(4); PG8_BAR;
    PG8_STAGE(PG8_SB(1, 0), cB + kstep, voffB); PG8_STAGE(PG8_SA(1, 0), cA + kstep, voffA); PG8_STAGE(PG8_SB(1, 1), cB + hstB + kstep, voffB);
    PG8_WAIT_V(6); PG8_BAR;
    }
    for (;;) {
        const bool has_next = S.next(ui + 1, nxt);
        const char* nA = has_next ? (const char*)g.A + (size_t)nxt.pm * tstA : cA; const char* nB = has_next ? (const char*)g.Bt + (size_t)nxt.pn * tstB : cB;
        if (g.rowvec && wid == 0)
            __builtin_amdgcn_global_load_lds((const unsigned*)(g.rowvec + cur.pm * BM + lane * 4), (LAS unsigned*)(lds + ROWV_OFF + (ui & 1) * 1024), 16, 0, 0);
        for (int t = 0; t < nt; t += 2) {
            const bool last = (t == nt - 2);
            const char* a1 = cA + (size_t)(t + 1) * kstep;
            const char* a2 = last ? nA : cA + (size_t)(t + 2) * kstep; const char* b2 = last ? nB : cB + (size_t)(t + 2) * kstep;
            const char* a3 = a2 + kstep; const char* b3 = b2 + kstep;
            if constexpr (SP2) {
            PG8_LDB(B0, 0, 0); PG8_LDB(B1, 0, 1); PG8_SCHED; PG8_LDA(At, 0, 0); PG8_STAGE(PG8_SA(1, 1), a1 + hstA, voffA);
            PG8_WAIT_V(8); PG8_WAIT_L(0); PG8_BAR; PG8_MMA(0, 0, At, B0); PG8_MMA(0, 1, At, B1); PG8_BAR; PG8_SCHED;
            PG8_LDA(At, 0, 1); PG8_STAGE(PG8_SB(0, 0), b2, voffB); PG8_STAGE(PG8_SB(0, 1), b2 + hstB, voffB); PG8_STAGE(PG8_SA(0, 0), a2, voffA);
            PG8_WAIT_V(8); PG8_WAIT_L(0); PG8_BAR; PG8_MMA(1, 0, At, B0); PG8_MMA(1, 1, At, B1); PG8_BAR; PG8_SCHED;
            PG8_LDB(B0, 1, 0); PG8_LDB(B1, 1, 1); PG8_SCHED; PG8_LDA(At, 1, 0); PG8_STAGE(PG8_SA(0, 1), a2 + hstA, voffA);
            PG8_WAIT_V(8); PG8_WAIT_L(0); PG8_BAR; PG8_MMA(0, 0, At, B0); PG8_MMA(0, 1, At, B1); PG8_BAR; PG8_SCHED;
            PG8_LDA(At, 1, 1); PG8_STAGE(PG8_SB(1, 0), b3, voffB); PG8_STAGE(PG8_SB(1, 1), b3 + hstB, voffB); PG8_STAGE(PG8_SA(1, 0), a3, voffA);
            PG8_WAIT_V(8); PG8_WAIT_L(0); PG8_BAR; PG8_MMA(1, 0, At, B0); PG8_MMA(1, 1, At, B1); PG8_BAR; PG8_SCHED;
            } else {
            PG8_LDB(B0, 0, 0); PG8_SCHED; PG8_LDA(At, 0, 0); PG8_STAGE(PG8_SA(1, 1), a1 + hstA, voffA);
            PG8_WAIT_L(8); PG8_BAR; PG8_WAIT_L(0); PG8_MMA(0, 0, At, B0); PG8_BAR; PG8_SCHED;
            PG8_LDB(B1, 0, 1); PG8_STAGE(PG8_SB(0, 0), b2, voffB);
            PG8_BAR; PG8_WAIT_L(0); PG8_MMA(0, 1, At, B1); PG8_BAR;
            PG8_LDA(At, 0, 1); PG8_STAGE(PG8_SA(0, 0), a2, voffA);
            PG8_BAR; PG8_WAIT_L(0); PG8_MMA(1, 0, At, B0); PG8_BAR; PG8_SCHED;
            PG8_STAGE(PG8_SB(0, 1), b2 + hstB, voffB);
            PG8_WAIT_V(6); PG8_BAR; PG8_MMA(1, 1, At, B1); PG8_BAR;
            PG8_LDB(B0, 1, 0); PG8_SCHED; PG8_LDA(At, 1, 0); PG8_STAGE(PG8_SA(0, 1), a2 + hstA, voffA);
            PG8_WAIT_L(8); PG8_BAR; PG8_WAIT_L(0); PG8_MMA(0, 0, At, B0); PG8_BAR; PG8_SCHED;
            PG8_LDB(B1, 1, 1); PG8_STAGE(PG8_SB(1, 0), b3, voffB);
            PG8_BAR; PG8_WAIT_L(0); PG8_MMA(0, 1, At, B1); PG8_BAR;
            PG8_LDA(At, 1, 1); PG8_STAGE(PG8_SA(1, 0), a3, voffA);
            PG8_BAR; PG8_WAIT_L(0); PG8_MMA(1, 0, At, B0); PG8_BAR; PG8_SCHED;
            PG8_STAGE(PG8_SB(1, 1), b3 + hstB, voffB);
            PG8_WAIT_V(6); PG8_BAR; PG8_MMA(1, 1, At, B1); PG8_BAR;
            }
        }
        if constexpr (ALIGN_EPI) { if (wr == 0) PG8_BAR; }
        E(acc, cur, wr, wc, fr, fq, (const LAS float*)(lds + ROWV_OFF + (ui & 1) * 1024));
        if (!has_next) break;
#pragma unroll
        for (int a = 0; a < 2; ++a)
#pragma unroll
            for (int b = 0; b < 2; ++b)
#pragma unroll
                for (int m = 0; m < 4; ++m)
#pragma unroll
                    for (int n = 0; n < 2; ++n) acc[a][b][m][n] = (f32x4){0.f, 0.f, 0.f, 0.f};
        cur = nxt; cA = nA; cB = nB; ++ui;
        if constexpr (ALIGN_EPI) { if (wr == 1) PG8_BAR; }
    }
    PG8_WAIT_V(0);
    if constexpr (!ALIGN_EPI) { if (wr == 0) PG8_BAR; }
    PG8_BAR;
#undef PG8_SA
#undef PG8_SB
#undef PG8_STAGE
#undef PG8_LDA
#undef PG8_LDB
#undef PG8_MMA
#undef PG8_WAIT_V
#undef PG8_WAIT_L
#undef PG8_BAR
#undef PG8_SCHED
}
}

typedef f32x4 AccT[2][2][4][2];

struct EpiGU {
    const float* ssq; bf16_t* O;
    __device__ __forceinline__ void operator()(const AccT& acc, const pg8::Unit& u, int wr, int wc, int fr, int fq, const LAS float* rowv) const {
        const int row0 = u.pm * 256 + wr * 64 + fr, col0 = u.pn * 128 + wc * 32 + 8 * fq;
        float rs[2][4];
#pragma unroll
        for (int ai = 0; ai < 2; ++ai)
#pragma unroll
            for (int m = 0; m < 4; ++m) rs[ai][m] = rowv[wr * 64 + fr + ai * 128 + m * 16];
#pragma unroll
        for (int ai = 0; ai < 2; ++ai)
#pragma unroll
            for (int m = 0; m < 4; ++m) {
                const int row = row0 + ai * 128 + m * 16;
                const float rstd = rsqrtf(rs[ai][m] * (1.f / D) + EPS);
                float v[8];
#pragma unroll
                for (int n = 0; n < 2; ++n)
#pragma unroll
                    for (int j = 0; j < 4; ++j) { const float gg = acc[ai][0][m][n][j] * rstd, uu = acc[ai][1][m][n][j] * rstd; v[4 * n + j] = siluf_(gg) * uu; }
                u32x4 w; w.x = cvt_pk_bf16(v[0], v[1]); w.y = cvt_pk_bf16(v[2], v[3]); w.z = cvt_pk_bf16(v[4], v[5]); w.w = cvt_pk_bf16(v[6], v[7]);
                *(u32x4*)(O + (size_t)row * DFF + col0) = w;
            }
    }
};
struct EpiRes {
    bf16_t* xb; float* ssq; float alpha;
    __device__ __forceinline__ void operator()(const AccT& acc, const pg8::Unit& u, int wr, int wc, int fr, int fq, const LAS float* rowv) const {
        const int row0 = u.pm * 256 + wr * 64 + fr, col0 = u.pn * 256 + wc * 32 + 8 * fq;
        u32x4 xv[2][4][2];
#pragma unroll
        for (int ai = 0; ai < 2; ++ai)
#pragma unroll
            for (int m = 0; m < 4; ++m)
#pragma unroll
                for (int bj = 0; bj < 2; ++bj) xv[ai][m][bj] = *(const u32x4*)(xb + (size_t)(row0 + ai * 128 + m * 16) * D + col0 + bj * 128);
        __builtin_amdgcn_sched_barrier(0);
#pragma unroll
        for (int ai = 0; ai < 2; ++ai)
#pragma unroll
            for (int m = 0; m < 4; ++m) {
                const int row = row0 + ai * 128 + m * 16;
                float s = 0.f;
#pragma unroll
                for (int bj = 0; bj < 2; ++bj) {
                    const u32x4 q = xv[ai][m][bj];
                    float y[8];
                    y[0] = bf_lo(q.x) + acc[ai][bj][m][0].x * alpha; y[1] = bf_hi(q.x) + acc[ai][bj][m][0].y * alpha; y[2] = bf_lo(q.y) + acc[ai][bj][m][0].z * alpha; y[3] = bf_hi(q.y) + acc[ai][bj][m][0].w * alpha;
                    y[4] = bf_lo(q.z) + acc[ai][bj][m][1].x * alpha; y[5] = bf_hi(q.z) + acc[ai][bj][m][1].y * alpha; y[6] = bf_lo(q.w) + acc[ai][bj][m][1].z * alpha; y[7] = bf_hi(q.w) + acc[ai][bj][m][1].w * alpha;
#pragma unroll
                    for (int e = 0; e < 8; ++e) s += y[e] * y[e];
                    u32x4 w; w.x = cvt_pk_bf16(y[0], y[1]); w.y = cvt_pk_bf16(y[2], y[3]); w.z = cvt_pk_bf16(y[4], y[5]); w.w = cvt_pk_bf16(y[6], y[7]);
                    *(u32x4*)(xb + (size_t)row * D + col0 + bj * 128) = w;
                }
                s += __shfl_xor(s, 16); s += __shfl_xor(s, 32);
                if (fq == 0) atomicAdd(ssq + row, s);
            }
    }
};
struct EpiIn {
    const float* ssq; unsigned char* T; bf16_t* halo; float* sm;
    __device__ __forceinline__ void operator()(const AccT& acc, const pg8::Unit& u, int wr, int wc, int fr, int fq, const LAS float* rowv) const {
        const int pn = u.pn;
        const int row0 = u.pm * 256 + wr * 64 + fr;
        float rs[2][4];
#pragma unroll
        for (int ai = 0; ai < 2; ++ai)
#pragma unroll
            for (int m = 0; m < 4; ++m) rs[ai][m] = rowv[wr * 64 + fr + ai * 128 + m * 16];
        int act = 0, ld, ct; bf16_t* base;
        if (pn < 2) { base = (bf16_t*)(T + T_Q); ld = 512; ct = pn; }
        else if (pn < 4) { base = (bf16_t*)(T + T_K); ld = 512; ct = pn - 2; }
        else if (pn < 8) { base = (bf16_t*)(T + T_V); ld = 1024; ct = pn - 4; }
        else if (pn < 12) { base = (bf16_t*)(T + T_SG); ld = 1024; ct = pn - 8; act = 1; }
        else if (pn < 20) { base = (bf16_t*)(T + T_SZ); ld = 2048; ct = pn - 12; act = 1; }
        else if (pn < 36) { base = (bf16_t*)(T + T_XBC); ld = 4096; ct = pn - 20; act = 3; }
        else if (pn < 44) { base = (bf16_t*)(T + T_GT); ld = 2048; ct = pn - 36; act = 2; }
        else { base = nullptr; ld = 0; ct = 0; act = 4; }
        if (act == 4) {
            if (wc < 2) {
#pragma unroll
                for (int ai = 0; ai < 2; ++ai)
#pragma unroll
                    for (int m = 0; m < 4; ++m) {
                        const int row = row0 + ai * 128 + m * 16;
                        const float rstd = rsqrtf(rs[ai][m] * (1.f / D) + EPS);
                        float* p = sm + (size_t)row * 64 + wc * 32 + 8 * fq;
                        *(f32x4*)p = acc[ai][0][m][0] * rstd; *(f32x4*)(p + 4) = acc[ai][0][m][1] * rstd;
                    }
            }
            return;
        }
        const int col0 = ct * 256 + wc * 32 + 8 * fq;
        if (act == 1) tile<1>(acc, rs, base, ld, row0, col0);
        else if (act == 2) tile<2>(acc, rs, base, ld, row0, col0);
        else if (act == 3) tile<3>(acc, rs, base, ld, row0, col0);
        else tile<0>(acc, rs, base, ld, row0, col0);
    }
    template <int ACT> __device__ __forceinline__ void tile(const AccT& acc, const float (&rs)[2][4], bf16_t* base, int ld, int row0, int col0) const {
#pragma unroll
        for (int ai = 0; ai < 2; ++ai)
#pragma unroll
            for (int m = 0; m < 4; ++m) {
                const int row = row0 + ai * 128 + m * 16;
                const float rstd = rsqrtf(rs[ai][m] * (1.f / D) + EPS);
#pragma unroll
                for (int bj = 0; bj < 2; ++bj) {
                    float v[8];
#pragma unroll
                    for (int n = 0; n < 2; ++n)
#pragma unroll
                        for (int j = 0; j < 4; ++j) { float x = acc[ai][bj][m][n][j] * rstd; if (ACT == 1) x = siluf_(x); else if (ACT == 2) x = sigmoidf_(x); v[4 * n + j] = x; }
                    u32x4 w; w.x = cvt_pk_bf16(v[0], v[1]); w.y = cvt_pk_bf16(v[2], v[3]); w.z = cvt_pk_bf16(v[4], v[5]); w.w = cvt_pk_bf16(v[6], v[7]);
                    *(u32x4*)(base + (size_t)row * ld + col0 + bj * 128) = w;
                    if (ACT == 3 && (row & 63) >= 61) *(u32x4*)(halo + ((size_t)(row >> 6) * 3 + ((row & 63) - 61)) * 4096 + col0 + bj * 128) = w;
                }
            }
    }
};
struct EpiGate {
    const bf16_t* gt; const bf16_t* t1; bf16_t* out; int mode;
    __device__ __forceinline__ void operator()(const AccT& acc, const pg8::Unit& u, int wr, int wc, int fr, int fq, const LAS float* rowv) const {
        const int row0 = u.pm * 256 + wr * 64 + fr, col0 = u.pn * 256 + wc * 32 + 8 * fq;
#pragma unroll
        for (int ai = 0; ai < 2; ++ai) {
            u32x4 gq[4][2], tq[4][2];
#pragma unroll
            for (int m = 0; m < 4; ++m)
#pragma unroll
                for (int bj = 0; bj < 2; ++bj) { const int row = row0 + ai * 128 + m * 16, col = col0 + bj * 128;
                    gq[m][bj] = *(const u32x4*)(gt + (size_t)row * 2048 + mode * 1024 + col);
                    tq[m][bj] = mode ? *(const u32x4*)(t1 + (size_t)row * D + col) : (u32x4){0u, 0u, 0u, 0u}; }
            __builtin_amdgcn_sched_barrier(0);
#pragma unroll
            for (int m = 0; m < 4; ++m)
#pragma unroll
                for (int bj = 0; bj < 2; ++bj) {
                    const int row = row0 + ai * 128 + m * 16, col = col0 + bj * 128;
                    const u32x4 g4 = gq[m][bj], t4 = tq[m][bj];
                    float v[8];
                    v[0] = acc[ai][bj][m][0].x * bf_lo(g4.x); v[1] = acc[ai][bj][m][0].y * bf_hi(g4.x); v[2] = acc[ai][bj][m][0].z * bf_lo(g4.y); v[3] = acc[ai][bj][m][0].w * bf_hi(g4.y);
                    v[4] = acc[ai][bj][m][1].x * bf_lo(g4.z); v[5] = acc[ai][bj][m][1].y * bf_hi(g4.z); v[6] = acc[ai][bj][m][1].z * bf_lo(g4.w); v[7] = acc[ai][bj][m][1].w * bf_hi(g4.w);
                    if (mode) { v[0] += bf_lo(t4.x); v[1] += bf_hi(t4.x); v[2] += bf_lo(t4.y); v[3] += bf_hi(t4.y); v[4] += bf_lo(t4.z); v[5] += bf_hi(t4.z); v[6] += bf_lo(t4.w); v[7] += bf_hi(t4.w); }
                    u32x4 w; w.x = cvt_pk_bf16(v[0], v[1]); w.y = cvt_pk_bf16(v[2], v[3]); w.z = cvt_pk_bf16(v[4], v[5]); w.w = cvt_pk_bf16(v[6], v[7]);
                    *(u32x4*)(out + (size_t)row * D + col) = w;
                }
        }
    }
};

__device__ __forceinline__ void tr_item(const float* srcp, int ld, const float* sk, float mul, int k0, int K, bf16_t* dst, int n0, LAS float* scr, int lane) {
#pragma unroll
    for (int i = 0; i < 32; ++i) { const int kk = 2 * i + (lane >> 5);
        float v = 0.f; if (srcp) v = srcp[(size_t)(k0 + kk) * ld] * (sk ? sk[k0 + kk] : 1.f) * mul;
        scr[kk * 33 + (lane & 31)] = v; }
    asm volatile("s_waitcnt lgkmcnt(0)" ::: "memory");
    const int c = lane & 7;
#pragma unroll
    for (int j = 0; j < 4; ++j) { const int n = (lane >> 3) + 8 * j; const LAS float* s = scr + (8 * c) * 33 + n;
        u32x4 o; o.x = cvt_pk_bf16(s[0 * 33], s[1 * 33]); o.y = cvt_pk_bf16(s[2 * 33], s[3 * 33]); o.z = cvt_pk_bf16(s[4 * 33], s[5 * 33]); o.w = cvt_pk_bf16(s[6 * 33], s[7 * 33]);
        *(u32x4*)(dst + (size_t)(n0 + n) * K + k0 + 8 * c) = o; }
    asm volatile("s_waitcnt lgkmcnt(0)" ::: "memory");
}
__device__ __forceinline__ int win_src_col(int nd) {
    if (nd < 3072) return nd;
    if (nd < 5120) return 3088 + (nd - 3072);
    if (nd < 9216) return 5136 + (nd - 5120);
    if (nd < 11264) return 9264 + (nd - 9216);
    if (nd < 11280) return 3072 + (nd - 11264);
    if (nd < 11312) return 9232 + (nd - 11280);
    return -1;
}

struct Params {
    const float* in[24];
    float* out;
    unsigned char* ws;
};

typedef __attribute__((address_space(4))) const Params* KP;
__device__ __forceinline__ Params load_params(KP p) { Params r;
#pragma unroll
    for (int i = 0; i < 24; ++i) r.in[i] = p->in[i];
    r.out = p->out; r.ws = p->ws; return r; }
__device__ __forceinline__ int tid_fresh() { int t = threadIdx.x; asm volatile("" : "+v"(t)); return t; }
__device__ __forceinline__ void p0_prologue(KP Pp, LAS unsigned char* lds, int G) {
    const Params P = load_params(Pp);
    const int tid = tid_fresh(), lane = tid & 63, wave = tid >> 6;
    LAS float* scr = (LAS float*)(lds + wave * 16384);
    const int gw = blockIdx.x * 8 + wave, NGW = G * 8;
    unsigned char* ws = P.ws;
    constexpr int I_GU = (D / 64) * (NGU / 32), I_DN = (DFF / 64) * (D / 32), I_IN = (D / 64) * (NIN / 32), I_GO = (D / 64) * (D / 32), I_SO = (2048 / 64) * (D / 32);
    constexpr int NITEMS = 2 * I_GU + 2 * I_DN + I_IN + 2 * I_GO + I_SO;
    for (int it = gw; it < NITEMS; it += NGW) {
        int r = it; const int j = lane & 31;
        if (r < 2 * I_GU) { const int l2 = r >= I_GU; r -= l2 * I_GU; const int nb = r % (NGU / 32), kb = r / (NGU / 32); const int nd = nb * 32 + j, tile = nd >> 8, w = nd & 255;
            const float* Wg = P.in[l2 ? 20 : 2]; const float* Wu = P.in[l2 ? 21 : 3];
            const float* sp = (w < 128 ? Wg : Wu) + 128 * tile + (w & 127);
            tr_item(sp, DFF, P.in[l2 ? 19 : 1], 1.f, kb * 64, D, (bf16_t*)(ws + (l2 ? WS_WGU2 : WS_WGU1)), nb * 32, scr, lane); continue; }
        r -= 2 * I_GU;
        if (r < 2 * I_DN) { const int l2 = r >= I_DN; r -= l2 * I_DN; const int nb = r % (D / 32), kb = r / (D / 32);
            tr_item(P.in[l2 ? 22 : 4] + nb * 32 + j, D, nullptr, 1.f, kb * 64, DFF, (bf16_t*)(ws + (l2 ? WS_WD2 : WS_WD1)), nb * 32, scr, lane); continue; }
        r -= 2 * I_DN;
        if (r < I_IN) { const int nb = r % (NIN / 32), kb = r / (NIN / 32); const int nd = nb * 32 + j, sc = win_src_col(nd);
            tr_item(sc >= 0 ? P.in[6] + sc : nullptr, IN_DIM, P.in[5], nd < 512 ? 0.08838834764831845f : 1.f, kb * 64, D, (bf16_t*)(ws + WS_WIN), nb * 32, scr, lane); continue; }
        r -= I_IN;
        if (r < 2 * I_GO) { const int l2 = r >= I_GO; r -= l2 * I_GO; const int nb = r % (D / 32), kb = r / (D / 32);
            tr_item(P.in[l2 ? 18 : 10] + nb * 32 + j, D, nullptr, 1.f, kb * 64, D, (bf16_t*)(ws + (l2 ? WS_WOUT : WS_WGO)), nb * 32, scr, lane); continue; }
        r -= 2 * I_GO;
        { const int nb = r % (D / 32), kb = r / (D / 32);
            tr_item(P.in[17] + nb * 32 + j, D, nullptr, 1.f, kb * 64, 2048, (bf16_t*)(ws + WS_WSO), nb * 32, scr, lane); }
    }
    const float* x = P.in[0]; bf16_t* xb = (bf16_t*)(ws + WS_XB); float* ssq = (float*)(ws + WS_SSQ);
    for (int m0 = gw; m0 < MTOK; m0 += 4 * NGW) {
        f32x4 v[4][4];
#pragma unroll
        for (int u = 0; u < 4; ++u) { const int m = m0 + u * NGW; if (m < MTOK) { const f32x4* xr = (const f32x4*)(x + (size_t)m * D) + lane;
#pragma unroll
            for (int jj = 0; jj < 4; ++jj) v[u][jj] = xr[64 * jj]; } }
#pragma unroll
        for (int u = 0; u < 4; ++u) { const int m = m0 + u * NGW; if (m < MTOK) {
            unsigned long long* o8 = (unsigned long long*)(xb + (size_t)m * D) + lane;
            float s = 0.f;
#pragma unroll
            for (int jj = 0; jj < 4; ++jj) { const f32x4 q = v[u][jj]; s += q.x * q.x + q.y * q.y + q.z * q.z + q.w * q.w;
                o8[64 * jj] = (unsigned long long)cvt_pk_bf16(q.x, q.y) | ((unsigned long long)cvt_pk_bf16(q.z, q.w) << 32); }
            s = wave_sum(s);
            if (lane == 0) { ssq[m] = s; ssq[MTOK + m] = 0.f; ssq[2 * MTOK + m] = 0.f; ssq[3 * MTOK + m] = 0.f; } } }
    }
}

__device__ __forceinline__ void p4_prep(KP Pp, LAS unsigned char* lds, int G) {
    const Params P = load_params(Pp);
    const int tid = tid_fresh();
    unsigned char* ws = P.ws; unsigned char* T = ws + WS_BIG;
    const float* sm = (const float*)(ws + WS_SM);
    for (int it = blockIdx.x; it < HB * NCH; it += G) {
        const int row0 = it * 64;
#pragma unroll
        for (int i = 0; i < 2; ++i) { const int idx = tid + 512 * i; *(LAS f32x4*)(lds + idx * 16) = *(const f32x4*)(sm + (size_t)row0 * 64 + idx * 4); }
        __syncthreads();
        {
            const int hc = tid;
            const float* wf = P.in[7]; float w[16];
#pragma unroll
            for (int j = 0; j < 16; ++j) w[j] = wf[j * 512 + hc];
            const float bfv = P.in[8][hc];
            float la[64]; float cum = 0.f;
#pragma unroll
            for (int t = 0; t < 64; ++t) { float z = bfv;
#pragma unroll
                for (int j4 = 0; j4 < 4; ++j4) { const f32x4 f = *(const LAS f32x4*)(lds + t * 256 + j4 * 16); z += f.x * w[4 * j4] + f.y * w[4 * j4 + 1] + f.z * w[4 * j4 + 2] + f.w * w[4 * j4 + 3]; }
                la[t] = (fminf(z, 0.f) - __logf(1.f + __expf(-fabsf(z)))) * (1.f / 16.f); cum += la[t]; }
            const float end = cum; cum = 0.f;
            bf16_t* kp = (bf16_t*)(T + T_K) + (size_t)row0 * 512 + hc;
#pragma unroll
            for (int tb = 0; tb < 4; ++tb) {
                bf16_t kk[16];
#pragma unroll
                for (int u = 0; u < 16; ++u) kk[u] = kp[(size_t)(tb * 16 + u) * 512];
#pragma unroll
                for (int u = 0; u < 16; ++u) { const int t = tb * 16 + u;
                    cum += la[t];
                    const float kv = __uint_as_float((unsigned)kk[u] << 16) * __expf(end - cum);
                    kp[(size_t)t * 512] = (bf16_t)(cvt_pk_bf16(kv, 0.f) & 0xffffu); }
            }
            ((float*)(ws + WS_DEC))[(size_t)it * 512 + hc] = __expf(end);
        }
        if (tid < 32) {
            const float bias = P.in[13][tid], A = -__expf(P.in[14][tid]);
            float cum = 0.f;
#pragma unroll 4
            for (int t = 0; t < 64; ++t) cum += softplusf_(*(const LAS float*)(lds + t * 256 + (16 + tid) * 4) + bias) * A;
            const float end = cum; cum = 0.f;
            float* wg = (float*)(ws + WS_WG);
#pragma unroll 4
            for (int t = 0; t < 64; ++t) { const float dt = softplusf_(*(const LAS float*)(lds + t * 256 + (16 + tid) * 4) + bias); cum += dt * A; wg[(size_t)(row0 + t) * 32 + tid] = __expf(end - cum) * dt; }
            ((float*)(ws + WS_DECS))[it * 32 + tid] = __expf(end);
        }
        __syncthreads();
    }
    const int co = tid & 63, rg = tid >> 6;
    u32x4 raw[11];
#define CONV_LOAD(itx) do { const int _ci = (itx) >> 3, _col = ((itx) & 7) * 512 + co * 8; \
        const bf16_t* _xp = (const bf16_t*)(T + T_XBC) + (size_t)(_ci * 64 + rg * 8) * 4096 + _col; \
        _Pragma("unroll") for (int i = 0; i < 8; ++i) raw[3 + i] = *(const u32x4*)(_xp + (size_t)i * 4096); \
        if (rg > 0) { _Pragma("unroll") for (int i = 0; i < 3; ++i) raw[i] = *(const u32x4*)(_xp - (size_t)(3 - i) * 4096); } \
        else if ((_ci & (NCH - 1)) != 0) { const bf16_t* _hp = (const bf16_t*)(ws + WS_HALO) + (size_t)(_ci - 1) * 3 * 4096 + _col; \
            _Pragma("unroll") for (int i = 0; i < 3; ++i) raw[i] = *(const u32x4*)(_hp + (size_t)i * 4096); } \
        else { _Pragma("unroll") for (int i = 0; i < 3; ++i) raw[i] = (u32x4){0u, 0u, 0u, 0u}; } } while (0)
    float cw[4][8], cbv[8];
    { const int colw = ((G & 7) == 0 ? ((int)blockIdx.x & 7) : 0) * 512 + co * 8;
#pragma unroll
      for (int k = 0; k < 4; ++k) { const f32x4 a = *(const f32x4*)(P.in[11] + k * 4096 + colw), b = *(const f32x4*)(P.in[11] + k * 4096 + colw + 4);
          cw[k][0] = a.x; cw[k][1] = a.y; cw[k][2] = a.z; cw[k][3] = a.w; cw[k][4] = b.x; cw[k][5] = b.y; cw[k][6] = b.z; cw[k][7] = b.w; }
      { const f32x4 a = *(const f32x4*)(P.in[12] + colw), b = *(const f32x4*)(P.in[12] + colw + 4);
          cbv[0] = a.x; cbv[1] = a.y; cbv[2] = a.z; cbv[3] = a.w; cbv[4] = b.x; cbv[5] = b.y; cbv[6] = b.z; cbv[7] = b.w; } }
    if ((int)blockIdx.x < HB * NCH * 8) CONV_LOAD((int)blockIdx.x);
    for (int it = blockIdx.x; it < HB * NCH * 8; it += G) {
        const int ci = it >> 3, cb = it & 7, col = cb * 512 + co * 8, row0 = ci * 64 + rg * 8;
        bf16_t* xp = (bf16_t*)(T + T_XBC) + (size_t)row0 * 4096 + col;
        if ((G & 7) != 0) {
#pragma unroll
            for (int k = 0; k < 4; ++k) { const f32x4 a = *(const f32x4*)(P.in[11] + k * 4096 + col), b = *(const f32x4*)(P.in[11] + k * 4096 + col + 4);
                cw[k][0] = a.x; cw[k][1] = a.y; cw[k][2] = a.z; cw[k][3] = a.w; cw[k][4] = b.x; cw[k][5] = b.y; cw[k][6] = b.z; cw[k][7] = b.w; }
            { const f32x4 a = *(const f32x4*)(P.in[12] + col), b = *(const f32x4*)(P.in[12] + col + 4);
                cbv[0] = a.x; cbv[1] = a.y; cbv[2] = a.z; cbv[3] = a.w; cbv[4] = b.x; cbv[5] = b.y; cbv[6] = b.z; cbv[7] = b.w; }
        }
        asm volatile("s_waitcnt vmcnt(0)" ::: "memory");
        __syncthreads();
        u32x4 outv[8];
#pragma unroll
        for (int i = 0; i < 8; ++i) {
            float v[8];
#pragma unroll
            for (int e = 0; e < 8; ++e) v[e] = cbv[e];
#pragma unroll
            for (int k = 0; k < 4; ++k) { const u32x4 q = raw[i + k];
                v[0] += cw[k][0] * bf_lo(q.x); v[1] += cw[k][1] * bf_hi(q.x); v[2] += cw[k][2] * bf_lo(q.y); v[3] += cw[k][3] * bf_hi(q.y);
                v[4] += cw[k][4] * bf_lo(q.z); v[5] += cw[k][5] * bf_hi(q.z); v[6] += cw[k][6] * bf_lo(q.w); v[7] += cw[k][7] * bf_hi(q.w); }
#pragma unroll
            for (int e = 0; e < 8; ++e) v[e] = siluf_(v[e]);
            outv[i].x = cvt_pk_bf16(v[0], v[1]); outv[i].y = cvt_pk_bf16(v[2], v[3]); outv[i].z = cvt_pk_bf16(v[4], v[5]); outv[i].w = cvt_pk_bf16(v[6], v[7]);
        }
        if (it + G < HB * NCH * 8) CONV_LOAD(it + G);
#pragma unroll
        for (int i = 0; i < 8; ++i) *(u32x4*)(xp + (size_t)i * 4096) = outv[i];
    }
#undef CONV_LOAD
}

struct MixArgs {
    const bf16_t* ak; int ld_ak;
    const bf16_t* qq; int ld_q;
    const bf16_t* bv; int ld_bv;
    const bf16_t* gt; int ld_g;
    bf16_t* out; int ld_o;
    const float* dec;
    const float* wg;
    const float* nw;
    const float* dsk;
};
constexpr int RSA = 320, RSB = 576, RSQ = 264, RSG = 520, RSX = 520;
constexpr int OFF_AK = 0, OFF_BV = 64 * RSA, OFF_QQ = OFF_BV + 64 * RSB, OFF_WGT = OFF_QQ + 64 * RSQ, OFF_DEC = OFF_WGT + 1024, OFF_RED = OFF_DEC + 512, OFF_NW = OFF_RED + 2048, OFF_GT = OFF_NW + 1024, OFF_XS2 = OFF_GT + 64 * RSG;
static_assert(OFF_XS2 + 64 * RSX <= LDS_XB, "mixer LDS");

#define LBAR() do { asm volatile("s_waitcnt lgkmcnt(0)" ::: "memory"); __builtin_amdgcn_s_barrier(); asm volatile("" ::: "memory"); } while (0)
template <bool SSD>
__device__ __forceinline__ void mixer_item(LAS unsigned char* lds, const MixArgs& a) {
    const int tid = tid_fresh(), lane = tid & 63, w = __builtin_amdgcn_readfirstlane(tid >> 6);
    const int r = lane & 31, h = lane >> 5, gg = lane >> 4, q = (lane & 15) >> 2, p = lane & 3;
    const int arow0 = tid >> 4, apc = tid & 15;
    const int brow0 = tid >> 5, bpc = tid & 31;
    u32x4 stA[2], stQ[2], stB[4], stG[4], stD; float stWp[4];
    stD = (u32x4){0u, 0u, 0u, 0u}; stWp[0] = stWp[1] = stWp[2] = stWp[3] = 0.f;
#define MIX_LOAD(c) do { const size_t _r0 = (size_t)(c) * 64; \
        _Pragma("unroll") for (int i = 0; i < 2; ++i) { stA[i] = *(const u32x4*)(a.ak + (_r0 + arow0 + 32 * i) * a.ld_ak + apc * 8); stQ[i] = *(const u32x4*)(a.qq + (_r0 + arow0 + 32 * i) * a.ld_q + apc * 8); } \
        _Pragma("unroll") for (int i = 0; i < 4; ++i) { stB[i] = *(const u32x4*)(a.bv + (_r0 + brow0 + 16 * i) * a.ld_bv + bpc * 8); stG[i] = *(const u32x4*)(a.gt + (_r0 + brow0 + 16 * i) * a.ld_g + bpc * 8); } \
        if (SSD) { _Pragma("unroll") for (int i = 0; i < 4; ++i) stWp[i] = a.wg[(_r0 + brow0 + 16 * i) * 32 + (bpc >> 3)]; }     \
        else { if (tid < 32) stD = *(const u32x4*)(a.dec + (size_t)(c) * 512 + tid * 4); } } while (0)
#define MIX_STORE() do { \
        _Pragma("unroll") for (int i = 0; i < 2; ++i) { *(LAS u32x4*)(lds + OFF_AK + (arow0 + 32 * i) * RSA + apc * 16) = stA[i]; \
            *(LAS u32x2*)(lds + OFF_QQ + (arow0 + 32 * i) * RSQ + apc * 16) = (u32x2){stQ[i].x, stQ[i].y}; *(LAS u32x2*)(lds + OFF_QQ + (arow0 + 32 * i) * RSQ + apc * 16 + 8) = (u32x2){stQ[i].z, stQ[i].w}; } \
        _Pragma("unroll") for (int i = 0; i < 4; ++i) { \
            if (SSD) { *(LAS u32x2*)(lds + OFF_XS2 + (brow0 + 16 * i) * RSX + bpc * 16) = (u32x2){stB[i].x, stB[i].y}; *(LAS u32x2*)(lds + OFF_XS2 + (brow0 + 16 * i) * RSX + bpc * 16 + 8) = (u32x2){stB[i].z, stB[i].w}; \
                const float _w = stWp[i]; u32x4 _b; _b.x = cvt_pk_bf16(bf_lo(stB[i].x) * _w, bf_hi(stB[i].x) * _w); _b.y = cvt_pk_bf16(bf_lo(stB[i].y) * _w, bf_hi(stB[i].y) * _w); \
                _b.z = cvt_pk_bf16(bf_lo(stB[i].z) * _w, bf_hi(stB[i].z) * _w); _b.w = cvt_pk_bf16(bf_lo(stB[i].w) * _w, bf_hi(stB[i].w) * _w); \
                *(LAS u32x4*)(lds + OFF_BV + (brow0 + 16 * i) * RSB + bpc * 16) = _b; } \
            else *(LAS u32x4*)(lds + OFF_BV + (brow0 + 16 * i) * RSB + bpc * 16) = stB[i]; \
            *(LAS u32x2*)(lds + OFF_GT + (brow0 + 16 * i) * RSG + bpc * 16) = (u32x2){stG[i].x, stG[i].y}; *(LAS u32x2*)(lds + OFF_GT + (brow0 + 16 * i) * RSG + bpc * 16 + 8) = (u32x2){stG[i].z, stG[i].w}; } \
        if (!SSD) { if (tid < 32) *(LAS u32x4*)(lds + OFF_DEC + tid * 16) = stD; } } while (0)

    if (tid < 256) *(LAS float*)(lds + OFF_NW + tid * 4) = a.nw[tid];
    MIX_LOAD(0);
    MIX_STORE();
    __syncthreads();

    f32x16 S[4];
#pragma unroll
    for (int i = 0; i < 4; ++i)
#pragma unroll
        for (int e = 0; e < 16; ++e) S[i][e] = 0.f;

    const int trA = OFF_AK + (8 * h + q) * RSA + (16 * (gg & 1) + 4 * p) * 2;
    const int trB = OFF_BV + (8 * h + q) * RSB + (32 * w + 16 * (gg & 1) + 4 * p) * 2;
    const int qB = OFF_QQ + r * RSQ + 8 * h;
    const int gB = OFF_GT + r * RSG + (32 * w + 4 * h) * 2;
    const float dsk = SSD ? a.dsk[w >> 1] : 0.f;
    float dc_next = SSD ? a.dec[w >> 1] : 0.f;

    for (int c = 0; c < NCH; ++c) {
        if (c + 1 < NCH) MIX_LOAD(c + 1);
        if (SSD) {
            const float dc = dc_next;
            if (c + 1 < NCH) dc_next = a.dec[(size_t)(c + 1) * 32 + (w >> 1)];
#pragma unroll
            for (int i = 0; i < 4; ++i)
#pragma unroll
                for (int e = 0; e < 16; ++e) S[i][e] *= dc;
        } else {
#pragma unroll
            for (int i = 0; i < 4; ++i)
#pragma unroll
                for (int g = 0; g < 4; ++g) { const f32x4 d4 = *(const LAS f32x4*)(lds + OFF_DEC + (32 * i + 8 * g + 4 * h) * 4);
                    S[i][4 * g + 0] *= d4.x; S[i][4 * g + 1] *= d4.y; S[i][4 * g + 2] *= d4.z; S[i][4 * g + 3] *= d4.w; }
        }
#define TRR(addr) __builtin_bit_cast(s16x4, __builtin_amdgcn_ds_read_tr16_b64_v4i16((LAS s16x4*)(lds + (addr))))
#define UPD_LOAD(s, B0, B1, A0, A1, W0, W1) do { B0 = TRR(trB + (16 * (s)) * RSB); B1 = TRR(trB + (16 * (s) + 4) * RSB); \
        _Pragma("unroll") for (int i = 0; i < 4; ++i) { A0[i] = TRR(trA + (16 * (s)) * RSA + 64 * i); A1[i] = TRR(trA + (16 * (s) + 4) * RSA + 64 * i); } \
        } while (0)
#define UPD_MMA(B0, B1, A0, A1, W0, W1) do { bf16x8 bfr = __builtin_shufflevector(B0, B1, 0, 1, 2, 3, 4, 5, 6, 7); \
        _Pragma("unroll") for (int i = 0; i < 4; ++i) S[i] = __builtin_amdgcn_mfma_f32_32x32x16_bf16(__builtin_shufflevector(A0[i], A1[i], 0, 1, 2, 3, 4, 5, 6, 7), bfr, S[i], 0, 0, 0); } while (0)
        {
            s16x4 xb0, xb1, xa0[4], xa1[4], yb0, yb1, ya0[4], ya1[4]; f32x4 xw0, xw1, yw0, yw1;
            xw0 = xw1 = yw0 = yw1 = (f32x4){0.f, 0.f, 0.f, 0.f};
            UPD_LOAD(0, xb0, xb1, xa0, xa1, xw0, xw1);
            UPD_LOAD(1, yb0, yb1, ya0, ya1, yw0, yw1);
            __builtin_amdgcn_sched_barrier(0);
            UPD_MMA(xb0, xb1, xa0, xa1, xw0, xw1);
            __builtin_amdgcn_sched_barrier(0);
            UPD_LOAD(2, xb0, xb1, xa0, xa1, xw0, xw1);
            __builtin_amdgcn_sched_barrier(0);
            UPD_MMA(yb0, yb1, ya0, ya1, yw0, yw1);
            __builtin_amdgcn_sched_barrier(0);
            UPD_LOAD(3, yb0, yb1, ya0, ya1, yw0, yw1);
            __builtin_amdgcn_sched_barrier(0);
            UPD_MMA(xb0, xb1, xa0, xa1, xw0, xw1);
            __builtin_amdgcn_sched_barrier(0);
            UPD_MMA(yb0, yb1, ya0, ya1, yw0, yw1);
        }
#undef UPD_LOAD
#undef UPD_MMA
        f32x16 OT[2];
#pragma unroll
        for (int j2 = 0; j2 < 2; ++j2)
#pragma unroll
            for (int e = 0; e < 16; ++e) OT[j2][e] = 0.f;
        {
            u32x2 qf[3][2][2];
#define Q_LOAD(sp, buf) do { _Pragma("unroll") for (int j2 = 0; j2 < 2; ++j2) { qf[buf][j2][0] = *(const LAS u32x2*)(lds + qB + 32 * j2 * RSQ + (16 * (sp)) * 2); qf[buf][j2][1] = *(const LAS u32x2*)(lds + qB + 32 * j2 * RSQ + (16 * (sp) + 8) * 2); } } while (0)
            Q_LOAD(0, 0); Q_LOAD(1, 1);
#pragma unroll
            for (int sp = 0; sp < 8; ++sp) {
                const int i = sp >> 1, o8 = 8 * (sp & 1);
                if (sp + 2 < 8) Q_LOAD(sp + 2, (sp + 2) % 3);
                u32x4 pk;
                pk.x = cvt_pk_bf16(S[i][o8 + 0], S[i][o8 + 1]); pk.y = cvt_pk_bf16(S[i][o8 + 2], S[i][o8 + 3]);
                pk.z = cvt_pk_bf16(S[i][o8 + 4], S[i][o8 + 5]); pk.w = cvt_pk_bf16(S[i][o8 + 6], S[i][o8 + 7]);
                const bf16x8 sfr = __builtin_bit_cast(bf16x8, pk);
                __builtin_amdgcn_sched_barrier(0);
#pragma unroll
                for (int j2 = 0; j2 < 2; ++j2) {
                    const bf16x8 qfr = __builtin_bit_cast(bf16x8, (u32x4){qf[sp % 3][j2][0].x, qf[sp % 3][j2][0].y, qf[sp % 3][j2][1].x, qf[sp % 3][j2][1].y});
                    OT[j2] = __builtin_amdgcn_mfma_f32_32x32x16_bf16(sfr, qfr, OT[j2], 0, 0, 0);
                }
                __builtin_amdgcn_sched_barrier(0);
            }
#undef Q_LOAD
        }
#undef TRR
        u32x2 gv[2][4];
#pragma unroll
        for (int j2 = 0; j2 < 2; ++j2)
#pragma unroll
            for (int g = 0; g < 4; ++g) gv[j2][g] = *(const LAS u32x2*)(lds + gB + 32 * j2 * RSG + 16 * g);
        float part[2] = {0.f, 0.f};
#pragma unroll
        for (int j2 = 0; j2 < 2; ++j2)
#pragma unroll
            for (int g = 0; g < 4; ++g) {
                if (SSD) {
                    const u32x2 xs = *(const LAS u32x2*)(lds + OFF_XS2 + (32 * j2 + r) * RSX + (32 * w + 8 * g + 4 * h) * 2);
                    OT[j2][4 * g + 0] = (OT[j2][4 * g + 0] + dsk * bf_lo(xs.x)) * bf_lo(gv[j2][g].x);
                    OT[j2][4 * g + 1] = (OT[j2][4 * g + 1] + dsk * bf_hi(xs.x)) * bf_hi(gv[j2][g].x);
                    OT[j2][4 * g + 2] = (OT[j2][4 * g + 2] + dsk * bf_lo(xs.y)) * bf_lo(gv[j2][g].y);
                    OT[j2][4 * g + 3] = (OT[j2][4 * g + 3] + dsk * bf_hi(xs.y)) * bf_hi(gv[j2][g].y);
                }
#pragma unroll
                for (int k = 0; k < 4; ++k) part[j2] += OT[j2][4 * g + k] * OT[j2][4 * g + k];
            }
        part[0] += __shfl_xor(part[0], 32); part[1] += __shfl_xor(part[1], 32);
        if (h == 0) { *(LAS float*)(lds + OFF_RED + (w * 64 + r) * 4) = part[0]; *(LAS float*)(lds + OFF_RED + (w * 64 + 32 + r) * 4) = part[1]; }
        LBAR();
#pragma unroll
        for (int j2 = 0; j2 < 2; ++j2) {
            float tot = 0.f;
#pragma unroll
            for (int ww = 0; ww < 8; ++ww) tot += *(const LAS float*)(lds + OFF_RED + (ww * 64 + 32 * j2 + r) * 4);
            const float rstd = rsqrtf(tot * (1.f / 256.f) + EPS);
#pragma unroll
            for (int g = 0; g < 4; ++g) {
                const f32x4 n4 = *(const LAS f32x4*)(lds + OFF_NW + (32 * w + 8 * g + 4 * h) * 4);
                float v0 = OT[j2][4 * g + 0] * rstd * n4.x, v1 = OT[j2][4 * g + 1] * rstd * n4.y, v2 = OT[j2][4 * g + 2] * rstd * n4.z, v3 = OT[j2][4 * g + 3] * rstd * n4.w;
                if (!SSD) { v0 *= bf_lo(gv[j2][g].x); v1 *= bf_hi(gv[j2][g].x); v2 *= bf_lo(gv[j2][g].y); v3 *= bf_hi(gv[j2][g].y); }
                *(LAS u32x2*)(lds + gB + 32 * j2 * RSG + 16 * g) = (u32x2){cvt_pk_bf16(v0, v1), cvt_pk_bf16(v2, v3)};
            }
        }
        LBAR();
#pragma unroll
        for (int i = 0; i < 4; ++i) {
            const u32x2 o0 = *(const LAS u32x2*)(lds + OFF_GT + (brow0 + 16 * i) * RSG + bpc * 16), o1 = *(const LAS u32x2*)(lds + OFF_GT + (brow0 + 16 * i) * RSG + bpc * 16 + 8);
            *(u32x4*)(a.out + ((size_t)c * 64 + brow0 + 16 * i) * a.ld_o + bpc * 8) = (u32x4){o0.x, o0.y, o1.x, o1.y};
        }
        if (c + 1 < NCH) MIX_STORE();
        LBAR();
    }
#undef MIX_LOAD
#undef MIX_STORE
}

__device__ __forceinline__ void p5_mixer(KP Pp, LAS unsigned char* lds, int G) {
    const Params P = load_params(Pp);
    unsigned char* ws = P.ws; unsigned char* T = ws + WS_BIG;
    for (int it = blockIdx.x; it < HB * 12; it += G) {
        const int b = it / 12, k = it % 12;
        const size_t row0 = (size_t)b * SEQ;
        MixArgs a;
        if (k < 4) {
            const int hd = k;
            a.ak = (const bf16_t*)(T + T_K) + row0 * 512 + hd * 128; a.ld_ak = 512;
            a.qq = (const bf16_t*)(T + T_Q) + row0 * 512 + hd * 128; a.ld_q = 512;
            a.bv = (const bf16_t*)(T + T_V) + row0 * 1024 + hd * 256; a.ld_bv = 1024;
            a.gt = (const bf16_t*)(T + T_SG) + row0 * 1024 + hd * 256; a.ld_g = 1024;
            a.out = (bf16_t*)(T + T_V) + row0 * 1024 + hd * 256; a.ld_o = 1024;
            a.dec = (const float*)(ws + WS_DEC) + (size_t)b * NCH * 512 + hd * 128;
            a.wg = nullptr; a.nw = P.in[9]; a.dsk = nullptr;
            mixer_item<false>(lds, a);
        } else {
            const int g = k - 4;
            const bf16_t* X = (const bf16_t*)(T + T_XBC) + row0 * 4096;
            a.ak = X + 2048 + g * 128; a.ld_ak = 4096;
            a.qq = X + 3072 + g * 128; a.ld_q = 4096;
            a.bv = X + g * 256; a.ld_bv = 4096;
            a.gt = (const bf16_t*)(T + T_SZ) + row0 * 2048 + g * 256; a.ld_g = 2048;
            a.out = (bf16_t*)(T + T_XBC) + row0 * 4096 + g * 256; a.ld_o = 4096;
            a.dec = (const float*)(ws + WS_DECS) + (size_t)b * NCH * 32 + g * 4;
            a.wg = (const float*)(ws + WS_WG) + row0 * 32 + g * 4;
            a.nw = P.in[16] + g * 256; a.dsk = P.in[15] + g * 4;
            mixer_item<true>(lds, a);
        }
        __syncthreads();
    }
}

__device__ __forceinline__ KP get_params() {
    KP p = (KP)__builtin_amdgcn_kernarg_segment_ptr(); asm volatile("" : "+s"(p)); return p;
}

#define XB_TMO      128
#define XB_XCNT(j)  (256  + 64 * (j))
#define XB_XSUB(j)  (1280 + 64 * (j))
#define XB_XGEN(j)  (2304 + 64 * (j))
#define XB_TOP      3328
#define XB_TOPGEN   3392
#define XCD_BAR_WORDS 3456
#define XB_SPIN_CAP (1u << 18)
__device__ __forceinline__ unsigned xb_ld(unsigned* p)              { return __hip_atomic_load(p, __ATOMIC_RELAXED, __HIP_MEMORY_SCOPE_AGENT); }
__device__ __forceinline__ unsigned xb_add(unsigned* p, unsigned v) { return __hip_atomic_fetch_add(p, v, __ATOMIC_RELAXED, __HIP_MEMORY_SCOPE_AGENT); }
__device__ __forceinline__ unsigned xb_xcc_id() { return (unsigned)__builtin_amdgcn_s_getreg((3 << 11) | 20) & 0xFu; }
#define XB_SPIN(cond, bar) do { unsigned _sp = 0; while (cond) { __builtin_amdgcn_s_sleep(1); \
    if ((++_sp & 255u) == 0u) { if (xb_ld(&(bar)[XB_TMO])) break; if (_sp > XB_SPIN_CAP) { atomicAdd(&(bar)[XB_TMO], 1u); break; } } } } while (0)
struct XcdBarrier { unsigned* bar; unsigned x; volatile LAS unsigned* st; };
__device__ __forceinline__ XcdBarrier xcd_barrier_post(unsigned* bar, volatile LAS unsigned* st) {
    XcdBarrier b; b.bar = bar; b.x = xb_xcc_id(); b.st = st;
    if (threadIdx.x == 0) (void)xb_add(&bar[XB_XCNT(b.x)], 1u);
    return b;
}
__device__ __forceinline__ void xcd_barrier_complete(unsigned* bar, unsigned x, unsigned& nloc, unsigned& nx) {
    const unsigned G = gridDim.x * gridDim.y * gridDim.z;
    unsigned sum, cnt, mine, sp = 0u;
    for (;;) {
        sum = 0u; cnt = 0u; mine = 0u;
#pragma unroll
        for (unsigned j = 0; j < 16; ++j) { const unsigned c = xb_ld(&bar[XB_XCNT(j)]); sum += c; cnt += (c > 0u) ? 1u : 0u; mine = (j == x) ? c : mine; }
        if (sum == G) break;
        __builtin_amdgcn_s_sleep(1);
        if ((++sp & 255u) == 0u) { if (xb_ld(&bar[XB_TMO])) break; if (sp > XB_SPIN_CAP) { atomicAdd(&bar[XB_TMO], 1u); break; } }
    }
    nloc = mine > 0u ? mine : 1u; nx = cnt > 0u ? cnt : 1u;
}
__device__ __forceinline__ void xcd_barrier(const XcdBarrier& b) {
    asm volatile("s_waitcnt vmcnt(0)" ::: "memory");
    __syncthreads();
    if (threadIdx.x == 0) {
        unsigned* bar = b.bar;
        __builtin_amdgcn_s_waitcnt(0);
        unsigned nloc = b.st[0], nx = b.st[1];
        if (nloc == 0u) { xcd_barrier_complete(bar, b.x, nloc, nx); b.st[0] = nloc; b.st[1] = nx; }
        const unsigned old = xb_add(&bar[XB_XSUB(b.x)], 1u);
        const unsigned gen = old / nloc;
        if (old + 1u == (gen + 1u) * nloc) {
            __builtin_amdgcn_fence(__ATOMIC_RELEASE, "agent");
            asm volatile("s_waitcnt vmcnt(0)" ::: "memory");
            const unsigned og = xb_add(&bar[XB_TOP], 1u);
            const unsigned tg = og / nx;
            if (og + 1u == (tg + 1u) * nx) xb_add(&bar[XB_TOPGEN], 1u);
            else XB_SPIN(xb_ld(&bar[XB_TOPGEN]) == tg, bar);
            __builtin_amdgcn_fence(__ATOMIC_ACQUIRE, "agent");
            xb_add(&bar[XB_XGEN(b.x)], 1u);
            asm volatile("s_waitcnt vmcnt(0)" ::: "memory");
        } else {
            XB_SPIN(xb_ld(&bar[XB_XGEN(b.x)]) == gen, bar);
            __builtin_amdgcn_fence(__ATOMIC_ACQUIRE, "agent");
            asm volatile("s_waitcnt vmcnt(0)" ::: "memory");
        }
    }
    __syncthreads();
}

#define PROBE_MASK 0x0
#define PROBE_DSYNC 0
#if PROBE_MASK
#define PH_BEGIN(i) const unsigned long long _t##i = __builtin_amdgcn_s_memrealtime();
#define PH_END(i) if ((PROBE_MASK >> (i)) & 1) probe_acc += __builtin_amdgcn_s_memrealtime() - _t##i;
#else
#define PH_BEGIN(i)
#define PH_END(i)
#endif
#define XBAR_NOW() XcdBarrier{(unsigned*)(get_params()->ws + WS_BAR), xb_xcc_id(), (volatile LAS unsigned*)(lds + LDS_XB)}
#if PROBE_DSYNC
#define GSYNC() do { xcd_barrier(XBAR_NOW()); xcd_barrier(XBAR_NOW()); } while (0)
#else
#define GSYNC() xcd_barrier(XBAR_NOW())
#endif
__global__ void __launch_bounds__(512, 2) fwd_megakernel(Params Parg) {
    extern __shared__ __attribute__((aligned(16))) unsigned char lds_raw[];
    LAS unsigned char* lds = (LAS unsigned char*)lds_raw;
    cg::grid_group grid = cg::this_grid();
    const int G = gridDim.x;
    pg8::StaticOrder S;
#if PROBE_MASK
    unsigned long long probe_acc = 0;
#endif

    { unsigned* bw = (unsigned*)(get_params()->ws + WS_BAR);
      if (blockIdx.x == 0) for (int i = threadIdx.x; i < XCD_BAR_WORDS; i += 512) bw[i] = 0u;
      if (threadIdx.x < 2) *(volatile LAS unsigned*)(lds + LDS_XB + threadIdx.x * 4) = 0u; }
    { PH_BEGIN(0) p0_prologue(get_params(), lds, G);
    grid.sync();
    (void)xcd_barrier_post((unsigned*)(get_params()->ws + WS_BAR), (volatile LAS unsigned*)(lds + LDS_XB));
    PH_END(0) }
    { PH_BEGIN(1) { KP P = get_params(); unsigned char* ws = P->ws;
      pg8::Gemm g{(const bf16_t*)(ws + WS_XB), (const bf16_t*)(ws + WS_WGU1), MTOK, NGU, D, D, D, (const float*)(ws + WS_SSQ)}; S.init(MTOK, NGU, G, blockIdx.x);
      EpiGU E{(const float*)(ws + WS_SSQ), (bf16_t*)(ws + WS_BIG)}; pg8::gemm_phase(lds, g, S, E); }
    GSYNC(); PH_END(1) }
    { PH_BEGIN(2) { KP P = get_params(); unsigned char* ws = P->ws;
      pg8::Gemm g{(const bf16_t*)(ws + WS_BIG), (const bf16_t*)(ws + WS_WD1), MTOK, D, DFF, DFF, DFF, nullptr}; S.init(MTOK, D, G, blockIdx.x);
      EpiRes E{(bf16_t*)(ws + WS_XB), (float*)(ws + WS_SSQ) + MTOK, 0.5f}; pg8::gemm_phase<EpiRes, false, true>(lds, g, S, E); }
    GSYNC(); PH_END(2) }
    for (int hf = 0; hf < 2; ++hf) {
        const size_t r0 = (size_t)hf * MH;
        { PH_BEGIN(3) { KP P = get_params(); unsigned char* ws = P->ws;
          pg8::Gemm g{(const bf16_t*)(ws + WS_XB) + r0 * D, (const bf16_t*)(ws + WS_WIN), MH, NIN, D, D, D, (const float*)(ws + WS_SSQ) + MTOK + r0}; S.init(MH, NIN, G, blockIdx.x);
          EpiIn E{(const float*)(ws + WS_SSQ) + MTOK + r0, ws + WS_BIG, (bf16_t*)(ws + WS_HALO), (float*)(ws + WS_SM)}; pg8::gemm_phase(lds, g, S, E); }
        GSYNC(); PH_END(3) }
        { PH_BEGIN(4) p4_prep(get_params(), lds, G);
        GSYNC(); PH_END(4) }
        { PH_BEGIN(5) p5_mixer(get_params(), lds, G);
        GSYNC(); PH_END(5) }
        { PH_BEGIN(6) { KP P = get_params(); unsigned char* ws = P->ws; unsigned char* T = ws + WS_BIG;
          pg8::Gemm g{(const bf16_t*)(T + T_V), (const bf16_t*)(ws + WS_WGO), MH, D, D, D, D, nullptr}; S.init(MH, D, G, blockIdx.x);
          EpiGate E{(const bf16_t*)(T + T_GT), nullptr, (bf16_t*)(T + T_T1), 0}; pg8::gemm_phase<EpiGate, false, true>(lds, g, S, E); }
        { KP P = get_params(); unsigned char* ws = P->ws; unsigned char* T = ws + WS_BIG;
          pg8::Gemm g{(const bf16_t*)(T + T_XBC), (const bf16_t*)(ws + WS_WSO), MH, D, 2048, 4096, 2048, nullptr}; S.init(MH, D, G, blockIdx.x);
          EpiGate E{(const bf16_t*)(T + T_GT), (const bf16_t*)(T + T_T1), (bf16_t*)(T + T_MRG), 1}; pg8::gemm_phase<EpiGate, false, true>(lds, g, S, E); }
        GSYNC(); PH_END(6) }
        { PH_BEGIN(7) { KP P = get_params(); unsigned char* ws = P->ws;
          pg8::Gemm g{(const bf16_t*)(ws + WS_BIG + T_MRG), (const bf16_t*)(ws + WS_WOUT), MH, D, D, D, D, nullptr}; S.init(MH, D, G, blockIdx.x);
          EpiRes E{(bf16_t*)(ws + WS_XB) + r0 * D, (float*)(ws + WS_SSQ) + 2 * MTOK + r0, 1.0f}; pg8::gemm_phase<EpiRes, false, true>(lds, g, S, E); }
        GSYNC(); PH_END(7) }
    }
    { PH_BEGIN(8) { KP P = get_params(); unsigned char* ws = P->ws;
      pg8::Gemm g{(const bf16_t*)(ws + WS_XB), (const bf16_t*)(ws + WS_WGU2), MTOK, NGU, D, D, D, (const float*)(ws + WS_SSQ) + 2 * MTOK}; S.init(MTOK, NGU, G, blockIdx.x);
      EpiGU E{(const float*)(ws + WS_SSQ) + 2 * MTOK, (bf16_t*)(ws + WS_BIG)}; pg8::gemm_phase(lds, g, S, E); }
    GSYNC(); PH_END(8) }
    { PH_BEGIN(9) { KP P = get_params(); unsigned char* ws = P->ws;
      pg8::Gemm g{(const bf16_t*)(ws + WS_BIG), (const bf16_t*)(ws + WS_WD2), MTOK, D, DFF, DFF, DFF, nullptr}; S.init(MTOK, D, G, blockIdx.x);
      EpiRes E{(bf16_t*)(ws + WS_XB), (float*)(ws + WS_SSQ) + 3 * MTOK, 0.5f}; pg8::gemm_phase<EpiRes, false, true>(lds, g, S, E); }
    GSYNC(); PH_END(9) }
    { PH_BEGIN(10)
    {
        KP P = get_params(); const float* ssq = (const float*)(P->ws + WS_SSQ) + 3 * MTOK;
        const int tid = tid_fresh(), lane = tid & 63, gw = blockIdx.x * 8 + (tid >> 6), NGW = G * 8;
        const float* fw = P->in[23]; float* outp = P->out; const bf16_t* xb = (const bf16_t*)(P->ws + WS_XB);
        f32x4 wv[4];
#pragma unroll
        for (int jj = 0; jj < 4; ++jj) wv[jj] = ((const f32x4*)fw)[lane + 64 * jj];
        for (int m = gw; m < MTOK; m += NGW) {
            const float rstd = rsqrtf(ssq[m] * (1.f / D) + EPS);
            const u32x2* xr = (const u32x2*)(xb + (size_t)m * D) + lane;
            f32x4* orow = (f32x4*)(outp + (size_t)m * D) + lane;
#pragma unroll
            for (int jj = 0; jj < 4; ++jj) { const u32x2 q = xr[64 * jj]; f32x4 v;
                v.x = bf_lo(q.x) * rstd * wv[jj].x; v.y = bf_hi(q.x) * rstd * wv[jj].y; v.z = bf_lo(q.y) * rstd * wv[jj].z; v.w = bf_hi(q.y) * rstd * wv[jj].w; orow[64 * jj] = v; }
        }
    }
    PH_END(10) }
#if PROBE_MASK
    if (blockIdx.x == 0) {
        const unsigned long long t0 = __builtin_amdgcn_s_memrealtime();
        while (__builtin_amdgcn_s_memrealtime() - t0 < probe_acc) __builtin_amdgcn_s_sleep(8);
    }
#endif
}

extern "C" void kernel_launch(void* const* d_in, const int* in_sizes, int n_in, void* d_out, int out_size, void* d_ws, size_t ws_size, hipStream_t stream) {
    static int grid = 0;
    if (grid == 0) {
        if (n_in != 24 || ws_size < WS_NEED) { fprintf(stderr, "kernel_launch: unexpected n_in %d or ws_size %zu (need %zu)\n", n_in, ws_size, (size_t)WS_NEED); grid = -1; return; }
        int dev = 0, cus = 0, per_cu = 0;
        hipGetDevice(&dev);
        hipDeviceGetAttribute(&cus, hipDeviceAttributeMultiprocessorCount, dev);
        hipFuncSetAttribute((const void*)fwd_megakernel, hipFuncAttributeMaxDynamicSharedMemorySize, LDS_BYTES);
        hipOccupancyMaxActiveBlocksPerMultiprocessor(&per_cu, (const void*)fwd_megakernel, 512, LDS_BYTES);
        if (per_cu < 1) { fprintf(stderr, "kernel_launch: occupancy query gave %d\n", per_cu); per_cu = 1; }
        grid = cus * per_cu;
        (void)hipGetLastError();
    }
    if (grid < 0) return;
    Params p{};
    for (int i = 0; i < 24; ++i) p.in[i] = (const float*)d_in[i];
    p.out = (float*)d_out; p.ws = (unsigned char*)d_ws;
    void* args[] = {&p};
    hipError_t e = hipLaunchCooperativeKernel((const void*)fwd_megakernel, dim3(grid), dim3(512), args, LDS_BYTES, stream);
    if (e != hipSuccess) fprintf(stderr, "cooperative launch failed: %s (grid %d)\n", hipGetErrorString(e), grid);
}
```

```cpp
#include <hip/hip_runtime.h>
#include <hip/hip_cooperative_groups.h>
#include <cstdio>
#include <cstdint>
namespace cg = cooperative_groups;

#define LAS __attribute__((address_space(3)))
typedef unsigned short bf16_t;
typedef short bf16x8 __attribute__((ext_vector_type(8)));
typedef short s16x4 __attribute__((ext_vector_type(4)));
typedef float f32x4 __attribute__((ext_vector_type(4)));
typedef float f32x16 __attribute__((ext_vector_type(16)));
typedef unsigned u32x4 __attribute__((ext_vector_type(4)));
typedef unsigned u32x2 __attribute__((ext_vector_type(2)));

constexpr int D = 1024, BATCH = 32, SEQ = 2048, MTOK = BATCH * SEQ;
constexpr int NCH = SEQ / 64;
constexpr int DFF = 2816, NGU = 2 * DFF;
constexpr int IN_DIM = 11312, NIN = 45 * 256;
constexpr int HB = 16, MH = HB * SEQ;
constexpr float EPS = 1e-6f;

constexpr size_t MiB = 1u << 20;
constexpr size_t WS_SSQ = 0;
constexpr size_t WS_WGU1 = 1 * MiB, WS_WD1 = 12 * MiB, WS_WIN = 18 * MiB, WS_WGO = 41 * MiB, WS_WSO = 43 * MiB, WS_WOUT = 47 * MiB, WS_WGU2 = 49 * MiB, WS_WD2 = 60 * MiB;
constexpr size_t WS_DEC = 66 * MiB, WS_DECS = 67 * MiB, WS_WG = 68 * MiB, WS_HALO = 72 * MiB, WS_SM = 84 * MiB;
constexpr size_t WS_BAR = 92 * MiB;
constexpr size_t WS_XB = 96 * MiB;
constexpr size_t WS_BIG = 224 * MiB;
constexpr size_t T_Q = 0, T_K = 32 * MiB, T_V = 64 * MiB, T_SG = 128 * MiB, T_SZ = 192 * MiB, T_XBC = 320 * MiB, T_GT = 576 * MiB, T_END = 704 * MiB;
constexpr size_t T_T1 = T_Q, T_MRG = T_SG;
constexpr size_t WS_NEED = WS_BIG + T_END;

constexpr int LDS_MAIN = 131072, LDS_XB = 149504, LDS_BYTES = LDS_XB + 64;

__device__ __forceinline__ unsigned cvt_pk_bf16(float lo, float hi) { unsigned r; asm volatile("v_cvt_pk_bf16_f32 %0, %1, %2" : "=v"(r) : "v"(lo), "v"(hi)); return r; }
__device__ __forceinline__ float bf_lo(unsigned u) { return __uint_as_float(u << 16); }
__device__ __forceinline__ float bf_hi(unsigned u) { return __uint_as_float(u & 0xffff0000u); }
__device__ __forceinline__ float fast_rcp(float x) { return __builtin_amdgcn_rcpf(x); }
__device__ __forceinline__ float sigmoidf_(float x) { return fast_rcp(1.f + __expf(-x)); }
__device__ __forceinline__ float siluf_(float x) { return x * sigmoidf_(x); }
__device__ __forceinline__ float softplusf_(float x) { return fmaxf(x, 0.f) + __logf(1.f + __expf(-fabsf(x))); }
__device__ __forceinline__ float wave_sum(float v) {
#pragma unroll
    for (int o = 1; o < 64; o <<= 1) v += __shfl_xor(v, o);
    return v;
}

namespace pg8 {
constexpr int BM = 256, BK = 64, HALF = 128, HTB = HALF * BK * 2, STAGE_BYTES = 8 * HTB, NXCD = 8, WGM = 8, ROWV_OFF = STAGE_BYTES;
__host__ __device__ __forceinline__ int lds_byte(int r, int c) { const int st = (r >> 4) * 2 + (c >> 5), rr = r & 15, cc = c & 31, ob = rr * 64 + cc * 2; return st * 1024 + (ob ^ (((ob >> 9) & 1) << 5)); }
__host__ __device__ __forceinline__ void stage_rc(int b, int& R, int& C) { const int st = b / 1024, sb = b % 1024, swz = sb ^ (((sb >> 9) & 1) << 5); R = (st >> 1) * 16 + swz / 64; C = (st & 1) * 32 + (swz % 64) / 2; }
__host__ __device__ __forceinline__ int perm32(int rho) { const int n = rho >> 4, i = rho & 15; return 8 * (i >> 2) + 4 * n + (i & 3); }

struct Unit { int pm, pn; };
struct Gemm { const bf16_t* A; const bf16_t* Bt; int M, N, K, lda, ldb; const float* rowvec; };

struct StaticOrder {
    int nM, nN, nwg, G, c;
    __device__ void init(int M, int N, int G_, int c_) { nM = M / BM; nN = N / BM; nwg = nM * nN; G = G_; c = c_; }
    __device__ bool next(int i, Unit& u) const {
        const long L = (long)i * G + c; if (L >= nwg) return false;
        int wgid = (int)L; { const int q = nwg / NXCD, r = nwg % NXCD, xcd = wgid % NXCD, off = wgid / NXCD; wgid = (xcd < r ? xcd * (q + 1) : r * (q + 1) + (xcd - r) * q) + off; }
        const int nig = WGM * nN, gid = wgid / nig, fm = gid * WGM, gsz = (nM - fm) < WGM ? (nM - fm) : WGM;
        u.pm = fm + ((wgid % nig) % gsz); u.pn = (wgid % nig) / gsz; return true;
    }
};

template <class Epi, bool ALIGN_EPI = true, bool SP2 = true>
__device__ __forceinline__ void gemm_phase(LAS unsigned char* lds, const Gemm g, const StaticOrder& S, const Epi& E) {
    int tid = threadIdx.x; asm volatile("" : "+v"(tid));
    const int wid = __builtin_amdgcn_readfirstlane(tid >> 6), lane = tid & 63, wr = wid >> 2, wc = wid & 3, fr = lane & 15, fq = lane >> 4;
    const int K = g.K, nt = K / BK;
    unsigned voffA[2], voffB[2];
#pragma unroll
    for (int i = 0; i < 2; ++i) { int R, C; stage_rc(tid * 16 + i * 8192, R, C); const int Rb = (R & ~31) + perm32(R & 31);
        voffA[i] = (unsigned)(R * g.lda + C) * 2u; voffB[i] = (unsigned)(Rb * g.ldb + C) * 2u; }
    const size_t kstep = (size_t)(BK * 2);
    const size_t hstA = (size_t)HALF * g.lda * 2, hstB = (size_t)HALF * g.ldb * 2;
    const size_t tstA = 2 * hstA, tstB = 2 * hstB;
    const unsigned ldsw = (unsigned)wid * 1024u;
    const int aoff = lds_byte(wr * 64 + fr, fq * 8), boff = lds_byte(wc * 32 + fr, fq * 8);
#define PG8_SA(b, h) (((b) * 2 + (h)) * HTB)
#define PG8_SB(b, h) ((4 + (b) * 2 + (h)) * HTB)
#define PG8_STAGE(bufoff, gbase, voff) do { _Pragma("unroll") for (int _i = 0; _i < 2; ++_i) \
        __builtin_amdgcn_global_load_lds((const unsigned*)((const char*)(gbase) + (voff)[_i]), (LAS unsigned*)(lds + (bufoff) + ldsw + _i * 8192), 16, 0, 0); } while (0)
#define PG8_LDA(dst, b, h) do { _Pragma("unroll") for (int m = 0; m < 4; ++m) _Pragma("unroll") for (int k = 0; k < 2; ++k) dst[m][k] = *(const LAS bf16x8*)(lds + PG8_SA(b, h) + aoff + m * 2048 + k * 1024); } while (0)
#define PG8_LDB(dst, b, h) do { _Pragma("unroll") for (int n = 0; n < 2; ++n) _Pragma("unroll") for (int k = 0; k < 2; ++k) dst[n][k] = *(const LAS bf16x8*)(lds + PG8_SB(b, h) + boff + n * 2048 + k * 1024); } while (0)
#define PG8_MMA(ai, bj, At, Bt) do { __builtin_amdgcn_s_setprio(1); _Pragma("unroll") for (int m = 0; m < 4; ++m) _Pragma("unroll") for (int n = 0; n < 2; ++n) _Pragma("unroll") for (int k = 0; k < 2; ++k) \
        acc[ai][bj][m][n] = __builtin_amdgcn_mfma_f32_16x16x32_bf16(Bt[n][k], At[m][k], acc[ai][bj][m][n], 0, 0, 0); __builtin_amdgcn_s_setprio(0); } while (0)
#define PG8_WAIT_V(n) asm volatile("s_waitcnt vmcnt(" #n ")" ::: "memory")
#define PG8_WAIT_L(n) asm volatile("s_waitcnt lgkmcnt(" #n ")" ::: "memory")
#define PG8_BAR __builtin_amdgcn_s_barrier()
#define PG8_SCHED __builtin_amdgcn_sched_barrier(0)
    Unit cur, nxt; int ui = 0;
    if (!S.next(0, cur)) return;
    f32x4 acc[2][2][4][2];
#pragma unroll
    for (int a = 0; a < 2; ++a)
#pragma unroll
        for (int b = 0; b < 2; ++b)
#pragma unroll
            for (int m = 0; m < 4; ++m)
#pragma unroll
                for (int n = 0; n < 2; ++n) acc[a][b][m][n] = (f32x4){0.f, 0.f, 0.f, 0.f};
    bf16x8 At[4][2], B0[2][2], B1[2][2];
    const char* cA = (const char*)g.A + (size_t)cur.pm * tstA; const char* cB = (const char*)g.Bt + (size_t)cur.pn * tstB;
    if constexpr (SP2) {
        PG8_STAGE(PG8_SB(0, 0), cB, voffB); PG8_STAGE(PG8_SB(0, 1), cB + hstB, voffB); PG8_STAGE(PG8_SA(0, 0), cA, voffA); PG8_STAGE(PG8_SA(0, 1), cA + hstA, voffA);
        if (wr == 1) PG8_BAR;
        PG8_WAIT_V(2); PG8_BAR;
        PG8_STAGE(PG8_SB(1, 0), cB + kstep, voffB); PG8_STAGE(PG8_SA(1, 0), cA + kstep, voffA); PG8_STAGE(PG8_SB(1, 1), cB + hstB + kstep, voffB);
        PG8_WAIT_V(6); PG8_BAR;
    } else {
    PG8_STAGE(PG8_SB(0, 0), cB, voffB); PG8_STAGE(PG8_SA(0, 0), cA, voffA); PG8_STAGE(PG8_SB(0, 1), cB + hstB, voffB); PG8_STAGE(PG8_SA(0, 1), cA + hstA, voffA);
    if (wr == 1) PG8_BAR;
    PG8_WAIT_V(4); PG8_BAR;
    PG8_STAGE(PG8_SB(1, 0), cB + kstep, voffB); PG8_STAGE(PG8_SA(1, 0), cA + kstep, voffA); PG8_STAGE(PG8_SB(1, 1), cB + hstB + kstep, voffB);
    PG8_WAIT_V(6); PG8_BAR;
    }
    for (;;) {
        const bool has_next = S.next(ui + 1, nxt);
        const char* nA = has_next ? (const char*)g.A + (size_t)nxt.pm * tstA : cA; const char* nB = has_next ? (const char*)g.Bt + (size_t)nxt.pn * tstB : cB;
        if (g.rowvec && wid == 0)
            __builtin_amdgcn_global_load_lds((const unsigned*)(g.rowvec + cur.pm * BM + lane * 4), (LAS unsigned*)(lds + ROWV_OFF + (ui & 1) * 1024), 16, 0, 0);
        for (int t = 0; t < nt; t += 2) {
            const bool last = (t == nt - 2);
            const char* a1 = cA + (size_t)(t + 1) * kstep;
            const char* a2 = last ? nA : cA + (size_t)(t + 2) * kstep; const char* b2 = last ? nB : cB + (size_t)(t + 2) * kstep;
            const char* a3 = a2 + kstep; const char* b3 = b2 + kstep;
            if constexpr (SP2) {
            PG8_LDB(B0, 0, 0); PG8_LDB(B1, 0, 1); PG8_SCHED; PG8_LDA(At, 0, 0); PG8_STAGE(PG8_SA(1, 1), a1 + hstA, voffA);
            PG8_WAIT_V(8); PG8_WAIT_L(0); PG8_BAR; PG8_MMA(0, 0, At, B0); PG8_MMA(0, 1, At, B1); PG8_BAR; PG8_SCHED;
            PG8_LDA(At, 0, 1); PG8_STAGE(PG8_SB(0, 0), b2, voffB); PG8_STAGE(PG8_SB(0, 1), b2 + hstB, voffB); PG8_STAGE(PG8_SA(0, 0), a2, voffA);
            PG8_WAIT_V(8); PG8_WAIT_L(0); PG8_BAR; PG8_MMA(1, 0, At, B0); PG8_MMA(1, 1, At, B1); PG8_BAR; PG8_SCHED;
            PG8_LDB(B0, 1, 0); PG8_LDB(B1, 1, 1); PG8_SCHED; PG8_LDA(At, 1, 0); PG8_STAGE(PG8_SA(0, 1), a2 + hstA, voffA);
            PG8_WAIT_V(8); PG8_WAIT_L(0); PG8_BAR; PG8_MMA(0, 0, At, B0); PG8_MMA(0, 1, At, B1); PG8_BAR; PG8_SCHED;
            PG8_LDA(At, 1, 1); PG8_STAGE(PG8_SB(1, 0), b3, voffB); PG8_STAGE(PG8_SB(1, 1), b3 + hstB, voffB); PG8_STAGE(PG8_SA(1, 0), a3, voffA);
            PG8_WAIT_V(8); PG8_WAIT_L(0); PG8_BAR; PG8_MMA(1, 0, At, B0); PG8_MMA(1, 1, At, B1); PG8_BAR; PG8_SCHED;
            } else {
            PG8_LDB(B0, 0, 0); PG8_SCHED; PG8_LDA(At, 0, 0); PG8_STAGE(PG8_SA(1, 1), a1 + hstA, voffA);
            PG8_WAIT_L(8); PG8_BAR; PG8_WAIT_L(0); PG8_MMA(0, 0, At, B0); PG8_BAR; PG8_SCHED;
            PG8_LDB(B1, 0, 1); PG8_STAGE(PG8_SB(0, 0), b2, voffB);
            PG8_BAR; PG8_WAIT_L(0); PG8_MMA(0, 1, At, B1); PG8_BAR;
            PG8_LDA(At, 0, 1); PG8_STAGE(PG8_SA(0, 0), a2, voffA);
            PG8_BAR; PG8_WAIT_L(0); PG8_MMA(1, 0, At, B0); PG8_BAR; PG8_SCHED;
            PG8_STAGE(PG8_SB(0, 1), b2 + hstB, voffB);
            PG8_WAIT_V(6); PG8_BAR; PG8_MMA(1, 1, At, B1); PG8_BAR;
            PG8_LDB(B0, 1, 0); PG8_SCHED; PG8_LDA(At, 1, 0); PG8_STAGE(PG8_SA(0, 1), a2 + hstA, voffA);
            PG8_WAIT_L(8); PG8_BAR; PG8_WAIT_L(0); PG8_MMA(0, 0, At, B0); PG8_BAR; PG8_SCHED;
            PG8_LDB(B1, 1, 1); PG8_STAGE(PG8_SB(1, 0), b3, voffB);
            PG8_BAR; PG8_WAIT_L(0); PG8_MMA(0, 1, At, B1); PG8_BAR;
            PG8_LDA(At, 1, 1); PG8_STAGE(PG8_SA(1, 0), a3, voffA);
            PG8_BAR; PG8_WAIT_L(0); PG8_MMA(1, 0, At, B0); PG8_BAR; PG8_SCHED;
            PG8_STAGE(PG8_SB(1, 1), b3 + hstB, voffB);
            PG8_WAIT_V(6); PG8_BAR; PG8_MMA(1, 1, At, B1); PG8_BAR;
            }
        }
        if constexpr (ALIGN_EPI) { if (wr == 0) PG8_BAR; }
        E(acc, cur, wr, wc, fr, fq, (const LAS float*)(lds + ROWV_OFF + (ui & 1) * 1024));
        if (!has_next) break;
#pragma unroll
        for (int a = 0; a < 2; ++a)
#pragma unroll
            for (int b = 0; b < 2; ++b)
#pragma unroll
                for (int m = 0; m < 4; ++m)
#pragma unroll
                    for (int n = 0; n < 2; ++n) acc[a][b][m][n] = (f32x4){0.f, 0.f, 0.f, 0.f};
        cur = nxt; cA = nA; cB = nB; ++ui;
        if constexpr (ALIGN_EPI) { if (wr == 1) PG8_BAR; }
    }
    PG8_WAIT_V(0);
    if constexpr (!ALIGN_EPI) { if (wr == 0) PG8_BAR; }
    PG8_BAR;
#undef PG8_SA
#undef PG8_SB
#undef PG8_STAGE
#undef PG8_LDA
#undef PG8_LDB
#undef PG8_MMA
#undef PG8_WAIT_V
#undef PG8_WAIT_L
#undef PG8_BAR
#undef PG8_SCHED
}
}

typedef f32x4 AccT[2][2][4][2];

struct EpiGU {
    const float* ssq; bf16_t* O;
    __device__ __forceinline__ void operator()(const AccT& acc, const pg8::Unit& u, int wr, int wc, int fr, int fq, const LAS float* rowv) const {
        const int row0 = u.pm * 256 + wr * 64 + fr, col0 = u.pn * 128 + wc * 32 + 8 * fq;
        float rs[2][4];
#pragma unroll
        for (int ai = 0; ai < 2; ++ai)
#pragma unroll
            for (int m = 0; m < 4; ++m) rs[ai][m] = rowv[wr * 64 + fr + ai * 128 + m * 16];
#pragma unroll
        for (int ai = 0; ai < 2; ++ai)
#pragma unroll
            for (int m = 0; m < 4; ++m) {
                const int row = row0 + ai * 128 + m * 16;
                const float rstd = rsqrtf(rs[ai][m] * (1.f / D) + EPS);
                float v[8];
#pragma unroll
                for (int n = 0; n < 2; ++n)
#pragma unroll
                    for (int j = 0; j < 4; ++j) { const float gg = acc[ai][0][m][n][j] * rstd, uu = acc[ai][1][m][n][j] * rstd; v[4 * n + j] = siluf_(gg) * uu; }
                u32x4 w; w.x = cvt_pk_bf16(v[0], v[1]); w.y = cvt_pk_bf16(v[2], v[3]); w.z = cvt_pk_bf16(v[4], v[5]); w.w = cvt_pk_bf16(v[6], v[7]);
                *(u32x4*)(O + (size_t)row * DFF + col0) = w;
            }
    }
};
struct EpiRes {
    bf16_t* xb; float* ssq; float alpha;
    __device__ __forceinline__ void operator()(const AccT& acc, const pg8::Unit& u, int wr, int wc, int fr, int fq, const LAS float* rowv) const {
        const int row0 = u.pm * 256 + wr * 64 + fr, col0 = u.pn * 256 + wc * 32 + 8 * fq;
        u32x4 xv[2][4][2];
#pragma unroll
        for (int ai = 0; ai < 2; ++ai)
#pragma unroll
            for (int m = 0; m < 4; ++m)
#pragma unroll
                for (int bj = 0; bj < 2; ++bj) xv[ai][m][bj] = *(const u32x4*)(xb + (size_t)(row0 + ai * 128 + m * 16) * D + col0 + bj * 128);
        __builtin_amdgcn_sched_barrier(0);
#pragma unroll
        for (int ai = 0; ai < 2; ++ai)
#pragma unroll
            for (int m = 0; m < 4; ++m) {
                const int row = row0 + ai * 128 + m * 16;
                float s = 0.f;
#pragma unroll
                for (int bj = 0; bj < 2; ++bj) {
                    const u32x4 q = xv[ai][m][bj];
                    float y[8];
                    y[0] = bf_lo(q.x) + acc[ai][bj][m][0].x * alpha; y[1] = bf_hi(q.x) + acc[ai][bj][m][0].y * alpha; y[2] = bf_lo(q.y) + acc[ai][bj][m][0].z * alpha; y[3] = bf_hi(q.y) + acc[ai][bj][m][0].w * alpha;
                    y[4] = bf_lo(q.z) + acc[ai][bj][m][1].x * alpha; y[5] = bf_hi(q.z) + acc[ai][bj][m][1].y * alpha; y[6] = bf_lo(q.w) + acc[ai][bj][m][1].z * alpha; y[7] = bf_hi(q.w) + acc[ai][bj][m][1].w * alpha;
#pragma unroll
                    for (int e = 0; e < 8; ++e) s += y[e] * y[e];
                    u32x4 w; w.x = cvt_pk_bf16(y[0], y[1]); w.y = cvt_pk_bf16(y[2], y[3]); w.z = cvt_pk_bf16(y[4], y[5]); w.w = cvt_pk_bf16(y[6], y[7]);
                    *(u32x4*)(xb + (size_t)row * D + col0 + bj * 128) = w;
                }
                s += __shfl_xor(s, 16); s += __shfl_xor(s, 32);
                if (fq == 0) atomicAdd(ssq + row, s);
            }
    }
};
struct EpiIn {
    const float* ssq; unsigned char* T; bf16_t* halo; float* sm;
    __device__ __forceinline__ void operator()(const AccT& acc, const pg8::Unit& u, int wr, int wc, int fr, int fq, const LAS float* rowv) const {
        const int pn = u.pn;
        const int row0 = u.pm * 256 + wr * 64 + fr;
        float rs[2][4];
#pragma unroll
        for (int ai = 0; ai < 2; ++ai)
#pragma unroll
            for (int m = 0; m < 4; ++m) rs[ai][m] = rowv[wr * 64 + fr + ai * 128 + m * 16];
        int act = 0, ld, ct; bf16_t* base;
        if (pn < 2) { base = (bf16_t*)(T + T_Q); ld = 512; ct = pn; }
        else if (pn < 4) { base = (bf16_t*)(T + T_K); ld = 512; ct = pn - 2; }
        else if (pn < 8) { base = (bf16_t*)(T + T_V); ld = 1024; ct = pn - 4; }
        else if (pn < 12) { base = (bf16_t*)(T + T_SG); ld = 1024; ct = pn - 8; act = 1; }
        else if (pn < 20) { base = (bf16_t*)(T + T_SZ); ld = 2048; ct = pn - 12; act = 1; }
        else if (pn < 36) { base = (bf16_t*)(T + T_XBC); ld = 4096; ct = pn - 20; act = 3; }
        else if (pn < 44) { base = (bf16_t*)(T + T_GT); ld = 2048; ct = pn - 36; act = 2; }
        else { base = nullptr; ld = 0; ct = 0; act = 4; }
        if (act == 4) {
            if (wc < 2) {
#pragma unroll
                for (int ai = 0; ai < 2; ++ai)
#pragma unroll
                    for (int m = 0; m < 4; ++m) {
                        const int row = row0 + ai * 128 + m * 16;
                        const float rstd = rsqrtf(rs[ai][m] * (1.f / D) + EPS);
                        float* p = sm + (size_t)row * 64 + wc * 32 + 8 * fq;
                        *(f32x4*)p = acc[ai][0][m][0] * rstd; *(f32x4*)(p + 4) = acc[ai][0][m][1] * rstd;
                    }
            }
            return;
        }
        const int col0 = ct * 256 + wc * 32 + 8 * fq;
        if (act == 1) tile<1>(acc, rs, base, ld, row0, col0);
        else if (act == 2) tile<2>(acc, rs, base, ld, row0, col0);
        else if (act == 3) tile<3>(acc, rs, base, ld, row0, col0);
        else tile<0>(acc, rs, base, ld, row0, col0);
    }
    template <int ACT> __device__ __forceinline__ void tile(const AccT& acc, const float (&rs)[2][4], bf16_t* base, int ld, int row0, int col0) const {
#pragma unroll
        for (int ai = 0; ai < 2; ++ai)
#pragma unroll
            for (int m = 0; m < 4; ++m) {
                const int row = row0 + ai * 128 + m * 16;
                const float rstd = rsqrtf(rs[ai][m] * (1.f / D) + EPS);
#pragma unroll
                for (int bj = 0; bj < 2; ++bj) {
                    float v[8];
#pragma unroll
                    for (int n = 0; n < 2; ++n)
#pragma unroll
                        for (int j = 0; j < 4; ++j) { float x = acc[ai][bj][m][n][j] * rstd; if (ACT == 1) x = siluf_(x); else if (ACT == 2) x = sigmoidf_(x); v[4 * n + j] = x; }
                    u32x4 w; w.x = cvt_pk_bf16(v[0], v[1]); w.y = cvt_pk_bf16(v[2], v[3]); w.z = cvt_pk_bf16(v[4], v[5]); w.w = cvt_pk_bf16(v[6], v[7]);
                    *(u32x4*)(base + (size_t)row * ld + col0 + bj * 128) = w;
                    if (ACT == 3 && (row & 63) >= 61) *(u32x4*)(halo + ((size_t)(row >> 6) * 3 + ((row & 63) - 61)) * 4096 + col0 + bj * 128) = w;
                }
            }
    }
};
struct EpiGate {
    const bf16_t* gt; const bf16_t* t1; bf16_t* out; int mode;
    __device__ __forceinline__ void operator()(const AccT& acc, const pg8::Unit& u, int wr, int wc, int fr, int fq, const LAS float* rowv) const {
        const int row0 = u.pm * 256 + wr * 64 + fr, col0 = u.pn * 256 + wc * 32 + 8 * fq;
#pragma unroll
        for (int ai = 0; ai < 2; ++ai) {
            u32x4 gq[4][2], tq[4][2];
#pragma unroll
            for (int m = 0; m < 4; ++m)
#pragma unroll
                for (int bj = 0; bj < 2; ++bj) { const int row = row0 + ai * 128 + m * 16, col = col0 + bj * 128;
                    gq[m][bj] = *(const u32x4*)(gt + (size_t)row * 2048 + mode * 1024 + col);
                    tq[m][bj] = mode ? *(const u32x4*)(t1 + (size_t)row * D + col) : (u32x4){0u, 0u, 0u, 0u}; }
            __builtin_amdgcn_sched_barrier(0);
#pragma unroll
            for (int m = 0; m < 4; ++m)
#pragma unroll
                for (int bj = 0; bj < 2; ++bj) {
                    const int row = row0 + ai * 128 + m * 16, col = col0 + bj * 128;
                    const u32x4 g4 = gq[m][bj], t4 = tq[m][bj];
                    float v[8];
                    v[0] = acc[ai][bj][m][0].x * bf_lo(g4.x); v[1] = acc[ai][bj][m][0].y * bf_hi(g4.x); v[2] = acc[ai][bj][m][0].z * bf_lo(g4.y); v[3] = acc[ai][bj][m][0].w * bf_hi(g4.y);
                    v[4] = acc[ai][bj][m][1].x * bf_lo(g4.z); v[5] = acc[ai][bj][m][1].y * bf_hi(g4.z); v[6] = acc[ai][bj][m][1].z * bf_lo(g4.w); v[7] = acc[ai][bj][m][1].w * bf_hi(g4.w);
                    if (mode) { v[0] += bf_lo(t4.x); v[1] += bf_hi(t4.x); v[2] += bf_lo(t4.y); v[3] += bf_hi(t4.y); v[4] += bf_lo(t4.z); v[5] += bf_hi(t4.z); v[6] += bf_lo(t4.w); v[7] += bf_hi(t4.w); }
                    u32x4 w; w.x = cvt_pk_bf16(v[0], v[1]); w.y = cvt_pk_bf16(v[2], v[3]); w.z = cvt_pk_bf16(v[4], v[5]); w.w = cvt_pk_bf16(v[6], v[7]);
                    *(u32x4*)(out + (size_t)row * D + col) = w;
                }
        }
    }
};

__device__ __forceinline__ void tr_item(const float* srcp, int ld, const float* sk, float mul, int k0, int K, bf16_t* dst, int n0, LAS float* scr, int lane) {
#pragma unroll
    for (int i = 0; i < 32; ++i) { const int kk = 2 * i + (lane >> 5);
        float v = 0.f; if (srcp) v = srcp[(size_t)(k0 + kk) * ld] * (sk ? sk[k0 + kk] : 1.f) * mul;
        scr[kk * 33 + (lane & 31)] = v; }
    asm volatile("s_waitcnt lgkmcnt(0)" ::: "memory");
    const int c = lane & 7;
#pragma unroll
    for (int j = 0; j < 4; ++j) { const int n = (lane >> 3) + 8 * j; const LAS float* s = scr + (8 * c) * 33 + n;
        u32x4 o; o.x = cvt_pk_bf16(s[0 * 33], s[1 * 33]); o.y = cvt_pk_bf16(s[2 * 33], s[3 * 33]); o.z = cvt_pk_bf16(s[4 * 33], s[5 * 33]); o.w = cvt_pk_bf16(s[6 * 33], s[7 * 33]);
        *(u32x4*)(dst + (size_t)(n0 + n) * K + k0 + 8 * c) = o; }
    asm volatile("s_waitcnt lgkmcnt(0)" ::: "memory");
}
__device__ __forceinline__ int win_src_col(int nd) {
    if (nd < 3072) return nd;
    if (nd < 5120) return 3088 + (nd - 3072);
    if (nd < 9216) return 5136 + (nd - 5120);
    if (nd < 11264) return 9264 + (nd - 9216);
    if (nd < 11280) return 3072 + (nd - 11264);
    if (nd < 11312) return 9232 + (nd - 11280);
    return -1;
}

struct Params {
    const float* in[24];
    float* out;
    unsigned char* ws;
};

typedef __attribute__((address_space(4))) const Params* KP;
__device__ __forceinline__ Params load_params(KP p) { Params r;
#pragma unroll
    for (int i = 0; i < 24; ++i) r.in[i] = p->in[i];
    r.out = p->out; r.ws = p->ws; return r; }
__device__ __forceinline__ int tid_fresh() { int t = threadIdx.x; asm volatile("" : "+v"(t)); return t; }
__device__ __forceinline__ void p0_prologue(KP Pp, LAS unsigned char* lds, int G) {
    const Params P = load_params(Pp);
    const int tid = tid_fresh(), lane = tid & 63, wave = tid >> 6;
    LAS float* scr = (LAS float*)(lds + wave * 16384);
    const int gw = blockIdx.x * 8 + wave, NGW = G * 8;
    unsigned char* ws = P.ws;
    constexpr int I_GU = (D / 64) * (NGU / 32), I_DN = (DFF / 64) * (D / 32), I_IN = (D / 64) * (NIN / 32), I_GO = (D / 64) * (D / 32), I_SO = (2048 / 64) * (D / 32);
    constexpr int NITEMS = 2 * I_GU + 2 * I_DN + I_IN + 2 * I_GO + I_SO;
    for (int it = gw; it < NITEMS; it += NGW) {
        int r = it; const int j = lane & 31;
        if (r < 2 * I_GU) { const int l2 = r >= I_GU; r -= l2 * I_GU; const int nb = r % (NGU / 32), kb = r / (NGU / 32); const int nd = nb * 32 + j, tile = nd >> 8, w = nd & 255;
            const float* Wg = P.in[l2 ? 20 : 2]; const float* Wu = P.in[l2 ? 21 : 3];
            const float* sp = (w < 128 ? Wg : Wu) + 128 * tile + (w & 127);
            tr_item(sp, DFF, P.in[l2 ? 19 : 1], 1.f, kb * 64, D, (bf16_t*)(ws + (l2 ? WS_WGU2 : WS_WGU1)), nb * 32, scr, lane); continue; }
        r -= 2 * I_GU;
        if (r < 2 * I_DN) { const int l2 = r >= I_DN; r -= l2 * I_DN; const int nb = r % (D / 32), kb = r / (D / 32);
            tr_item(P.in[l2 ? 22 : 4] + nb * 32 + j, D, nullptr, 1.f, kb * 64, DFF, (bf16_t*)(ws + (l2 ? WS_WD2 : WS_WD1)), nb * 32, scr, lane); continue; }
        r -= 2 * I_DN;
        if (r < I_IN) { const int nb = r % (NIN / 32), kb = r / (NIN / 32); const int nd = nb * 32 + j, sc = win_src_col(nd);
            tr_item(sc >= 0 ? P.in[6] + sc : nullptr, IN_DIM, P.in[5], nd < 512 ? 0.08838834764831845f : 1.f, kb * 64, D, (bf16_t*)(ws + WS_WIN), nb * 32, scr, lane); continue; }
        r -= I_IN;
        if (r < 2 * I_GO) { const int l2 = r >= I_GO; r -= l2 * I_GO; const int nb = r % (D / 32), kb = r / (D / 32);
            tr_item(P.in[l2 ? 18 : 10] + nb * 32 + j, D, nullptr, 1.f, kb * 64, D, (bf16_t*)(ws + (l2 ? WS_WOUT : WS_WGO)), nb * 32, scr, lane); continue; }
        r -= 2 * I_GO;
        { const int nb = r % (D / 32), kb = r / (D / 32);
            tr_item(P.in[17] + nb * 32 + j, D, nullptr, 1.f, kb * 64, 2048, (bf16_t*)(ws + WS_WSO), nb * 32, scr, lane); }
    }
    const float* x = P.in[0]; bf16_t* xb = (bf16_t*)(ws + WS_XB); float* ssq = (float*)(ws + WS_SSQ);
    for (int m0 = gw; m0 < MTOK; m0 += 4 * NGW) {
        f32x4 v[4][4];
#pragma unroll
        for (int u = 0; u < 4; ++u) { const int m = m0 + u * NGW; if (m < MTOK) { const f32x4* xr = (const f32x4*)(x + (size_t)m * D) + lane;
#pragma unroll
            for (int jj = 0; jj < 4; ++jj) v[u][jj] = xr[64 * jj]; } }
#pragma unroll
        for (int u = 0; u < 4; ++u) { const int m = m0 + u * NGW; if (m < MTOK) {
            unsigned long long* o8 = (unsigned long long*)(xb + (size_t)m * D) + lane;
            float s = 0.f;
#pragma unroll
            for (int jj = 0; jj < 4; ++jj) { const f32x4 q = v[u][jj]; s += q.x * q.x + q.y * q.y + q.z * q.z + q.w * q.w;
                o8[64 * jj] = (unsigned long long)cvt_pk_bf16(q.x, q.y) | ((unsigned long long)cvt_pk_bf16(q.z, q.w) << 32); }
            s = wave_sum(s);
            if (lane == 0) { ssq[m] = s; ssq[MTOK + m] = 0.f; ssq[2 * MTOK + m] = 0.f; ssq[3 * MTOK + m] = 0.f; } } }
    }
}

__device__ __forceinline__ void p4_prep(KP Pp, LAS unsigned char* lds, int G) {
    const Params P = load_params(Pp);
    const int tid = tid_fresh();
    unsigned char* ws = P.ws; unsigned char* T = ws + WS_BIG;
    const float* sm = (const float*)(ws + WS_SM);
    for (int it = blockIdx.x; it < HB * NCH; it += G) {
        const int row0 = it * 64;
#pragma unroll
        for (int i = 0; i < 2; ++i) { const int idx = tid + 512 * i; *(LAS f32x4*)(lds + idx * 16) = *(const f32x4*)(sm + (size_t)row0 * 64 + idx * 4); }
        __syncthreads();
        {
            const int hc = tid;
            const float* wf = P.in[7]; float w[16];
#pragma unroll
            for (int j = 0; j < 16; ++j) w[j] = wf[j * 512 + hc];
            const float bfv = P.in[8][hc];
            float la[64]; float cum = 0.f;
#pragma unroll
            for (int t = 0; t < 64; ++t) { float z = bfv;
#pragma unroll
                for (int j4 = 0; j4 < 4; ++j4) { const f32x4 f = *(const LAS f32x4*)(lds + t * 256 + j4 * 16); z += f.x * w[4 * j4] + f.y * w[4 * j4 + 1] + f.z * w[4 * j4 + 2] + f.w * w[4 * j4 + 3]; }
                la[t] = (fminf(z, 0.f) - __logf(1.f + __expf(-fabsf(z)))) * (1.f / 16.f); cum += la[t]; }
            const float end = cum; cum = 0.f;
            bf16_t* kp = (bf16_t*)(T + T_K) + (size_t)row0 * 512 + hc;
#pragma unroll
            for (int tb = 0; tb < 4; ++tb) {
                bf16_t kk[16];
#pragma unroll
                for (int u = 0; u < 16; ++u) kk[u] = kp[(size_t)(tb * 16 + u) * 512];
#pragma unroll
                for (int u = 0; u < 16; ++u) { const int t = tb * 16 + u;
                    cum += la[t];
                    const float kv = __uint_as_float((unsigned)kk[u] << 16) * __expf(end - cum);
                    kp[(size_t)t * 512] = (bf16_t)(cvt_pk_bf16(kv, 0.f) & 0xffffu); }
            }
            ((float*)(ws + WS_DEC))[(size_t)it * 512 + hc] = __expf(end);
        }
        if (tid < 32) {
            const float bias = P.in[13][tid], A = -__expf(P.in[14][tid]);
            float cum = 0.f;
#pragma unroll 4
            for (int t = 0; t < 64; ++t) cum += softplusf_(*(const LAS float*)(lds + t * 256 + (16 + tid) * 4) + bias) * A;
            const float end = cum; cum = 0.f;
            float* wg = (float*)(ws + WS_WG);
#pragma unroll 4
            for (int t = 0; t < 64; ++t) { const float dt = softplusf_(*(const LAS float*)(lds + t * 256 + (16 + tid) * 4) + bias); cum += dt * A; wg[(size_t)(row0 + t) * 32 + tid] = __expf(end - cum) * dt; }
            ((float*)(ws + WS_DECS))[it * 32 + tid] = __expf(end);
        }
        __syncthreads();
    }
    const int co = tid & 63, rg = tid >> 6;
    u32x4 raw[11];
#define CONV_LOAD(itx) do { const int _ci = (itx) >> 3, _col = ((itx) & 7) * 512 + co * 8; \
        const bf16_t* _xp = (const bf16_t*)(T + T_XBC) + (size_t)(_ci * 64 + rg * 8) * 4096 + _col; \
        _Pragma("unroll") for (int i = 0; i < 8; ++i) raw[3 + i] = *(const u32x4*)(_xp + (size_t)i * 4096); \
        if (rg > 0) { _Pragma("unroll") for (int i = 0; i < 3; ++i) raw[i] = *(const u32x4*)(_xp - (size_t)(3 - i) * 4096); } \
        else if ((_ci & (NCH - 1)) != 0) { const bf16_t* _hp = (const bf16_t*)(ws + WS_HALO) + (size_t)(_ci - 1) * 3 * 4096 + _col; \
            _Pragma("unroll") for (int i = 0; i < 3; ++i) raw[i] = *(const u32x4*)(_hp + (size_t)i * 4096); } \
        else { _Pragma("unroll") for (int i = 0; i < 3; ++i) raw[i] = (u32x4){0u, 0u, 0u, 0u}; } } while (0)
    float cw[4][8], cbv[8];
    { const int colw = ((G & 7) == 0 ? ((int)blockIdx.x & 7) : 0) * 512 + co * 8;
#pragma unroll
      for (int k = 0; k < 4; ++k) { const f32x4 a = *(const f32x4*)(P.in[11] + k * 4096 + colw), b = *(const f32x4*)(P.in[11] + k * 4096 + colw + 4);
          cw[k][0] = a.x; cw[k][1] = a.y; cw[k][2] = a.z; cw[k][3] = a.w; cw[k][4] = b.x; cw[k][5] = b.y; cw[k][6] = b.z; cw[k][7] = b.w; }
      { const f32x4 a = *(const f32x4*)(P.in[12] + colw), b = *(const f32x4*)(P.in[12] + colw + 4);
          cbv[0] = a.x; cbv[1] = a.y; cbv[2] = a.z; cbv[3] = a.w; cbv[4] = b.x; cbv[5] = b.y; cbv[6] = b.z; cbv[7] = b.w; } }
    if ((int)blockIdx.x < HB * NCH * 8) CONV_LOAD((int)blockIdx.x);
    for (int it = blockIdx.x; it < HB * NCH * 8; it += G) {
        const int ci = it >> 3, cb = it & 7, col = cb * 512 + co * 8, row0 = ci * 64 + rg * 8;
        bf16_t* xp = (bf16_t*)(T + T_XBC) + (size_t)row0 * 4096 + col;
        if ((G & 7) != 0) {
#pragma unroll
            for (int k = 0; k < 4; ++k) { const f32x4 a = *(const f32x4*)(P.in[11] + k * 4096 + col), b = *(const f32x4*)(P.in[11] + k * 4096 + col + 4);
                cw[k][0] = a.x; cw[k][1] = a.y; cw[k][2] = a.z; cw[k][3] = a.w; cw[k][4] = b.x; cw[k][5] = b.y; cw[k][6] = b.z; cw[k][7] = b.w; }
            { const f32x4 a = *(const f32x4*)(P.in[12] + col), b = *(const f32x4*)(P.in[12] + col + 4);
                cbv[0] = a.x; cbv[1] = a.y; cbv[2] = a.z; cbv[3] = a.w; cbv[4] = b.x; cbv[5] = b.y; cbv[6] = b.z; cbv[7] = b.w; }
        }
        asm volatile("s_waitcnt vmcnt(0)" ::: "memory");
        __syncthreads();
        u32x4 outv[8];
#pragma unroll
        for (int i = 0; i < 8; ++i) {
            float v[8];
#pragma unroll
            for (int e = 0; e < 8; ++e) v[e] = cbv[e];
#pragma unroll
            for (int k = 0; k < 4; ++k) { const u32x4 q = raw[i + k];
                v[0] += cw[k][0] * bf_lo(q.x); v[1] += cw[k][1] * bf_hi(q.x); v[2] += cw[k][2] * bf_lo(q.y); v[3] += cw[k][3] * bf_hi(q.y);
                v[4] += cw[k][4] * bf_lo(q.z); v[5] += cw[k][5] * bf_hi(q.z); v[6] += cw[k][6] * bf_lo(q.w); v[7] += cw[k][7] * bf_hi(q.w); }
#pragma unroll
            for (int e = 0; e < 8; ++e) v[e] = siluf_(v[e]);
            outv[i].x = cvt_pk_bf16(v[0], v[1]); outv[i].y = cvt_pk_bf16(v[2], v[3]); outv[i].z = cvt_pk_bf16(v[4], v[5]); outv[i].w = cvt_pk_bf16(v[6], v[7]);
        }
        if (it + G < HB * NCH * 8) CONV_LOAD(it + G);
#pragma unroll
        for (int i = 0; i < 8; ++i) *(u32x4*)(xp + (size_t)i * 4096) = outv[i];
    }
#undef CONV_LOAD
}

struct MixArgs {
    const bf16_t* ak; int ld_ak;
    const bf16_t* qq; int ld_q;
    const bf16_t* bv; int ld_bv;
    const bf16_t* gt; int ld_g;
    bf16_t* out; int ld_o;
    const float* dec;
    const float* wg;
    const float* nw;
    const float* dsk;
};
constexpr int RSA = 320, RSB = 576, RSQ = 264, RSG = 520, RSX = 520;
constexpr int OFF_AK = 0, OFF_BV = 64 * RSA, OFF_QQ = OFF_BV + 64 * RSB, OFF_WGT = OFF_QQ + 64 * RSQ, OFF_DEC = OFF_WGT + 1024, OFF_RED = OFF_DEC + 512, OFF_NW = OFF_RED + 2048, OFF_GT = OFF_NW + 1024, OFF_XS2 = OFF_GT + 64 * RSG;
static_assert(OFF_XS2 + 64 * RSX <= LDS_XB, "mixer LDS");

#define LBAR() do { asm volatile("s_waitcnt lgkmcnt(0)" ::: "memory"); __builtin_amdgcn_s_barrier(); asm volatile("" ::: "memory"); } while (0)
template <bool SSD>
__device__ __forceinline__ void mixer_item(LAS unsigned char* lds, const MixArgs& a) {
    const int tid = tid_fresh(), lane = tid & 63, w = __builtin_amdgcn_readfirstlane(tid >> 6);
    const int r = lane & 31, h = lane >> 5, gg = lane >> 4, q = (lane & 15) >> 2, p = lane & 3;
    const int arow0 = tid >> 4, apc = tid & 15;
    const int brow0 = tid >> 5, bpc = tid & 31;
    u32x4 stA[2], stQ[2], stB[4], stG[4], stD; float stWp[4];
    stD = (u32x4){0u, 0u, 0u, 0u}; stWp[0] = stWp[1] = stWp[2] = stWp[3] = 0.f;
#define MIX_LOAD(c) do { const size_t _r0 = (size_t)(c) * 64; \
        _Pragma("unroll") for (int i = 0; i < 2; ++i) { stA[i] = *(const u32x4*)(a.ak + (_r0 + arow0 + 32 * i) * a.ld_ak + apc * 8); stQ[i] = *(const u32x4*)(a.qq + (_r0 + arow0 + 32 * i) * a.ld_q + apc * 8); } \
        _Pragma("unroll") for (int i = 0; i < 4; ++i) { stB[i] = *(const u32x4*)(a.bv + (_r0 + brow0 + 16 * i) * a.ld_bv + bpc * 8); stG[i] = *(const u32x4*)(a.gt + (_r0 + brow0 + 16 * i) * a.ld_g + bpc * 8); } \
        if (SSD) { _Pragma("unroll") for (int i = 0; i < 4; ++i) stWp[i] = a.wg[(_r0 + brow0 + 16 * i) * 32 + (bpc >> 3)]; }     \
        else { if (tid < 32) stD = *(const u32x4*)(a.dec + (size_t)(c) * 512 + tid * 4); } } while (0)
#define MIX_STORE() do { \
        _Pragma("unroll") for (int i = 0; i < 2; ++i) { *(LAS u32x4*)(lds + OFF_AK + (arow0 + 32 * i) * RSA + apc * 16) = stA[i]; \
            *(LAS u32x2*)(lds + OFF_QQ + (arow0 + 32 * i) * RSQ + apc * 16) = (u32x2){stQ[i].x, stQ[i].y}; *(LAS u32x2*)(lds + OFF_QQ + (arow0 + 32 * i) * RSQ + apc * 16 + 8) = (u32x2){stQ[i].z, stQ[i].w}; } \
        _Pragma("unroll") for (int i = 0; i < 4; ++i) { \
            if (SSD) { *(LAS u32x2*)(lds + OFF_XS2 + (brow0 + 16 * i) * RSX + bpc * 16) = (u32x2){stB[i].x, stB[i].y}; *(LAS u32x2*)(lds + OFF_XS2 + (brow0 + 16 * i) * RSX + bpc * 16 + 8) = (u32x2){stB[i].z, stB[i].w}; \
                const float _w = stWp[i]; u32x4 _b; _b.x = cvt_pk_bf16(bf_lo(stB[i].x) * _w, bf_hi(stB[i].x) * _w); _b.y = cvt_pk_bf16(bf_lo(stB[i].y) * _w, bf_hi(stB[i].y) * _w); \
                _b.z = cvt_pk_bf16(bf_lo(stB[i].z) * _w, bf_hi(stB[i].z) * _w); _b.w = cvt_pk_bf16(bf_lo(stB[i].w) * _w, bf_hi(stB[i].w) * _w); \
                *(LAS u32x4*)(lds + OFF_BV + (brow0 + 16 * i) * RSB + bpc * 16) = _b; } \
            else *(LAS u32x4*)(lds + OFF_BV + (brow0 + 16 * i) * RSB + bpc * 16) = stB[i]; \
            *(LAS u32x2*)(lds + OFF_GT + (brow0 + 16 * i) * RSG + bpc * 16) = (u32x2){stG[i].x, stG[i].y}; *(LAS u32x2*)(lds + OFF_GT + (brow0 + 16 * i) * RSG + bpc * 16 + 8) = (u32x2){stG[i].z, stG[i].w}; } \
        if (!SSD) { if (tid < 32) *(LAS u32x4*)(lds + OFF_DEC + tid * 16) = stD; } } while (0)

    if (tid < 256) *(LAS float*)(lds + OFF_NW + tid * 4) = a.nw[tid];
    MIX_LOAD(0);
    MIX_STORE();
    __syncthreads();

    f32x16 S[4];
#pragma unroll
    for (int i = 0; i < 4; ++i)
#pragma unroll
        for (int e = 0; e < 16; ++e) S[i][e] = 0.f;

    const int trA = OFF_AK + (8 * h + q) * RSA + (16 * (gg & 1) + 4 * p) * 2;
    const int trB = OFF_BV + (8 * h + q) * RSB + (32 * w + 16 * (gg & 1) + 4 * p) * 2;
    const int qB = OFF_QQ + r * RSQ + 8 * h;
    const int gB = OFF_GT + r * RSG + (32 * w + 4 * h) * 2;
    const float dsk = SSD ? a.dsk[w >> 1] : 0.f;
    float dc_next = SSD ? a.dec[w >> 1] : 0.f;

    for (int c = 0; c < NCH; ++c) {
        if (c + 1 < NCH) MIX_LOAD(c + 1);
        if (SSD) {
            const float dc = dc_next;
            if (c + 1 < NCH) dc_next = a.dec[(size_t)(c + 1) * 32 + (w >> 1)];
#pragma unroll
            for (int i = 0; i < 4; ++i)
#pragma unroll
                for (int e = 0; e < 16; ++e) S[i][e] *= dc;
        } else {
#pragma unroll
            for (int i = 0; i < 4; ++i)
#pragma unroll
                for (int g = 0; g < 4; ++g) { const f32x4 d4 = *(const LAS f32x4*)(lds + OFF_DEC + (32 * i + 8 * g + 4 * h) * 4);
                    S[i][4 * g + 0] *= d4.x; S[i][4 * g + 1] *= d4.y; S[i][4 * g + 2] *= d4.z; S[i][4 * g + 3] *= d4.w; }
        }
#define TRR(addr) __builtin_bit_cast(s16x4, __builtin_amdgcn_ds_read_tr16_b64_v4i16((LAS s16x4*)(lds + (addr))))
#define UPD_LOAD(s, B0, B1, A0, A1, W0, W1) do { B0 = TRR(trB + (16 * (s)) * RSB); B1 = TRR(trB + (16 * (s) + 4) * RSB); \
        _Pragma("unroll") for (int i = 0; i < 4; ++i) { A0[i] = TRR(trA + (16 * (s)) * RSA + 64 * i); A1[i] = TRR(trA + (16 * (s) + 4) * RSA + 64 * i); } \
        } while (0)
#define UPD_MMA(B0, B1, A0, A1, W0, W1) do { bf16x8 bfr = __builtin_shufflevector(B0, B1, 0, 1, 2, 3, 4, 5, 6, 7); \
        _Pragma("unroll") for (int i = 0; i < 4; ++i) S[i] = __builtin_amdgcn_mfma_f32_32x32x16_bf16(__builtin_shufflevector(A0[i], A1[i], 0, 1, 2, 3, 4, 5, 6, 7), bfr, S[i], 0, 0, 0); } while (0)
        {
            s16x4 xb0, xb1, xa0[4], xa1[4], yb0, yb1, ya0[4], ya1[4]; f32x4 xw0, xw1, yw0, yw1;
            xw0 = xw1 = yw0 = yw1 = (f32x4){0.f, 0.f, 0.f, 0.f};
            UPD_LOAD(0, xb0, xb1, xa0, xa1, xw0, xw1);
            UPD_LOAD(1, yb0, yb1, ya0, ya1, yw0, yw1);
            __builtin_amdgcn_sched_barrier(0);
            UPD_MMA(xb0, xb1, xa0, xa1, xw0, xw1);
            __builtin_amdgcn_sched_barrier(0);
            UPD_LOAD(2, xb0, xb1, xa0, xa1, xw0, xw1);
            __builtin_amdgcn_sched_barrier(0);
            UPD_MMA(yb0, yb1, ya0, ya1, yw0, yw1);
            __builtin_amdgcn_sched_barrier(0);
            UPD_LOAD(3, yb0, yb1, ya0, ya1, yw0, yw1);
            __builtin_amdgcn_sched_barrier(0);
            UPD_MMA(xb0, xb1, xa0, xa1, xw0, xw1);
            __builtin_amdgcn_sched_barrier(0);
            UPD_MMA(yb0, yb1, ya0, ya1, yw0, yw1);
        }
#undef UPD_LOAD
#undef UPD_MMA
        f32x16 OT[2];
#pragma unroll
        for (int j2 = 0; j2 < 2; ++j2)
#pragma unroll
            for (int e = 0; e < 16; ++e) OT[j2][e] = 0.f;
        {
            u32x2 qf[3][2][2];
#define Q_LOAD(sp, buf) do { _Pragma("unroll") for (int j2 = 0; j2 < 2; ++j2) { qf[buf][j2][0] = *(const LAS u32x2*)(lds + qB + 32 * j2 * RSQ + (16 * (sp)) * 2); qf[buf][j2][1] = *(const LAS u32x2*)(lds + qB + 32 * j2 * RSQ + (16 * (sp) + 8) * 2); } } while (0)
            Q_LOAD(0, 0); Q_LOAD(1, 1);
#pragma unroll
            for (int sp = 0; sp < 8; ++sp) {
                const int i = sp >> 1, o8 = 8 * (sp & 1);
                if (sp + 2 < 8) Q_LOAD(sp + 2, (sp + 2) % 3);
                u32x4 pk;
                pk.x = cvt_pk_bf16(S[i][o8 + 0], S[i][o8 + 1]); pk.y = cvt_pk_bf16(S[i][o8 + 2], S[i][o8 + 3]);
                pk.z = cvt_pk_bf16(S[i][o8 + 4], S[i][o8 + 5]); pk.w = cvt_pk_bf16(S[i][o8 + 6], S[i][o8 + 7]);
                const bf16x8 sfr = __builtin_bit_cast(bf16x8, pk);
                __builtin_amdgcn_sched_barrier(0);
#pragma unroll
                for (int j2 = 0; j2 < 2; ++j2) {
                    const bf16x8 qfr = __builtin_bit_cast(bf16x8, (u32x4){qf[sp % 3][j2][0].x, qf[sp % 3][j2][0].y, qf[sp % 3][j2][1].x, qf[sp % 3][j2][1].y});
                    OT[j2] = __builtin_amdgcn_mfma_f32_32x32x16_bf16(sfr, qfr, OT[j2], 0, 0, 0);
                }
                __builtin_amdgcn_sched_barrier(0);
            }
#undef Q_LOAD
        }
#undef TRR
        u32x2 gv[2][4];
#pragma unroll
        for (int j2 = 0; j2 < 2; ++j2)
#pragma unroll
            for (int g = 0; g < 4; ++g) gv[j2][g] = *(const LAS u32x2*)(lds + gB + 32 * j2 * RSG + 16 * g);
        float part[2] = {0.f, 0.f};
#pragma unroll
        for (int j2 = 0; j2 < 2; ++j2)
#pragma unroll
            for (int g = 0; g < 4; ++g) {
                if (SSD) {
                    const u32x2 xs = *(const LAS u32x2*)(lds + OFF_XS2 + (32 * j2 + r) * RSX + (32 * w + 8 * g + 4 * h) * 2);
                    OT[j2][4 * g + 0] = (OT[j2][4 * g + 0] + dsk * bf_lo(xs.x)) * bf_lo(gv[j2][g].x);
                    OT[j2][4 * g + 1] = (OT[j2][4 * g + 1] + dsk * bf_hi(xs.x)) * bf_hi(gv[j2][g].x);
                    OT[j2][4 * g + 2] = (OT[j2][4 * g + 2] + dsk * bf_lo(xs.y)) * bf_lo(gv[j2][g].y);
                    OT[j2][4 * g + 3] = (OT[j2][4 * g + 3] + dsk * bf_hi(xs.y)) * bf_hi(gv[j2][g].y);
                }
#pragma unroll
                for (int k = 0; k < 4; ++k) part[j2] += OT[j2][4 * g + k] * OT[j2][4 * g + k];
            }
        part[0] += __shfl_xor(part[0], 32); part[1] += __shfl_xor(part[1], 32);
        if (h == 0) { *(LAS float*)(lds + OFF_RED + (w * 64 + r) * 4) = part[0]; *(LAS float*)(lds + OFF_RED + (w * 64 + 32 + r) * 4) = part[1]; }
        LBAR();
#pragma unroll
        for (int j2 = 0; j2 < 2; ++j2) {
            float tot = 0.f;
#pragma unroll
            for (int ww = 0; ww < 8; ++ww) tot += *(const LAS float*)(lds + OFF_RED + (ww * 64 + 32 * j2 + r) * 4);
            const float rstd = rsqrtf(tot * (1.f / 256.f) + EPS);
#pragma unroll
            for (int g = 0; g < 4; ++g) {
                const f32x4 n4 = *(const LAS f32x4*)(lds + OFF_NW + (32 * w + 8 * g + 4 * h) * 4);
                float v0 = OT[j2][4 * g + 0] * rstd * n4.x, v1 = OT[j2][4 * g + 1] * rstd * n4.y, v2 = OT[j2][4 * g + 2] * rstd * n4.z, v3 = OT[j2][4 * g + 3] * rstd * n4.w;
                if (!SSD) { v0 *= bf_lo(gv[j2][g].x); v1 *= bf_hi(gv[j2][g].x); v2 *= bf_lo(gv[j2][g].y); v3 *= bf_hi(gv[j2][g].y); }
                *(LAS u32x2*)(lds + gB + 32 * j2 * RSG + 16 * g) = (u32x2){cvt_pk_bf16(v0, v1), cvt_pk_bf16(v2, v3)};
            }
        }
        LBAR();
#pragma unroll
        for (int i = 0; i < 4; ++i) {
            const u32x2 o0 = *(const LAS u32x2*)(lds + OFF_GT + (brow0 + 16 * i) * RSG + bpc * 16), o1 = *(const LAS u32x2*)(lds + OFF_GT + (brow0 + 16 * i) * RSG + bpc * 16 + 8);
            *(u32x4*)(a.out + ((size_t)c * 64 + brow0 + 16 * i) * a.ld_o + bpc * 8) = (u32x4){o0.x, o0.y, o1.x, o1.y};
        }
        if (c + 1 < NCH) MIX_STORE();
        LBAR();
    }
#undef MIX_LOAD
#undef MIX_STORE
}

__device__ __forceinline__ void p5_mixer(KP Pp, LAS unsigned char* lds, int G) {
    const Params P = load_params(Pp);
    unsigned char* ws = P.ws; unsigned char* T = ws + WS_BIG;
    for (int it = blockIdx.x; it < HB * 12; it += G) {
        const int b = it / 12, k = it % 12;
        const size_t row0 = (size_t)b * SEQ;
        MixArgs a;
        if (k < 4) {
            const int hd = k;
            a.ak = (const bf16_t*)(T + T_K) + row0 * 512 + hd * 128; a.ld_ak = 512;
            a.qq = (const bf16_t*)(T + T_Q) + row0 * 512 + hd * 128; a.ld_q = 512;
            a.bv = (const bf16_t*)(T + T_V) + row0 * 1024 + hd * 256; a.ld_bv = 1024;
            a.gt = (const bf16_t*)(T + T_SG) + row0 * 1024 + hd * 256; a.ld_g = 1024;
            a.out = (bf16_t*)(T + T_V) + row0 * 1024 + hd * 256; a.ld_o = 1024;
            a.dec = (const float*)(ws + WS_DEC) + (size_t)b * NCH * 512 + hd * 128;
            a.wg = nullptr; a.nw = P.in[9]; a.dsk = nullptr;
            mixer_item<false>(lds, a);
        } else {
            const int g = k - 4;
            const bf16_t* X = (const bf16_t*)(T + T_XBC) + row0 * 4096;
            a.ak = X + 2048 + g * 128; a.ld_ak = 4096;
            a.qq = X + 3072 + g * 128; a.ld_q = 4096;
            a.bv = X + g * 256; a.ld_bv = 4096;
            a.gt = (const bf16_t*)(T + T_SZ) + row0 * 2048 + g * 256; a.ld_g = 2048;
            a.out = (bf16_t*)(T + T_XBC) + row0 * 4096 + g * 256; a.ld_o = 4096;
            a.dec = (const float*)(ws + WS_DECS) + (size_t)b * NCH * 32 + g * 4;
            a.wg = (const float*)(ws + WS_WG) + row0 * 32 + g * 4;
            a.nw = P.in[16] + g * 256; a.dsk = P.in[15] + g * 4;
            mixer_item<true>(lds, a);
        }
        __syncthreads();
    }
}

__device__ __forceinline__ KP get_params() {
    KP p = (KP)__builtin_amdgcn_kernarg_segment_ptr(); asm volatile("" : "+s"(p)); return p;
}

#define XB_TMO      128
#define XB_XCNT(j)  (256  + 64 * (j))
#define XB_XSUB(j)  (1280 + 64 * (j))
#define XB_XGEN(j)  (2304 + 64 * (j))
#define XB_TOP      3328
#define XB_TOPGEN   3392
#define XCD_BAR_WORDS 3456
#define XB_SPIN_CAP (1u << 18)
__device__ __forceinline__ unsigned xb_ld(unsigned* p)              { return __hip_atomic_load(p, __ATOMIC_RELAXED, __HIP_MEMORY_SCOPE_AGENT); }
__device__ __forceinline__ unsigned xb_add(unsigned* p, unsigned v) { return __hip_atomic_fetch_add(p, v, __ATOMIC_RELAXED, __HIP_MEMORY_SCOPE_AGENT); }
__device__ __forceinline__ unsigned xb_xcc_id() { return (unsigned)__builtin_amdgcn_s_getreg((3 << 11) | 20) & 0xFu; }
#define XB_SPIN(cond, bar) do { unsigned _sp = 0; while (cond) { __builtin_amdgcn_s_sleep(1); \
    if ((++_sp & 255u) == 0u) { if (xb_ld(&(bar)[XB_TMO])) break; if (_sp > XB_SPIN_CAP) { atomicAdd(&(bar)[XB_TMO], 1u); break; } } } } while (0)
struct XcdBarrier { unsigned* bar; unsigned x; volatile LAS unsigned* st; };
__device__ __forceinline__ XcdBarrier xcd_barrier_post(unsigned* bar, volatile LAS unsigned* st) {
    XcdBarrier b; b.bar = bar; b.x = xb_xcc_id(); b.st = st;
    if (threadIdx.x == 0) (void)xb_add(&bar[XB_XCNT(b.x)], 1u);
    return b;
}
__device__ __forceinline__ void xcd_barrier_complete(unsigned* bar, unsigned x, unsigned& nloc, unsigned& nx) {
    const unsigned G = gridDim.x * gridDim.y * gridDim.z;
    unsigned sum, cnt, mine, sp = 0u;
    for (;;) {
        sum = 0u; cnt = 0u; mine = 0u;
#pragma unroll
        for (unsigned j = 0; j < 16; ++j) { const unsigned c = xb_ld(&bar[XB_XCNT(j)]); sum += c; cnt += (c > 0u) ? 1u : 0u; mine = (j == x) ? c : mine; }
        if (sum == G) break;
        __builtin_amdgcn_s_sleep(1);
        if ((++sp & 255u) == 0u) { if (xb_ld(&bar[XB_TMO])) break; if (sp > XB_SPIN_CAP) { atomicAdd(&bar[XB_TMO], 1u); break; } }
    }
    nloc = mine > 0u ? mine : 1u; nx = cnt > 0u ? cnt : 1u;
}
__device__ __forceinline__ void xcd_barrier(const XcdBarrier& b) {
    asm volatile("s_waitcnt vmcnt(0)" ::: "memory");
    __syncthreads();
    if (threadIdx.x == 0) {
        unsigned* bar = b.bar;
        __builtin_amdgcn_s_waitcnt(0);
        unsigned nloc = b.st[0], nx = b.st[1];
        if (nloc == 0u) { xcd_barrier_complete(bar, b.x, nloc, nx); b.st[0] = nloc; b.st[1] = nx; }
        const unsigned old = xb_add(&bar[XB_XSUB(b.x)], 1u);
        const unsigned gen = old / nloc;
        if (old + 1u == (gen + 1u) * nloc) {
            __builtin_amdgcn_fence(__ATOMIC_RELEASE, "agent");
            asm volatile("s_waitcnt vmcnt(0)" ::: "memory");
            const unsigned og = xb_add(&bar[XB_TOP], 1u);
            const unsigned tg = og / nx;
            if (og + 1u == (tg + 1u) * nx) xb_add(&bar[XB_TOPGEN], 1u);
            else XB_SPIN(xb_ld(&bar[XB_TOPGEN]) == tg, bar);
            __builtin_amdgcn_fence(__ATOMIC_ACQUIRE, "agent");
            xb_add(&bar[XB_XGEN(b.x)], 1u);
            asm volatile("s_waitcnt vmcnt(0)" ::: "memory");
        } else {
            XB_SPIN(xb_ld(&bar[XB_XGEN(b.x)]) == gen, bar);
            __builtin_amdgcn_fence(__ATOMIC_ACQUIRE, "agent");
            asm volatile("s_waitcnt vmcnt(0)" ::: "memory");
        }
    }
    __syncthreads();
}

#define PROBE_MASK 0x0
#define PROBE_DSYNC 0
#if PROBE_MASK
#define PH_BEGIN(i) const unsigned long long _t##i = __builtin_amdgcn_s_memrealtime();
#define PH_END(i) if ((PROBE_MASK >> (i)) & 1) probe_acc += __builtin_amdgcn_s_memrealtime() - _t##i;
#else
#define PH_BEGIN(i)
#define PH_END(i)
#endif
#define XBAR_NOW() XcdBarrier{(unsigned*)(get_params()->ws + WS_BAR), xb_xcc_id(), (volatile LAS unsigned*)(lds + LDS_XB)}
#if PROBE_DSYNC
#define GSYNC() do { xcd_barrier(XBAR_NOW()); xcd_barrier(XBAR_NOW()); } while (0)
#else
#define GSYNC() xcd_barrier(XBAR_NOW())
#endif
__global__ void __launch_bounds__(512, 2) fwd_megakernel(Params Parg) {
    extern __shared__ __attribute__((aligned(16))) unsigned char lds_raw[];
    LAS unsigned char* lds = (LAS unsigned char*)lds_raw;
    cg::grid_group grid = cg::this_grid();
    const int G = gridDim.x;
    pg8::StaticOrder S;
#if PROBE_MASK
    unsigned long long probe_acc = 0;
#endif

    if (threadIdx.x < 2) *(volatile LAS unsigned*)(lds + LDS_XB + threadIdx.x * 4) = 0u;
    __syncthreads();
    (void)xcd_barrier_post((unsigned*)(get_params()->ws + WS_BAR), (volatile LAS unsigned*)(lds + LDS_XB));
    if (gridDim.x == 0x7fffffffu) grid.sync();
    { PH_BEGIN(0) p0_prologue(get_params(), lds, G);
    GSYNC();
    PH_END(0) }
    { PH_BEGIN(1) { KP P = get_params(); unsigned char* ws = P->ws;
      pg8::Gemm g{(const bf16_t*)(ws + WS_XB), (const bf16_t*)(ws + WS_WGU1), MTOK, NGU, D, D, D, (const float*)(ws + WS_SSQ)}; S.init(MTOK, NGU, G, blockIdx.x);
      EpiGU E{(const float*)(ws + WS_SSQ), (bf16_t*)(ws + WS_BIG)}; pg8::gemm_phase(lds, g, S, E); }
    GSYNC(); PH_END(1) }
    { PH_BEGIN(2) { KP P = get_params(); unsigned char* ws = P->ws;
      pg8::Gemm g{(const bf16_t*)(ws + WS_BIG), (const bf16_t*)(ws + WS_WD1), MTOK, D, DFF, DFF, DFF, nullptr}; S.init(MTOK, D, G, blockIdx.x);
      EpiRes E{(bf16_t*)(ws + WS_XB), (float*)(ws + WS_SSQ) + MTOK, 0.5f}; pg8::gemm_phase<EpiRes, false, true>(lds, g, S, E); }
    GSYNC(); PH_END(2) }
    for (int hf = 0; hf < 2; ++hf) {
        const size_t r0 = (size_t)hf * MH;
        { PH_BEGIN(3) { KP P = get_params(); unsigned char* ws = P->ws;
          pg8::Gemm g{(const bf16_t*)(ws + WS_XB) + r0 * D, (const bf16_t*)(ws + WS_WIN), MH, NIN, D, D, D, (const float*)(ws + WS_SSQ) + MTOK + r0}; S.init(MH, NIN, G, blockIdx.x);
          EpiIn E{(const float*)(ws + WS_SSQ) + MTOK + r0, ws + WS_BIG, (bf16_t*)(ws + WS_HALO), (float*)(ws + WS_SM)}; pg8::gemm_phase(lds, g, S, E); }
        GSYNC(); PH_END(3) }
        { PH_BEGIN(4) p4_prep(get_params(), lds, G);
        GSYNC(); PH_END(4) }
        { PH_BEGIN(5) p5_mixer(get_params(), lds, G);
        GSYNC(); PH_END(5) }
        { PH_BEGIN(6) { KP P = get_params(); unsigned char* ws = P->ws; unsigned char* T = ws + WS_BIG;
          pg8::Gemm g{(const bf16_t*)(T + T_V), (const bf16_t*)(ws + WS_WGO), MH, D, D, D, D, nullptr}; S.init(MH, D, G, blockIdx.x);
          EpiGate E{(const bf16_t*)(T + T_GT), nullptr, (bf16_t*)(T + T_T1), 0}; pg8::gemm_phase<EpiGate, false, true>(lds, g, S, E); }
        { KP P = get_params(); unsigned char* ws = P->ws; unsigned char* T = ws + WS_BIG;
          pg8::Gemm g{(const bf16_t*)(T + T_XBC), (const bf16_t*)(ws + WS_WSO), MH, D, 2048, 4096, 2048, nullptr}; S.init(MH, D, G, blockIdx.x);
          EpiGate E{(const bf16_t*)(T + T_GT), (const bf16_t*)(T + T_T1), (bf16_t*)(T + T_MRG), 1}; pg8::gemm_phase<EpiGate, false, true>(lds, g, S, E); }
        GSYNC(); PH_END(6) }
        { PH_BEGIN(7) { KP P = get_params(); unsigned char* ws = P->ws;
          pg8::Gemm g{(const bf16_t*)(ws + WS_BIG + T_MRG), (const bf16_t*)(ws + WS_WOUT), MH, D, D, D, D, nullptr}; S.init(MH, D, G, blockIdx.x);
          EpiRes E{(bf16_t*)(ws + WS_XB) + r0 * D, (float*)(ws + WS_SSQ) + 2 * MTOK + r0, 1.0f}; pg8::gemm_phase<EpiRes, false, true>(lds, g, S, E); }
        GSYNC(); PH_END(7) }
    }
    { PH_BEGIN(8) { KP P = get_params(); unsigned char* ws = P->ws;
      pg8::Gemm g{(const bf16_t*)(ws + WS_XB), (const bf16_t*)(ws + WS_WGU2), MTOK, NGU, D, D, D, (const float*)(ws + WS_SSQ) + 2 * MTOK}; S.init(MTOK, NGU, G, blockIdx.x);
      EpiGU E{(const float*)(ws + WS_SSQ) + 2 * MTOK, (bf16_t*)(ws + WS_BIG)}; pg8::gemm_phase(lds, g, S, E); }
    GSYNC(); PH_END(8) }
    { PH_BEGIN(9) { KP P = get_params(); unsigned char* ws = P->ws;
      pg8::Gemm g{(const bf16_t*)(ws + WS_BIG), (const bf16_t*)(ws + WS_WD2), MTOK, D, DFF, DFF, DFF, nullptr}; S.init(MTOK, D, G, blockIdx.x);
      EpiRes E{(bf16_t*)(ws + WS_XB), (float*)(ws + WS_SSQ) + 3 * MTOK, 0.5f}; pg8::gemm_phase<EpiRes, false, true>(lds, g, S, E); }
    GSYNC(); PH_END(9) }
    { PH_BEGIN(10)
    {
        KP P = get_params(); const float* ssq = (const float*)(P->ws + WS_SSQ) + 3 * MTOK;
        const int tid = tid_fresh(), lane = tid & 63, gw = blockIdx.x * 8 + (tid >> 6), NGW = G * 8;
        const float* fw = P->in[23]; float* outp = P->out; const bf16_t* xb = (const bf16_t*)(P->ws + WS_XB);
        f32x4 wv[4];
#pragma unroll
        for (int jj = 0; jj < 4; ++jj) wv[jj] = ((const f32x4*)fw)[lane + 64 * jj];
        for (int m = gw; m < MTOK; m += NGW) {
            const float rstd = rsqrtf(ssq[m] * (1.f / D) + EPS);
            const u32x2* xr = (const u32x2*)(xb + (size_t)m * D) + lane;
            f32x4* orow = (f32x4*)(outp + (size_t)m * D) + lane;
#pragma unroll
            for (int jj = 0; jj < 4; ++jj) { const u32x2 q = xr[64 * jj]; f32x4 v;
                v.x = bf_lo(q.x) * rstd * wv[jj].x; v.y = bf_hi(q.x) * rstd * wv[jj].y; v.z = bf_lo(q.y) * rstd * wv[jj].z; v.w = bf_hi(q.y) * rstd * wv[jj].w; orow[64 * jj] = v; }
        }
    }
    PH_END(10) }
#if PROBE_MASK
    if (blockIdx.x == 0) {
        const unsigned long long t0 = __builtin_amdgcn_s_memrealtime();
        while (__builtin_amdgcn_s_memrealtime() - t0 < probe_acc) __builtin_amdgcn_s_sleep(8);
    }
#endif
}

extern "C" void kernel_launch(void* const* d_in, const int* in_sizes, int n_in, void* d_out, int out_size, void* d_ws, size_t ws_size, hipStream_t stream) {
    static int grid = 0;
    if (grid == 0) {
        if (n_in != 24 || ws_size < WS_NEED) { fprintf(stderr, "kernel_launch: unexpected n_in %d or ws_size %zu (need %zu)\n", n_in, ws_size, (size_t)WS_NEED); grid = -1; return; }
        int dev = 0, cus = 0, per_cu = 0;
        hipGetDevice(&dev);
        hipDeviceGetAttribute(&cus, hipDeviceAttributeMultiprocessorCount, dev);
        hipFuncSetAttribute((const void*)fwd_megakernel, hipFuncAttributeMaxDynamicSharedMemorySize, LDS_BYTES);
        hipOccupancyMaxActiveBlocksPerMultiprocessor(&per_cu, (const void*)fwd_megakernel, 512, LDS_BYTES);
        if (per_cu < 1) { fprintf(stderr, "kernel_launch: occupancy query gave %d\n", per_cu); per_cu = 1; }
        grid = cus * per_cu;
        (void)hipGetLastError();
    }
    if (grid < 0) return;
    if (hipMemsetAsync((char*)d_ws + WS_BAR, 0, XCD_BAR_WORDS * sizeof(unsigned), stream) != hipSuccess) { fprintf(stderr, "kernel_launch: memset of the barrier words failed\n"); return; }
    Params p{};
    for (int i = 0; i < 24; ++i) p.in[i] = (const float*)d_in[i];
    p.out = (float*)d_out; p.ws = (unsigned char*)d_ws;
    void* args[] = {&p};
    hipError_t e = hipLaunchCooperativeKernel((const void*)fwd_megakernel, dim3(grid), dim3(512), args, LDS_BYTES, stream);
    if (e != hipSuccess) fprintf(stderr, "cooperative launch failed: %s (grid %d)\n", hipGetErrorString(e), grid);
}
```
